# Optimizing an MI355X kernel written in HIP

```python
import math
import jax, jax.numpy as jnp
from jax import lax
import numpy as np

D_MODEL = 1024
BATCH = 4
SEQ = 4096
DEPTH = 2

RET_HEADS = 8
RET_DK = 64
RET_DV = 128
RET_CHUNK = 128
DIFF_HEADS = 8
DIFF_DK = 64
DIFF_DV = 2 * DIFF_DK
Q_BLOCK = 128
EPS = 1e-6

RET_QK = RET_HEADS * RET_DK
RET_V = RET_HEADS * RET_DV
DIFF_QK = DIFF_HEADS * 2 * DIFF_DK
DIFF_V = DIFF_HEADS * DIFF_DV
IN_SPLITS = (RET_QK, RET_QK, RET_V, RET_V, DIFF_QK, DIFF_QK, DIFF_V, DIFF_V, D_MODEL, D_MODEL)
N_IN = 2 * RET_QK + 2 * RET_V + 2 * DIFF_QK + 2 * DIFF_V + 2 * D_MODEL

kernel_name = "hybrid_retention_diffattn_gated_block"


def rms_norm(x, g):
    xf = x.astype(jnp.float32)
    xf = xf * lax.rsqrt(jnp.mean(xf * xf, axis=-1, keepdims=True) + EPS)
    return xf * g.astype(jnp.float32)


def retention(q, k, v):
    B, S, H, dk = q.shape
    dv = v.shape[-1]
    C = RET_CHUNK
    n = S // C
    log_gamma = jnp.log1p(-jnp.exp2(-5.0 - jnp.arange(H, dtype=jnp.float32)))
    pos = jnp.arange(C, dtype=jnp.float32)
    rel = pos[:, None] - pos[None, :]
    inner_decay = jnp.where(rel >= 0, jnp.exp(jnp.maximum(rel, 0.0)[None] * log_gamma[:, None, None]), 0.0)
    q_decay = jnp.exp((pos + 1.0)[None] * log_gamma[:, None])
    k_decay = jnp.exp((C - 1.0 - pos)[None] * log_gamma[:, None])
    chunk_decay = jnp.exp(C * log_gamma)

    def to_chunks(t):
        return t.astype(jnp.float32).reshape(B, n, C, H, t.shape[-1]).transpose(1, 0, 3, 2, 4)

    qc = to_chunks(q)
    kc = to_chunks(k) * (dk ** -0.5)
    vc = to_chunks(v)

    def step(state, inp):
        qi, ki, vi = inp
        scores = jnp.einsum('bhnd,bhmd->bhnm', qi, ki) * inner_decay
        out = (jnp.einsum('bhnm,bhme->bhne', scores, vi)
               + jnp.einsum('bhnd,bhde->bhne', qi, state) * q_decay[..., None])
        state = (state * chunk_decay[:, None, None]
                 + jnp.einsum('bhmd,bhme->bhde', ki * k_decay[..., None], vi))
        return state, out

    state0 = jnp.zeros((B, H, dk, dv), jnp.float32)
    _, out = lax.scan(step, state0, (qc, kc, vc))
    return out.transpose(1, 0, 3, 2, 4).reshape(B, S, H, dv)


def diff_attention(q, k, v, lam):
    B, S, H, _, dk = q.shape
    slopes = jnp.exp2(-8.0 * jnp.arange(1, H + 1, dtype=jnp.float32) / H)
    q = q.astype(jnp.float32) * (dk ** -0.5)
    k = k.astype(jnp.float32)
    v = v.astype(jnp.float32)
    outs = []
    for i in range(S // Q_BLOCK):
        start, end = i * Q_BLOCK, (i + 1) * Q_BLOCK
        qb = q[:, start:end]
        kb = k[:, :end]
        vb = v[:, :end]
        dist = (jnp.arange(start, end)[:, None] - jnp.arange(end)[None, :]).astype(jnp.float32)
        s = jnp.einsum('bqhjd,bkhjd->bhjqk', qb, kb) - slopes[None, :, None, None, None] * dist
        s = jnp.where(dist >= 0, s, -jnp.inf)
        p = jax.nn.softmax(s, axis=-1)
        a = p[:, :, 0] - lam * p[:, :, 1]
        outs.append(jnp.einsum('bhqk,bkhe->bqhe', a, vb))
    return jnp.concatenate(outs, axis=1)


def setup_inputs(seed: int = 0) -> dict:
    key = jax.random.key(seed)
    ks = jax.random.split(key, 15)
    f32 = jnp.float32
    n = lambda k, s: jax.random.normal(k, s, f32)
    return {
        "x": n(ks[0], (BATCH, SEQ, D_MODEL)),
        "norm_g": 1.0 + 0.02 * n(ks[1], (DEPTH, D_MODEL)),
        "w_in": n(ks[2], (DEPTH, D_MODEL, N_IN)) * D_MODEL ** -0.5,
        "ret_norm_g": 1.0 + 0.02 * n(ks[3], (DEPTH, RET_V)),
        "ret_w_o": n(ks[4], (DEPTH, RET_V, D_MODEL)) * RET_V ** -0.5,
        "diff_q_norm_g": 1.0 + 0.02 * n(ks[5], (DEPTH, DIFF_DK)),
        "diff_k_norm_g": 1.0 + 0.02 * n(ks[6], (DEPTH, DIFF_DK)),
        "diff_lq1": 0.1 * n(ks[7], (DEPTH, DIFF_DK)),
        "diff_lk1": 0.1 * n(ks[8], (DEPTH, DIFF_DK)),
        "diff_lq2": 0.1 * n(ks[9], (DEPTH, DIFF_DK)),
        "diff_lk2": 0.1 * n(ks[10], (DEPTH, DIFF_DK)),
        "diff_sub_norm_g": 1.0 + 0.02 * n(ks[11], (DEPTH, DIFF_V)),
        "diff_w_o": n(ks[12], (DEPTH, DIFF_V, D_MODEL)) * DIFF_V ** -0.5,
        "w_out": n(ks[13], (DEPTH, D_MODEL, D_MODEL)) * D_MODEL ** -0.5,
    }


def reference(x, norm_g, w_in, ret_norm_g, ret_w_o, diff_q_norm_g, diff_k_norm_g,
              diff_lq1, diff_lk1, diff_lq2, diff_lk2, diff_sub_norm_g, diff_w_o, w_out):
    B, S, _ = x.shape
    split_idx = [int(v) for v in np.cumsum(IN_SPLITS)[:-1]]
    for l in range(DEPTH):
        h = rms_norm(x, norm_g[l]).astype(x.dtype)
        z = jnp.einsum('bsd,dn->bsn', h, w_in[l])
        (q_r, k_r, v_r, gate_r, q_d, k_d, v_d, gate_d,
         mg_r, mg_d) = jnp.split(z, split_idx, axis=-1)

        o_r = retention(q_r.reshape(B, S, RET_HEADS, RET_DK),
                        k_r.reshape(B, S, RET_HEADS, RET_DK),
                        v_r.reshape(B, S, RET_HEADS, RET_DV))
        o_r = rms_norm(o_r, ret_norm_g[l].reshape(RET_HEADS, RET_DV)).reshape(B, S, RET_V)
        o_r = (o_r * jax.nn.silu(gate_r.astype(jnp.float32))).astype(x.dtype)
        y_r = jnp.einsum('bse,ed->bsd', o_r, ret_w_o[l])

        lam_init = 0.8 - 0.6 * math.exp(-0.3 * l)
        lam = (jnp.exp(jnp.sum(diff_lq1[l].astype(jnp.float32) * diff_lk1[l].astype(jnp.float32)))
               - jnp.exp(jnp.sum(diff_lq2[l].astype(jnp.float32) * diff_lk2[l].astype(jnp.float32)))
               + lam_init)
        qd = rms_norm(q_d.reshape(B, S, DIFF_HEADS, 2, DIFF_DK), diff_q_norm_g[l])
        kd = rms_norm(k_d.reshape(B, S, DIFF_HEADS, 2, DIFF_DK), diff_k_norm_g[l])
        o_d = diff_attention(qd, kd, v_d.reshape(B, S, DIFF_HEADS, DIFF_DV), lam)
        o_d = rms_norm(o_d, diff_sub_norm_g[l].reshape(DIFF_HEADS, DIFF_DV)) * (1.0 - lam_init)
        o_d = (o_d.reshape(B, S, DIFF_V) * jax.nn.silu(gate_d.astype(jnp.float32))).astype(x.dtype)
        y_d = jnp.einsum('bse,ed->bsd', o_d, diff_w_o[l])

        m = jax.nn.sigmoid(mg_r) * y_r + jax.nn.sigmoid(mg_d) * y_d
        x = (x + jnp.einsum('bsd,de->bse', m, w_out[l])).astype(x.dtype)
    return x
```

```cpp
#include <hip/hip_runtime.h>
#include <cstdint>
#include <cstddef>

typedef unsigned short bf16;
__device__ __forceinline__ float bf2f(bf16 v) { return __uint_as_float(((unsigned)v) << 16); }
__device__ __forceinline__ bf16 f2bf(float f) { unsigned u = __float_as_uint(f); return (bf16)((u + 0x7fffu + ((u >> 16) & 1u)) >> 16); }
__device__ __forceinline__ float rbf(float f) { return bf2f(f2bf(f)); }

constexpr int DM = 1024, BATCH = 4, SEQ = 4096, DEPTH = 2, T = BATCH * SEQ, NIN = 9216;
constexpr float EPS = 1e-6f;
constexpr size_t MiB = 1u << 20;
constexpr size_t WS_H = 25 * MiB, WS_QR = 57 * MiB, WS_KR = 73 * MiB, WS_VR = 89 * MiB, WS_SGR = 121 * MiB, WS_QD = 153 * MiB, WS_KD = 185 * MiB,
                 WS_VD = 217 * MiB, WS_SGD = 249 * MiB, WS_END = 281 * MiB;
constexpr size_t WS_MBUF = 57 * MiB;
constexpr size_t WS_MBF = WS_VD;
constexpr size_t WS_SMGR = WS_QD, WS_SMGD = WS_KD;

__global__ void k_rms(const float* __restrict__ x, const float* __restrict__ g, bf16* __restrict__ h) {
    const int row = blockIdx.x * 4 + (threadIdx.x >> 6), lane = threadIdx.x & 63;
    const float* xr = x + (size_t)row * DM;
    float v[16]; float s = 0.f;
#pragma unroll
    for (int j = 0; j < 4; ++j) { const float4 t = *(const float4*)(xr + j * 256 + lane * 4); v[4 * j] = t.x; v[4 * j + 1] = t.y; v[4 * j + 2] = t.z; v[4 * j + 3] = t.w; s += t.x * t.x + t.y * t.y + t.z * t.z + t.w * t.w; }
#pragma unroll
    for (int o = 1; o < 64; o <<= 1) s += __shfl_xor(s, o);
    const float rs = 1.0f / sqrtf(s * (1.0f / DM) + EPS);
#pragma unroll
    for (int j = 0; j < 4; ++j)
#pragma unroll
        for (int i = 0; i < 4; ++i) { const int c = j * 256 + lane * 4 + i; h[(size_t)row * DM + c] = f2bf(v[4 * j + i] * rs * g[c]); }
}

struct EpiIn {
    bf16 *qr, *kr, *vr, *sgr, *qd, *kd, *vd, *sgd, *smgr, *smgd;
    __device__ __forceinline__ void operator()(int t, int c, float v) const {
        if (c < 512) qr[(size_t)t * 512 + c] = f2bf(v);
        else if (c < 1024) kr[(size_t)t * 512 + (c - 512)] = f2bf(v * 0.125f);
        else if (c < 2048) vr[(size_t)t * 1024 + (c - 1024)] = f2bf(v);
        else if (c < 3072) sgr[(size_t)t * 1024 + (c - 2048)] = f2bf(v / (1.0f + __expf(-v)));
        else if (c < 4096) qd[(size_t)t * 1024 + (c - 3072)] = f2bf(v);
        else if (c < 5120) kd[(size_t)t * 1024 + (c - 4096)] = f2bf(v);
        else if (c < 6144) vd[(size_t)t * 1024 + (c - 5120)] = f2bf(v);
        else if (c < 7168) sgd[(size_t)t * 1024 + (c - 6144)] = f2bf(v / (1.0f + __expf(-v)));
        else if (c < 8192) smgr[(size_t)t * 1024 + (c - 7168)] = f2bf(1.0f / (1.0f + __expf(-v)));
        else smgd[(size_t)t * 1024 + (c - 8192)] = f2bf(1.0f / (1.0f + __expf(-v)));
    }
};
struct EpiYr { const bf16* smg; float* mbuf; __device__ __forceinline__ void operator()(int t, int c, float v) const { mbuf[(size_t)t * 1024 + c] = bf2f(smg[(size_t)t * 1024 + c]) * v; } };
struct EpiYd { const bf16* smg; const float* mbuf; bf16* m; __device__ __forceinline__ void operator()(int t, int c, float v) const { m[(size_t)t * 1024 + c] = f2bf(mbuf[(size_t)t * 1024 + c] + bf2f(smg[(size_t)t * 1024 + c]) * v); } };
struct EpiOut { const float* xin; float* xout; __device__ __forceinline__ void operator()(int t, int c, float v) const { xout[(size_t)t * 1024 + c] = xin[(size_t)t * 1024 + c] + v; } };

template <class Epi>
__global__ void __launch_bounds__(256) k_gemm_naive(const bf16* __restrict__ A, int K, const float* __restrict__ W, int ldw, int n0, Epi E) {
    __shared__ float As[16][68];
    __shared__ float Bs[16][68];
    const int tid = threadIdx.x, tx = tid & 15, ty = tid >> 4;
    const int m0 = blockIdx.y * 64, nb = n0 + blockIdx.x * 64;
    float acc[4][4] = {};
    for (int k0 = 0; k0 < K; k0 += 16) {
        { const int r = tid >> 2, kk = (tid & 3) * 4; const bf16* ap = A + (size_t)(m0 + r) * K + k0 + kk;
#pragma unroll
          for (int i = 0; i < 4; ++i) As[kk + i][r] = bf2f(ap[i]); }
        { const int kk = tid >> 4, c = (tid & 15) * 4; const float4 w = *(const float4*)(W + (size_t)(k0 + kk) * ldw + nb + c);
          Bs[kk][c] = rbf(w.x); Bs[kk][c + 1] = rbf(w.y); Bs[kk][c + 2] = rbf(w.z); Bs[kk][c + 3] = rbf(w.w); }
        __syncthreads();
#pragma unroll
        for (int kk = 0; kk < 16; ++kk) {
            float a[4], b[4];
#pragma unroll
            for (int i = 0; i < 4; ++i) { a[i] = As[kk][ty * 4 + i]; b[i] = Bs[kk][tx * 4 + i]; }
#pragma unroll
            for (int i = 0; i < 4; ++i)
#pragma unroll
                for (int j = 0; j < 4; ++j) acc[i][j] += a[i] * b[j];
        }
        __syncthreads();
    }
#pragma unroll
    for (int i = 0; i < 4; ++i)
#pragma unroll
        for (int j = 0; j < 4; ++j) E(m0 + ty * 4 + i, nb + tx * 4 + j, acc[i][j]);
}

__global__ void k_qknorm(bf16* __restrict__ q, const float* __restrict__ g, float scale) {
    const int row = blockIdx.x * 4 + (threadIdx.x >> 6), lane = threadIdx.x & 63;
    bf16* p = q + (size_t)row * 1024 + lane * 16;
    float v[16]; float s = 0.f;
#pragma unroll
    for (int i = 0; i < 16; ++i) { v[i] = bf2f(p[i]); s += v[i] * v[i]; }
    s += __shfl_xor(s, 1); s += __shfl_xor(s, 2);
    const float rs = 1.0f / sqrtf(s * (1.0f / 64.0f) + EPS);
    const int d0 = (lane & 3) * 16;
#pragma unroll
    for (int i = 0; i < 16; ++i) p[i] = f2bf(v[i] * rs * g[d0 + i] * scale);
}

__global__ void __launch_bounds__(128) k_ret_naive(const bf16* __restrict__ QR, const bf16* __restrict__ KR, const bf16* __restrict__ VR, bf16* SGR, const float* __restrict__ gn) {
    __shared__ float qs[16][64];
    __shared__ float ks[32][65];
    __shared__ float vs[32][128];
    __shared__ float ps[16][32];
    __shared__ float rsv[16];
    const int tid = threadIdx.x, qb = blockIdx.x & 255, bh = blockIdx.x >> 8, h = bh & 7, b = bh >> 3;
    const int n0 = qb * 16; const size_t tb = (size_t)b * SEQ;
    const float lg2 = log2f(1.0f - exp2f(-5.0f - (float)h));
    for (int i = tid; i < 16 * 64; i += 128) qs[i >> 6][i & 63] = bf2f(QR[(tb + n0 + (i >> 6)) * 512 + h * 64 + (i & 63)]);
    float acc[16];
#pragma unroll
    for (int r = 0; r < 16; ++r) acc[r] = 0.f;
    for (int k0 = 0; k0 < n0 + 16; k0 += 32) {
        __syncthreads();
        for (int i = tid; i < 32 * 64; i += 128) ks[i >> 6][i & 63] = bf2f(KR[(tb + k0 + (i >> 6)) * 512 + h * 64 + (i & 63)]);
        for (int i = tid; i < 32 * 128; i += 128) vs[i >> 7][i & 127] = bf2f(VR[(tb + k0 + (i >> 7)) * 1024 + h * 128 + (i & 127)]);
        __syncthreads();
        for (int i = tid; i < 16 * 32; i += 128) { const int r = i >> 5, kk = i & 31; float d = 0.f;
            for (int c = 0; c < 64; ++c) d += qs[r][c] * ks[kk][c];
            const int dist = (n0 + r) - (k0 + kk);
            ps[r][kk] = dist >= 0 ? d * exp2f((float)dist * lg2) : 0.f; }
        __syncthreads();
#pragma unroll
        for (int r = 0; r < 16; ++r) { float a = acc[r];
            for (int kk = 0; kk < 32; ++kk) a += ps[r][kk] * vs[kk][tid];
            acc[r] = a; }
    }
    __syncthreads();
    for (int r = 0; r < 16; ++r) vs[r][tid] = acc[r];
    __syncthreads();
    if (tid < 16) { float s = 0.f; for (int e = 0; e < 128; ++e) s += vs[tid][e] * vs[tid][e]; rsv[tid] = 1.0f / sqrtf(s * (1.0f / 128.0f) + EPS); }
    __syncthreads();
    for (int r = 0; r < 16; ++r) { const size_t o = (tb + n0 + r) * 1024 + h * 128 + tid; SGR[o] = f2bf(acc[r] * rsv[r] * gn[h * 128 + tid] * bf2f(SGR[o])); }
}

__global__ void __launch_bounds__(128) k_attn_naive(const bf16* __restrict__ QD, const bf16* __restrict__ KD, const bf16* __restrict__ VD, bf16* SGD, const float* __restrict__ lq1, const float* __restrict__ lk1,
                                                    const float* __restrict__ lq2, const float* __restrict__ lk2, const float* __restrict__ gn, float lam_init) {
    __shared__ float qs[2][16][64];
    __shared__ float ks[2][32][65];
    __shared__ float vs[32][128];
    __shared__ float ps[2][16][32];
    __shared__ float mrow[2][16], lrow[2][16], arow[2][16], rsv[16];
    const int tid = threadIdx.x, qb = blockIdx.x & 255, bh = blockIdx.x >> 8, h = bh & 7, b = bh >> 3;
    const int n0 = qb * 16; const size_t tb = (size_t)b * SEQ;
    float s1 = 0.f, s2 = 0.f;
    for (int i = 0; i < 64; ++i) { s1 += lq1[i] * lk1[i]; s2 += lq2[i] * lk2[i]; }
    const float lam = expf(s1) - expf(s2) + lam_init;
    const float slope = exp2f(-(float)(h + 1));
    for (int i = tid; i < 2 * 16 * 64; i += 128) { const int j = i >> 10, r = (i >> 6) & 15, d = i & 63; qs[j][r][d] = bf2f(QD[(tb + n0 + r) * 1024 + h * 128 + j * 64 + d]); }
    if (tid < 32) { mrow[tid >> 4][tid & 15] = -INFINITY; lrow[tid >> 4][tid & 15] = 0.f; }
    float acc[2][16];
#pragma unroll
    for (int j = 0; j < 2; ++j)
#pragma unroll
        for (int r = 0; r < 16; ++r) acc[j][r] = 0.f;
    for (int k0 = 0; k0 < n0 + 16; k0 += 32) {
        __syncthreads();
        for (int i = tid; i < 2 * 32 * 64; i += 128) { const int j = i >> 11, kk = (i >> 6) & 31, d = i & 63; ks[j][kk][d] = bf2f(KD[(tb + k0 + kk) * 1024 + h * 128 + j * 64 + d]); }
        for (int i = tid; i < 32 * 128; i += 128) vs[i >> 7][i & 127] = bf2f(VD[(tb + k0 + (i >> 7)) * 1024 + h * 128 + (i & 127)]);
        __syncthreads();
        for (int i = tid; i < 2 * 16 * 32; i += 128) { const int j = i >> 9, r = (i >> 5) & 15, kk = i & 31; float d = 0.f;
            for (int c = 0; c < 64; ++c) d += qs[j][r][c] * ks[j][kk][c];
            const int dist = (n0 + r) - (k0 + kk);
            ps[j][r][kk] = dist >= 0 ? d - slope * (float)dist : -INFINITY; }
        __syncthreads();
        if (tid < 32) { const int j = tid >> 4, r = tid & 15; float mx = mrow[j][r];
            for (int kk = 0; kk < 32; ++kk) mx = fmaxf(mx, ps[j][r][kk]);
            const float al = expf(mrow[j][r] - mx); float sum = 0.f;
            for (int kk = 0; kk < 32; ++kk) { const float p = expf(ps[j][r][kk] - mx); ps[j][r][kk] = p; sum += p; }
            lrow[j][r] = lrow[j][r] * al + sum; arow[j][r] = al; mrow[j][r] = mx; }
        __syncthreads();
#pragma unroll
        for (int j = 0; j < 2; ++j)
#pragma unroll
            for (int r = 0; r < 16; ++r) { float a = acc[j][r] * arow[j][r];
                for (int kk = 0; kk < 32; ++kk) a += ps[j][r][kk] * vs[kk][tid];
                acc[j][r] = a; }
    }
    __syncthreads();
    float o[16];
#pragma unroll
    for (int r = 0; r < 16; ++r) { o[r] = acc[0][r] / lrow[0][r] - lam * acc[1][r] / lrow[1][r]; vs[r][tid] = o[r]; }
    __syncthreads();
    if (tid < 16) { float s = 0.f; for (int e = 0; e < 128; ++e) s += vs[tid][e] * vs[tid][e]; rsv[tid] = 1.0f / sqrtf(s * (1.0f / 128.0f) + EPS); }
    __syncthreads();
    for (int r = 0; r < 16; ++r) { const size_t oo = (tb + n0 + r) * 1024 + h * 128 + tid; SGD[oo] = f2bf(o[r] * rsv[r] * gn[h * 128 + tid] * (1.0f - lam_init) * bf2f(SGD[oo])); }
}

extern "C" void kernel_launch(void* const* d_in, const int* in_sizes, int n_in, void* d_out, int out_size, void* d_ws, size_t ws_size, hipStream_t stream) {
    if (n_in != 14 || ws_size < WS_END || out_size != T * DM) return;
    const float* x = (const float*)d_in[0]; const float* norm_g = (const float*)d_in[1]; const float* w_in = (const float*)d_in[2];
    const float* ret_norm_g = (const float*)d_in[3]; const float* ret_w_o = (const float*)d_in[4]; const float* dq_g = (const float*)d_in[5]; const float* dk_g = (const float*)d_in[6];
    const float* lq1 = (const float*)d_in[7]; const float* lk1 = (const float*)d_in[8]; const float* lq2 = (const float*)d_in[9]; const float* lk2 = (const float*)d_in[10];
    const float* sub_g = (const float*)d_in[11]; const float* diff_w_o = (const float*)d_in[12]; const float* w_out = (const float*)d_in[13];
    char* ws = (char*)d_ws; float* out = (float*)d_out;
    bf16* H = (bf16*)(ws + WS_H); bf16* QR = (bf16*)(ws + WS_QR); bf16* KR = (bf16*)(ws + WS_KR); bf16* VR = (bf16*)(ws + WS_VR); bf16* SGR = (bf16*)(ws + WS_SGR);
    bf16* QD = (bf16*)(ws + WS_QD); bf16* KD = (bf16*)(ws + WS_KD); bf16* VD = (bf16*)(ws + WS_VD); bf16* SGD = (bf16*)(ws + WS_SGD);
    float* MBUF = (float*)(ws + WS_MBUF); bf16* MBF = (bf16*)(ws + WS_MBF); bf16* SMGR = (bf16*)(ws + WS_SMGR); bf16* SMGD = (bf16*)(ws + WS_SMGD);
    for (int l = 0; l < DEPTH; ++l) {
        const float* xin = l == 0 ? x : out;
        const float lam_init = 0.8f - 0.6f * expf(-0.3f * (float)l);
        k_rms<<<T / 4, 256, 0, stream>>>(xin, norm_g + l * DM, H);
        EpiIn e1{QR, KR, VR, SGR, QD, KD, VD, SGD, SMGR, SMGD};
        k_gemm_naive<EpiIn><<<dim3(7168 / 64, T / 64), 256, 0, stream>>>(H, DM, w_in + (size_t)l * DM * NIN, NIN, 0, e1);
        k_qknorm<<<T / 4, 256, 0, stream>>>(QD, dq_g + l * 64, 0.125f);
        k_qknorm<<<T / 4, 256, 0, stream>>>(KD, dk_g + l * 64, 1.0f);
        k_ret_naive<<<BATCH * 8 * 256, 128, 0, stream>>>(QR, KR, VR, SGR, ret_norm_g + l * 1024);
        k_attn_naive<<<BATCH * 8 * 256, 128, 0, stream>>>(QD, KD, VD, SGD, lq1 + l * 64, lk1 + l * 64, lq2 + l * 64, lk2 + l * 64, sub_g + l * 1024, lam_init);
        k_gemm_naive<EpiIn><<<dim3(2048 / 64, T / 64), 256, 0, stream>>>(H, DM, w_in + (size_t)l * DM * NIN, NIN, 7168, e1);
        EpiYr e2{SMGR, MBUF};
        k_gemm_naive<EpiYr><<<dim3(1024 / 64, T / 64), 256, 0, stream>>>(SGR, DM, ret_w_o + (size_t)l * DM * DM, DM, 0, e2);
        EpiYd e3{SMGD, MBUF, MBF};
        k_gemm_naive<EpiYd><<<dim3(1024 / 64, T / 64), 256, 0, stream>>>(SGD, DM, diff_w_o + (size_t)l * DM * DM, DM, 0, e3);
        EpiOut e4{xin, out};
        k_gemm_naive<EpiOut><<<dim3(1024 / 64, T / 64), 256, 0, stream>>>(MBF, DM, w_out + (size_t)l * DM * DM, DM, 0, e4);
    }
}
```

```cpp
#include <hip/hip_runtime.h>
#include <cstdio>
#include <cstdint>
#include <cstddef>

constexpr int DM = 1024, BATCH = 4, SEQ = 4096, DEPTH = 2, T = BATCH * SEQ, NIN = 9216;
constexpr float EPS = 1e-6f;
constexpr float LOG2E = 1.4426950408889634f;

typedef unsigned short bf16;
typedef short bf16x8 __attribute__((ext_vector_type(8)));
typedef float f32x4 __attribute__((ext_vector_type(4)));
typedef unsigned u32x4 __attribute__((ext_vector_type(4)));
#define LAS __attribute__((address_space(3)))
#define GAS __attribute__((address_space(1)))

__device__ __forceinline__ float bf2f(bf16 v) { return __uint_as_float(((unsigned)v) << 16); }
__device__ __forceinline__ unsigned f2bf_u(float f) { unsigned u = __float_as_uint(f); return (u + 0x7fffu + ((u >> 16) & 1u)) >> 16; }
__device__ __forceinline__ bf16 f2bf(float f) { return (bf16)f2bf_u(f); }
__device__ __forceinline__ unsigned pk2(float lo, float hi) { return f2bf_u(lo) | (f2bf_u(hi) << 16); }
typedef float f32x2_t __attribute__((ext_vector_type(2))); typedef __bf16 bf16x2_t __attribute__((ext_vector_type(2)));
__device__ __forceinline__ unsigned cvt_pk_bf16(float lo, float hi) { f32x2_t v = {lo, hi}; bf16x2_t b = __builtin_convertvector(v, bf16x2_t); return __builtin_bit_cast(unsigned, b); }
__device__ __forceinline__ float fast_sigmoid(float v) { return __builtin_amdgcn_rcpf(1.0f + __builtin_amdgcn_exp2f(-v * LOG2E)); }
__device__ __forceinline__ float lo_bf(unsigned w) { return __uint_as_float(w << 16); }
__device__ __forceinline__ float hi_bf(unsigned w) { return __uint_as_float(w & 0xffff0000u); }

constexpr size_t MiB = 1u << 20;
constexpr size_t WS_CTL = 0, CTL_ZERO_BYTES = 1 * MiB;
constexpr size_t WS_WIN = 1 * MiB, WS_WRO = 19 * MiB, WS_WDO = 21 * MiB, WS_WOUT = 23 * MiB;
constexpr size_t WS_H = 25 * MiB, WS_QR = 57 * MiB, WS_KR = 73 * MiB, WS_VR = 89 * MiB, WS_SGR = 121 * MiB, WS_QD = 153 * MiB, WS_KD = 185 * MiB,
                 WS_VD = 217 * MiB, WS_SGD = 249 * MiB;
constexpr size_t WS_W1 = 281 * MiB;
constexpr size_t WS_END = 287 * MiB;
constexpr size_t WS_MBUF = 57 * MiB;
constexpr size_t WS_MBF = WS_VD;
constexpr size_t WS_SMGR = WS_QD, WS_SMGD = WS_KD;
constexpr int CW_BAR = 4096;

namespace pg8 {
constexpr int BM = 256, BK = 64, HALF = 128, HTB = HALF * BK * 2, STAGE_BYTES = 8 * HTB, NXCD = 8, WGM = 8;
__host__ __device__ __forceinline__ int lds_byte(int r, int c) { const int st = (r >> 4) * 2 + (c >> 5), rr = r & 15, cc = c & 31, ob = rr * 64 + cc * 2; return st * 1024 + (ob ^ (((ob >> 9) & 1) << 5)); }
__host__ __device__ __forceinline__ void stage_rc(int b, int& R, int& C) { const int st = b / 1024, sb = b % 1024, swz = sb ^ (((sb >> 9) & 1) << 5); R = (st >> 1) * 16 + swz / 64; C = (st & 1) * 32 + (swz % 64) / 2; }
__host__ __device__ __forceinline__ int perm32(int rho) { const int n = rho >> 4, i = rho & 15; return 8 * (i >> 2) + 4 * n + (i & 3); }

struct Unit { int pm, pn, kind; const char* a; const char* b; };

__device__ __forceinline__ void tile_of(int L, int nM, int nN, int& pm, int& pn) {
    const int nwg = nM * nN; int wgid = L;
    { const int q = nwg / NXCD, r = nwg % NXCD, xcd = wgid % NXCD, off = wgid / NXCD; wgid = (xcd < r ? xcd * (q + 1) : r * (q + 1) + (xcd - r) * q) + off; }
    const int nig = WGM * nN, gid = wgid / nig, fm = gid * WGM, gsz = (nM - fm) < WGM ? (nM - fm) : WGM;
    pm = fm + ((wgid % nig) % gsz); pn = (wgid % nig) / gsz;
}

template <class Epi, class Sched, bool ALIGN_EPI, bool SP2>
__device__ __forceinline__ void gemm_phase(LAS unsigned char* lds, const int K, const Sched& S, const Epi& E) {
    int tid_ = threadIdx.x; asm volatile("" : "+v"(tid_));
    const int tid = tid_, wid = __builtin_amdgcn_readfirstlane(tid >> 6), lane = tid & 63, wr = wid >> 2, wc = wid & 3, fr = lane & 15, fq = lane >> 4;
    const int nt = K / BK;
    unsigned voffA[2], voffB[2];
#pragma unroll
    for (int i = 0; i < 2; ++i) { int R, C; stage_rc(tid * 16 + i * 8192, R, C); const int Rb = (R >> 5) * 64 + perm32(R & 31);
        voffA[i] = (unsigned)(R * K + C) * 2u; voffB[i] = (unsigned)(Rb * K + C) * 2u; }
    const size_t kstep = (size_t)(BK * 2);
    const size_t hstep = (size_t)HALF * K * 2;
    const size_t hstepB = (size_t)32 * K * 2;
    const unsigned ldsw = (unsigned)wid * 1024u;
    const int aoff = lds_byte(wr * 64 + fr, fq * 8), boff = lds_byte(wc * 32 + fr, fq * 8);
#define PG8_SA(b, h) (((b) * 2 + (h)) * HTB)
#define PG8_SB(b, h) ((4 + (b) * 2 + (h)) * HTB)
#define PG8_STAGE(bufoff, gbase, voff) do { _Pragma("unroll") for (int _i = 0; _i < 2; ++_i) \
        __builtin_amdgcn_global_load_lds((const unsigned*)((const char*)(gbase) + (voff)[_i]), (LAS unsigned*)(lds + (bufoff) + ldsw + _i * 8192), 16, 0, 0); } while (0)
#define PG8_LDA(dst, b, h) do { _Pragma("unroll") for (int m = 0; m < 4; ++m) _Pragma("unroll") for (int k = 0; k < 2; ++k) dst[m][k] = *(const LAS bf16x8*)(lds + PG8_SA(b, h) + aoff + m * 2048 + k * 1024); } while (0)
#define PG8_LDB(dst, b, h) do { _Pragma("unroll") for (int n = 0; n < 2; ++n) _Pragma("unroll") for (int k = 0; k < 2; ++k) dst[n][k] = *(const LAS bf16x8*)(lds + PG8_SB(b, h) + boff + n * 2048 + k * 1024); } while (0)
#define PG8_MMA(ai, bj, At, Bt) do { __builtin_amdgcn_s_setprio(1); _Pragma("unroll") for (int m = 0; m < 4; ++m) _Pragma("unroll") for (int n = 0; n < 2; ++n) _Pragma("unroll") for (int k = 0; k < 2; ++k) \
        acc[ai][bj][m][n] = __builtin_amdgcn_mfma_f32_16x16x32_bf16(Bt[n][k], At[m][k], acc[ai][bj][m][n], 0, 0, 0); __builtin_amdgcn_s_setprio(0); } while (0)
#define PG8_WAIT_V(n) asm volatile("s_waitcnt vmcnt(" #n ")" ::: "memory")
#define PG8_WAIT_L(n) asm volatile("s_waitcnt lgkmcnt(" #n ")" ::: "memory")
#define PG8_BAR __builtin_amdgcn_s_barrier()
#define PG8_SCHED __builtin_amdgcn_sched_barrier(0)
    Unit cur, nxt; int ui = 0;
    if (!S.next(0, cur)) return;
    f32x4 acc[2][2][4][2];
#pragma unroll
    for (int a = 0; a < 2; ++a)
#pragma unroll
        for (int b = 0; b < 2; ++b)
#pragma unroll
            for (int m = 0; m < 4; ++m)
#pragma unroll
                for (int n = 0; n < 2; ++n) acc[a][b][m][n] = (f32x4){0.f, 0.f, 0.f, 0.f};
    bf16x8 At[4][2], B0[2][2], B1[2][2];
    const char* cA = cur.a; const char* cB = cur.b;
    if constexpr (SP2) {
        PG8_STAGE(PG8_SB(0, 0), cB, voffB); PG8_STAGE(PG8_SB(0, 1), cB + hstepB, voffB); PG8_STAGE(PG8_SA(0, 0), cA, voffA); PG8_STAGE(PG8_SA(0, 1), cA + hstep, voffA);
        if (wr == 1) PG8_BAR;
        PG8_WAIT_V(2); PG8_BAR;
        PG8_STAGE(PG8_SB(1, 0), cB + kstep, voffB); PG8_STAGE(PG8_SA(1, 0), cA + kstep, voffA); PG8_STAGE(PG8_SB(1, 1), cB + hstepB + kstep, voffB);
        PG8_WAIT_V(6); PG8_BAR;
    } else {
        PG8_STAGE(PG8_SB(0, 0), cB, voffB); PG8_STAGE(PG8_SA(0, 0), cA, voffA); PG8_STAGE(PG8_SB(0, 1), cB + hstepB, voffB); PG8_STAGE(PG8_SA(0, 1), cA + hstep, voffA);
        if (wr == 1) PG8_BAR;
        PG8_WAIT_V(4); PG8_BAR;
        PG8_STAGE(PG8_SB(1, 0), cB + kstep, voffB); PG8_STAGE(PG8_SA(1, 0), cA + kstep, voffA); PG8_STAGE(PG8_SB(1, 1), cB + hstepB + kstep, voffB);
        PG8_WAIT_V(6); PG8_BAR;
    }
    for (;;) {
        const bool has_next = S.next(ui + 1, nxt);
        const char* nA = has_next ? nxt.a : cA; const char* nB = has_next ? nxt.b : cB;
        for (int t = 0; t < nt; t += 2) {
            const bool last = (t == nt - 2);
            const char* a1 = cA + (size_t)(t + 1) * kstep;
            const char* a2 = last ? nA : cA + (size_t)(t + 2) * kstep; const char* b2 = last ? nB : cB + (size_t)(t + 2) * kstep;
            const char* a3 = a2 + kstep; const char* b3 = b2 + kstep;
            if constexpr (SP2) {
            PG8_LDB(B0, 0, 0); PG8_LDB(B1, 0, 1); PG8_SCHED; PG8_LDA(At, 0, 0); PG8_STAGE(PG8_SA(1, 1), a1 + hstep, voffA);
            PG8_WAIT_V(8); PG8_WAIT_L(0); PG8_BAR; PG8_MMA(0, 0, At, B0); PG8_MMA(0, 1, At, B1); PG8_BAR; PG8_SCHED;
            PG8_LDA(At, 0, 1); PG8_STAGE(PG8_SB(0, 0), b2, voffB); PG8_STAGE(PG8_SB(0, 1), b2 + hstepB, voffB); PG8_STAGE(PG8_SA(0, 0), a2, voffA);
            PG8_WAIT_V(8); PG8_WAIT_L(0); PG8_BAR; PG8_MMA(1, 0, At, B0); PG8_MMA(1, 1, At, B1); PG8_BAR; PG8_SCHED;
            PG8_LDB(B0, 1, 0); PG8_LDB(B1, 1, 1); PG8_SCHED; PG8_LDA(At, 1, 0); PG8_STAGE(PG8_SA(0, 1), a2 + hstep, voffA);
            PG8_WAIT_V(8); PG8_WAIT_L(0); PG8_BAR; PG8_MMA(0, 0, At, B0); PG8_MMA(0, 1, At, B1); PG8_BAR; PG8_SCHED;
            PG8_LDA(At, 1, 1); PG8_STAGE(PG8_SB(1, 0), b3, voffB); PG8_STAGE(PG8_SB(1, 1), b3 + hstepB, voffB); PG8_STAGE(PG8_SA(1, 0), a3, voffA);
            PG8_WAIT_V(8); PG8_WAIT_L(0); PG8_BAR; PG8_MMA(1, 0, At, B0); PG8_MMA(1, 1, At, B1); PG8_BAR; PG8_SCHED;
            } else {
            PG8_LDB(B0, 0, 0); PG8_SCHED; PG8_LDA(At, 0, 0); PG8_STAGE(PG8_SA(1, 1), a1 + hstep, voffA);
            PG8_WAIT_L(8); PG8_BAR; PG8_WAIT_L(0); PG8_MMA(0, 0, At, B0); PG8_BAR; PG8_SCHED;
            PG8_LDB(B1, 0, 1); PG8_STAGE(PG8_SB(0, 0), b2, voffB);
            PG8_BAR; PG8_WAIT_L(0); PG8_MMA(0, 1, At, B1); PG8_BAR;
            PG8_LDA(At, 0, 1); PG8_STAGE(PG8_SA(0, 0), a2, voffA);
            PG8_BAR; PG8_WAIT_L(0); PG8_MMA(1, 0, At, B0); PG8_BAR; PG8_SCHED;
            PG8_STAGE(PG8_SB(0, 1), b2 + hstepB, voffB);
            PG8_WAIT_V(6); PG8_BAR; PG8_MMA(1, 1, At, B1); PG8_BAR;
            PG8_LDB(B0, 1, 0); PG8_SCHED; PG8_LDA(At, 1, 0); PG8_STAGE(PG8_SA(0, 1), a2 + hstep, voffA);
            PG8_WAIT_L(8); PG8_BAR; PG8_WAIT_L(0); PG8_MMA(0, 0, At, B0); PG8_BAR; PG8_SCHED;
            PG8_LDB(B1, 1, 1); PG8_STAGE(PG8_SB(1, 0), b3, voffB);
            PG8_BAR; PG8_WAIT_L(0); PG8_MMA(0, 1, At, B1); PG8_BAR;
            PG8_LDA(At, 1, 1); PG8_STAGE(PG8_SA(1, 0), a3, voffA);
            PG8_BAR; PG8_WAIT_L(0); PG8_MMA(1, 0, At, B0); PG8_BAR; PG8_SCHED;
            PG8_STAGE(PG8_SB(1, 1), b3 + hstepB, voffB);
            PG8_WAIT_V(6); PG8_BAR; PG8_MMA(1, 1, At, B1); PG8_BAR;
            }
        }
        if constexpr (ALIGN_EPI) { if (wr == 0) PG8_BAR; }
        E(acc, cur, wr, wc, fr, fq);
        if (!has_next) break;
#pragma unroll
        for (int a = 0; a < 2; ++a)
#pragma unroll
            for (int b = 0; b < 2; ++b)
#pragma unroll
                for (int m = 0; m < 4; ++m)
#pragma unroll
                    for (int n = 0; n < 2; ++n) acc[a][b][m][n] = (f32x4){0.f, 0.f, 0.f, 0.f};
        cur = nxt; cA = nA; cB = nB; ++ui;
        if constexpr (ALIGN_EPI) { if (wr == 1) PG8_BAR; }
    }
    PG8_WAIT_V(0);
    if constexpr (!ALIGN_EPI) { if (wr == 0) PG8_BAR; }
    PG8_BAR;
#undef PG8_SA
#undef PG8_SB
#undef PG8_STAGE
#undef PG8_LDA
#undef PG8_LDB
#undef PG8_MMA
#undef PG8_WAIT_V
#undef PG8_WAIT_L
#undef PG8_BAR
#undef PG8_SCHED
}
}

enum { K_QR = 0, K_KR, K_VR, K_SGR, K_QD, K_KD, K_VD, K_SGD, K_MGR, K_YR, K_MGD, K_YD, K_OUT };
constexpr size_t TSTEP = (size_t)256 * DM * 2;

template <int PC  > struct Epi {
    unsigned char* ws; const float* xin; float* xout; const float* gq; const float* gk;
    __device__ __forceinline__ static void st8(bf16* p, const f32x4 a, const f32x4 b) {
        u32x4 w; w.x = cvt_pk_bf16(a[0], a[1]); w.y = cvt_pk_bf16(a[2], a[3]); w.z = cvt_pk_bf16(b[0], b[1]); w.w = cvt_pk_bf16(b[2], b[3]); *(u32x4*)p = w; }
    __device__ __forceinline__ void operator()(const f32x4 (&acc)[2][2][4][2], const pg8::Unit& u, int wr, int wc, int fr, int fq) const {
        const int row0 = u.pm * 256 + wr * 64 + fr;
        const int cl = wc * 64 + 8 * fq;
        const int kind = u.kind;
        bf16* const qr = (bf16*)(ws + WS_QR); bf16* const kr = (bf16*)(ws + WS_KR); bf16* const vr = (bf16*)(ws + WS_VR); bf16* const sgr = (bf16*)(ws + WS_SGR);
        bf16* const qd = (bf16*)(ws + WS_QD); bf16* const kd = (bf16*)(ws + WS_KD); bf16* const vd = (bf16*)(ws + WS_VD); bf16* const sgd = (bf16*)(ws + WS_SGD);
        bf16* const smgr = (bf16*)(ws + WS_SMGR); bf16* const smgd = (bf16*)(ws + WS_SMGD); bf16* const mbf = (bf16*)(ws + WS_MBF); float* const mbuf = (float*)(ws + WS_MBUF);
        if (PC == 0 && (kind == K_VR || kind == K_VD)) {
            bf16* base = (kind == K_VR ? vr : vd) + u.pn * 256 + cl;
#pragma unroll
            for (int ai = 0; ai < 2; ++ai)
#pragma unroll
                for (int m = 0; m < 4; ++m) { bf16* rp = base + (size_t)(row0 + ai * 128 + m * 16) * 1024;
#pragma unroll
                    for (int bj = 0; bj < 2; ++bj) st8(rp + 32 * bj, acc[ai][bj][m][0], acc[ai][bj][m][1]); }
        } else if (PC == 0 && (kind == K_SGR || kind == K_SGD)) {
            bf16* base = (kind == K_SGR ? sgr : sgd) + u.pn * 256 + cl;
#pragma unroll
            for (int ai = 0; ai < 2; ++ai)
#pragma unroll
                for (int m = 0; m < 4; ++m) { bf16* rp = base + (size_t)(row0 + ai * 128 + m * 16) * 1024;
#pragma unroll
                    for (int bj = 0; bj < 2; ++bj) { f32x4 a = acc[ai][bj][m][0], b = acc[ai][bj][m][1];
#pragma unroll
                        for (int i = 0; i < 4; ++i) { a[i] = a[i] * fast_sigmoid(a[i]); b[i] = b[i] * fast_sigmoid(b[i]); }
                        st8(rp + 32 * bj, a, b); } }
        } else if (PC == 1 && (kind == K_MGR || kind == K_MGD)) {
            bf16* base = (kind == K_MGR ? smgr : smgd) + u.pn * 256 + cl;
#pragma unroll
            for (int ai = 0; ai < 2; ++ai)
#pragma unroll
                for (int m = 0; m < 4; ++m) { bf16* rp = base + (size_t)(row0 + ai * 128 + m * 16) * 1024;
#pragma unroll
                    for (int bj = 0; bj < 2; ++bj) { f32x4 a = acc[ai][bj][m][0], b = acc[ai][bj][m][1];
#pragma unroll
                        for (int i = 0; i < 4; ++i) { a[i] = fast_sigmoid(a[i]); b[i] = fast_sigmoid(b[i]); }
                        st8(rp + 32 * bj, a, b); } }
        } else if (PC == 0 && (kind == K_QR || kind == K_KR)) {
            const int h = u.pn * 4 + wc; const float lg = __log2f(1.0f - __builtin_amdgcn_exp2f(-5.0f - (float)h));
            bf16* base = (kind == K_QR ? qr : kr) + u.pn * 256 + cl;
            const float sgn = (kind == K_QR) ? lg : -lg, mul = (kind == K_QR) ? 1.0f : 0.125f;
#pragma unroll
            for (int ai = 0; ai < 2; ++ai)
#pragma unroll
                for (int m = 0; m < 4; ++m) { const int row = row0 + ai * 128 + m * 16; bf16* rp = base + (size_t)row * 512;
                    const float f = mul * __builtin_amdgcn_exp2f((float)(row & 127) * sgn);
#pragma unroll
                    for (int bj = 0; bj < 2; ++bj) st8(rp + 32 * bj, acc[ai][bj][m][0] * f, acc[ai][bj][m][1] * f); }
        } else if (PC == 0 && (kind == K_QD || kind == K_KD)) {
            const float* g = (kind == K_QD) ? gq : gk; const float mul = (kind == K_QD) ? 0.125f * LOG2E : 1.0f;
            bf16* base = (kind == K_QD ? qd : kd) + u.pn * 256 + cl;
            f32x4 gv[2][2];
#pragma unroll
            for (int bj = 0; bj < 2; ++bj)
#pragma unroll
                for (int n = 0; n < 2; ++n) gv[bj][n] = *(const f32x4*)(g + 32 * bj + 8 * fq + 4 * n) * mul;
#pragma unroll
            for (int ai = 0; ai < 2; ++ai)
#pragma unroll
                for (int m = 0; m < 4; ++m) { bf16* rp = base + (size_t)(row0 + ai * 128 + m * 16) * 1024;
                    float ss = 0.f;
#pragma unroll
                    for (int bj = 0; bj < 2; ++bj)
#pragma unroll
                        for (int n = 0; n < 2; ++n) { const f32x4 x = acc[ai][bj][m][n]; ss += (x[0] * x[0] + x[1] * x[1]) + (x[2] * x[2] + x[3] * x[3]); }
                    ss += __shfl_xor(ss, 16); ss += __shfl_xor(ss, 32);
                    const float rs = __builtin_amdgcn_rsqf(ss * (1.0f / 64.0f) + EPS);
#pragma unroll
                    for (int bj = 0; bj < 2; ++bj) st8(rp + 32 * bj, acc[ai][bj][m][0] * gv[bj][0] * rs, acc[ai][bj][m][1] * gv[bj][1] * rs); }
        } else if (PC == 1 && kind == K_YR) {
            bf16* const yrb = (bf16*)mbuf + (size_t)u.pn * 256 + cl;
#pragma unroll
            for (int ai = 0; ai < 2; ++ai)
#pragma unroll
                for (int m = 0; m < 4; ++m) { bf16* rp = yrb + (size_t)(row0 + ai * 128 + m * 16) * 1024;
#pragma unroll
                    for (int bj = 0; bj < 2; ++bj) st8(rp + 32 * bj, acc[ai][bj][m][0], acc[ai][bj][m][1]); }
        } else if (PC == 1 && kind == K_YD) {
            const size_t cb = (size_t)u.pn * 256 + cl; const bf16* const yrb = (const bf16*)mbuf;
#pragma unroll
            for (int ai = 0; ai < 2; ++ai)
#pragma unroll
                for (int m = 0; m < 4; ++m) { const size_t ro = (size_t)(row0 + ai * 128 + m * 16) * 1024 + cb;
#pragma unroll
                    for (int bj = 0; bj < 2; ++bj) { const u32x4 sr = *(const u32x4*)(smgr + ro + 32 * bj), sd = *(const u32x4*)(smgd + ro + 32 * bj), yr = *(const u32x4*)(yrb + ro + 32 * bj);
                        const f32x4 a = acc[ai][bj][m][0], b = acc[ai][bj][m][1];
                        f32x4 o0, o1;
                        o0[0] = lo_bf(sr.x) * lo_bf(yr.x) + lo_bf(sd.x) * a[0]; o0[1] = hi_bf(sr.x) * hi_bf(yr.x) + hi_bf(sd.x) * a[1];
                        o0[2] = lo_bf(sr.y) * lo_bf(yr.y) + lo_bf(sd.y) * a[2]; o0[3] = hi_bf(sr.y) * hi_bf(yr.y) + hi_bf(sd.y) * a[3];
                        o1[0] = lo_bf(sr.z) * lo_bf(yr.z) + lo_bf(sd.z) * b[0]; o1[1] = hi_bf(sr.z) * hi_bf(yr.z) + hi_bf(sd.z) * b[1];
                        o1[2] = lo_bf(sr.w) * lo_bf(yr.w) + lo_bf(sd.w) * b[2]; o1[3] = hi_bf(sr.w) * hi_bf(yr.w) + hi_bf(sd.w) * b[3];
                        st8(mbf + ro + 32 * bj, o0, o1); }
                    asm volatile("" ::: "memory"); }
        } else if (PC == 2 && kind == K_OUT) {
            const size_t cb = (size_t)u.pn * 256 + cl;
#pragma unroll
            for (int ai = 0; ai < 2; ++ai)
#pragma unroll
                for (int m = 0; m < 4; ++m) { const size_t ro = (size_t)(row0 + ai * 128 + m * 16) * 1024 + cb;
#pragma unroll
                    for (int bj = 0; bj < 2; ++bj) { const f32x4 p0 = *(const f32x4*)(xin + ro + 32 * bj), p1 = *(const f32x4*)(xin + ro + 32 * bj + 4);
                        *(f32x4*)(xout + ro + 32 * bj) = p0 + acc[ai][bj][m][0]; *(f32x4*)(xout + ro + 32 * bj + 4) = p1 + acc[ai][bj][m][1]; }
                    asm volatile("" ::: "memory"); }
        }
    }
};

struct SchedG1A {
    const char* A; const char* B; int G, c;
    __device__ __forceinline__ bool next(int i, pg8::Unit& u) const {
        const int L = i * G + c; if (L >= 64 * 28) return false;
        int pm, pg; pg8::tile_of(L, 64, 28, pm, pg);
        u.pm = pm; u.a = A + (size_t)pm * TSTEP; u.b = B + (size_t)pg * TSTEP;
        if (pg < 2) { u.kind = K_QR; u.pn = pg; } else if (pg < 4) { u.kind = K_KR; u.pn = pg - 2; } else if (pg < 8) { u.kind = K_VR; u.pn = pg - 4; } else if (pg < 12) { u.kind = K_SGR; u.pn = pg - 8; }
        else if (pg < 16) { u.kind = K_QD; u.pn = pg - 12; } else if (pg < 20) { u.kind = K_KD; u.pn = pg - 16; } else if (pg < 24) { u.kind = K_VD; u.pn = pg - 20; } else { u.kind = K_SGD; u.pn = pg - 24; }
        return true;
    }
};
struct SchedP34 {
    const char *ws, *Wro; int c;
    __device__ __forceinline__ bool next(int i, pg8::Unit& u) const {
        if (i >= 4) return false;
        const char* H = ws + WS_H; const char* OR = ws + WS_SGR; const char* OD = ws + WS_SGD; const char* Win = ws + WS_WIN; const char* Wdo = Wro + 2 * MiB;
        int pm, pn; pg8::tile_of(c, 64, 4, pm, pn); u.pm = pm; u.pn = pn;
        if (i == 0) { u.kind = K_MGR; u.a = H + (size_t)pm * TSTEP; u.b = Win + (size_t)(28 + pn) * TSTEP; }
        else if (i == 1) { u.kind = K_MGD; u.a = H + (size_t)pm * TSTEP; u.b = Win + (size_t)(32 + pn) * TSTEP; }
        else if (i == 2) { u.kind = K_YR; u.a = OR + (size_t)pm * TSTEP; u.b = Wro + (size_t)pn * TSTEP; }
        else { u.kind = K_YD; u.a = OD + (size_t)pm * TSTEP; u.b = Wdo + (size_t)pn * TSTEP; }
        return true;
    }
};
struct SchedG4 {
    const char *Mb, *Wout; int c;
    __device__ __forceinline__ bool next(int i, pg8::Unit& u) const {
        if (i >= 1) return false;
        int pm, pn; pg8::tile_of(c, 64, 4, pm, pn); u.pm = pm; u.pn = pn; u.kind = K_OUT; u.a = Mb + (size_t)pm * TSTEP; u.b = Wout + (size_t)pn * TSTEP; return true;
    }
};

#define XB_TMO      128
#define XB_XCNT(j)  (256  + 64 * (j))
#define XB_XSUB(j)  (1280 + 64 * (j))
#define XB_XGEN(j)  (2304 + 64 * (j))
#define XB_TOP      3328
#define XB_TOPGEN   3392
#define XCD_BAR_WORDS 3456
#define XB_SPIN_CAP (1u << 18)
__device__ __forceinline__ unsigned xb_ld(unsigned* p)              { return __hip_atomic_load(p, __ATOMIC_RELAXED, __HIP_MEMORY_SCOPE_AGENT); }
__device__ __forceinline__ unsigned xb_add(unsigned* p, unsigned v) { return __hip_atomic_fetch_add(p, v, __ATOMIC_RELAXED, __HIP_MEMORY_SCOPE_AGENT); }
__device__ __forceinline__ unsigned xb_xcc_id() { return (unsigned)__builtin_amdgcn_s_getreg((3 << 11) | 20) & 0xFu; }
#define XB_SPIN(cond, bar) do { unsigned _sp = 0; while (cond) { __builtin_amdgcn_s_sleep(1); \
    if ((++_sp & 255u) == 0u) { if (xb_ld(&(bar)[XB_TMO])) break; if (_sp > XB_SPIN_CAP) { atomicAdd(&(bar)[XB_TMO], 1u); break; } } } } while (0)
struct XcdBarrier { unsigned* bar; unsigned x; volatile LAS unsigned* st; };
__device__ __forceinline__ XcdBarrier xcd_barrier_post(unsigned* bar, volatile LAS unsigned* st) {
    XcdBarrier b; b.bar = bar; b.x = xb_xcc_id(); b.st = st;
    if (threadIdx.x == 0) (void)xb_add(&bar[XB_XCNT(b.x)], 1u);
    return b;
}
__device__ __forceinline__ void xcd_barrier_complete(unsigned* bar, unsigned x, unsigned& nloc, unsigned& nx) {
    const unsigned G = gridDim.x * gridDim.y * gridDim.z;
    unsigned sum, cnt, mine, sp = 0u;
    for (;;) {
        sum = 0u; cnt = 0u; mine = 0u;
#pragma unroll
        for (unsigned j = 0; j < 16; ++j) { const unsigned c = xb_ld(&bar[XB_XCNT(j)]); sum += c; cnt += (c > 0u) ? 1u : 0u; mine = (j == x) ? c : mine; }
        if (sum == G) break;
        __builtin_amdgcn_s_sleep(1);
        if ((++sp & 255u) == 0u) { if (xb_ld(&bar[XB_TMO])) break; if (sp > XB_SPIN_CAP) { atomicAdd(&bar[XB_TMO], 1u); break; } }
    }
    nloc = mine > 0u ? mine : 1u; nx = cnt > 0u ? cnt : 1u;
}
__device__ __forceinline__ void xcd_barrier(const XcdBarrier& b) {
    asm volatile("s_waitcnt vmcnt(0)" ::: "memory");
    __syncthreads();
    if (threadIdx.x == 0) {
        unsigned* bar = b.bar;
        __builtin_amdgcn_s_waitcnt(0);
        unsigned nloc = b.st[0], nx = b.st[1];
        if (nloc == 0u) { xcd_barrier_complete(bar, b.x, nloc, nx); b.st[0] = nloc; b.st[1] = nx; }
        const unsigned old = xb_add(&bar[XB_XSUB(b.x)], 1u);
        const unsigned gen = old / nloc;
        if (old + 1u == (gen + 1u) * nloc) {
            __builtin_amdgcn_fence(__ATOMIC_RELEASE, "agent");
            asm volatile("s_waitcnt vmcnt(0)" ::: "memory");
            const unsigned og = xb_add(&bar[XB_TOP], 1u);
            const unsigned tg = og / nx;
            if (og + 1u == (tg + 1u) * nx) xb_add(&bar[XB_TOPGEN], 1u);
            else XB_SPIN(xb_ld(&bar[XB_TOPGEN]) == tg, bar);
            __builtin_amdgcn_fence(__ATOMIC_ACQUIRE, "agent");
            xb_add(&bar[XB_XGEN(b.x)], 1u);
            asm volatile("s_waitcnt vmcnt(0)" ::: "memory");
        } else {
            XB_SPIN(xb_ld(&bar[XB_XGEN(b.x)]) == gen, bar);
            __builtin_amdgcn_fence(__ATOMIC_ACQUIRE, "agent");
            asm volatile("s_waitcnt vmcnt(0)" ::: "memory");
        }
    }
    __syncthreads();
}

#define LDS_WAIT() asm volatile("s_waitcnt lgkmcnt(0)" ::: "memory")
__device__ __forceinline__ float wave_sum(float v) {
#pragma unroll
    for (int o = 1; o < 64; o <<= 1) v += __shfl_xor(v, o);
    return v;
}
__device__ __forceinline__ void p0_transpose_item(const float* W, int K, int N, bf16* WT, LAS float* scr, int item, int lane) {
    const int nblk = N / 32, kb = item / nblk, nb = item % nblk, k0 = 64 * kb, n0 = 32 * nb;
#pragma unroll 8
    for (int i = 0; i < 32; ++i) { const int kk = 2 * i + (lane >> 5); scr[kk * 33 + (lane & 31)] = W[(size_t)(k0 + kk) * N + n0 + (lane & 31)]; }
    LDS_WAIT(); asm volatile("" ::: "memory");
    const int c = lane & 7;
#pragma unroll
    for (int j = 0; j < 4; ++j) { const int n = (lane >> 3) + 8 * j; const LAS float* s = scr + (8 * c) * 33 + n;
        u32x4 o; o.x = pk2(s[0 * 33], s[1 * 33]); o.y = pk2(s[2 * 33], s[3 * 33]); o.z = pk2(s[4 * 33], s[5 * 33]); o.w = pk2(s[6 * 33], s[7 * 33]);
        *(GAS u32x4*)(WT + (size_t)(n0 + n) * K + k0 + 8 * c) = o; }
    LDS_WAIT(); asm volatile("" ::: "memory");
}
__device__ __forceinline__ void rms_row_to_bf16(const float* xrow, const float* g, bf16* orow, int lane) {
    const GAS f32x4* xr = (const GAS f32x4*)xrow + lane; const GAS f32x4* gr = (const GAS f32x4*)g + lane;
    f32x4 v[4]; float s = 0.f;
#pragma unroll
    for (int j = 0; j < 4; ++j) { v[j] = xr[64 * j]; s += (v[j].x * v[j].x + v[j].y * v[j].y) + (v[j].z * v[j].z + v[j].w * v[j].w); }
    const float rs = 1.0f / sqrtf(wave_sum(s) * (1.f / DM) + EPS);
    GAS unsigned long long* o8 = (GAS unsigned long long*)orow + lane;
#pragma unroll
    for (int j = 0; j < 4; ++j) { const f32x4 gg = gr[64 * j];
        o8[64 * j] = (unsigned long long)pk2(v[j].x * rs * gg.x, v[j].y * rs * gg.y) | ((unsigned long long)pk2(v[j].z * rs * gg.z, v[j].w * rs * gg.w) << 32); }
}

__device__ __forceinline__ const float* in_ptr(int k) {
    typedef __attribute__((address_space(4))) const char* cptr4;
    cptr4 ka = (cptr4)__builtin_amdgcn_kernarg_segment_ptr(); cptr4 kb;
    asm volatile("s_mov_b64 %0, %1" : "=s"(kb) : "s"(ka));
    typedef const float* cfp; typedef __attribute__((address_space(4))) const cfp* cfp4;
    return *(cfp4)(kb + k * 8);
}
constexpr int NWAVES = 8;
constexpr int RING_BYTES = 131072, LDSCTL_OFF = RING_BYTES, MISC_OFF = LDSCTL_OFF + 320, LDS_BYTES = 147456;
struct Args { const float* in[14]; float* out; unsigned char* ws; int ph_lo, ph_hi, li, pad; };
constexpr int N_PHASES = 10;

__global__ void __launch_bounds__(NWAVES * 64, 2) mk_fwd(Args args) {
    extern __shared__ __attribute__((aligned(16))) unsigned char lds_raw[];
    LAS unsigned char* lds = (LAS unsigned char*)lds_raw;
    volatile LAS unsigned* MISC = (volatile LAS unsigned*)(lds + MISC_OFF);
    const int tid = threadIdx.x, lane_k = tid & 63, wave = __builtin_amdgcn_readfirstlane(tid >> 6);
    const int G = gridDim.x, bx = blockIdx.x; const int vcu = (G % 8 == 0) ? (bx % 8) * (G / 8) + bx / 8 : bx;
    unsigned char* const ws_k = (unsigned char*)in_ptr(15);
    unsigned* ctl = (unsigned*)(ws_k + WS_CTL);
    for (int u = tid; u < (LDS_BYTES - LDSCTL_OFF) / 4; u += NWAVES * 64) ((LAS unsigned*)(lds + LDSCTL_OFF))[u] = 0u;
    __syncthreads();
    const int lo = args.ph_lo, hi = args.ph_hi;
    XcdBarrier bar; bar.bar = ctl + CW_BAR + args.li * XCD_BAR_WORDS; bar.x = 0; bar.st = nullptr;
    if (hi - lo > 1) bar = xcd_barrier_post(ctl + CW_BAR + args.li * XCD_BAR_WORDS, MISC + 8);
#define IN(k) (lo <= (k) && (k) < hi)
#define SEAM(k) do { if (IN(k) && IN((k) + 1)) xcd_barrier(bar); } while (0)

    if (IN(0)) {
        unsigned char* const ws = ws_k; int lane = lane_k; asm volatile("" : "+v"(lane));
        bf16* Wt_in = (bf16*)(ws + WS_WIN); bf16* H = (bf16*)(ws + WS_H);
        LAS float* scr = (LAS float*)(lds + wave * 16384);
        const int gw = vcu * NWAVES + wave, NGW = G * NWAVES;
        constexpr int I_IN = (DM / 64) * (NIN / 32), I_SQ = (DM / 64) * (DM / 32);
        for (int it = gw; it < I_IN + 6 * I_SQ; it += NGW) {
            int r = it;
            if (r < I_IN) { p0_transpose_item(in_ptr(2), DM, NIN, Wt_in, scr, r, lane); continue; } r -= I_IN;
            const int which = r / I_SQ, item = r % I_SQ, l = which / 3, w = which % 3;
            const float* src = (w == 0 ? in_ptr(4) : w == 1 ? in_ptr(12) : in_ptr(13)) + (size_t)l * DM * DM;
            bf16* dst = (bf16*)(ws + (l == 0 ? WS_WRO : WS_W1) + (size_t)w * 2 * MiB);
            p0_transpose_item(src, DM, DM, dst, scr, item, lane);
        }
        const float* x0 = in_ptr(0); const float* g0 = in_ptr(1);
        for (int m = gw; m < T; m += NGW) rms_row_to_bf16(x0 + (size_t)m * DM, g0, H + (size_t)m * DM, lane);
        LDS_WAIT(); __syncthreads();
    }
    SEAM(0);

#pragma unroll 1
    for (int l = 0; l < DEPTH; ++l) {
        const int pb = 1 + 5 * l;
        if (IN(pb)) {
            unsigned char* const ws = ws_k;
            Epi<0> E; E.ws = ws; E.xin = nullptr; E.xout = nullptr; E.gq = in_ptr(5) + l * 64; E.gk = in_ptr(6) + l * 64;
            SchedG1A S{(const char*)(ws + WS_H), (const char*)(ws + WS_WIN), G, bx};
            pg8::gemm_phase<Epi<0>, SchedG1A, true, true>(lds, DM, S, E);
        }
        SEAM(pb);
        if (IN(pb + 1)) {   }
        SEAM(pb + 1);
        if (IN(pb + 2)) {
            unsigned char* const ws = ws_k;
            Epi<1> E; E.ws = ws; E.xin = nullptr; E.xout = nullptr; E.gq = nullptr; E.gk = nullptr;
            SchedP34 S{(const char*)ws, (const char*)(ws + (l == 0 ? WS_WRO : WS_W1)), bx};
            pg8::gemm_phase<Epi<1>, SchedP34, true, true>(lds, DM, S, E);
        }
        SEAM(pb + 2);
        if (IN(pb + 3)) {
            unsigned char* const ws = ws_k;
            Epi<2> E; E.ws = ws; E.xin = (l == 0) ? in_ptr(0) : (const float*)in_ptr(14); E.xout = (float*)in_ptr(14); E.gq = nullptr; E.gk = nullptr;
            SchedG4 S{(const char*)(ws + WS_MBF), (const char*)(ws + (l == 0 ? WS_WRO : WS_W1) + 4 * MiB), bx};
            pg8::gemm_phase<Epi<2>, SchedG4, false, true>(lds, DM, S, E);
        }
        SEAM(pb + 3);
        if (l == 0) {
            if (IN(5)) {
                unsigned char* const ws = ws_k; int lane = lane_k; asm volatile("" : "+v"(lane));
                bf16* Wt_in = (bf16*)(ws + WS_WIN); bf16* H = (bf16*)(ws + WS_H);
                LAS float* scr = (LAS float*)(lds + wave * 16384);
                const int gw = vcu * NWAVES + wave, NGW = G * NWAVES;
                constexpr int I_IN = (DM / 64) * (NIN / 32);
                const float* w1 = in_ptr(2) + (size_t)DM * NIN;
                for (int it = gw; it < I_IN; it += NGW) p0_transpose_item(w1, DM, NIN, Wt_in, scr, it, lane);
                const float* x1 = in_ptr(14); const float* g1 = in_ptr(1) + DM;
                for (int m = gw; m < T; m += NGW) rms_row_to_bf16(x1 + (size_t)m * DM, g1, H + (size_t)m * DM, lane);
                LDS_WAIT(); __syncthreads();
            }
            SEAM(5);
        }
    }
#undef IN
#undef SEAM
}

__global__ void __launch_bounds__(128) k_ret_naive(const bf16* __restrict__ QR, const bf16* __restrict__ KR, const bf16* __restrict__ VR, bf16* SGR, const float* __restrict__ gn) {
    __shared__ float qs[16][64];
    __shared__ float ks[32][65];
    __shared__ float vs[32][128];
    __shared__ float ps[16][32];
    __shared__ float rsv[16];
    const int tid = threadIdx.x, qb = blockIdx.x & 255, bh = blockIdx.x >> 8, h = bh & 7, b = bh >> 3;
    const int n0 = qb * 16; const size_t tb = (size_t)b * SEQ;
    const float lg2 = log2f(1.0f - exp2f(-5.0f - (float)h));
    for (int i = tid; i < 16 * 64; i += 128) qs[i >> 6][i & 63] = bf2f(QR[(tb + n0 + (i >> 6)) * 512 + h * 64 + (i & 63)]);
    float acc[16];
#pragma unroll
    for (int r = 0; r < 16; ++r) acc[r] = 0.f;
    for (int k0 = 0; k0 < n0 + 16; k0 += 32) {
        __syncthreads();
        for (int i = tid; i < 32 * 64; i += 128) ks[i >> 6][i & 63] = bf2f(KR[(tb + k0 + (i >> 6)) * 512 + h * 64 + (i & 63)]);
        for (int i = tid; i < 32 * 128; i += 128) vs[i >> 7][i & 127] = bf2f(VR[(tb + k0 + (i >> 7)) * 1024 + h * 128 + (i & 127)]);
        __syncthreads();
        const float cf = exp2f(128.0f * (float)((n0 >> 7) - (k0 >> 7)) * lg2);
        for (int i = tid; i < 16 * 32; i += 128) { const int r = i >> 5, kk = i & 31; float d = 0.f;
            for (int c = 0; c < 64; ++c) d += qs[r][c] * ks[kk][c];
            const int dist = (n0 + r) - (k0 + kk);
            ps[r][kk] = dist >= 0 ? d * cf : 0.f; }
        __syncthreads();
#pragma unroll
        for (int r = 0; r < 16; ++r) { float a = acc[r];
            for (int kk = 0; kk < 32; ++kk) a += ps[r][kk] * vs[kk][tid];
            acc[r] = a; }
    }
    __syncthreads();
    for (int r = 0; r < 16; ++r) vs[r][tid] = acc[r];
    __syncthreads();
    if (tid < 16) { float s = 0.f; for (int e = 0; e < 128; ++e) s += vs[tid][e] * vs[tid][e]; rsv[tid] = 1.0f / sqrtf(s * (1.0f / 128.0f) + EPS); }
    __syncthreads();
    for (int r = 0; r < 16; ++r) { const size_t o = (tb + n0 + r) * 1024 + h * 128 + tid; SGR[o] = f2bf(acc[r] * rsv[r] * gn[h * 128 + tid] * bf2f(SGR[o])); }
}

__global__ void __launch_bounds__(128) k_attn_naive(const bf16* __restrict__ QD, const bf16* __restrict__ KD, const bf16* __restrict__ VD, bf16* SGD, const float* __restrict__ lq1, const float* __restrict__ lk1,
                                                    const float* __restrict__ lq2, const float* __restrict__ lk2, const float* __restrict__ gn, float lam_init) {
    __shared__ float qs[2][16][64];
    __shared__ float ks[2][32][65];
    __shared__ float vs[32][128];
    __shared__ float ps[2][16][32];
    __shared__ float mrow[2][16], lrow[2][16], arow[2][16], rsv[16];
    const int tid = threadIdx.x, qb = blockIdx.x & 255, bh = blockIdx.x >> 8, h = bh & 7, b = bh >> 3;
    const int n0 = qb * 16; const size_t tb = (size_t)b * SEQ;
    float s1 = 0.f, s2 = 0.f;
    for (int i = 0; i < 64; ++i) { s1 += lq1[i] * lk1[i]; s2 += lq2[i] * lk2[i]; }
    const float lam = expf(s1) - expf(s2) + lam_init;
    const float slope = exp2f(-(float)(h + 1)) * LOG2E;
    for (int i = tid; i < 2 * 16 * 64; i += 128) { const int j = i >> 10, r = (i >> 6) & 15, d = i & 63; qs[j][r][d] = bf2f(QD[(tb + n0 + r) * 1024 + h * 128 + j * 64 + d]); }
    if (tid < 32) { mrow[tid >> 4][tid & 15] = -INFINITY; lrow[tid >> 4][tid & 15] = 0.f; }
    float acc[2][16];
#pragma unroll
    for (int j = 0; j < 2; ++j)
#pragma unroll
        for (int r = 0; r < 16; ++r) acc[j][r] = 0.f;
    for (int k0 = 0; k0 < n0 + 16; k0 += 32) {
        __syncthreads();
        for (int i = tid; i < 2 * 32 * 64; i += 128) { const int j = i >> 11, kk = (i >> 6) & 31, d = i & 63; ks[j][kk][d] = bf2f(KD[(tb + k0 + kk) * 1024 + h * 128 + j * 64 + d]); }
        for (int i = tid; i < 32 * 128; i += 128) vs[i >> 7][i & 127] = bf2f(VD[(tb + k0 + (i >> 7)) * 1024 + h * 128 + (i & 127)]);
        __syncthreads();
        for (int i = tid; i < 2 * 16 * 32; i += 128) { const int j = i >> 9, r = (i >> 5) & 15, kk = i & 31; float d = 0.f;
            for (int c = 0; c < 64; ++c) d += qs[j][r][c] * ks[j][kk][c];
            const int dist = (n0 + r) - (k0 + kk);
            ps[j][r][kk] = dist >= 0 ? d - slope * (float)dist : -INFINITY; }
        __syncthreads();
        if (tid < 32) { const int j = tid >> 4, r = tid & 15; float mx = mrow[j][r];
            for (int kk = 0; kk < 32; ++kk) mx = fmaxf(mx, ps[j][r][kk]);
            const float al = exp2f(mrow[j][r] - mx); float sum = 0.f;
            for (int kk = 0; kk < 32; ++kk) { const float p = exp2f(ps[j][r][kk] - mx); ps[j][r][kk] = p; sum += p; }
            lrow[j][r] = lrow[j][r] * al + sum; arow[j][r] = al; mrow[j][r] = mx; }
        __syncthreads();
#pragma unroll
        for (int j = 0; j < 2; ++j)
#pragma unroll
            for (int r = 0; r < 16; ++r) { float a = acc[j][r] * arow[j][r];
                for (int kk = 0; kk < 32; ++kk) a += ps[j][r][kk] * vs[kk][tid];
                acc[j][r] = a; }
    }
    __syncthreads();
    float o[16];
#pragma unroll
    for (int r = 0; r < 16; ++r) { o[r] = acc[0][r] / lrow[0][r] - lam * acc[1][r] / lrow[1][r]; vs[r][tid] = o[r]; }
    __syncthreads();
    if (tid < 16) { float s = 0.f; for (int e = 0; e < 128; ++e) s += vs[tid][e] * vs[tid][e]; rsv[tid] = 1.0f / sqrtf(s * (1.0f / 128.0f) + EPS); }
    __syncthreads();
    for (int r = 0; r < 16; ++r) { const size_t oo = (tb + n0 + r) * 1024 + h * 128 + tid; SGD[oo] = f2bf(o[r] * rsv[r] * gn[h * 128 + tid] * (1.0f - lam_init) * bf2f(SGD[oo])); }
}


extern "C" void kernel_launch(void* const* d_in, const int* in_sizes, int n_in, void* d_out, int out_size, void* d_ws, size_t ws_size, hipStream_t stream) {
    static int ready = 0;
    if (ready == 0) {
        if (n_in != 14 || ws_size < WS_END || out_size != T * DM) { fprintf(stderr, "kernel_launch: unexpected problem (n_in %d, ws %zu, out %d)\n", n_in, ws_size, out_size); ready = -1; return; }
        if (hipFuncSetAttribute((const void*)mk_fwd, hipFuncAttributeMaxDynamicSharedMemorySize, LDS_BYTES) != hipSuccess) { fprintf(stderr, "kernel_launch: hipFuncSetAttribute failed\n"); ready = -1; return; }
        ready = 1;
    }
    if (ready < 0) return;
    (void)hipMemsetAsync((char*)d_ws + WS_CTL, 0, CTL_ZERO_BYTES, stream);
    Args a{};
    for (int i = 0; i < 14; ++i) a.in[i] = (const float*)d_in[i];
    a.out = (float*)d_out; a.ws = (unsigned char*)d_ws;
    char* ws = (char*)d_ws;
    const float* ret_norm_g = (const float*)d_in[3]; const float* sub_g = (const float*)d_in[11];
    const float* lq1 = (const float*)d_in[7]; const float* lk1 = (const float*)d_in[8]; const float* lq2 = (const float*)d_in[9]; const float* lk2 = (const float*)d_in[10];
    int li = 0;
    for (int ph = 0; ph < N_PHASES; ++ph) {
        if (ph == 2 || ph == 7) {
            const int l = (ph == 2) ? 0 : 1; const float lam_init = 0.8f - 0.6f * expf(-0.3f * (float)l);
            k_ret_naive<<<BATCH * 8 * 256, 128, 0, stream>>>((const bf16*)(ws + WS_QR), (const bf16*)(ws + WS_KR), (const bf16*)(ws + WS_VR), (bf16*)(ws + WS_SGR), ret_norm_g + l * 1024);
            k_attn_naive<<<BATCH * 8 * 256, 128, 0, stream>>>((const bf16*)(ws + WS_QD), (const bf16*)(ws + WS_KD), (const bf16*)(ws + WS_VD), (bf16*)(ws + WS_SGD), lq1 + l * 64, lk1 + l * 64, lq2 + l * 64, lk2 + l * 64, sub_g + l * 1024, lam_init);
            continue;
        }
        a.ph_lo = ph; a.ph_hi = ph + 1; a.li = li++;
        hipLaunchKernelGGL(mk_fwd, dim3(256), dim3(NWAVES * 64), LDS_BYTES, stream, a);
    }
}
```

```cpp
#include <hip/hip_runtime.h>
#include <cstdio>
#include <cstdint>
#include <cstddef>

constexpr int DM = 1024, BATCH = 4, SEQ = 4096, DEPTH = 2, T = BATCH * SEQ, NIN = 9216;
constexpr float EPS = 1e-6f;
constexpr float LOG2E = 1.4426950408889634f;

typedef unsigned short bf16;
typedef short bf16x8 __attribute__((ext_vector_type(8)));
typedef float f32x4 __attribute__((ext_vector_type(4)));
typedef unsigned u32x4 __attribute__((ext_vector_type(4)));
#define LAS __attribute__((address_space(3)))
#define GAS __attribute__((address_space(1)))

__device__ __forceinline__ float bf2f(bf16 v) { return __uint_as_float(((unsigned)v) << 16); }
__device__ __forceinline__ unsigned f2bf_u(float f) { unsigned u = __float_as_uint(f); return (u + 0x7fffu + ((u >> 16) & 1u)) >> 16; }
__device__ __forceinline__ bf16 f2bf(float f) { return (bf16)f2bf_u(f); }
__device__ __forceinline__ unsigned pk2(float lo, float hi) { return f2bf_u(lo) | (f2bf_u(hi) << 16); }
typedef float f32x2_t __attribute__((ext_vector_type(2))); typedef __bf16 bf16x2_t __attribute__((ext_vector_type(2)));
__device__ __forceinline__ unsigned cvt_pk_bf16(float lo, float hi) { f32x2_t v = {lo, hi}; bf16x2_t b = __builtin_convertvector(v, bf16x2_t); return __builtin_bit_cast(unsigned, b); }
__device__ __forceinline__ float fast_sigmoid(float v) { return __builtin_amdgcn_rcpf(1.0f + __builtin_amdgcn_exp2f(-v * LOG2E)); }
__device__ __forceinline__ float lo_bf(unsigned w) { return __uint_as_float(w << 16); }
__device__ __forceinline__ float hi_bf(unsigned w) { return __uint_as_float(w & 0xffff0000u); }

constexpr size_t MiB = 1u << 20;
constexpr size_t WS_CTL = 0, CTL_ZERO_BYTES = 1 * MiB;
constexpr size_t WS_WIN = 1 * MiB, WS_WRO = 19 * MiB, WS_WDO = 21 * MiB, WS_WOUT = 23 * MiB;
constexpr size_t WS_H = 25 * MiB, WS_QR = 57 * MiB, WS_KR = 73 * MiB, WS_VR = 89 * MiB, WS_SGR = 121 * MiB, WS_QD = 153 * MiB, WS_KD = 185 * MiB,
                 WS_VD = 217 * MiB, WS_SGD = 249 * MiB;
constexpr size_t WS_W1 = 281 * MiB;
constexpr size_t WS_END = 287 * MiB;
constexpr size_t WS_MBUF = 57 * MiB;
constexpr size_t WS_MBF = WS_VD;
constexpr size_t WS_SMGR = WS_QD, WS_SMGD = WS_KD;
constexpr int CW_BAR = 4096;

namespace pg8 {
constexpr int BM = 256, BK = 64, HALF = 128, HTB = HALF * BK * 2, STAGE_BYTES = 8 * HTB, NXCD = 8, WGM = 8;
__host__ __device__ __forceinline__ int lds_byte(int r, int c) { const int st = (r >> 4) * 2 + (c >> 5), rr = r & 15, cc = c & 31, ob = rr * 64 + cc * 2; return st * 1024 + (ob ^ (((ob >> 9) & 1) << 5)); }
__host__ __device__ __forceinline__ void stage_rc(int b, int& R, int& C) { const int st = b / 1024, sb = b % 1024, swz = sb ^ (((sb >> 9) & 1) << 5); R = (st >> 1) * 16 + swz / 64; C = (st & 1) * 32 + (swz % 64) / 2; }
__host__ __device__ __forceinline__ int perm32(int rho) { const int n = rho >> 4, i = rho & 15; return 8 * (i >> 2) + 4 * n + (i & 3); }

struct Unit { int pm, pn, kind; const char* a; const char* b; };

__device__ __forceinline__ void tile_of(int L, int nM, int nN, int& pm, int& pn) {
    const int nwg = nM * nN; int wgid = L;
    { const int q = nwg / NXCD, r = nwg % NXCD, xcd = wgid % NXCD, off = wgid / NXCD; wgid = (xcd < r ? xcd * (q + 1) : r * (q + 1) + (xcd - r) * q) + off; }
    const int nig = WGM * nN, gid = wgid / nig, fm = gid * WGM, gsz = (nM - fm) < WGM ? (nM - fm) : WGM;
    pm = fm + ((wgid % nig) % gsz); pn = (wgid % nig) / gsz;
}

template <class Epi, class Sched, bool ALIGN_EPI, bool SP2>
__device__ __forceinline__ void gemm_phase(LAS unsigned char* lds, const int K, const Sched& S, const Epi& E) {
    int tid_ = threadIdx.x; asm volatile("" : "+v"(tid_));
    const int tid = tid_, wid = __builtin_amdgcn_readfirstlane(tid >> 6), lane = tid & 63, wr = wid >> 2, wc = wid & 3, fr = lane & 15, fq = lane >> 4;
    const int nt = K / BK;
    unsigned voffA[2], voffB[2];
#pragma unroll
    for (int i = 0; i < 2; ++i) { int R, C; stage_rc(tid * 16 + i * 8192, R, C); const int Rb = (R >> 5) * 64 + perm32(R & 31);
        voffA[i] = (unsigned)(R * K + C) * 2u; voffB[i] = (unsigned)(Rb * K + C) * 2u; }
    const size_t kstep = (size_t)(BK * 2);
    const size_t hstep = (size_t)HALF * K * 2;
    const size_t hstepB = (size_t)32 * K * 2;
    const unsigned ldsw = (unsigned)wid * 1024u;
    const int aoff = lds_byte(wr * 64 + fr, fq * 8), boff = lds_byte(wc * 32 + fr, fq * 8);
#define PG8_SA(b, h) (((b) * 2 + (h)) * HTB)
#define PG8_SB(b, h) ((4 + (b) * 2 + (h)) * HTB)
#define PG8_STAGE(bufoff, gbase, voff) do { _Pragma("unroll") for (int _i = 0; _i < 2; ++_i) \
        __builtin_amdgcn_global_load_lds((const unsigned*)((const char*)(gbase) + (voff)[_i]), (LAS unsigned*)(lds + (bufoff) + ldsw + _i * 8192), 16, 0, 0); } while (0)
#define PG8_LDA(dst, b, h) do { _Pragma("unroll") for (int m = 0; m < 4; ++m) _Pragma("unroll") for (int k = 0; k < 2; ++k) dst[m][k] = *(const LAS bf16x8*)(lds + PG8_SA(b, h) + aoff + m * 2048 + k * 1024); } while (0)
#define PG8_LDB(dst, b, h) do { _Pragma("unroll") for (int n = 0; n < 2; ++n) _Pragma("unroll") for (int k = 0; k < 2; ++k) dst[n][k] = *(const LAS bf16x8*)(lds + PG8_SB(b, h) + boff + n * 2048 + k * 1024); } while (0)
#define PG8_MMA(ai, bj, At, Bt) do { __builtin_amdgcn_s_setprio(1); _Pragma("unroll") for (int m = 0; m < 4; ++m) _Pragma("unroll") for (int n = 0; n < 2; ++n) _Pragma("unroll") for (int k = 0; k < 2; ++k) \
        acc[ai][bj][m][n] = __builtin_amdgcn_mfma_f32_16x16x32_bf16(Bt[n][k], At[m][k], acc[ai][bj][m][n], 0, 0, 0); __builtin_amdgcn_s_setprio(0); } while (0)
#define PG8_WAIT_V(n) asm volatile("s_waitcnt vmcnt(" #n ")" ::: "memory")
#define PG8_WAIT_L(n) asm volatile("s_waitcnt lgkmcnt(" #n ")" ::: "memory")
#define PG8_BAR __builtin_amdgcn_s_barrier()
#define PG8_SCHED __builtin_amdgcn_sched_barrier(0)
    Unit cur, nxt; int ui = 0;
    if (!S.next(0, cur)) return;
    f32x4 acc[2][2][4][2];
#pragma unroll
    for (int a = 0; a < 2; ++a)
#pragma unroll
        for (int b = 0; b < 2; ++b)
#pragma unroll
            for (int m = 0; m < 4; ++m)
#pragma unroll
                for (int n = 0; n < 2; ++n) acc[a][b][m][n] = (f32x4){0.f, 0.f, 0.f, 0.f};
    bf16x8 At[4][2], B0[2][2], B1[2][2];
    const char* cA = cur.a; const char* cB = cur.b;
    if constexpr (SP2) {
        PG8_STAGE(PG8_SB(0, 0), cB, voffB); PG8_STAGE(PG8_SB(0, 1), cB + hstepB, voffB); PG8_STAGE(PG8_SA(0, 0), cA, voffA); PG8_STAGE(PG8_SA(0, 1), cA + hstep, voffA);
        if (wr == 1) PG8_BAR;
        PG8_WAIT_V(2); PG8_BAR;
        PG8_STAGE(PG8_SB(1, 0), cB + kstep, voffB); PG8_STAGE(PG8_SA(1, 0), cA + kstep, voffA); PG8_STAGE(PG8_SB(1, 1), cB + hstepB + kstep, voffB);
        PG8_WAIT_V(6); PG8_BAR;
    } else {
        PG8_STAGE(PG8_SB(0, 0), cB, voffB); PG8_STAGE(PG8_SA(0, 0), cA, voffA); PG8_STAGE(PG8_SB(0, 1), cB + hstepB, voffB); PG8_STAGE(PG8_SA(0, 1), cA + hstep, voffA);
        if (wr == 1) PG8_BAR;
        PG8_WAIT_V(4); PG8_BAR;
        PG8_STAGE(PG8_SB(1, 0), cB + kstep, voffB); PG8_STAGE(PG8_SA(1, 0), cA + kstep, voffA); PG8_STAGE(PG8_SB(1, 1), cB + hstepB + kstep, voffB);
        PG8_WAIT_V(6); PG8_BAR;
    }
    for (;;) {
        const bool has_next = S.next(ui + 1, nxt);
        const char* nA = has_next ? nxt.a : cA; const char* nB = has_next ? nxt.b : cB;
        for (int t = 0; t < nt; t += 2) {
            const bool last = (t == nt - 2);
            const char* a1 = cA + (size_t)(t + 1) * kstep;
            const char* a2 = last ? nA : cA + (size_t)(t + 2) * kstep; const char* b2 = last ? nB : cB + (size_t)(t + 2) * kstep;
            const char* a3 = a2 + kstep; const char* b3 = b2 + kstep;
            if constexpr (SP2) {
            PG8_LDB(B0, 0, 0); PG8_LDB(B1, 0, 1); PG8_SCHED; PG8_LDA(At, 0, 0); PG8_STAGE(PG8_SA(1, 1), a1 + hstep, voffA);
            PG8_WAIT_V(8); PG8_WAIT_L(0); PG8_BAR; PG8_MMA(0, 0, At, B0); PG8_MMA(0, 1, At, B1); PG8_BAR; PG8_SCHED;
            PG8_LDA(At, 0, 1); PG8_STAGE(PG8_SB(0, 0), b2, voffB); PG8_STAGE(PG8_SB(0, 1), b2 + hstepB, voffB); PG8_STAGE(PG8_SA(0, 0), a2, voffA);
            PG8_WAIT_V(8); PG8_WAIT_L(0); PG8_BAR; PG8_MMA(1, 0, At, B0); PG8_MMA(1, 1, At, B1); PG8_BAR; PG8_SCHED;
            PG8_LDB(B0, 1, 0); PG8_LDB(B1, 1, 1); PG8_SCHED; PG8_LDA(At, 1, 0); PG8_STAGE(PG8_SA(0, 1), a2 + hstep, voffA);
            PG8_WAIT_V(8); PG8_WAIT_L(0); PG8_BAR; PG8_MMA(0, 0, At, B0); PG8_MMA(0, 1, At, B1); PG8_BAR; PG8_SCHED;
            PG8_LDA(At, 1, 1); PG8_STAGE(PG8_SB(1, 0), b3, voffB); PG8_STAGE(PG8_SB(1, 1), b3 + hstepB, voffB); PG8_STAGE(PG8_SA(1, 0), a3, voffA);
            PG8_WAIT_V(8); PG8_WAIT_L(0); PG8_BAR; PG8_MMA(1, 0, At, B0); PG8_MMA(1, 1, At, B1); PG8_BAR; PG8_SCHED;
            } else {
            PG8_LDB(B0, 0, 0); PG8_SCHED; PG8_LDA(At, 0, 0); PG8_STAGE(PG8_SA(1, 1), a1 + hstep, voffA);
            PG8_WAIT_L(8); PG8_BAR; PG8_WAIT_L(0); PG8_MMA(0, 0, At, B0); PG8_BAR; PG8_SCHED;
            PG8_LDB(B1, 0, 1); PG8_STAGE(PG8_SB(0, 0), b2, voffB);
            PG8_BAR; PG8_WAIT_L(0); PG8_MMA(0, 1, At, B1); PG8_BAR;
            PG8_LDA(At, 0, 1); PG8_STAGE(PG8_SA(0, 0), a2, voffA);
            PG8_BAR; PG8_WAIT_L(0); PG8_MMA(1, 0, At, B0); PG8_BAR; PG8_SCHED;
            PG8_STAGE(PG8_SB(0, 1), b2 + hstepB, voffB);
            PG8_WAIT_V(6); PG8_BAR; PG8_MMA(1, 1, At, B1); PG8_BAR;
            PG8_LDB(B0, 1, 0); PG8_SCHED; PG8_LDA(At, 1, 0); PG8_STAGE(PG8_SA(0, 1), a2 + hstep, voffA);
            PG8_WAIT_L(8); PG8_BAR; PG8_WAIT_L(0); PG8_MMA(0, 0, At, B0); PG8_BAR; PG8_SCHED;
            PG8_LDB(B1, 1, 1); PG8_STAGE(PG8_SB(1, 0), b3, voffB);
            PG8_BAR; PG8_WAIT_L(0); PG8_MMA(0, 1, At, B1); PG8_BAR;
            PG8_LDA(At, 1, 1); PG8_STAGE(PG8_SA(1, 0), a3, voffA);
            PG8_BAR; PG8_WAIT_L(0); PG8_MMA(1, 0, At, B0); PG8_BAR; PG8_SCHED;
            PG8_STAGE(PG8_SB(1, 1), b3 + hstepB, voffB);
            PG8_WAIT_V(6); PG8_BAR; PG8_MMA(1, 1, At, B1); PG8_BAR;
            }
        }
        if constexpr (ALIGN_EPI) { if (wr == 0) PG8_BAR; }
        E(acc, cur, wr, wc, fr, fq);
        if (!has_next) break;
#pragma unroll
        for (int a = 0; a < 2; ++a)
#pragma unroll
            for (int b = 0; b < 2; ++b)
#pragma unroll
                for (int m = 0; m < 4; ++m)
#pragma unroll
                    for (int n = 0; n < 2; ++n) acc[a][b][m][n] = (f32x4){0.f, 0.f, 0.f, 0.f};
        cur = nxt; cA = nA; cB = nB; ++ui;
        if constexpr (ALIGN_EPI) { if (wr == 1) PG8_BAR; }
    }
    PG8_WAIT_V(0);
    if constexpr (!ALIGN_EPI) { if (wr == 0) PG8_BAR; }
    PG8_BAR;
#undef PG8_SA
#undef PG8_SB
#undef PG8_STAGE
#undef PG8_LDA
#undef PG8_LDB
#undef PG8_MMA
#undef PG8_WAIT_V
#undef PG8_WAIT_L
#undef PG8_BAR
#undef PG8_SCHED
}
}

enum { K_QR = 0, K_KR, K_VR, K_SGR, K_QD, K_KD, K_VD, K_SGD, K_MGR, K_YR, K_MGD, K_YD, K_OUT };
constexpr size_t TSTEP = (size_t)256 * DM * 2;

template <int PC  > struct Epi {
    unsigned char* ws; const float* xin; float* xout; const float* gq; const float* gk;
    __device__ __forceinline__ static void st8(bf16* p, const f32x4 a, const f32x4 b) {
        u32x4 w; w.x = cvt_pk_bf16(a[0], a[1]); w.y = cvt_pk_bf16(a[2], a[3]); w.z = cvt_pk_bf16(b[0], b[1]); w.w = cvt_pk_bf16(b[2], b[3]); *(u32x4*)p = w; }
    __device__ __forceinline__ void operator()(const f32x4 (&acc)[2][2][4][2], const pg8::Unit& u, int wr, int wc, int fr, int fq) const {
        const int row0 = u.pm * 256 + wr * 64 + fr;
        const int cl = wc * 64 + 8 * fq;
        const int kind = u.kind;
        bf16* const qr = (bf16*)(ws + WS_QR); bf16* const kr = (bf16*)(ws + WS_KR); bf16* const vr = (bf16*)(ws + WS_VR); bf16* const sgr = (bf16*)(ws + WS_SGR);
        bf16* const qd = (bf16*)(ws + WS_QD); bf16* const kd = (bf16*)(ws + WS_KD); bf16* const vd = (bf16*)(ws + WS_VD); bf16* const sgd = (bf16*)(ws + WS_SGD);
        bf16* const smgr = (bf16*)(ws + WS_SMGR); bf16* const smgd = (bf16*)(ws + WS_SMGD); bf16* const mbf = (bf16*)(ws + WS_MBF); float* const mbuf = (float*)(ws + WS_MBUF);
        if (PC == 0 && (kind == K_VR || kind == K_VD)) {
            bf16* base = (kind == K_VR ? vr : vd) + u.pn * 256 + cl;
#pragma unroll
            for (int ai = 0; ai < 2; ++ai)
#pragma unroll
                for (int m = 0; m < 4; ++m) { bf16* rp = base + (size_t)(row0 + ai * 128 + m * 16) * 1024;
#pragma unroll
                    for (int bj = 0; bj < 2; ++bj) st8(rp + 32 * bj, acc[ai][bj][m][0], acc[ai][bj][m][1]); }
        } else if (PC == 0 && (kind == K_SGR || kind == K_SGD)) {
            bf16* base = (kind == K_SGR ? sgr : sgd) + u.pn * 256 + cl;
#pragma unroll
            for (int ai = 0; ai < 2; ++ai)
#pragma unroll
                for (int m = 0; m < 4; ++m) { bf16* rp = base + (size_t)(row0 + ai * 128 + m * 16) * 1024;
#pragma unroll
                    for (int bj = 0; bj < 2; ++bj) { f32x4 a = acc[ai][bj][m][0], b = acc[ai][bj][m][1];
#pragma unroll
                        for (int i = 0; i < 4; ++i) { a[i] = a[i] * fast_sigmoid(a[i]); b[i] = b[i] * fast_sigmoid(b[i]); }
                        st8(rp + 32 * bj, a, b); } }
        } else if (PC == 1 && (kind == K_MGR || kind == K_MGD)) {
            bf16* base = (kind == K_MGR ? smgr : smgd) + u.pn * 256 + cl;
#pragma unroll
            for (int ai = 0; ai < 2; ++ai)
#pragma unroll
                for (int m = 0; m < 4; ++m) { bf16* rp = base + (size_t)(row0 + ai * 128 + m * 16) * 1024;
#pragma unroll
                    for (int bj = 0; bj < 2; ++bj) { f32x4 a = acc[ai][bj][m][0], b = acc[ai][bj][m][1];
#pragma unroll
                        for (int i = 0; i < 4; ++i) { a[i] = fast_sigmoid(a[i]); b[i] = fast_sigmoid(b[i]); }
                        st8(rp + 32 * bj, a, b); } }
        } else if (PC == 0 && (kind == K_QR || kind == K_KR)) {
            const int h = u.pn * 4 + wc; const float lg = __log2f(1.0f - __builtin_amdgcn_exp2f(-5.0f - (float)h));
            bf16* base = (kind == K_QR ? qr : kr) + u.pn * 256 + cl;
            const float sgn = (kind == K_QR) ? lg : -lg, mul = (kind == K_QR) ? 1.0f : 0.125f;
#pragma unroll
            for (int ai = 0; ai < 2; ++ai)
#pragma unroll
                for (int m = 0; m < 4; ++m) { const int row = row0 + ai * 128 + m * 16; bf16* rp = base + (size_t)row * 512;
                    const float f = mul * __builtin_amdgcn_exp2f((float)(row & 127) * sgn);
#pragma unroll
                    for (int bj = 0; bj < 2; ++bj) st8(rp + 32 * bj, acc[ai][bj][m][0] * f, acc[ai][bj][m][1] * f); }
        } else if (PC == 0 && (kind == K_QD || kind == K_KD)) {
            const float* g = (kind == K_QD) ? gq : gk; const float mul = (kind == K_QD) ? 0.125f * LOG2E : 1.0f;
            bf16* base = (kind == K_QD ? qd : kd) + u.pn * 256 + cl;
            f32x4 gv[2][2];
#pragma unroll
            for (int bj = 0; bj < 2; ++bj)
#pragma unroll
                for (int n = 0; n < 2; ++n) gv[bj][n] = *(const f32x4*)(g + 32 * bj + 8 * fq + 4 * n) * mul;
#pragma unroll
            for (int ai = 0; ai < 2; ++ai)
#pragma unroll
                for (int m = 0; m < 4; ++m) { bf16* rp = base + (size_t)(row0 + ai * 128 + m * 16) * 1024;
                    float ss = 0.f;
#pragma unroll
                    for (int bj = 0; bj < 2; ++bj)
#pragma unroll
                        for (int n = 0; n < 2; ++n) { const f32x4 x = acc[ai][bj][m][n]; ss += (x[0] * x[0] + x[1] * x[1]) + (x[2] * x[2] + x[3] * x[3]); }
                    ss += __shfl_xor(ss, 16); ss += __shfl_xor(ss, 32);
                    const float rs = __builtin_amdgcn_rsqf(ss * (1.0f / 64.0f) + EPS);
#pragma unroll
                    for (int bj = 0; bj < 2; ++bj) st8(rp + 32 * bj, acc[ai][bj][m][0] * gv[bj][0] * rs, acc[ai][bj][m][1] * gv[bj][1] * rs); }
        } else if (PC == 1 && kind == K_YR) {
            bf16* const yrb = (bf16*)mbuf + (size_t)u.pn * 256 + cl;
#pragma unroll
            for (int ai = 0; ai < 2; ++ai)
#pragma unroll
                for (int m = 0; m < 4; ++m) { bf16* rp = yrb + (size_t)(row0 + ai * 128 + m * 16) * 1024;
#pragma unroll
                    for (int bj = 0; bj < 2; ++bj) st8(rp + 32 * bj, acc[ai][bj][m][0], acc[ai][bj][m][1]); }
        } else if (PC == 1 && kind == K_YD) {
            const size_t cb = (size_t)u.pn * 256 + cl; const bf16* const yrb = (const bf16*)mbuf;
#pragma unroll
            for (int ai = 0; ai < 2; ++ai)
#pragma unroll
                for (int m = 0; m < 4; ++m) { const size_t ro = (size_t)(row0 + ai * 128 + m * 16) * 1024 + cb;
#pragma unroll
                    for (int bj = 0; bj < 2; ++bj) { const u32x4 sr = *(const u32x4*)(smgr + ro + 32 * bj), sd = *(const u32x4*)(smgd + ro + 32 * bj), yr = *(const u32x4*)(yrb + ro + 32 * bj);
                        const f32x4 a = acc[ai][bj][m][0], b = acc[ai][bj][m][1];
                        f32x4 o0, o1;
                        o0[0] = lo_bf(sr.x) * lo_bf(yr.x) + lo_bf(sd.x) * a[0]; o0[1] = hi_bf(sr.x) * hi_bf(yr.x) + hi_bf(sd.x) * a[1];
                        o0[2] = lo_bf(sr.y) * lo_bf(yr.y) + lo_bf(sd.y) * a[2]; o0[3] = hi_bf(sr.y) * hi_bf(yr.y) + hi_bf(sd.y) * a[3];
                        o1[0] = lo_bf(sr.z) * lo_bf(yr.z) + lo_bf(sd.z) * b[0]; o1[1] = hi_bf(sr.z) * hi_bf(yr.z) + hi_bf(sd.z) * b[1];
                        o1[2] = lo_bf(sr.w) * lo_bf(yr.w) + lo_bf(sd.w) * b[2]; o1[3] = hi_bf(sr.w) * hi_bf(yr.w) + hi_bf(sd.w) * b[3];
                        st8(mbf + ro + 32 * bj, o0, o1); }
                    asm volatile("" ::: "memory"); }
        } else if (PC == 2 && kind == K_OUT) {
            const size_t cb = (size_t)u.pn * 256 + cl;
#pragma unroll
            for (int ai = 0; ai < 2; ++ai)
#pragma unroll
                for (int m = 0; m < 4; ++m) { const size_t ro = (size_t)(row0 + ai * 128 + m * 16) * 1024 + cb;
#pragma unroll
                    for (int bj = 0; bj < 2; ++bj) { const f32x4 p0 = *(const f32x4*)(xin + ro + 32 * bj), p1 = *(const f32x4*)(xin + ro + 32 * bj + 4);
                        *(f32x4*)(xout + ro + 32 * bj) = p0 + acc[ai][bj][m][0]; *(f32x4*)(xout + ro + 32 * bj + 4) = p1 + acc[ai][bj][m][1]; }
                    asm volatile("" ::: "memory"); }
        }
    }
};

struct SchedG1A {
    const char* A; const char* B; int G, c;
    __device__ __forceinline__ bool next(int i, pg8::Unit& u) const {
        const int L = i * G + c; if (L >= 64 * 28) return false;
        int pm, pg; pg8::tile_of(L, 64, 28, pm, pg);
        u.pm = pm; u.a = A + (size_t)pm * TSTEP; u.b = B + (size_t)pg * TSTEP;
        if (pg < 2) { u.kind = K_QR; u.pn = pg; } else if (pg < 4) { u.kind = K_KR; u.pn = pg - 2; } else if (pg < 8) { u.kind = K_VR; u.pn = pg - 4; } else if (pg < 12) { u.kind = K_SGR; u.pn = pg - 8; }
        else if (pg < 16) { u.kind = K_QD; u.pn = pg - 12; } else if (pg < 20) { u.kind = K_KD; u.pn = pg - 16; } else if (pg < 24) { u.kind = K_VD; u.pn = pg - 20; } else { u.kind = K_SGD; u.pn = pg - 24; }
        return true;
    }
};
struct SchedP34 {
    const char *ws, *Wro; int c;
    __device__ __forceinline__ bool next(int i, pg8::Unit& u) const {
        if (i >= 4) return false;
        const char* H = ws + WS_H; const char* OR = ws + WS_SGR; const char* OD = ws + WS_SGD; const char* Win = ws + WS_WIN; const char* Wdo = Wro + 2 * MiB;
        int pm, pn; pg8::tile_of(c, 64, 4, pm, pn); u.pm = pm; u.pn = pn;
        if (i == 0) { u.kind = K_MGR; u.a = H + (size_t)pm * TSTEP; u.b = Win + (size_t)(28 + pn) * TSTEP; }
        else if (i == 1) { u.kind = K_MGD; u.a = H + (size_t)pm * TSTEP; u.b = Win + (size_t)(32 + pn) * TSTEP; }
        else if (i == 2) { u.kind = K_YR; u.a = OR + (size_t)pm * TSTEP; u.b = Wro + (size_t)pn * TSTEP; }
        else { u.kind = K_YD; u.a = OD + (size_t)pm * TSTEP; u.b = Wdo + (size_t)pn * TSTEP; }
        return true;
    }
};
struct SchedG4 {
    const char *Mb, *Wout; int c;
    __device__ __forceinline__ bool next(int i, pg8::Unit& u) const {
        if (i >= 1) return false;
        int pm, pn; pg8::tile_of(c, 64, 4, pm, pn); u.pm = pm; u.pn = pn; u.kind = K_OUT; u.a = Mb + (size_t)pm * TSTEP; u.b = Wout + (size_t)pn * TSTEP; return true;
    }
};


namespace att {
typedef float f32x16 __attribute__((ext_vector_type(16)));
typedef short s16x4 __attribute__((ext_vector_type(4)));
typedef short v4i16_t __attribute__((ext_vector_type(4)));
constexpr int SLOT_OFF = 65536, SLOT_BYTES = 32768, V_OFF = 16384;
__device__ __forceinline__ int crow(int r, int hi) { return (r & 3) + 8 * (r >> 2) + 4 * hi; }
__device__ __forceinline__ s16x4 vtr(LAS const unsigned char* p) { return __builtin_bit_cast(s16x4, __builtin_amdgcn_ds_read_tr16_b64_v4i16((LAS v4i16_t*)p)); }
#define ATT_MFMA(a, b, c) __builtin_amdgcn_mfma_f32_32x32x16_bf16(a, b, c, 0, 0, 0)

__device__ __forceinline__ void attn_unit(LAS unsigned char* lds, const unsigned char* ws, const int b, const int h, const int qb, const float lam, const float omli, const float* __restrict__ gsub) {
    int tid_ = threadIdx.x; asm volatile("" : "+v"(tid_));
    const int tid = tid_, lane = tid & 63, r32 = lane & 31, hi = lane >> 5, w = __builtin_amdgcn_readfirstlane(tid >> 6);
    const bf16* QD = (const bf16*)(ws + WS_QD); const bf16* KD = (const bf16*)(ws + WS_KD); const bf16* VD = (const bf16*)(ws + WS_VD); bf16* SGD = (bf16*)(ws + WS_SGD);
    const size_t tb = (size_t)b * SEQ; const int q0 = qb * 256, NT = (q0 + 256) / 64;
#pragma unroll
    for (int p = 0; p < 8; ++p) { const bf16* src = QD + (tb + q0 + 32 * w + r32) * 1024 + h * 128 + (p >> 2) * 64 + (p & 3) * 16 + hi * 8;
        __builtin_amdgcn_global_load_lds((const unsigned*)src, (LAS unsigned*)(lds + w * 8192 + p * 1024), 16, 0, 0); }
    const bf16* ksrc = KD + (tb + lane) * 1024 + h * 128 + (w & 7) * 8;
    const bf16* vsrc = VD + (tb + 16 * (w & 3) + (lane >> 2)) * 1024 + h * 128 + (w >> 2) * 32 + (lane & 3) * 8;
#define ATT_STAGE(t, slot) do { _Pragma("unroll") for (int rr = 0; rr < 2; ++rr) { \
        __builtin_amdgcn_global_load_lds((const unsigned*)(ksrc + (size_t)(t) * 65536 + rr * 64), (LAS unsigned*)(lds + SLOT_OFF + (slot) * SLOT_BYTES + (rr * 8 + w) * 1024), 16, 0, 0); \
        __builtin_amdgcn_global_load_lds((const unsigned*)(vsrc + (size_t)(t) * 65536 + rr * 64), (LAS unsigned*)(lds + SLOT_OFF + (slot) * SLOT_BYTES + V_OFF + (rr * 8 + w) * 1024), 16, 0, 0); } } while (0)
    ATT_STAGE(0, 0);
    __syncthreads();
    const float slope = __builtin_amdgcn_exp2f(-(float)(h + 1)) * LOG2E;
    const int n = q0 + 32 * w + r32;
    f32x16 O[2][4];
#pragma unroll
    for (int j = 0; j < 2; ++j)
#pragma unroll
        for (int e = 0; e < 4; ++e)
#pragma unroll
            for (int r = 0; r < 16; ++r) O[j][e][r] = 0.f;
    float lsum[2] = {0.f, 0.f};
    const int qoff = w * 8192 + lane * 16;
    const int koff = hi * 1024 + r32 * 16;
    const int voff = V_OFF + ((lane >> 4) & 1) * 32 + (lane & 3) * 8 + (4 * hi + ((lane & 15) >> 2)) * 64;
    for (int t = 0; t < NT; ++t) {
        if (t + 1 < NT) ATT_STAGE(t + 1, (t + 1) & 1);
        const int k0 = t * 64;
        if (k0 <= q0 + 32 * w + 31) {
            LAS const unsigned char* slot = lds + SLOT_OFF + (t & 1) * SLOT_BYTES;
            float sl = slope; asm volatile("" : "+v"(sl));
            const int dn = n - k0 - 4 * hi; const float base = -sl * (float)dn;
            const bool diag = (k0 + 63 > q0 + 32 * w);
#pragma unroll
            for (int j = 0; j < 2; ++j) {
                f32x16 p0, p1;
#pragma unroll
                for (int r = 0; r < 16; ++r) { const int kc = (r & 3) + 8 * (r >> 2); p0[r] = __builtin_fmaf(sl, (float)kc, base); p1[r] = __builtin_fmaf(sl, (float)(kc + 32), base); }
                if (diag) {
#pragma unroll
                    for (int r = 0; r < 16; ++r) { const int kc = (r & 3) + 8 * (r >> 2); if (kc > dn) p0[r] = -INFINITY; if (kc + 32 > dn) p1[r] = -INFINITY; }
                }
#pragma unroll
                for (int d0 = 0; d0 < 4; ++d0) {
                    const bf16x8 kf0 = *(LAS const bf16x8*)(slot + koff + (j * 8 + 2 * d0) * 1024), kf1 = *(LAS const bf16x8*)(slot + koff + (j * 8 + 2 * d0) * 1024 + 512);
                    const bf16x8 qf = *(LAS const bf16x8*)(lds + qoff + (j * 4 + d0) * 1024);
                    p0 = ATT_MFMA(kf0, qf, p0); p1 = ATT_MFMA(kf1, qf, p1);
                    if (d0 & 1) __builtin_amdgcn_sched_barrier(0);
                }
                float s = 0.f;
#pragma unroll
                for (int r = 0; r < 16; ++r) { p0[r] = __builtin_amdgcn_exp2f(p0[r]); p1[r] = __builtin_amdgcn_exp2f(p1[r]); s += p0[r] + p1[r]; }
                lsum[j] += s;
                u32x4 pw[4];
#pragma unroll
                for (int i = 0; i < 4; ++i) { pw[0][i] = cvt_pk_bf16(p0[2 * i], p0[2 * i + 1]); pw[1][i] = cvt_pk_bf16(p0[8 + 2 * i], p0[9 + 2 * i]); pw[2][i] = cvt_pk_bf16(p1[2 * i], p1[2 * i + 1]); pw[3][i] = cvt_pk_bf16(p1[8 + 2 * i], p1[9 + 2 * i]); }
#pragma unroll
                for (int eb = 0; eb < 4; ++eb)
#pragma unroll
                    for (int ks = 0; ks < 4; ++ks) {
                        const s16x4 vlo = vtr(slot + voff + eb * 4096 + ks * 1024), vhi = vtr(slot + voff + eb * 4096 + ks * 1024 + 512);
                        const bf16x8 vf = (bf16x8){vlo[0], vlo[1], vlo[2], vlo[3], vhi[0], vhi[1], vhi[2], vhi[3]};
                        O[j][eb] = ATT_MFMA(__builtin_bit_cast(bf16x8, pw[ks]), vf, O[j][eb]);
                        if (ks == 3) __builtin_amdgcn_sched_barrier(0);
                    }
            }
        }
        __syncthreads();
    }
    lsum[0] += __shfl_xor(lsum[0], 32); lsum[1] += __shfl_xor(lsum[1], 32);
    LAS float* wsf = (LAS float*)(lds + w * 8192);
    if (hi == 0) { wsf[r32] = 1.0f / lsum[0]; wsf[32 + r32] = lam / lsum[1]; }
    asm volatile("s_waitcnt lgkmcnt(0)" ::: "memory");
    float gv[4];
#pragma unroll
    for (int eb = 0; eb < 4; ++eb) gv[eb] = gsub[h * 128 + eb * 32 + r32] * omli;
#pragma unroll
    for (int r = 0; r < 16; ++r) { const int qr = crow(r, hi); const float i0 = wsf[qr], i1 = wsf[32 + qr];
        float o[4], ss = 0.f;
#pragma unroll
        for (int eb = 0; eb < 4; ++eb) { o[eb] = O[0][eb][r] * i0 - O[1][eb][r] * i1; ss += o[eb] * o[eb]; }
        ss += __shfl_xor(ss, 1); ss += __shfl_xor(ss, 2); ss += __shfl_xor(ss, 4); ss += __shfl_xor(ss, 8); ss += __shfl_xor(ss, 16);
        const float rs = __builtin_amdgcn_rsqf(ss * (1.0f / 128.0f) + EPS);
        bf16* rowp = SGD + (tb + q0 + 32 * w + qr) * 1024 + h * 128 + r32;
#pragma unroll
        for (int eb = 0; eb < 4; ++eb) rowp[eb * 32] = f2bf(o[eb] * rs * gv[eb] * bf2f(rowp[eb * 32]));
    }
    asm volatile("s_waitcnt lgkmcnt(0)" ::: "memory");
    __syncthreads();
#undef ATT_STAGE
}
}

namespace ret {
using att::f32x16; using att::s16x4; using att::crow; using att::vtr;
constexpr int QF = 0, KA = 16384, KT = 32768, VI = 49152, ST = 81920, RED = 98304;
__device__ __forceinline__ void ret_unit(LAS unsigned char* lds, const unsigned char* ws, const int b, const int h, const float* __restrict__ gn) {
    int tid_ = threadIdx.x; asm volatile("" : "+v"(tid_));
    const int tid = tid_, lane = tid & 63, r32 = lane & 31, hi = lane >> 5, w = __builtin_amdgcn_readfirstlane(tid >> 6);
    const int ib = w & 3, eh = w >> 2, dh = w & 1, ebo = w >> 1;
    const bf16* QR = (const bf16*)(ws + WS_QR); const bf16* KR = (const bf16*)(ws + WS_KR); const bf16* VR = (const bf16*)(ws + WS_VR); bf16* SGR = (bf16*)(ws + WS_SGR);
    const size_t tb = (size_t)b * SEQ;
    const float lg = __log2f(1.0f - __builtin_amdgcn_exp2f(-5.0f - (float)h)), gC = __builtin_amdgcn_exp2f(128.0f * lg);
    for (int i = tid; i < 16384 / 16; i += 512) *(LAS u32x4*)(lds + ST + i * 16) = (u32x4){0u, 0u, 0u, 0u};
    f32x16 sblk;
#pragma unroll
    for (int r = 0; r < 16; ++r) sblk[r] = 0.f;
    float gv[2];
#pragma unroll
    for (int eb = 0; eb < 2; ++eb) gv[eb] = gn[h * 128 + 32 * (2 * eh + eb) + r32];
    const int vpat = ((lane >> 4) & 1) * 32 + (lane & 3) * 8 + (4 * hi + ((lane & 15) >> 2)) * 64;
    for (int c = 0; c < SEQ / 128; ++c) {
        const size_t t0 = tb + (size_t)c * 128;
        __syncthreads();
#pragma unroll
        for (int k = 0; k < 2; ++k) { const int p = 2 * w + k;
            { const int i = p >> 2, d0 = p & 3; __builtin_amdgcn_global_load_lds((const unsigned*)(QR + (t0 + 32 * i + r32) * 512 + h * 64 + d0 * 16 + hi * 8), (LAS unsigned*)(lds + QF + p * 1024), 16, 0, 0); }
            { const int ch = p >> 1, kh = p & 1; __builtin_amdgcn_global_load_lds((const unsigned*)(KR + (t0 + 64 * kh + lane) * 512 + h * 64 + ch * 8), (LAS unsigned*)(lds + KA + p * 1024), 16, 0, 0); }
            { const int d2 = p >> 3, kg = p & 7; __builtin_amdgcn_global_load_lds((const unsigned*)(KR + (t0 + 16 * kg + (lane >> 2)) * 512 + h * 64 + d2 * 32 + (lane & 3) * 8), (LAS unsigned*)(lds + KT + p * 1024), 16, 0, 0); } }
#pragma unroll
        for (int k = 0; k < 4; ++k) { const int p = 4 * w + k, eg = p >> 3, kg = p & 7;
            __builtin_amdgcn_global_load_lds((const unsigned*)(VR + (t0 + 16 * kg + (lane >> 2)) * 1024 + h * 128 + eg * 32 + (lane & 3) * 8), (LAS unsigned*)(lds + VI + p * 1024), 16, 0, 0); }
        __syncthreads();
        bf16x8 qf[4];
#pragma unroll
        for (int d0 = 0; d0 < 4; ++d0) qf[d0] = *(LAS const bf16x8*)(lds + QF + (ib * 4 + d0) * 1024 + lane * 16);
        f32x16 O[2];
#pragma unroll
        for (int eb = 0; eb < 2; ++eb)
#pragma unroll
            for (int r = 0; r < 16; ++r) O[eb][r] = 0.f;
#pragma unroll
        for (int jb = 0; jb < 4; ++jb) {
            if (jb <= ib) {
                f32x16 s;
#pragma unroll
                for (int r = 0; r < 16; ++r) s[r] = 0.f;
#pragma unroll
                for (int d0 = 0; d0 < 4; ++d0) { const bf16x8 kf = *(LAS const bf16x8*)(lds + KA + (2 * d0 + hi) * 2048 + (32 * jb + r32) * 16); s = ATT_MFMA(kf, qf[d0], s); }
                if (jb == ib) {
#pragma unroll
                    for (int r = 0; r < 16; ++r) if (crow(r, hi) > r32) s[r] = 0.f;
                }
                u32x4 pw[2];
#pragma unroll
                for (int i = 0; i < 4; ++i) { pw[0][i] = cvt_pk_bf16(s[2 * i], s[2 * i + 1]); pw[1][i] = cvt_pk_bf16(s[8 + 2 * i], s[9 + 2 * i]); }
#pragma unroll
                for (int eb = 0; eb < 2; ++eb)
#pragma unroll
                    for (int ks = 0; ks < 2; ++ks) { LAS const unsigned char* vp = lds + VI + (2 * eh + eb) * 8192 + (2 * jb + ks) * 1024 + vpat;
                        const s16x4 vlo = vtr(vp), vhi = vtr(vp + 512);
                        O[eb] = ATT_MFMA(__builtin_bit_cast(bf16x8, pw[ks]), ((bf16x8){vlo[0], vlo[1], vlo[2], vlo[3], vhi[0], vhi[1], vhi[2], vhi[3]}), O[eb]); }
                __builtin_amdgcn_sched_barrier(0);
            }
        }
#pragma unroll
        for (int eb = 0; eb < 2; ++eb)
#pragma unroll
            for (int d0 = 0; d0 < 4; ++d0) { const bf16x8 sf = *(LAS const bf16x8*)(lds + ST + (32 * (2 * eh + eb) + r32) * 128 + (16 * d0 + 8 * hi) * 2); O[eb] = ATT_MFMA(qf[d0], sf, O[eb]); }
        { f32x16 kv;
#pragma unroll
          for (int r = 0; r < 16; ++r) kv[r] = 0.f;
#pragma unroll
          for (int ks = 0; ks < 8; ++ks) { LAS const unsigned char* kp = lds + KT + dh * 8192 + ks * 1024 + vpat; LAS const unsigned char* vp = lds + VI + ebo * 8192 + ks * 1024 + vpat;
              const s16x4 klo = vtr(kp), khi = vtr(kp + 512), vlo = vtr(vp), vhi = vtr(vp + 512);
              kv = ATT_MFMA(((bf16x8){klo[0], klo[1], klo[2], klo[3], khi[0], khi[1], khi[2], khi[3]}), ((bf16x8){vlo[0], vlo[1], vlo[2], vlo[3], vhi[0], vhi[1], vhi[2], vhi[3]}), kv);
              if (ks & 1) __builtin_amdgcn_sched_barrier(0); }
#pragma unroll
          for (int r = 0; r < 16; ++r) sblk[r] = gC * (sblk[r] + kv[r]); }
        float ss[16];
#pragma unroll
        for (int r = 0; r < 16; ++r) { float s2 = O[0][r] * O[0][r] + O[1][r] * O[1][r];
            s2 += __shfl_xor(s2, 1); s2 += __shfl_xor(s2, 2); s2 += __shfl_xor(s2, 4); s2 += __shfl_xor(s2, 8); s2 += __shfl_xor(s2, 16); ss[r] = s2; }
        if (r32 == 0) {
#pragma unroll
            for (int r = 0; r < 16; ++r) ((LAS float*)(lds + RED))[(32 * ib + crow(r, hi)) * 2 + eh] = ss[r]; }
        __syncthreads();
#pragma unroll
        for (int g = 0; g < 4; ++g) { unsigned long long v = (unsigned long long)cvt_pk_bf16(sblk[4 * g], sblk[4 * g + 1]) | ((unsigned long long)cvt_pk_bf16(sblk[4 * g + 2], sblk[4 * g + 3]) << 32);
            *(LAS unsigned long long*)(lds + ST + (32 * ebo + r32) * 128 + (32 * dh + 8 * g + 4 * hi) * 2) = v; }
#pragma unroll
        for (int r = 0; r < 16; ++r) { const int row = 32 * ib + crow(r, hi); const LAS float* rp = (const LAS float*)(lds + RED) + row * 2;
            const float rs = __builtin_amdgcn_rsqf((rp[0] + rp[1]) * (1.0f / 128.0f) + EPS);
            bf16* gp = SGR + (t0 + row) * 1024 + h * 128 + 32 * (2 * eh) + r32;
#pragma unroll
            for (int eb = 0; eb < 2; ++eb) gp[32 * eb] = f2bf(O[eb][r] * rs * gv[eb] * bf2f(gp[32 * eb])); }
    }
    __syncthreads();
}
}

#define XB_TMO      128
#define XB_XCNT(j)  (256  + 64 * (j))
#define XB_XSUB(j)  (1280 + 64 * (j))
#define XB_XGEN(j)  (2304 + 64 * (j))
#define XB_TOP      3328
#define XB_TOPGEN   3392
#define XCD_BAR_WORDS 3456
#define XB_SPIN_CAP (1u << 18)
__device__ __forceinline__ unsigned xb_ld(unsigned* p)              { return __hip_atomic_load(p, __ATOMIC_RELAXED, __HIP_MEMORY_SCOPE_AGENT); }
__device__ __forceinline__ unsigned xb_add(unsigned* p, unsigned v) { return __hip_atomic_fetch_add(p, v, __ATOMIC_RELAXED, __HIP_MEMORY_SCOPE_AGENT); }
__device__ __forceinline__ unsigned xb_xcc_id() { return (unsigned)__builtin_amdgcn_s_getreg((3 << 11) | 20) & 0xFu; }
#define XB_SPIN(cond, bar) do { unsigned _sp = 0; while (cond) { __builtin_amdgcn_s_sleep(1); \
    if ((++_sp & 255u) == 0u) { if (xb_ld(&(bar)[XB_TMO])) break; if (_sp > XB_SPIN_CAP) { atomicAdd(&(bar)[XB_TMO], 1u); break; } } } } while (0)
struct XcdBarrier { unsigned* bar; unsigned x; volatile LAS unsigned* st; };
__device__ __forceinline__ XcdBarrier xcd_barrier_post(unsigned* bar, volatile LAS unsigned* st) {
    XcdBarrier b; b.bar = bar; b.x = xb_xcc_id(); b.st = st;
    if (threadIdx.x == 0) (void)xb_add(&bar[XB_XCNT(b.x)], 1u);
    return b;
}
__device__ __forceinline__ void xcd_barrier_complete(unsigned* bar, unsigned x, unsigned& nloc, unsigned& nx) {
    const unsigned G = gridDim.x * gridDim.y * gridDim.z;
    unsigned sum, cnt, mine, sp = 0u;
    for (;;) {
        sum = 0u; cnt = 0u; mine = 0u;
#pragma unroll
        for (unsigned j = 0; j < 16; ++j) { const unsigned c = xb_ld(&bar[XB_XCNT(j)]); sum += c; cnt += (c > 0u) ? 1u : 0u; mine = (j == x) ? c : mine; }
        if (sum == G) break;
        __builtin_amdgcn_s_sleep(1);
        if ((++sp & 255u) == 0u) { if (xb_ld(&bar[XB_TMO])) break; if (sp > XB_SPIN_CAP) { atomicAdd(&bar[XB_TMO], 1u); break; } }
    }
    nloc = mine > 0u ? mine : 1u; nx = cnt > 0u ? cnt : 1u;
}
__device__ __forceinline__ void xcd_barrier(const XcdBarrier& b) {
    asm volatile("s_waitcnt vmcnt(0)" ::: "memory");
    __syncthreads();
    if (threadIdx.x == 0) {
        unsigned* bar = b.bar;
        __builtin_amdgcn_s_waitcnt(0);
        unsigned nloc = b.st[0], nx = b.st[1];
        if (nloc == 0u) { xcd_barrier_complete(bar, b.x, nloc, nx); b.st[0] = nloc; b.st[1] = nx; }
        const unsigned old = xb_add(&bar[XB_XSUB(b.x)], 1u);
        const unsigned gen = old / nloc;
        if (old + 1u == (gen + 1u) * nloc) {
            __builtin_amdgcn_fence(__ATOMIC_RELEASE, "agent");
            asm volatile("s_waitcnt vmcnt(0)" ::: "memory");
            const unsigned og = xb_add(&bar[XB_TOP], 1u);
            const unsigned tg = og / nx;
            if (og + 1u == (tg + 1u) * nx) xb_add(&bar[XB_TOPGEN], 1u);
            else XB_SPIN(xb_ld(&bar[XB_TOPGEN]) == tg, bar);
            __builtin_amdgcn_fence(__ATOMIC_ACQUIRE, "agent");
            xb_add(&bar[XB_XGEN(b.x)], 1u);
            asm volatile("s_waitcnt vmcnt(0)" ::: "memory");
        } else {
            XB_SPIN(xb_ld(&bar[XB_XGEN(b.x)]) == gen, bar);
            __builtin_amdgcn_fence(__ATOMIC_ACQUIRE, "agent");
            asm volatile("s_waitcnt vmcnt(0)" ::: "memory");
        }
    }
    __syncthreads();
}

#define LDS_WAIT() asm volatile("s_waitcnt lgkmcnt(0)" ::: "memory")
__device__ __forceinline__ float wave_sum(float v) {
#pragma unroll
    for (int o = 1; o < 64; o <<= 1) v += __shfl_xor(v, o);
    return v;
}
__device__ __forceinline__ void p0_transpose_item(const float* W, int K, int N, bf16* WT, LAS float* scr, int item, int lane) {
    const int nblk = N / 32, kb = item / nblk, nb = item % nblk, k0 = 64 * kb, n0 = 32 * nb;
#pragma unroll 8
    for (int i = 0; i < 32; ++i) { const int kk = 2 * i + (lane >> 5); scr[kk * 33 + (lane & 31)] = W[(size_t)(k0 + kk) * N + n0 + (lane & 31)]; }
    LDS_WAIT(); asm volatile("" ::: "memory");
    const int c = lane & 7;
#pragma unroll
    for (int j = 0; j < 4; ++j) { const int n = (lane >> 3) + 8 * j; const LAS float* s = scr + (8 * c) * 33 + n;
        u32x4 o; o.x = pk2(s[0 * 33], s[1 * 33]); o.y = pk2(s[2 * 33], s[3 * 33]); o.z = pk2(s[4 * 33], s[5 * 33]); o.w = pk2(s[6 * 33], s[7 * 33]);
        *(GAS u32x4*)(WT + (size_t)(n0 + n) * K + k0 + 8 * c) = o; }
    LDS_WAIT(); asm volatile("" ::: "memory");
}
__device__ __forceinline__ void rms_row_to_bf16(const float* xrow, const float* g, bf16* orow, int lane) {
    const GAS f32x4* xr = (const GAS f32x4*)xrow + lane; const GAS f32x4* gr = (const GAS f32x4*)g + lane;
    f32x4 v[4]; float s = 0.f;
#pragma unroll
    for (int j = 0; j < 4; ++j) { v[j] = xr[64 * j]; s += (v[j].x * v[j].x + v[j].y * v[j].y) + (v[j].z * v[j].z + v[j].w * v[j].w); }
    const float rs = 1.0f / sqrtf(wave_sum(s) * (1.f / DM) + EPS);
    GAS unsigned long long* o8 = (GAS unsigned long long*)orow + lane;
#pragma unroll
    for (int j = 0; j < 4; ++j) { const f32x4 gg = gr[64 * j];
        o8[64 * j] = (unsigned long long)pk2(v[j].x * rs * gg.x, v[j].y * rs * gg.y) | ((unsigned long long)pk2(v[j].z * rs * gg.z, v[j].w * rs * gg.w) << 32); }
}

__device__ __forceinline__ const float* in_ptr(int k) {
    typedef __attribute__((address_space(4))) const char* cptr4;
    cptr4 ka = (cptr4)__builtin_amdgcn_kernarg_segment_ptr(); cptr4 kb;
    asm volatile("s_mov_b64 %0, %1" : "=s"(kb) : "s"(ka));
    typedef const float* cfp; typedef __attribute__((address_space(4))) const cfp* cfp4;
    return *(cfp4)(kb + k * 8);
}
constexpr int NWAVES = 8;
constexpr int RING_BYTES = 131072, LDSCTL_OFF = RING_BYTES, MISC_OFF = LDSCTL_OFF + 320, LDS_BYTES = 147456;
struct Args { const float* in[14]; float* out; unsigned char* ws; int ph_lo, ph_hi, li, pad; };
constexpr int N_PHASES = 10;

__global__ void __launch_bounds__(NWAVES * 64, 2) mk_fwd(Args args) {
    extern __shared__ __attribute__((aligned(16))) unsigned char lds_raw[];
    LAS unsigned char* lds = (LAS unsigned char*)lds_raw;
    volatile LAS unsigned* MISC = (volatile LAS unsigned*)(lds + MISC_OFF);
    const int tid = threadIdx.x, lane_k = tid & 63, wave = __builtin_amdgcn_readfirstlane(tid >> 6);
    const int G = gridDim.x, bx = blockIdx.x; const int vcu = (G % 8 == 0) ? (bx % 8) * (G / 8) + bx / 8 : bx;
    unsigned char* const ws_k = (unsigned char*)in_ptr(15);
    unsigned* ctl = (unsigned*)(ws_k + WS_CTL);
    for (int u = tid; u < (LDS_BYTES - LDSCTL_OFF) / 4; u += NWAVES * 64) ((LAS unsigned*)(lds + LDSCTL_OFF))[u] = 0u;
    __syncthreads();
    const int lo = args.ph_lo, hi = args.ph_hi;
    XcdBarrier bar; bar.bar = ctl + CW_BAR + args.li * XCD_BAR_WORDS; bar.x = 0; bar.st = nullptr;
    if (hi - lo > 1) bar = xcd_barrier_post(ctl + CW_BAR + args.li * XCD_BAR_WORDS, MISC + 8);
#define IN(k) (lo <= (k) && (k) < hi)
#define SEAM(k) do { if (IN(k) && IN((k) + 1)) xcd_barrier(bar); } while (0)

    if (IN(0)) {
        unsigned char* const ws = ws_k; int lane = lane_k; asm volatile("" : "+v"(lane));
        bf16* Wt_in = (bf16*)(ws + WS_WIN); bf16* H = (bf16*)(ws + WS_H);
        LAS float* scr = (LAS float*)(lds + wave * 16384);
        const int gw = vcu * NWAVES + wave, NGW = G * NWAVES;
        constexpr int I_IN = (DM / 64) * (NIN / 32), I_SQ = (DM / 64) * (DM / 32);
        for (int it = gw; it < I_IN + 6 * I_SQ; it += NGW) {
            int r = it;
            if (r < I_IN) { p0_transpose_item(in_ptr(2), DM, NIN, Wt_in, scr, r, lane); continue; } r -= I_IN;
            const int which = r / I_SQ, item = r % I_SQ, l = which / 3, w = which % 3;
            const float* src = (w == 0 ? in_ptr(4) : w == 1 ? in_ptr(12) : in_ptr(13)) + (size_t)l * DM * DM;
            bf16* dst = (bf16*)(ws + (l == 0 ? WS_WRO : WS_W1) + (size_t)w * 2 * MiB);
            p0_transpose_item(src, DM, DM, dst, scr, item, lane);
        }
        const float* x0 = in_ptr(0); const float* g0 = in_ptr(1);
        for (int m = gw; m < T; m += NGW) rms_row_to_bf16(x0 + (size_t)m * DM, g0, H + (size_t)m * DM, lane);
        LDS_WAIT(); __syncthreads();
    }
    SEAM(0);

#pragma unroll 1
    for (int l = 0; l < DEPTH; ++l) {
        const int pb = 1 + 5 * l;
        if (IN(pb)) {
            unsigned char* const ws = ws_k;
            Epi<0> E; E.ws = ws; E.xin = nullptr; E.xout = nullptr; E.gq = in_ptr(5) + l * 64; E.gk = in_ptr(6) + l * 64;
            SchedG1A S{(const char*)(ws + WS_H), (const char*)(ws + WS_WIN), G, bx};
            pg8::gemm_phase<Epi<0>, SchedG1A, true, true>(lds, DM, S, E);
        }
        SEAM(pb);
        if (IN(pb + 1)) {
            unsigned char* const ws = ws_k;
            float s1 = 0.f, s2 = 0.f; { const float* q1 = in_ptr(7) + l * 64; const float* k1 = in_ptr(8) + l * 64; const float* q2 = in_ptr(9) + l * 64; const float* k2 = in_ptr(10) + l * 64;
                for (int i = 0; i < 64; ++i) { s1 += q1[i] * k1[i]; s2 += q2[i] * k2[i]; } }
            const float lam_init = 0.8f - 0.6f * __expf(-0.3f * (float)l), lam = __expf(s1) - __expf(s2) + lam_init;
            const float* gsub = in_ptr(11) + l * 1024;
            if (bx < 32) ret::ret_unit(lds, ws, bx >> 3, bx & 7, in_ptr(3) + l * 1024);
            const int bh = bx >> 3, s = bx & 7;
#pragma unroll 1
            for (int i = 0; i < 2; ++i) att::attn_unit(lds, ws, bh >> 3, bh & 7, i == 0 ? s : 15 - s, lam, 1.0f - lam_init, gsub);
        }
        SEAM(pb + 1);
        if (IN(pb + 2)) {
            unsigned char* const ws = ws_k;
            Epi<1> E; E.ws = ws; E.xin = nullptr; E.xout = nullptr; E.gq = nullptr; E.gk = nullptr;
            SchedP34 S{(const char*)ws, (const char*)(ws + (l == 0 ? WS_WRO : WS_W1)), bx};
            pg8::gemm_phase<Epi<1>, SchedP34, true, true>(lds, DM, S, E);
        }
        SEAM(pb + 2);
        if (IN(pb + 3)) {
            unsigned char* const ws = ws_k;
            Epi<2> E; E.ws = ws; E.xin = (l == 0) ? in_ptr(0) : (const float*)in_ptr(14); E.xout = (float*)in_ptr(14); E.gq = nullptr; E.gk = nullptr;
            SchedG4 S{(const char*)(ws + WS_MBF), (const char*)(ws + (l == 0 ? WS_WRO : WS_W1) + 4 * MiB), bx};
            pg8::gemm_phase<Epi<2>, SchedG4, false, true>(lds, DM, S, E);
        }
        SEAM(pb + 3);
        if (l == 0) {
            if (IN(5)) {
                unsigned char* const ws = ws_k; int lane = lane_k; asm volatile("" : "+v"(lane));
                bf16* Wt_in = (bf16*)(ws + WS_WIN); bf16* H = (bf16*)(ws + WS_H);
                LAS float* scr = (LAS float*)(lds + wave * 16384);
                const int gw = vcu * NWAVES + wave, NGW = G * NWAVES;
                constexpr int I_IN = (DM / 64) * (NIN / 32);
                const float* w1 = in_ptr(2) + (size_t)DM * NIN;
                for (int it = gw; it < I_IN; it += NGW) p0_transpose_item(w1, DM, NIN, Wt_in, scr, it, lane);
                const float* x1 = in_ptr(14); const float* g1 = in_ptr(1) + DM;
                for (int m = gw; m < T; m += NGW) rms_row_to_bf16(x1 + (size_t)m * DM, g1, H + (size_t)m * DM, lane);
                LDS_WAIT(); __syncthreads();
            }
            SEAM(5);
        }
    }
#undef IN
#undef SEAM
}

__global__ void __launch_bounds__(128) k_ret_naive(const bf16* __restrict__ QR, const bf16* __restrict__ KR, const bf16* __restrict__ VR, bf16* SGR, const float* __restrict__ gn) {
    __shared__ float qs[16][64];
    __shared__ float ks[32][65];
    __shared__ float vs[32][128];
    __shared__ float ps[16][32];
    __shared__ float rsv[16];
    const int tid = threadIdx.x, qb = blockIdx.x & 255, bh = blockIdx.x >> 8, h = bh & 7, b = bh >> 3;
    const int n0 = qb * 16; const size_t tb = (size_t)b * SEQ;
    const float lg2 = log2f(1.0f - exp2f(-5.0f - (float)h));
    for (int i = tid; i < 16 * 64; i += 128) qs[i >> 6][i & 63] = bf2f(QR[(tb + n0 + (i >> 6)) * 512 + h * 64 + (i & 63)]);
    float acc[16];
#pragma unroll
    for (int r = 0; r < 16; ++r) acc[r] = 0.f;
    for (int k0 = 0; k0 < n0 + 16; k0 += 32) {
        __syncthreads();
        for (int i = tid; i < 32 * 64; i += 128) ks[i >> 6][i & 63] = bf2f(KR[(tb + k0 + (i >> 6)) * 512 + h * 64 + (i & 63)]);
        for (int i = tid; i < 32 * 128; i += 128) vs[i >> 7][i & 127] = bf2f(VR[(tb + k0 + (i >> 7)) * 1024 + h * 128 + (i & 127)]);
        __syncthreads();
        const float cf = exp2f(128.0f * (float)((n0 >> 7) - (k0 >> 7)) * lg2);
        for (int i = tid; i < 16 * 32; i += 128) { const int r = i >> 5, kk = i & 31; float d = 0.f;
            for (int c = 0; c < 64; ++c) d += qs[r][c] * ks[kk][c];
            const int dist = (n0 + r) - (k0 + kk);
            ps[r][kk] = dist >= 0 ? d * cf : 0.f; }
        __syncthreads();
#pragma unroll
        for (int r = 0; r < 16; ++r) { float a = acc[r];
            for (int kk = 0; kk < 32; ++kk) a += ps[r][kk] * vs[kk][tid];
            acc[r] = a; }
    }
    __syncthreads();
    for (int r = 0; r < 16; ++r) vs[r][tid] = acc[r];
    __syncthreads();
    if (tid < 16) { float s = 0.f; for (int e = 0; e < 128; ++e) s += vs[tid][e] * vs[tid][e]; rsv[tid] = 1.0f / sqrtf(s * (1.0f / 128.0f) + EPS); }
    __syncthreads();
    for (int r = 0; r < 16; ++r) { const size_t o = (tb + n0 + r) * 1024 + h * 128 + tid; SGR[o] = f2bf(acc[r] * rsv[r] * gn[h * 128 + tid] * bf2f(SGR[o])); }
}

__global__ void __launch_bounds__(128) k_attn_naive(const bf16* __restrict__ QD, const bf16* __restrict__ KD, const bf16* __restrict__ VD, bf16* SGD, const float* __restrict__ lq1, const float* __restrict__ lk1,
                                                    const float* __restrict__ lq2, const float* __restrict__ lk2, const float* __restrict__ gn, float lam_init) {
    __shared__ float qs[2][16][64];
    __shared__ float ks[2][32][65];
    __shared__ float vs[32][128];
    __shared__ float ps[2][16][32];
    __shared__ float mrow[2][16], lrow[2][16], arow[2][16], rsv[16];
    const int tid = threadIdx.x, qb = blockIdx.x & 255, bh = blockIdx.x >> 8, h = bh & 7, b = bh >> 3;
    const int n0 = qb * 16; const size_t tb = (size_t)b * SEQ;
    float s1 = 0.f, s2 = 0.f;
    for (int i = 0; i < 64; ++i) { s1 += lq1[i] * lk1[i]; s2 += lq2[i] * lk2[i]; }
    const float lam = expf(s1) - expf(s2) + lam_init;
    const float slope = exp2f(-(float)(h + 1)) * LOG2E;
    for (int i = tid; i < 2 * 16 * 64; i += 128) { const int j = i >> 10, r = (i >> 6) & 15, d = i & 63; qs[j][r][d] = bf2f(QD[(tb + n0 + r) * 1024 + h * 128 + j * 64 + d]); }
    if (tid < 32) { mrow[tid >> 4][tid & 15] = -INFINITY; lrow[tid >> 4][tid & 15] = 0.f; }
    float acc[2][16];
#pragma unroll
    for (int j = 0; j < 2; ++j)
#pragma unroll
        for (int r = 0; r < 16; ++r) acc[j][r] = 0.f;
    for (int k0 = 0; k0 < n0 + 16; k0 += 32) {
        __syncthreads();
        for (int i = tid; i < 2 * 32 * 64; i += 128) { const int j = i >> 11, kk = (i >> 6) & 31, d = i & 63; ks[j][kk][d] = bf2f(KD[(tb + k0 + kk) * 1024 + h * 128 + j * 64 + d]); }
        for (int i = tid; i < 32 * 128; i += 128) vs[i >> 7][i & 127] = bf2f(VD[(tb + k0 + (i >> 7)) * 1024 + h * 128 + (i & 127)]);
        __syncthreads();
        for (int i = tid; i < 2 * 16 * 32; i += 128) { const int j = i >> 9, r = (i >> 5) & 15, kk = i & 31; float d = 0.f;
            for (int c = 0; c < 64; ++c) d += qs[j][r][c] * ks[j][kk][c];
            const int dist = (n0 + r) - (k0 + kk);
            ps[j][r][kk] = dist >= 0 ? d - slope * (float)dist : -INFINITY; }
        __syncthreads();
        if (tid < 32) { const int j = tid >> 4, r = tid & 15; float mx = mrow[j][r];
            for (int kk = 0; kk < 32; ++kk) mx = fmaxf(mx, ps[j][r][kk]);
            const float al = exp2f(mrow[j][r] - mx); float sum = 0.f;
            for (int kk = 0; kk < 32; ++kk) { const float p = exp2f(ps[j][r][kk] - mx); ps[j][r][kk] = p; sum += p; }
            lrow[j][r] = lrow[j][r] * al + sum; arow[j][r] = al; mrow[j][r] = mx; }
        __syncthreads();
#pragma unroll
        for (int j = 0; j < 2; ++j)
#pragma unroll
            for (int r = 0; r < 16; ++r) { float a = acc[j][r] * arow[j][r];
                for (int kk = 0; kk < 32; ++kk) a += ps[j][r][kk] * vs[kk][tid];
                acc[j][r] = a; }
    }
    __syncthreads();
    float o[16];
#pragma unroll
    for (int r = 0; r < 16; ++r) { o[r] = acc[0][r] / lrow[0][r] - lam * acc[1][r] / lrow[1][r]; vs[r][tid] = o[r]; }
    __syncthreads();
    if (tid < 16) { float s = 0.f; for (int e = 0; e < 128; ++e) s += vs[tid][e] * vs[tid][e]; rsv[tid] = 1.0f / sqrtf(s * (1.0f / 128.0f) + EPS); }
    __syncthreads();
    for (int r = 0; r < 16; ++r) { const size_t oo = (tb + n0 + r) * 1024 + h * 128 + tid; SGD[oo] = f2bf(o[r] * rsv[r] * gn[h * 128 + tid] * (1.0f - lam_init) * bf2f(SGD[oo])); }
}


extern "C" void kernel_launch(void* const* d_in, const int* in_sizes, int n_in, void* d_out, int out_size, void* d_ws, size_t ws_size, hipStream_t stream) {
    static int ready = 0;
    if (ready == 0) {
        if (n_in != 14 || ws_size < WS_END || out_size != T * DM) { fprintf(stderr, "kernel_launch: unexpected problem (n_in %d, ws %zu, out %d)\n", n_in, ws_size, out_size); ready = -1; return; }
        if (hipFuncSetAttribute((const void*)mk_fwd, hipFuncAttributeMaxDynamicSharedMemorySize, LDS_BYTES) != hipSuccess) { fprintf(stderr, "kernel_launch: hipFuncSetAttribute failed\n"); ready = -1; return; }
        ready = 1;
    }
    if (ready < 0) return;
    (void)hipMemsetAsync((char*)d_ws + WS_CTL, 0, CTL_ZERO_BYTES, stream);
    Args a{};
    for (int i = 0; i < 14; ++i) a.in[i] = (const float*)d_in[i];
    a.out = (float*)d_out; a.ws = (unsigned char*)d_ws;
    char* ws = (char*)d_ws;
    const float* ret_norm_g = (const float*)d_in[3]; const float* sub_g = (const float*)d_in[11];
    const float* lq1 = (const float*)d_in[7]; const float* lk1 = (const float*)d_in[8]; const float* lq2 = (const float*)d_in[9]; const float* lk2 = (const float*)d_in[10];
    a.ph_lo = 0; a.ph_hi = N_PHASES; a.li = 0;
    hipLaunchKernelGGL(mk_fwd, dim3(256), dim3(NWAVES * 64), LDS_BYTES, stream, a);
}
```

```cpp
#include <hip/hip_runtime.h>
#include <cstdio>
#include <cstdint>
#include <cstddef>

constexpr int DM = 1024, BATCH = 4, SEQ = 4096, DEPTH = 2, T = BATCH * SEQ, NIN = 9216;
constexpr float EPS = 1e-6f;
constexpr float LOG2E = 1.4426950408889634f;

typedef unsigned short bf16;
typedef short bf16x8 __attribute__((ext_vector_type(8)));
typedef float f32x4 __attribute__((ext_vector_type(4)));
typedef unsigned u32x4 __attribute__((ext_vector_type(4)));
#define LAS __attribute__((address_space(3)))
#define GAS __attribute__((address_space(1)))

__device__ __forceinline__ float bf2f(bf16 v) { return __uint_as_float(((unsigned)v) << 16); }
__device__ __forceinline__ unsigned f2bf_u(float f) { unsigned u = __float_as_uint(f); return (u + 0x7fffu + ((u >> 16) & 1u)) >> 16; }
__device__ __forceinline__ bf16 f2bf(float f) { return (bf16)f2bf_u(f); }
__device__ __forceinline__ unsigned pk2(float lo, float hi) { return f2bf_u(lo) | (f2bf_u(hi) << 16); }
typedef float f32x2_t __attribute__((ext_vector_type(2))); typedef __bf16 bf16x2_t __attribute__((ext_vector_type(2)));
__device__ __forceinline__ unsigned cvt_pk_bf16(float lo, float hi) { f32x2_t v = {lo, hi}; bf16x2_t b = __builtin_convertvector(v, bf16x2_t); return __builtin_bit_cast(unsigned, b); }
__device__ __forceinline__ float fast_sigmoid(float v) { return __builtin_amdgcn_rcpf(1.0f + __builtin_amdgcn_exp2f(-v * LOG2E)); }
__device__ __forceinline__ float lo_bf(unsigned w) { return __uint_as_float(w << 16); }
__device__ __forceinline__ float hi_bf(unsigned w) { return __uint_as_float(w & 0xffff0000u); }

constexpr size_t MiB = 1u << 20;
constexpr size_t WS_CTL = 0, CTL_ZERO_BYTES = 1 * MiB;
constexpr size_t WS_WIN = 1 * MiB, WS_WRO = 19 * MiB, WS_WDO = 21 * MiB, WS_WOUT = 23 * MiB;
constexpr size_t WS_H = 25 * MiB, WS_QR = 57 * MiB, WS_KR = 73 * MiB, WS_VR = 89 * MiB, WS_SGR = 121 * MiB, WS_QD = 153 * MiB, WS_KD = 185 * MiB,
                 WS_VD = 217 * MiB, WS_SGD = 249 * MiB;
constexpr size_t WS_W1 = 281 * MiB;
constexpr size_t WS_END = 287 * MiB;
constexpr size_t WS_MBUF = 57 * MiB;
constexpr size_t WS_MBF = WS_VD;
constexpr size_t WS_SMGR = WS_QD, WS_SMGD = WS_KD;
constexpr int CW_BAR = 4096;

namespace pg8 {
constexpr int BM = 256, BK = 64, HALF = 128, HTB = HALF * BK * 2, STAGE_BYTES = 8 * HTB, NXCD = 8, WGM = 8;
__host__ __device__ __forceinline__ int lds_byte(int r, int c) { const int st = (r >> 4) * 2 + (c >> 5), rr = r & 15, cc = c & 31, ob = rr * 64 + cc * 2; return st * 1024 + (ob ^ (((ob >> 9) & 1) << 5)); }
__host__ __device__ __forceinline__ void stage_rc(int b, int& R, int& C) { const int st = b / 1024, sb = b % 1024, swz = sb ^ (((sb >> 9) & 1) << 5); R = (st >> 1) * 16 + swz / 64; C = (st & 1) * 32 + (swz % 64) / 2; }
__host__ __device__ __forceinline__ int perm32(int rho) { const int n = rho >> 4, i = rho & 15; return 8 * (i >> 2) + 4 * n + (i & 3); }

struct Unit { int pm, pn, kind; const char* a; const char* b; };

__device__ __forceinline__ void tile_of(int L, int nM, int nN, int& pm, int& pn) {
    const int nwg = nM * nN; int wgid = L;
    { const int q = nwg / NXCD, r = nwg % NXCD, xcd = wgid % NXCD, off = wgid / NXCD; wgid = (xcd < r ? xcd * (q + 1) : r * (q + 1) + (xcd - r) * q) + off; }
    const int nig = WGM * nN, gid = wgid / nig, fm = gid * WGM, gsz = (nM - fm) < WGM ? (nM - fm) : WGM;
    pm = fm + ((wgid % nig) % gsz); pn = (wgid % nig) / gsz;
}

template <class Epi, class Sched, bool ALIGN_EPI, bool SP2>
__device__ __forceinline__ void gemm_phase(LAS unsigned char* lds, const int K, const Sched& S, const Epi& E) {
    int tid_ = threadIdx.x; asm volatile("" : "+v"(tid_));
    const int tid = tid_, wid = __builtin_amdgcn_readfirstlane(tid >> 6), lane = tid & 63, wr = wid >> 2, wc = wid & 3, fr = lane & 15, fq = lane >> 4;
    const int nt = K / BK;
    unsigned voffA[2], voffB[2];
#pragma unroll
    for (int i = 0; i < 2; ++i) { int R, C; stage_rc(tid * 16 + i * 8192, R, C); const int Rb = (R >> 5) * 64 + perm32(R & 31);
        voffA[i] = (unsigned)(R * K + C) * 2u; voffB[i] = (unsigned)(Rb * K + C) * 2u; }
    const size_t kstep = (size_t)(BK * 2);
    const size_t hstep = (size_t)HALF * K * 2;
    const size_t hstepB = (size_t)32 * K * 2;
    const unsigned ldsw = (unsigned)wid * 1024u;
    const int aoff = lds_byte(wr * 64 + fr, fq * 8), boff = lds_byte(wc * 32 + fr, fq * 8);
#define PG8_SA(b, h) (((b) * 2 + (h)) * HTB)
#define PG8_SB(b, h) ((4 + (b) * 2 + (h)) * HTB)
#define PG8_STAGE(bufoff, gbase, voff) do { _Pragma("unroll") for (int _i = 0; _i < 2; ++_i) \
        __builtin_amdgcn_global_load_lds((const unsigned*)((const char*)(gbase) + (voff)[_i]), (LAS unsigned*)(lds + (bufoff) + ldsw + _i * 8192), 16, 0, 0); } while (0)
#define PG8_LDA(dst, b, h) do { _Pragma("unroll") for (int m = 0; m < 4; ++m) _Pragma("unroll") for (int k = 0; k < 2; ++k) dst[m][k] = *(const LAS bf16x8*)(lds + PG8_SA(b, h) + aoff + m * 2048 + k * 1024); } while (0)
#define PG8_LDB(dst, b, h) do { _Pragma("unroll") for (int n = 0; n < 2; ++n) _Pragma("unroll") for (int k = 0; k < 2; ++k) dst[n][k] = *(const LAS bf16x8*)(lds + PG8_SB(b, h) + boff + n * 2048 + k * 1024); } while (0)
#define PG8_MMA(ai, bj, At, Bt) do { __builtin_amdgcn_s_setprio(1); _Pragma("unroll") for (int m = 0; m < 4; ++m) _Pragma("unroll") for (int n = 0; n < 2; ++n) _Pragma("unroll") for (int k = 0; k < 2; ++k) \
        acc[ai][bj][m][n] = __builtin_amdgcn_mfma_f32_16x16x32_bf16(Bt[n][k], At[m][k], acc[ai][bj][m][n], 0, 0, 0); __builtin_amdgcn_s_setprio(0); } while (0)
#define PG8_WAIT_V(n) asm volatile("s_waitcnt vmcnt(" #n ")" ::: "memory")
#define PG8_WAIT_L(n) asm volatile("s_waitcnt lgkmcnt(" #n ")" ::: "memory")
#define PG8_BAR __builtin_amdgcn_s_barrier()
#define PG8_SCHED __builtin_amdgcn_sched_barrier(0)
    Unit cur, nxt; int ui = 0;
    if (!S.next(0, cur)) return;
    f32x4 acc[2][2][4][2];
#pragma unroll
    for (int a = 0; a < 2; ++a)
#pragma unroll
        for (int b = 0; b < 2; ++b)
#pragma unroll
            for (int m = 0; m < 4; ++m)
#pragma unroll
                for (int n = 0; n < 2; ++n) acc[a][b][m][n] = (f32x4){0.f, 0.f, 0.f, 0.f};
    bf16x8 At[4][2], B0[2][2], B1[2][2];
    const char* cA = cur.a; const char* cB = cur.b;
    if constexpr (SP2) {
        PG8_STAGE(PG8_SB(0, 0), cB, voffB); PG8_STAGE(PG8_SB(0, 1), cB + hstepB, voffB); PG8_STAGE(PG8_SA(0, 0), cA, voffA); PG8_STAGE(PG8_SA(0, 1), cA + hstep, voffA);
        if (wr == 1) PG8_BAR;
        PG8_WAIT_V(2); PG8_BAR;
        PG8_STAGE(PG8_SB(1, 0), cB + kstep, voffB); PG8_STAGE(PG8_SA(1, 0), cA + kstep, voffA); PG8_STAGE(PG8_SB(1, 1), cB + hstepB + kstep, voffB);
        PG8_WAIT_V(6); PG8_BAR;
    } else {
        PG8_STAGE(PG8_SB(0, 0), cB, voffB); PG8_STAGE(PG8_SA(0, 0), cA, voffA); PG8_STAGE(PG8_SB(0, 1), cB + hstepB, voffB); PG8_STAGE(PG8_SA(0, 1), cA + hstep, voffA);
        if (wr == 1) PG8_BAR;
        PG8_WAIT_V(4); PG8_BAR;
        PG8_STAGE(PG8_SB(1, 0), cB + kstep, voffB); PG8_STAGE(PG8_SA(1, 0), cA + kstep, voffA); PG8_STAGE(PG8_SB(1, 1), cB + hstepB + kstep, voffB);
        PG8_WAIT_V(6); PG8_BAR;
    }
    for (;;) {
        const bool has_next = S.next(ui + 1, nxt);
        const char* nA = has_next ? nxt.a : cA; const char* nB = has_next ? nxt.b : cB;
        for (int t = 0; t < nt; t += 2) {
            const bool last = (t == nt - 2);
            const char* a1 = cA + (size_t)(t + 1) * kstep;
            const char* a2 = last ? nA : cA + (size_t)(t + 2) * kstep; const char* b2 = last ? nB : cB + (size_t)(t + 2) * kstep;
            const char* a3 = a2 + kstep; const char* b3 = b2 + kstep;
            if constexpr (SP2) {
            PG8_LDB(B0, 0, 0); PG8_LDB(B1, 0, 1); PG8_SCHED; PG8_LDA(At, 0, 0); PG8_STAGE(PG8_SA(1, 1), a1 + hstep, voffA);
            PG8_WAIT_V(8); PG8_WAIT_L(0); PG8_BAR; PG8_MMA(0, 0, At, B0); PG8_MMA(0, 1, At, B1); PG8_BAR; PG8_SCHED;
            PG8_LDA(At, 0, 1); PG8_STAGE(PG8_SB(0, 0), b2, voffB); PG8_STAGE(PG8_SB(0, 1), b2 + hstepB, voffB); PG8_STAGE(PG8_SA(0, 0), a2, voffA);
            PG8_WAIT_V(8); PG8_WAIT_L(0); PG8_BAR; PG8_MMA(1, 0, At, B0); PG8_MMA(1, 1, At, B1); PG8_BAR; PG8_SCHED;
            PG8_LDB(B0, 1, 0); PG8_LDB(B1, 1, 1); PG8_SCHED; PG8_LDA(At, 1, 0); PG8_STAGE(PG8_SA(0, 1), a2 + hstep, voffA);
            PG8_WAIT_V(8); PG8_WAIT_L(0); PG8_BAR; PG8_MMA(0, 0, At, B0); PG8_MMA(0, 1, At, B1); PG8_BAR; PG8_SCHED;
            PG8_LDA(At, 1, 1); PG8_STAGE(PG8_SB(1, 0), b3, voffB); PG8_STAGE(PG8_SB(1, 1), b3 + hstepB, voffB); PG8_STAGE(PG8_SA(1, 0), a3, voffA);
            PG8_WAIT_V(8); PG8_WAIT_L(0); PG8_BAR; PG8_MMA(1, 0, At, B0); PG8_MMA(1, 1, At, B1); PG8_BAR; PG8_SCHED;
            } else {
            PG8_LDB(B0, 0, 0); PG8_SCHED; PG8_LDA(At, 0, 0); PG8_STAGE(PG8_SA(1, 1), a1 + hstep, voffA);
            PG8_WAIT_L(8); PG8_BAR; PG8_WAIT_L(0); PG8_MMA(0, 0, At, B0); PG8_BAR; PG8_SCHED;
            PG8_LDB(B1, 0, 1); PG8_STAGE(PG8_SB(0, 0), b2, voffB);
            PG8_BAR; PG8_WAIT_L(0); PG8_MMA(0, 1, At, B1); PG8_BAR;
            PG8_LDA(At, 0, 1); PG8_STAGE(PG8_SA(0, 0), a2, voffA);
            PG8_BAR; PG8_WAIT_L(0); PG8_MMA(1, 0, At, B0); PG8_BAR; PG8_SCHED;
            PG8_STAGE(PG8_SB(0, 1), b2 + hstepB, voffB);
            PG8_WAIT_V(6); PG8_BAR; PG8_MMA(1, 1, At, B1); PG8_BAR;
            PG8_LDB(B0, 1, 0); PG8_SCHED; PG8_LDA(At, 1, 0); PG8_STAGE(PG8_SA(0, 1), a2 + hstep, voffA);
            PG8_WAIT_L(8); PG8_BAR; PG8_WAIT_L(0); PG8_MMA(0, 0, At, B0); PG8_BAR; PG8_SCHED;
            PG8_LDB(B1, 1, 1); PG8_STAGE(PG8_SB(1, 0), b3, voffB);
            PG8_BAR; PG8_WAIT_L(0); PG8_MMA(0, 1, At, B1); PG8_BAR;
            PG8_LDA(At, 1, 1); PG8_STAGE(PG8_SA(1, 0), a3, voffA);
            PG8_BAR; PG8_WAIT_L(0); PG8_MMA(1, 0, At, B0); PG8_BAR; PG8_SCHED;
            PG8_STAGE(PG8_SB(1, 1), b3 + hstepB, voffB);
            PG8_WAIT_V(6); PG8_BAR; PG8_MMA(1, 1, At, B1); PG8_BAR;
            }
        }
        if constexpr (ALIGN_EPI) { if (wr == 0) PG8_BAR; }
        E(acc, cur, wr, wc, fr, fq);
        if (!has_next) break;
#pragma unroll
        for (int a = 0; a < 2; ++a)
#pragma unroll
            for (int b = 0; b < 2; ++b)
#pragma unroll
                for (int m = 0; m < 4; ++m)
#pragma unroll
                    for (int n = 0; n < 2; ++n) acc[a][b][m][n] = (f32x4){0.f, 0.f, 0.f, 0.f};
        cur = nxt; cA = nA; cB = nB; ++ui;
        if constexpr (ALIGN_EPI) { if (wr == 1) PG8_BAR; }
    }
    PG8_WAIT_V(0);
    if constexpr (!ALIGN_EPI) { if (wr == 0) PG8_BAR; }
    PG8_BAR;
#undef PG8_SA
#undef PG8_SB
#undef PG8_STAGE
#undef PG8_LDA
#undef PG8_LDB
#undef PG8_MMA
#undef PG8_WAIT_V
#undef PG8_WAIT_L
#undef PG8_BAR
#undef PG8_SCHED
}
}

enum { K_QR = 0, K_KR, K_VR, K_SGR, K_QD, K_KD, K_VD, K_SGD, K_MGR, K_YR, K_MGD, K_YD, K_OUT };
constexpr size_t TSTEP = (size_t)256 * DM * 2;

template <int PC  > struct Epi {
    unsigned char* ws; const float* xin; float* xout; const float* gq; const float* gk;
    __device__ __forceinline__ static void st8(bf16* p, const f32x4 a, const f32x4 b) {
        u32x4 w; w.x = cvt_pk_bf16(a[0], a[1]); w.y = cvt_pk_bf16(a[2], a[3]); w.z = cvt_pk_bf16(b[0], b[1]); w.w = cvt_pk_bf16(b[2], b[3]); *(u32x4*)p = w; }
    __device__ __forceinline__ void operator()(const f32x4 (&acc)[2][2][4][2], const pg8::Unit& u, int wr, int wc, int fr, int fq) const {
        const int row0 = u.pm * 256 + wr * 64 + fr;
        const int cl = wc * 64 + 8 * fq;
        const int kind = u.kind;
        bf16* const qr = (bf16*)(ws + WS_QR); bf16* const kr = (bf16*)(ws + WS_KR); bf16* const vr = (bf16*)(ws + WS_VR); bf16* const sgr = (bf16*)(ws + WS_SGR);
        bf16* const qd = (bf16*)(ws + WS_QD); bf16* const kd = (bf16*)(ws + WS_KD); bf16* const vd = (bf16*)(ws + WS_VD); bf16* const sgd = (bf16*)(ws + WS_SGD);
        bf16* const smgr = (bf16*)(ws + WS_SMGR); bf16* const smgd = (bf16*)(ws + WS_SMGD); bf16* const mbf = (bf16*)(ws + WS_MBF); float* const mbuf = (float*)(ws + WS_MBUF);
        if (PC == 0 && (kind == K_VR || kind == K_VD)) {
            bf16* base = (kind == K_VR ? vr : vd) + u.pn * 256 + cl;
#pragma unroll
            for (int ai = 0; ai < 2; ++ai)
#pragma unroll
                for (int m = 0; m < 4; ++m) { bf16* rp = base + (size_t)(row0 + ai * 128 + m * 16) * 1024;
#pragma unroll
                    for (int bj = 0; bj < 2; ++bj) st8(rp + 32 * bj, acc[ai][bj][m][0], acc[ai][bj][m][1]); }
        } else if (PC == 0 && (kind == K_SGR || kind == K_SGD)) {
            bf16* base = (kind == K_SGR ? sgr : sgd) + u.pn * 256 + cl;
#pragma unroll
            for (int ai = 0; ai < 2; ++ai)
#pragma unroll
                for (int m = 0; m < 4; ++m) { bf16* rp = base + (size_t)(row0 + ai * 128 + m * 16) * 1024;
#pragma unroll
                    for (int bj = 0; bj < 2; ++bj) { f32x4 a = acc[ai][bj][m][0], b = acc[ai][bj][m][1];
#pragma unroll
                        for (int i = 0; i < 4; ++i) { a[i] = a[i] * fast_sigmoid(a[i]); b[i] = b[i] * fast_sigmoid(b[i]); }
                        st8(rp + 32 * bj, a, b); } }
        } else if (PC == 1 && (kind == K_MGR || kind == K_MGD)) {
            bf16* base = (kind == K_MGR ? smgr : smgd) + u.pn * 256 + cl;
#pragma unroll
            for (int ai = 0; ai < 2; ++ai)
#pragma unroll
                for (int m = 0; m < 4; ++m) { bf16* rp = base + (size_t)(row0 + ai * 128 + m * 16) * 1024;
#pragma unroll
                    for (int bj = 0; bj < 2; ++bj) { f32x4 a = acc[ai][bj][m][0], b = acc[ai][bj][m][1];
#pragma unroll
                        for (int i = 0; i < 4; ++i) { a[i] = fast_sigmoid(a[i]); b[i] = fast_sigmoid(b[i]); }
                        st8(rp + 32 * bj, a, b); } }
        } else if (PC == 0 && (kind == K_QR || kind == K_KR)) {
            const int h = u.pn * 4 + wc; const float lg = __log2f(1.0f - __builtin_amdgcn_exp2f(-5.0f - (float)h));
            bf16* base = (kind == K_QR ? qr : kr) + u.pn * 256 + cl;
            const float sgn = (kind == K_QR) ? lg : -lg, mul = (kind == K_QR) ? 1.0f : 0.125f;
#pragma unroll
            for (int ai = 0; ai < 2; ++ai)
#pragma unroll
                for (int m = 0; m < 4; ++m) { const int row = row0 + ai * 128 + m * 16; bf16* rp = base + (size_t)row * 512;
                    const float f = mul * __builtin_amdgcn_exp2f((float)(row & 127) * sgn);
#pragma unroll
                    for (int bj = 0; bj < 2; ++bj) st8(rp + 32 * bj, acc[ai][bj][m][0] * f, acc[ai][bj][m][1] * f); }
        } else if (PC == 0 && (kind == K_QD || kind == K_KD)) {
            const float* g = (kind == K_QD) ? gq : gk; const float mul = (kind == K_QD) ? 0.125f * LOG2E : 1.0f;
            bf16* base = (kind == K_QD ? qd : kd) + u.pn * 256 + cl;
            f32x4 gv[2][2];
#pragma unroll
            for (int bj = 0; bj < 2; ++bj)
#pragma unroll
                for (int n = 0; n < 2; ++n) gv[bj][n] = *(const f32x4*)(g + 32 * bj + 8 * fq + 4 * n) * mul;
#pragma unroll
            for (int ai = 0; ai < 2; ++ai)
#pragma unroll
                for (int m = 0; m < 4; ++m) { bf16* rp = base + (size_t)(row0 + ai * 128 + m * 16) * 1024;
                    float ss = 0.f;
#pragma unroll
                    for (int bj = 0; bj < 2; ++bj)
#pragma unroll
                        for (int n = 0; n < 2; ++n) { const f32x4 x = acc[ai][bj][m][n]; ss += (x[0] * x[0] + x[1] * x[1]) + (x[2] * x[2] + x[3] * x[3]); }
                    ss += __shfl_xor(ss, 16); ss += __shfl_xor(ss, 32);
                    const float rs = __builtin_amdgcn_rsqf(ss * (1.0f / 64.0f) + EPS);
#pragma unroll
                    for (int bj = 0; bj < 2; ++bj) st8(rp + 32 * bj, acc[ai][bj][m][0] * gv[bj][0] * rs, acc[ai][bj][m][1] * gv[bj][1] * rs); }
        } else if (PC == 1 && kind == K_YR) {
            bf16* const yrb = (bf16*)mbuf + (size_t)u.pn * 256 + cl;
#pragma unroll
            for (int ai = 0; ai < 2; ++ai)
#pragma unroll
                for (int m = 0; m < 4; ++m) { bf16* rp = yrb + (size_t)(row0 + ai * 128 + m * 16) * 1024;
#pragma unroll
                    for (int bj = 0; bj < 2; ++bj) st8(rp + 32 * bj, acc[ai][bj][m][0], acc[ai][bj][m][1]); }
        } else if (PC == 1 && kind == K_YD) {
            const size_t cb = (size_t)u.pn * 256 + cl; const bf16* const yrb = (const bf16*)mbuf;
#pragma unroll
            for (int ai = 0; ai < 2; ++ai)
#pragma unroll
                for (int m = 0; m < 4; ++m) { const size_t ro = (size_t)(row0 + ai * 128 + m * 16) * 1024 + cb;
#pragma unroll
                    for (int bj = 0; bj < 2; ++bj) { const u32x4 sr = *(const u32x4*)(smgr + ro + 32 * bj), sd = *(const u32x4*)(smgd + ro + 32 * bj), yr = *(const u32x4*)(yrb + ro + 32 * bj);
                        const f32x4 a = acc[ai][bj][m][0], b = acc[ai][bj][m][1];
                        f32x4 o0, o1;
                        o0[0] = lo_bf(sr.x) * lo_bf(yr.x) + lo_bf(sd.x) * a[0]; o0[1] = hi_bf(sr.x) * hi_bf(yr.x) + hi_bf(sd.x) * a[1];
                        o0[2] = lo_bf(sr.y) * lo_bf(yr.y) + lo_bf(sd.y) * a[2]; o0[3] = hi_bf(sr.y) * hi_bf(yr.y) + hi_bf(sd.y) * a[3];
                        o1[0] = lo_bf(sr.z) * lo_bf(yr.z) + lo_bf(sd.z) * b[0]; o1[1] = hi_bf(sr.z) * hi_bf(yr.z) + hi_bf(sd.z) * b[1];
                        o1[2] = lo_bf(sr.w) * lo_bf(yr.w) + lo_bf(sd.w) * b[2]; o1[3] = hi_bf(sr.w) * hi_bf(yr.w) + hi_bf(sd.w) * b[3];
                        st8(mbf + ro + 32 * bj, o0, o1); }
                    asm volatile("" ::: "memory"); }
        } else if (PC == 2 && kind == K_OUT) {
            const size_t cb = (size_t)u.pn * 256 + cl;
#pragma unroll
            for (int ai = 0; ai < 2; ++ai)
#pragma unroll
                for (int m = 0; m < 4; ++m) { const size_t ro = (size_t)(row0 + ai * 128 + m * 16) * 1024 + cb;
#pragma unroll
                    for (int bj = 0; bj < 2; ++bj) { const f32x4 p0 = *(const f32x4*)(xin + ro + 32 * bj), p1 = *(const f32x4*)(xin + ro + 32 * bj + 4);
                        *(f32x4*)(xout + ro + 32 * bj) = p0 + acc[ai][bj][m][0]; *(f32x4*)(xout + ro + 32 * bj + 4) = p1 + acc[ai][bj][m][1]; }
                    asm volatile("" ::: "memory"); }
        }
    }
};

struct SchedG1A {
    const char* A; const char* B; int G, c;
    __device__ __forceinline__ bool next(int i, pg8::Unit& u) const {
        const int L = i * G + c; if (L >= 64 * 28) return false;
        int pm, pg; pg8::tile_of(L, 64, 28, pm, pg);
        u.pm = pm; u.a = A + (size_t)pm * TSTEP; u.b = B + (size_t)pg * TSTEP;
        if (pg < 2) { u.kind = K_QR; u.pn = pg; } else if (pg < 4) { u.kind = K_KR; u.pn = pg - 2; } else if (pg < 8) { u.kind = K_VR; u.pn = pg - 4; } else if (pg < 12) { u.kind = K_SGR; u.pn = pg - 8; }
        else if (pg < 16) { u.kind = K_QD; u.pn = pg - 12; } else if (pg < 20) { u.kind = K_KD; u.pn = pg - 16; } else if (pg < 24) { u.kind = K_VD; u.pn = pg - 20; } else { u.kind = K_SGD; u.pn = pg - 24; }
        return true;
    }
};
struct SchedP34 {
    const char *ws, *Wro; int c;
    __device__ __forceinline__ bool next(int i, pg8::Unit& u) const {
        if (i >= 4) return false;
        const char* H = ws + WS_H; const char* OR = ws + WS_SGR; const char* OD = ws + WS_SGD; const char* Win = ws + WS_WIN; const char* Wdo = Wro + 2 * MiB;
        int pm, pn; pg8::tile_of(c, 64, 4, pm, pn); u.pm = pm; u.pn = pn;
        if (i == 0) { u.kind = K_MGR; u.a = H + (size_t)pm * TSTEP; u.b = Win + (size_t)(28 + pn) * TSTEP; }
        else if (i == 1) { u.kind = K_MGD; u.a = H + (size_t)pm * TSTEP; u.b = Win + (size_t)(32 + pn) * TSTEP; }
        else if (i == 2) { u.kind = K_YR; u.a = OR + (size_t)pm * TSTEP; u.b = Wro + (size_t)pn * TSTEP; }
        else { u.kind = K_YD; u.a = OD + (size_t)pm * TSTEP; u.b = Wdo + (size_t)pn * TSTEP; }
        return true;
    }
};
struct SchedG4 {
    const char *Mb, *Wout; int c;
    __device__ __forceinline__ bool next(int i, pg8::Unit& u) const {
        if (i >= 1) return false;
        int pm, pn; pg8::tile_of(c, 64, 4, pm, pn); u.pm = pm; u.pn = pn; u.kind = K_OUT; u.a = Mb + (size_t)pm * TSTEP; u.b = Wout + (size_t)pn * TSTEP; return true;
    }
};


namespace att {
typedef float f32x16 __attribute__((ext_vector_type(16)));
typedef short s16x4 __attribute__((ext_vector_type(4)));
typedef short v4i16_t __attribute__((ext_vector_type(4)));
constexpr int SLOT_OFF = 65536, SLOT_BYTES = 32768, V_OFF = 16384;
__device__ __forceinline__ int crow(int r, int hi) { return (r & 3) + 8 * (r >> 2) + 4 * hi; }
__device__ __forceinline__ s16x4 vtr(LAS const unsigned char* p) { return __builtin_bit_cast(s16x4, __builtin_amdgcn_ds_read_tr16_b64_v4i16((LAS v4i16_t*)p)); }
#define ATT_MFMA(a, b, c) __builtin_amdgcn_mfma_f32_32x32x16_bf16(a, b, c, 0, 0, 0)

__device__ __forceinline__ void attn_unit(LAS unsigned char* lds, const unsigned char* ws, const int b, const int h, const int qb, const float lam, const float omli, const float* __restrict__ gsub, const int win) {
    int tid_ = threadIdx.x; asm volatile("" : "+v"(tid_));
    const int tid = tid_, lane = tid & 63, r32 = lane & 31, hi = lane >> 5, w = __builtin_amdgcn_readfirstlane(tid >> 6);
    const bf16* QD = (const bf16*)(ws + WS_QD); const bf16* KD = (const bf16*)(ws + WS_KD); const bf16* VD = (const bf16*)(ws + WS_VD); bf16* SGD = (bf16*)(ws + WS_SGD);
    const size_t tb = (size_t)b * SEQ; const int q0 = qb * 256, NT = (q0 + 256) / 64;
    const int T0 = (q0 > win ? q0 - win : 0) >> 6;
#pragma unroll
    for (int p = 0; p < 8; ++p) { const bf16* src = QD + (tb + q0 + 32 * w + r32) * 1024 + h * 128 + (p >> 2) * 64 + (p & 3) * 16 + hi * 8;
        __builtin_amdgcn_global_load_lds((const unsigned*)src, (LAS unsigned*)(lds + w * 8192 + p * 1024), 16, 0, 0); }
    const bf16* ksrc = KD + (tb + lane) * 1024 + h * 128 + (w & 7) * 8;
    const bf16* vsrc = VD + (tb + 16 * (w & 3) + (lane >> 2)) * 1024 + h * 128 + (w >> 2) * 32 + (lane & 3) * 8;
#define ATT_STAGE(t, slot) do { _Pragma("unroll") for (int rr = 0; rr < 2; ++rr) { \
        __builtin_amdgcn_global_load_lds((const unsigned*)(ksrc + (size_t)(t) * 65536 + rr * 64), (LAS unsigned*)(lds + SLOT_OFF + (slot) * SLOT_BYTES + (rr * 8 + w) * 1024), 16, 0, 0); \
        __builtin_amdgcn_global_load_lds((const unsigned*)(vsrc + (size_t)(t) * 65536 + rr * 64), (LAS unsigned*)(lds + SLOT_OFF + (slot) * SLOT_BYTES + V_OFF + (rr * 8 + w) * 1024), 16, 0, 0); } } while (0)
    ATT_STAGE(T0, 0);
    __syncthreads();
    const float slope = __builtin_amdgcn_exp2f(-(float)(h + 1)) * LOG2E;
    const int n = q0 + 32 * w + r32;
    f32x16 O[2][4];
#pragma unroll
    for (int j = 0; j < 2; ++j)
#pragma unroll
        for (int e = 0; e < 4; ++e)
#pragma unroll
            for (int r = 0; r < 16; ++r) O[j][e][r] = 0.f;
    float lsum[2] = {0.f, 0.f};
    const int qoff = w * 8192 + lane * 16;
    const int koff = hi * 1024 + r32 * 16;
    const int voff = V_OFF + ((lane >> 4) & 1) * 32 + (lane & 3) * 8 + (4 * hi + ((lane & 15) >> 2)) * 64;
    for (int t = T0; t < NT; ++t) {
        if (t + 1 < NT) ATT_STAGE(t + 1, (t + 1 - T0) & 1);
        const int k0 = t * 64;
        if (k0 <= q0 + 32 * w + 31) {
            LAS const unsigned char* slot = lds + SLOT_OFF + ((t - T0) & 1) * SLOT_BYTES;
            float sl = slope; asm volatile("" : "+v"(sl));
            const int dn = n - k0 - 4 * hi; const float base = -sl * (float)dn;
            const bool diag = (k0 + 63 > q0 + 32 * w);
#pragma unroll
            for (int j = 0; j < 2; ++j) {
                f32x16 p0, p1;
#pragma unroll
                for (int r = 0; r < 16; ++r) { const int kc = (r & 3) + 8 * (r >> 2); p0[r] = __builtin_fmaf(sl, (float)kc, base); p1[r] = __builtin_fmaf(sl, (float)(kc + 32), base); }
                if (diag) {
#pragma unroll
                    for (int r = 0; r < 16; ++r) { const int kc = (r & 3) + 8 * (r >> 2); if (kc > dn) p0[r] = -INFINITY; if (kc + 32 > dn) p1[r] = -INFINITY; }
                }
#pragma unroll
                for (int d0 = 0; d0 < 4; ++d0) {
                    const bf16x8 kf0 = *(LAS const bf16x8*)(slot + koff + (j * 8 + 2 * d0) * 1024), kf1 = *(LAS const bf16x8*)(slot + koff + (j * 8 + 2 * d0) * 1024 + 512);
                    const bf16x8 qf = *(LAS const bf16x8*)(lds + qoff + (j * 4 + d0) * 1024);
                    p0 = ATT_MFMA(kf0, qf, p0); p1 = ATT_MFMA(kf1, qf, p1);
                    if (d0 & 1) __builtin_amdgcn_sched_barrier(0);
                }
                float s = 0.f;
#pragma unroll
                for (int r = 0; r < 16; ++r) { p0[r] = __builtin_amdgcn_exp2f(p0[r]); p1[r] = __builtin_amdgcn_exp2f(p1[r]); s += p0[r] + p1[r]; }
                lsum[j] += s;
                u32x4 pw[4];
#pragma unroll
                for (int i = 0; i < 4; ++i) { pw[0][i] = cvt_pk_bf16(p0[2 * i], p0[2 * i + 1]); pw[1][i] = cvt_pk_bf16(p0[8 + 2 * i], p0[9 + 2 * i]); pw[2][i] = cvt_pk_bf16(p1[2 * i], p1[2 * i + 1]); pw[3][i] = cvt_pk_bf16(p1[8 + 2 * i], p1[9 + 2 * i]); }
#pragma unroll
                for (int eb = 0; eb < 4; ++eb)
#pragma unroll
                    for (int ks = 0; ks < 4; ++ks) {
                        const s16x4 vlo = vtr(slot + voff + eb * 4096 + ks * 1024), vhi = vtr(slot + voff + eb * 4096 + ks * 1024 + 512);
                        const bf16x8 vf = (bf16x8){vlo[0], vlo[1], vlo[2], vlo[3], vhi[0], vhi[1], vhi[2], vhi[3]};
                        O[j][eb] = ATT_MFMA(__builtin_bit_cast(bf16x8, pw[ks]), vf, O[j][eb]);
                        if (ks == 3) __builtin_amdgcn_sched_barrier(0);
                    }
            }
        }
        __syncthreads();
    }
    lsum[0] += __shfl_xor(lsum[0], 32); lsum[1] += __shfl_xor(lsum[1], 32);
    LAS float* wsf = (LAS float*)(lds + w * 8192);
    if (hi == 0) { wsf[r32] = 1.0f / lsum[0]; wsf[32 + r32] = lam / lsum[1]; }
    asm volatile("s_waitcnt lgkmcnt(0)" ::: "memory");
    float gv[4];
#pragma unroll
    for (int eb = 0; eb < 4; ++eb) gv[eb] = gsub[h * 128 + eb * 32 + r32] * omli;
#pragma unroll
    for (int r = 0; r < 16; ++r) { const int qr = crow(r, hi); const float i0 = wsf[qr], i1 = wsf[32 + qr];
        float o[4], ss = 0.f;
#pragma unroll
        for (int eb = 0; eb < 4; ++eb) { o[eb] = O[0][eb][r] * i0 - O[1][eb][r] * i1; ss += o[eb] * o[eb]; }
        ss += __shfl_xor(ss, 1); ss += __shfl_xor(ss, 2); ss += __shfl_xor(ss, 4); ss += __shfl_xor(ss, 8); ss += __shfl_xor(ss, 16);
        const float rs = __builtin_amdgcn_rsqf(ss * (1.0f / 128.0f) + EPS);
        bf16* rowp = SGD + (tb + q0 + 32 * w + qr) * 1024 + h * 128 + r32;
#pragma unroll
        for (int eb = 0; eb < 4; ++eb) rowp[eb * 32] = f2bf(o[eb] * rs * gv[eb] * bf2f(rowp[eb * 32]));
    }
    asm volatile("s_waitcnt lgkmcnt(0)" ::: "memory");
    __syncthreads();
#undef ATT_STAGE
}
}

namespace ret {
using att::f32x16; using att::s16x4; using att::crow; using att::vtr;
constexpr int QF = 0, KA = 16384, KT = 32768, VI = 49152, ST = 81920, RED = 98304;
__device__ __forceinline__ void ret_unit(LAS unsigned char* lds, const unsigned char* ws, const int b, const int h, const float* __restrict__ gn) {
    int tid_ = threadIdx.x; asm volatile("" : "+v"(tid_));
    const int tid = tid_, lane = tid & 63, r32 = lane & 31, hi = lane >> 5, w = __builtin_amdgcn_readfirstlane(tid >> 6);
    const int ib = w & 3, eh = w >> 2, dh = w & 1, ebo = w >> 1;
    const bf16* QR = (const bf16*)(ws + WS_QR); const bf16* KR = (const bf16*)(ws + WS_KR); const bf16* VR = (const bf16*)(ws + WS_VR); bf16* SGR = (bf16*)(ws + WS_SGR);
    const size_t tb = (size_t)b * SEQ;
    const float lg = __log2f(1.0f - __builtin_amdgcn_exp2f(-5.0f - (float)h)), gC = __builtin_amdgcn_exp2f(128.0f * lg);
    for (int i = tid; i < 16384 / 16; i += 512) *(LAS u32x4*)(lds + ST + i * 16) = (u32x4){0u, 0u, 0u, 0u};
    f32x16 sblk;
#pragma unroll
    for (int r = 0; r < 16; ++r) sblk[r] = 0.f;
    float gv[2];
#pragma unroll
    for (int eb = 0; eb < 2; ++eb) gv[eb] = gn[h * 128 + 32 * (2 * eh + eb) + r32];
    const int vpat = ((lane >> 4) & 1) * 32 + (lane & 3) * 8 + (4 * hi + ((lane & 15) >> 2)) * 64;
    for (int c = 0; c < SEQ / 128; ++c) {
        const size_t t0 = tb + (size_t)c * 128;
        __syncthreads();
#pragma unroll
        for (int k = 0; k < 2; ++k) { const int p = 2 * w + k;
            { const int i = p >> 2, d0 = p & 3; __builtin_amdgcn_global_load_lds((const unsigned*)(QR + (t0 + 32 * i + r32) * 512 + h * 64 + d0 * 16 + hi * 8), (LAS unsigned*)(lds + QF + p * 1024), 16, 0, 0); }
            { const int ch = p >> 1, kh = p & 1; __builtin_amdgcn_global_load_lds((const unsigned*)(KR + (t0 + 64 * kh + lane) * 512 + h * 64 + ch * 8), (LAS unsigned*)(lds + KA + p * 1024), 16, 0, 0); }
            { const int d2 = p >> 3, kg = p & 7; __builtin_amdgcn_global_load_lds((const unsigned*)(KR + (t0 + 16 * kg + (lane >> 2)) * 512 + h * 64 + d2 * 32 + (lane & 3) * 8), (LAS unsigned*)(lds + KT + p * 1024), 16, 0, 0); } }
#pragma unroll
        for (int k = 0; k < 4; ++k) { const int p = 4 * w + k, eg = p >> 3, kg = p & 7;
            __builtin_amdgcn_global_load_lds((const unsigned*)(VR + (t0 + 16 * kg + (lane >> 2)) * 1024 + h * 128 + eg * 32 + (lane & 3) * 8), (LAS unsigned*)(lds + VI + p * 1024), 16, 0, 0); }
        __syncthreads();
        bf16x8 qf[4];
#pragma unroll
        for (int d0 = 0; d0 < 4; ++d0) qf[d0] = *(LAS const bf16x8*)(lds + QF + (ib * 4 + d0) * 1024 + lane * 16);
        f32x16 O[2];
#pragma unroll
        for (int eb = 0; eb < 2; ++eb)
#pragma unroll
            for (int r = 0; r < 16; ++r) O[eb][r] = 0.f;
#pragma unroll
        for (int jb = 0; jb < 4; ++jb) {
            if (jb <= ib) {
                f32x16 s;
#pragma unroll
                for (int r = 0; r < 16; ++r) s[r] = 0.f;
#pragma unroll
                for (int d0 = 0; d0 < 4; ++d0) { const bf16x8 kf = *(LAS const bf16x8*)(lds + KA + (2 * d0 + hi) * 2048 + (32 * jb + r32) * 16); s = ATT_MFMA(kf, qf[d0], s); }
                if (jb == ib) {
#pragma unroll
                    for (int r = 0; r < 16; ++r) if (crow(r, hi) > r32) s[r] = 0.f;
                }
                u32x4 pw[2];
#pragma unroll
                for (int i = 0; i < 4; ++i) { pw[0][i] = cvt_pk_bf16(s[2 * i], s[2 * i + 1]); pw[1][i] = cvt_pk_bf16(s[8 + 2 * i], s[9 + 2 * i]); }
#pragma unroll
                for (int eb = 0; eb < 2; ++eb)
#pragma unroll
                    for (int ks = 0; ks < 2; ++ks) { LAS const unsigned char* vp = lds + VI + (2 * eh + eb) * 8192 + (2 * jb + ks) * 1024 + vpat;
                        const s16x4 vlo = vtr(vp), vhi = vtr(vp + 512);
                        O[eb] = ATT_MFMA(__builtin_bit_cast(bf16x8, pw[ks]), ((bf16x8){vlo[0], vlo[1], vlo[2], vlo[3], vhi[0], vhi[1], vhi[2], vhi[3]}), O[eb]); }
                __builtin_amdgcn_sched_barrier(0);
            }
        }
#pragma unroll
        for (int eb = 0; eb < 2; ++eb)
#pragma unroll
            for (int d0 = 0; d0 < 4; ++d0) { const bf16x8 sf = *(LAS const bf16x8*)(lds + ST + (32 * (2 * eh + eb) + r32) * 128 + (16 * d0 + 8 * hi) * 2); O[eb] = ATT_MFMA(qf[d0], sf, O[eb]); }
        { f32x16 kv;
#pragma unroll
          for (int r = 0; r < 16; ++r) kv[r] = 0.f;
#pragma unroll
          for (int ks = 0; ks < 8; ++ks) { LAS const unsigned char* kp = lds + KT + dh * 8192 + ks * 1024 + vpat; LAS const unsigned char* vp = lds + VI + ebo * 8192 + ks * 1024 + vpat;
              const s16x4 klo = vtr(kp), khi = vtr(kp + 512), vlo = vtr(vp), vhi = vtr(vp + 512);
              kv = ATT_MFMA(((bf16x8){klo[0], klo[1], klo[2], klo[3], khi[0], khi[1], khi[2], khi[3]}), ((bf16x8){vlo[0], vlo[1], vlo[2], vlo[3], vhi[0], vhi[1], vhi[2], vhi[3]}), kv);
              if (ks & 1) __builtin_amdgcn_sched_barrier(0); }
#pragma unroll
          for (int r = 0; r < 16; ++r) sblk[r] = gC * (sblk[r] + kv[r]); }
        float ss[16];
#pragma unroll
        for (int r = 0; r < 16; ++r) { float s2 = O[0][r] * O[0][r] + O[1][r] * O[1][r];
            s2 += __shfl_xor(s2, 1); s2 += __shfl_xor(s2, 2); s2 += __shfl_xor(s2, 4); s2 += __shfl_xor(s2, 8); s2 += __shfl_xor(s2, 16); ss[r] = s2; }
        if (r32 == 0) {
#pragma unroll
            for (int r = 0; r < 16; ++r) ((LAS float*)(lds + RED))[(32 * ib + crow(r, hi)) * 2 + eh] = ss[r]; }
        __syncthreads();
#pragma unroll
        for (int g = 0; g < 4; ++g) { unsigned long long v = (unsigned long long)cvt_pk_bf16(sblk[4 * g], sblk[4 * g + 1]) | ((unsigned long long)cvt_pk_bf16(sblk[4 * g + 2], sblk[4 * g + 3]) << 32);
            *(LAS unsigned long long*)(lds + ST + (32 * ebo + r32) * 128 + (32 * dh + 8 * g + 4 * hi) * 2) = v; }
#pragma unroll
        for (int r = 0; r < 16; ++r) { const int row = 32 * ib + crow(r, hi); const LAS float* rp = (const LAS float*)(lds + RED) + row * 2;
            const float rs = __builtin_amdgcn_rsqf((rp[0] + rp[1]) * (1.0f / 128.0f) + EPS);
            bf16* gp = SGR + (t0 + row) * 1024 + h * 128 + 32 * (2 * eh) + r32;
#pragma unroll
            for (int eb = 0; eb < 2; ++eb) gp[32 * eb] = f2bf(O[eb][r] * rs * gv[eb] * bf2f(gp[32 * eb])); }
    }
    __syncthreads();
}
}

__device__ const unsigned short att_order[512] = {111, 127, 239, 255, 367, 383, 495, 511, 110, 126, 238, 254, 366, 382, 494, 510, 109, 125, 237, 253, 365, 381, 493, 509, 108, 124, 236, 252, 364, 380, 492, 508, 107, 123, 235, 251, 363, 379, 491, 507, 106, 122, 234, 250, 362, 378, 490, 506, 90, 91, 92, 93, 94, 95, 218, 219, 220, 221, 222, 223, 346, 347, 348, 349, 350, 351, 474, 475, 476, 477, 478, 479, 89, 105, 121, 217, 233, 249, 345, 361, 377, 473, 489, 505, 88, 104, 120, 216, 232, 248, 344, 360, 376, 472, 488, 504, 87, 103, 119, 215, 231, 247, 343, 359, 375, 471, 487, 503, 86, 102, 118, 214, 230, 246, 342, 358, 374, 470, 486, 502, 85, 101, 117, 213, 229, 245, 341, 357, 373, 469, 485, 501, 69, 70, 71, 72, 73, 74, 75, 76, 77, 78, 79, 197, 198, 199, 200, 201, 202, 203, 204, 205, 206, 207, 325, 326, 327, 328, 329, 330, 331, 332, 333, 334, 335, 453, 454, 455, 456, 457, 458, 459, 460, 461, 462, 463, 68, 84, 100, 116, 196, 212, 228, 244, 324, 340, 356, 372, 452, 468, 484, 500, 67, 83, 99, 115, 195, 211, 227, 243, 323, 339, 355, 371, 451, 467, 483, 499, 51, 52, 53, 54, 55, 56, 57, 58, 59, 60, 61, 62, 63, 179, 180, 181, 182, 183, 184, 185, 186, 187, 188, 189, 190, 191, 307, 308, 309, 310, 311, 312, 313, 314, 315, 316, 317, 318, 319, 435, 436, 437, 438, 439, 440, 441, 442, 443, 444, 445, 446, 447, 50, 66, 82, 98, 114, 178, 194, 210, 226, 242, 306, 322, 338, 354, 370, 434, 450, 466, 482, 498, 34, 35, 36, 37, 38, 39, 40, 41, 42, 43, 44, 45, 46, 47, 162, 163, 164, 165, 166, 167, 168, 169, 170, 171, 172, 173, 174, 175, 290, 291, 292, 293, 294, 295, 296, 297, 298, 299, 300, 301, 302, 303, 418, 419, 420, 421, 422, 423, 424, 425, 426, 427, 428, 429, 430, 431, 33, 49, 65, 81, 97, 113, 161, 177, 193, 209, 225, 241, 289, 305, 321, 337, 353, 369, 417, 433, 449, 465, 481, 497, 17, 18, 19, 20, 21, 22, 23, 24, 25, 26, 27, 28, 29, 30, 31, 145, 146, 147, 148, 149, 150, 151, 152, 153, 154, 155, 156, 157, 158, 159, 273, 274, 275, 276, 277, 278, 279, 280, 281, 282, 283, 284, 285, 286, 287, 401, 402, 403, 404, 405, 406, 407, 408, 409, 410, 411, 412, 413, 414, 415, 1, 2, 3, 4, 5, 6, 7, 8, 9, 10, 11, 12, 13, 14, 15, 129, 130, 131, 132, 133, 134, 135, 136, 137, 138, 139, 140, 141, 142, 143, 257, 258, 259, 260, 261, 262, 263, 264, 265, 266, 267, 268, 269, 270, 271, 385, 386, 387, 388, 389, 390, 391, 392, 393, 394, 395, 396, 397, 398, 399, 0, 16, 32, 48, 64, 80, 96, 112, 128, 144, 160, 176, 192, 208, 224, 240, 256, 272, 288, 304, 320, 336, 352, 368, 384, 400, 416, 432, 448, 464, 480, 496};
constexpr int CW_QUEUE = 2048;

#define XB_TMO      128
#define XB_XCNT(j)  (256  + 64 * (j))
#define XB_XSUB(j)  (1280 + 64 * (j))
#define XB_XGEN(j)  (2304 + 64 * (j))
#define XB_TOP      3328
#define XB_TOPGEN   3392
#define XCD_BAR_WORDS 3456
#define XB_SPIN_CAP (1u << 18)
__device__ __forceinline__ unsigned xb_ld(unsigned* p)              { return __hip_atomic_load(p, __ATOMIC_RELAXED, __HIP_MEMORY_SCOPE_AGENT); }
__device__ __forceinline__ unsigned xb_add(unsigned* p, unsigned v) { return __hip_atomic_fetch_add(p, v, __ATOMIC_RELAXED, __HIP_MEMORY_SCOPE_AGENT); }
__device__ __forceinline__ unsigned xb_xcc_id() { return (unsigned)__builtin_amdgcn_s_getreg((3 << 11) | 20) & 0xFu; }
#define XB_SPIN(cond, bar) do { unsigned _sp = 0; while (cond) { __builtin_amdgcn_s_sleep(1); \
    if ((++_sp & 255u) == 0u) { if (xb_ld(&(bar)[XB_TMO])) break; if (_sp > XB_SPIN_CAP) { atomicAdd(&(bar)[XB_TMO], 1u); break; } } } } while (0)
struct XcdBarrier { unsigned* bar; unsigned x; volatile LAS unsigned* st; };
__device__ __forceinline__ XcdBarrier xcd_barrier_post(unsigned* bar, volatile LAS unsigned* st) {
    XcdBarrier b; b.bar = bar; b.x = xb_xcc_id(); b.st = st;
    if (threadIdx.x == 0) (void)xb_add(&bar[XB_XCNT(b.x)], 1u);
    return b;
}
__device__ __forceinline__ void xcd_barrier_complete(unsigned* bar, unsigned x, unsigned& nloc, unsigned& nx) {
    const unsigned G = gridDim.x * gridDim.y * gridDim.z;
    unsigned sum, cnt, mine, sp = 0u;
    for (;;) {
        sum = 0u; cnt = 0u; mine = 0u;
#pragma unroll
        for (unsigned j = 0; j < 16; ++j) { const unsigned c = xb_ld(&bar[XB_XCNT(j)]); sum += c; cnt += (c > 0u) ? 1u : 0u; mine = (j == x) ? c : mine; }
        if (sum == G) break;
        __builtin_amdgcn_s_sleep(1);
        if ((++sp & 255u) == 0u) { if (xb_ld(&bar[XB_TMO])) break; if (sp > XB_SPIN_CAP) { atomicAdd(&bar[XB_TMO], 1u); break; } }
    }
    nloc = mine > 0u ? mine : 1u; nx = cnt > 0u ? cnt : 1u;
}
__device__ __forceinline__ void xcd_barrier(const XcdBarrier& b) {
    asm volatile("s_waitcnt vmcnt(0)" ::: "memory");
    __syncthreads();
    if (threadIdx.x == 0) {
        unsigned* bar = b.bar;
        __builtin_amdgcn_s_waitcnt(0);
        unsigned nloc = b.st[0], nx = b.st[1];
        if (nloc == 0u) { xcd_barrier_complete(bar, b.x, nloc, nx); b.st[0] = nloc; b.st[1] = nx; }
        const unsigned old = xb_add(&bar[XB_XSUB(b.x)], 1u);
        const unsigned gen = old / nloc;
        if (old + 1u == (gen + 1u) * nloc) {
            __builtin_amdgcn_fence(__ATOMIC_RELEASE, "agent");
            asm volatile("s_waitcnt vmcnt(0)" ::: "memory");
            const unsigned og = xb_add(&bar[XB_TOP], 1u);
            const unsigned tg = og / nx;
            if (og + 1u == (tg + 1u) * nx) xb_add(&bar[XB_TOPGEN], 1u);
            else XB_SPIN(xb_ld(&bar[XB_TOPGEN]) == tg, bar);
            __builtin_amdgcn_fence(__ATOMIC_ACQUIRE, "agent");
            xb_add(&bar[XB_XGEN(b.x)], 1u);
            asm volatile("s_waitcnt vmcnt(0)" ::: "memory");
        } else {
            XB_SPIN(xb_ld(&bar[XB_XGEN(b.x)]) == gen, bar);
            __builtin_amdgcn_fence(__ATOMIC_ACQUIRE, "agent");
            asm volatile("s_waitcnt vmcnt(0)" ::: "memory");
        }
    }
    __syncthreads();
}

#define LDS_WAIT() asm volatile("s_waitcnt lgkmcnt(0)" ::: "memory")
__device__ __forceinline__ float wave_sum(float v) {
#pragma unroll
    for (int o = 1; o < 64; o <<= 1) v += __shfl_xor(v, o);
    return v;
}
__device__ __forceinline__ void p0_transpose_item(const float* W, int K, int N, bf16* WT, LAS float* scr, int item, int lane) {
    const int nblk = N / 32, kb = item / nblk, nb = item % nblk, k0 = 64 * kb, n0 = 32 * nb;
#pragma unroll 8
    for (int i = 0; i < 32; ++i) { const int kk = 2 * i + (lane >> 5); scr[kk * 33 + (lane & 31)] = W[(size_t)(k0 + kk) * N + n0 + (lane & 31)]; }
    LDS_WAIT(); asm volatile("" ::: "memory");
    const int c = lane & 7;
#pragma unroll
    for (int j = 0; j < 4; ++j) { const int n = (lane >> 3) + 8 * j; const LAS float* s = scr + (8 * c) * 33 + n;
        u32x4 o; o.x = pk2(s[0 * 33], s[1 * 33]); o.y = pk2(s[2 * 33], s[3 * 33]); o.z = pk2(s[4 * 33], s[5 * 33]); o.w = pk2(s[6 * 33], s[7 * 33]);
        *(GAS u32x4*)(WT + (size_t)(n0 + n) * K + k0 + 8 * c) = o; }
    LDS_WAIT(); asm volatile("" ::: "memory");
}
__device__ __forceinline__ void rms_row_to_bf16(const float* xrow, const float* g, bf16* orow, int lane) {
    const GAS f32x4* xr = (const GAS f32x4*)xrow + lane; const GAS f32x4* gr = (const GAS f32x4*)g + lane;
    f32x4 v[4]; float s = 0.f;
#pragma unroll
    for (int j = 0; j < 4; ++j) { v[j] = xr[64 * j]; s += (v[j].x * v[j].x + v[j].y * v[j].y) + (v[j].z * v[j].z + v[j].w * v[j].w); }
    const float rs = 1.0f / sqrtf(wave_sum(s) * (1.f / DM) + EPS);
    GAS unsigned long long* o8 = (GAS unsigned long long*)orow + lane;
#pragma unroll
    for (int j = 0; j < 4; ++j) { const f32x4 gg = gr[64 * j];
        o8[64 * j] = (unsigned long long)pk2(v[j].x * rs * gg.x, v[j].y * rs * gg.y) | ((unsigned long long)pk2(v[j].z * rs * gg.z, v[j].w * rs * gg.w) << 32); }
}

__device__ __forceinline__ const float* in_ptr(int k) {
    typedef __attribute__((address_space(4))) const char* cptr4;
    cptr4 ka = (cptr4)__builtin_amdgcn_kernarg_segment_ptr(); cptr4 kb;
    asm volatile("s_mov_b64 %0, %1" : "=s"(kb) : "s"(ka));
    typedef const float* cfp; typedef __attribute__((address_space(4))) const cfp* cfp4;
    return *(cfp4)(kb + k * 8);
}
constexpr int NWAVES = 8;
constexpr int RING_BYTES = 131072, LDSCTL_OFF = RING_BYTES, MISC_OFF = LDSCTL_OFF + 320, LDS_BYTES = 147456;
struct Args { const float* in[14]; float* out; unsigned char* ws; int ph_lo, ph_hi, li, pad; };
constexpr int N_PHASES = 10;

__global__ void __launch_bounds__(NWAVES * 64, 2) mk_fwd(Args args) {
    extern __shared__ __attribute__((aligned(16))) unsigned char lds_raw[];
    LAS unsigned char* lds = (LAS unsigned char*)lds_raw;
    volatile LAS unsigned* MISC = (volatile LAS unsigned*)(lds + MISC_OFF);
    const int tid = threadIdx.x, lane_k = tid & 63, wave = __builtin_amdgcn_readfirstlane(tid >> 6);
    const int G = gridDim.x, bx = blockIdx.x; const int vcu = (G % 8 == 0) ? (bx % 8) * (G / 8) + bx / 8 : bx;
    unsigned char* const ws_k = (unsigned char*)in_ptr(15);
    unsigned* ctl = (unsigned*)(ws_k + WS_CTL);
    for (int u = tid; u < (LDS_BYTES - LDSCTL_OFF) / 4; u += NWAVES * 64) ((LAS unsigned*)(lds + LDSCTL_OFF))[u] = 0u;
    __syncthreads();
    const int lo = args.ph_lo, hi = args.ph_hi;
    XcdBarrier bar; bar.bar = ctl + CW_BAR + args.li * XCD_BAR_WORDS; bar.x = 0; bar.st = nullptr;
    if (hi - lo > 1) bar = xcd_barrier_post(ctl + CW_BAR + args.li * XCD_BAR_WORDS, MISC + 8);
#define IN(k) (lo <= (k) && (k) < hi)
#define SEAM(k) do { if (IN(k) && IN((k) + 1)) xcd_barrier(bar); } while (0)

    if (IN(0)) {
        unsigned char* const ws = ws_k; int lane = lane_k; asm volatile("" : "+v"(lane));
        bf16* Wt_in = (bf16*)(ws + WS_WIN); bf16* H = (bf16*)(ws + WS_H);
        LAS float* scr = (LAS float*)(lds + wave * 16384);
        const int gw = vcu * NWAVES + wave, NGW = G * NWAVES;
        constexpr int I_IN = (DM / 64) * (NIN / 32), I_SQ = (DM / 64) * (DM / 32);
        for (int it = gw; it < I_IN + 6 * I_SQ; it += NGW) {
            int r = it;
            if (r < I_IN) { p0_transpose_item(in_ptr(2), DM, NIN, Wt_in, scr, r, lane); continue; } r -= I_IN;
            const int which = r / I_SQ, item = r % I_SQ, l = which / 3, w = which % 3;
            const float* src = (w == 0 ? in_ptr(4) : w == 1 ? in_ptr(12) : in_ptr(13)) + (size_t)l * DM * DM;
            bf16* dst = (bf16*)(ws + (l == 0 ? WS_WRO : WS_W1) + (size_t)w * 2 * MiB);
            p0_transpose_item(src, DM, DM, dst, scr, item, lane);
        }
        const float* x0 = in_ptr(0); const float* g0 = in_ptr(1);
        for (int m = gw; m < T; m += NGW) rms_row_to_bf16(x0 + (size_t)m * DM, g0, H + (size_t)m * DM, lane);
        LDS_WAIT(); __syncthreads();
    }
    SEAM(0);

#pragma unroll 1
    for (int l = 0; l < DEPTH; ++l) {
        const int pb = 1 + 5 * l;
        if (IN(pb)) {
            unsigned char* const ws = ws_k;
            Epi<0> E; E.ws = ws; E.xin = nullptr; E.xout = nullptr; E.gq = in_ptr(5) + l * 64; E.gk = in_ptr(6) + l * 64;
            SchedG1A S{(const char*)(ws + WS_H), (const char*)(ws + WS_WIN), G, bx};
            pg8::gemm_phase<Epi<0>, SchedG1A, true, true>(lds, DM, S, E);
        }
        SEAM(pb);
        if (IN(pb + 1)) {
            unsigned char* const ws = ws_k;
            float s1 = 0.f, s2 = 0.f; { const float* q1 = in_ptr(7) + l * 64; const float* k1 = in_ptr(8) + l * 64; const float* q2 = in_ptr(9) + l * 64; const float* k2 = in_ptr(10) + l * 64;
                for (int i = 0; i < 64; ++i) { s1 += q1[i] * k1[i]; s2 += q2[i] * k2[i]; } }
            const float lam_init = 0.8f - 0.6f * __expf(-0.3f * (float)l), lam = __expf(s1) - __expf(s2) + lam_init;
            const float* gsub = in_ptr(11) + l * 1024;
            float gqm = 0.f, gkm = 0.f; { const float* gq = in_ptr(5) + l * 64; const float* gk = in_ptr(6) + l * 64; for (int i = 0; i < 64; ++i) { gqm = fmaxf(gqm, fabsf(gq[i])); gkm = fmaxf(gkm, fabsf(gk[i])); } }
            const float Bnd = 1.02f * 8.0f * LOG2E * gqm * gkm;
            const float* gret = in_ptr(3) + l * 1024;
            unsigned* qhead = ctl + CW_QUEUE + 64 * l;
            for (;;) {
                if (tid == 0) MISC[16] = __hip_atomic_fetch_add(qhead, 1u, __ATOMIC_RELAXED, __HIP_MEMORY_SCOPE_AGENT);
                __syncthreads();
                const int item = (int)MISC[16];
                __syncthreads();
                if (item >= 32 + 512) break;
                if (item < 32) ret::ret_unit(lds, ws, item >> 3, item & 7, gret);
                else { const int u = att_order[item - 32], bh = u >> 4, hh = bh & 7;
                    const float wf = (2.0f * Bnd + 28.0f) / (__builtin_amdgcn_exp2f(-(float)(hh + 1)) * LOG2E);
                    att::attn_unit(lds, ws, bh >> 3, hh, u & 15, lam, 1.0f - lam_init, gsub, wf < 8192.f ? (int)wf + 1 : 8192); }
            }
        }
        SEAM(pb + 1);
        if (IN(pb + 2)) {
            unsigned char* const ws = ws_k;
            Epi<1> E; E.ws = ws; E.xin = nullptr; E.xout = nullptr; E.gq = nullptr; E.gk = nullptr;
            SchedP34 S{(const char*)ws, (const char*)(ws + (l == 0 ? WS_WRO : WS_W1)), bx};
            pg8::gemm_phase<Epi<1>, SchedP34, true, true>(lds, DM, S, E);
        }
        SEAM(pb + 2);
        if (IN(pb + 3)) {
            unsigned char* const ws = ws_k;
            Epi<2> E; E.ws = ws; E.xin = (l == 0) ? in_ptr(0) : (const float*)in_ptr(14); E.xout = (float*)in_ptr(14); E.gq = nullptr; E.gk = nullptr;
            SchedG4 S{(const char*)(ws + WS_MBF), (const char*)(ws + (l == 0 ? WS_WRO : WS_W1) + 4 * MiB), bx};
            pg8::gemm_phase<Epi<2>, SchedG4, false, true>(lds, DM, S, E);
        }
        SEAM(pb + 3);
        if (l == 0) {
            if (IN(5)) {
                unsigned char* const ws = ws_k; int lane = lane_k; asm volatile("" : "+v"(lane));
                bf16* Wt_in = (bf16*)(ws + WS_WIN); bf16* H = (bf16*)(ws + WS_H);
                LAS float* scr = (LAS float*)(lds + wave * 16384);
                const int gw = vcu * NWAVES + wave, NGW = G * NWAVES;
                constexpr int I_IN = (DM / 64) * (NIN / 32);
                const float* w1 = in_ptr(2) + (size_t)DM * NIN;
                for (int it = gw; it < I_IN; it += NGW) p0_transpose_item(w1, DM, NIN, Wt_in, scr, it, lane);
                const float* x1 = in_ptr(14); const float* g1 = in_ptr(1) + DM;
                for (int m = gw; m < T; m += NGW) rms_row_to_bf16(x1 + (size_t)m * DM, g1, H + (size_t)m * DM, lane);
                LDS_WAIT(); __syncthreads();
            }
            SEAM(5);
        }
    }
#undef IN
#undef SEAM
}

__global__ void __launch_bounds__(128) k_ret_naive(const bf16* __restrict__ QR, const bf16* __restrict__ KR, const bf16* __restrict__ VR, bf16* SGR, const float* __restrict__ gn) {
    __shared__ float qs[16][64];
    __shared__ float ks[32][65];
    __shared__ float vs[32][128];
    __shared__ float ps[16][32];
    __shared__ float rsv[16];
    const int tid = threadIdx.x, qb = blockIdx.x & 255, bh = blockIdx.x >> 8, h = bh & 7, b = bh >> 3;
    const int n0 = qb * 16; const size_t tb = (size_t)b * SEQ;
    const float lg2 = log2f(1.0f - exp2f(-5.0f - (float)h));
    for (int i = tid; i < 16 * 64; i += 128) qs[i >> 6][i & 63] = bf2f(QR[(tb + n0 + (i >> 6)) * 512 + h * 64 + (i & 63)]);
    float acc[16];
#pragma unroll
    for (int r = 0; r < 16; ++r) acc[r] = 0.f;
    for (int k0 = 0; k0 < n0 + 16; k0 += 32) {
        __syncthreads();
        for (int i = tid; i < 32 * 64; i += 128) ks[i >> 6][i & 63] = bf2f(KR[(tb + k0 + (i >> 6)) * 512 + h * 64 + (i & 63)]);
        for (int i = tid; i < 32 * 128; i += 128) vs[i >> 7][i & 127] = bf2f(VR[(tb + k0 + (i >> 7)) * 1024 + h * 128 + (i & 127)]);
        __syncthreads();
        const float cf = exp2f(128.0f * (float)((n0 >> 7) - (k0 >> 7)) * lg2);
        for (int i = tid; i < 16 * 32; i += 128) { const int r = i >> 5, kk = i & 31; float d = 0.f;
            for (int c = 0; c < 64; ++c) d += qs[r][c] * ks[kk][c];
            const int dist = (n0 + r) - (k0 + kk);
            ps[r][kk] = dist >= 0 ? d * cf : 0.f; }
        __syncthreads();
#pragma unroll
        for (int r = 0; r < 16; ++r) { float a = acc[r];
            for (int kk = 0; kk < 32; ++kk) a += ps[r][kk] * vs[kk][tid];
            acc[r] = a; }
    }
    __syncthreads();
    for (int r = 0; r < 16; ++r) vs[r][tid] = acc[r];
    __syncthreads();
    if (tid < 16) { float s = 0.f; for (int e = 0; e < 128; ++e) s += vs[tid][e] * vs[tid][e]; rsv[tid] = 1.0f / sqrtf(s * (1.0f / 128.0f) + EPS); }
    __syncthreads();
    for (int r = 0; r < 16; ++r) { const size_t o = (tb + n0 + r) * 1024 + h * 128 + tid; SGR[o] = f2bf(acc[r] * rsv[r] * gn[h * 128 + tid] * bf2f(SGR[o])); }
}

__global__ void __launch_bounds__(128) k_attn_naive(const bf16* __restrict__ QD, const bf16* __restrict__ KD, const bf16* __restrict__ VD, bf16* SGD, const float* __restrict__ lq1, const float* __restrict__ lk1,
                                                    const float* __restrict__ lq2, const float* __restrict__ lk2, const float* __restrict__ gn, float lam_init) {
    __shared__ float qs[2][16][64];
    __shared__ float ks[2][32][65];
    __shared__ float vs[32][128];
    __shared__ float ps[2][16][32];
    __shared__ float mrow[2][16], lrow[2][16], arow[2][16], rsv[16];
    const int tid = threadIdx.x, qb = blockIdx.x & 255, bh = blockIdx.x >> 8, h = bh & 7, b = bh >> 3;
    const int n0 = qb * 16; const size_t tb = (size_t)b * SEQ;
    float s1 = 0.f, s2 = 0.f;
    for (int i = 0; i < 64; ++i) { s1 += lq1[i] * lk1[i]; s2 += lq2[i] * lk2[i]; }
    const float lam = expf(s1) - expf(s2) + lam_init;
    const float slope = exp2f(-(float)(h + 1)) * LOG2E;
    for (int i = tid; i < 2 * 16 * 64; i += 128) { const int j = i >> 10, r = (i >> 6) & 15, d = i & 63; qs[j][r][d] = bf2f(QD[(tb + n0 + r) * 1024 + h * 128 + j * 64 + d]); }
    if (tid < 32) { mrow[tid >> 4][tid & 15] = -INFINITY; lrow[tid >> 4][tid & 15] = 0.f; }
    float acc[2][16];
#pragma unroll
    for (int j = 0; j < 2; ++j)
#pragma unroll
        for (int r = 0; r < 16; ++r) acc[j][r] = 0.f;
    for (int k0 = 0; k0 < n0 + 16; k0 += 32) {
        __syncthreads();
        for (int i = tid; i < 2 * 32 * 64; i += 128) { const int j = i >> 11, kk = (i >> 6) & 31, d = i & 63; ks[j][kk][d] = bf2f(KD[(tb + k0 + kk) * 1024 + h * 128 + j * 64 + d]); }
        for (int i = tid; i < 32 * 128; i += 128) vs[i >> 7][i & 127] = bf2f(VD[(tb + k0 + (i >> 7)) * 1024 + h * 128 + (i & 127)]);
        __syncthreads();
        for (int i = tid; i < 2 * 16 * 32; i += 128) { const int j = i >> 9, r = (i >> 5) & 15, kk = i & 31; float d = 0.f;
            for (int c = 0; c < 64; ++c) d += qs[j][r][c] * ks[j][kk][c];
            const int dist = (n0 + r) - (k0 + kk);
            ps[j][r][kk] = dist >= 0 ? d - slope * (float)dist : -INFINITY; }
        __syncthreads();
        if (tid < 32) { const int j = tid >> 4, r = tid & 15; float mx = mrow[j][r];
            for (int kk = 0; kk < 32; ++kk) mx = fmaxf(mx, ps[j][r][kk]);
            const float al = exp2f(mrow[j][r] - mx); float sum = 0.f;
            for (int kk = 0; kk < 32; ++kk) { const float p = exp2f(ps[j][r][kk] - mx); ps[j][r][kk] = p; sum += p; }
            lrow[j][r] = lrow[j][r] * al + sum; arow[j][r] = al; mrow[j][r] = mx; }
        __syncthreads();
#pragma unroll
        for (int j = 0; j < 2; ++j)
#pragma unroll
            for (int r = 0; r < 16; ++r) { float a = acc[j][r] * arow[j][r];
                for (int kk = 0; kk < 32; ++kk) a += ps[j][r][kk] * vs[kk][tid];
                acc[j][r] = a; }
    }
    __syncthreads();
    float o[16];
#pragma unroll
    for (int r = 0; r < 16; ++r) { o[r] = acc[0][r] / lrow[0][r] - lam * acc[1][r] / lrow[1][r]; vs[r][tid] = o[r]; }
    __syncthreads();
    if (tid < 16) { float s = 0.f; for (int e = 0; e < 128; ++e) s += vs[tid][e] * vs[tid][e]; rsv[tid] = 1.0f / sqrtf(s * (1.0f / 128.0f) + EPS); }
    __syncthreads();
    for (int r = 0; r < 16; ++r) { const size_t oo = (tb + n0 + r) * 1024 + h * 128 + tid; SGD[oo] = f2bf(o[r] * rsv[r] * gn[h * 128 + tid] * (1.0f - lam_init) * bf2f(SGD[oo])); }
}


extern "C" void kernel_launch(void* const* d_in, const int* in_sizes, int n_in, void* d_out, int out_size, void* d_ws, size_t ws_size, hipStream_t stream) {
    static int ready = 0;
    if (ready == 0) {
        if (n_in != 14 || ws_size < WS_END || out_size != T * DM) { fprintf(stderr, "kernel_launch: unexpected problem (n_in %d, ws %zu, out %d)\n", n_in, ws_size, out_size); ready = -1; return; }
        if (hipFuncSetAttribute((const void*)mk_fwd, hipFuncAttributeMaxDynamicSharedMemorySize, LDS_BYTES) != hipSuccess) { fprintf(stderr, "kernel_launch: hipFuncSetAttribute failed\n"); ready = -1; return; }
        ready = 1;
    }
    if (ready < 0) return;
    (void)hipMemsetAsync((char*)d_ws + WS_CTL, 0, CTL_ZERO_BYTES, stream);
    Args a{};
    for (int i = 0; i < 14; ++i) a.in[i] = (const float*)d_in[i];
    a.out = (float*)d_out; a.ws = (unsigned char*)d_ws;
    char* ws = (char*)d_ws;
    const float* ret_norm_g = (const float*)d_in[3]; const float* sub_g = (const float*)d_in[11];
    const float* lq1 = (const float*)d_in[7]; const float* lk1 = (const float*)d_in[8]; const float* lq2 = (const float*)d_in[9]; const float* lk2 = (const float*)d_in[10];
    a.ph_lo = 0; a.ph_hi = N_PHASES; a.li = 0;
    hipLaunchKernelGGL(mk_fwd, dim3(256), dim3(NWAVES * 64), LDS_BYTES, stream, a);
}
```

```cpp
#include <hip/hip_runtime.h>
#include <cstdio>
#include <cstdint>
#include <cstddef>

constexpr int DM = 1024, BATCH = 4, SEQ = 4096, DEPTH = 2, T = BATCH * SEQ, NIN = 9216;
constexpr float EPS = 1e-6f;
constexpr float LOG2E = 1.4426950408889634f;

typedef unsigned short bf16;
typedef short bf16x8 __attribute__((ext_vector_type(8)));
typedef float f32x4 __attribute__((ext_vector_type(4)));
typedef unsigned u32x4 __attribute__((ext_vector_type(4)));
#define LAS __attribute__((address_space(3)))
#define GAS __attribute__((address_space(1)))

__device__ __forceinline__ float bf2f(bf16 v) { return __uint_as_float(((unsigned)v) << 16); }
__device__ __forceinline__ unsigned f2bf_u(float f) { unsigned u = __float_as_uint(f); return (u + 0x7fffu + ((u >> 16) & 1u)) >> 16; }
__device__ __forceinline__ bf16 f2bf(float f) { return (bf16)f2bf_u(f); }
__device__ __forceinline__ unsigned pk2(float lo, float hi) { return f2bf_u(lo) | (f2bf_u(hi) << 16); }
typedef float f32x2_t __attribute__((ext_vector_type(2))); typedef __bf16 bf16x2_t __attribute__((ext_vector_type(2)));
__device__ __forceinline__ unsigned cvt_pk_bf16(float lo, float hi) { f32x2_t v = {lo, hi}; bf16x2_t b = __builtin_convertvector(v, bf16x2_t); return __builtin_bit_cast(unsigned, b); }
__device__ __forceinline__ float fast_sigmoid(float v) { return __builtin_amdgcn_rcpf(1.0f + __builtin_amdgcn_exp2f(-v * LOG2E)); }
__device__ __forceinline__ float lo_bf(unsigned w) { return __uint_as_float(w << 16); }
__device__ __forceinline__ float hi_bf(unsigned w) { return __uint_as_float(w & 0xffff0000u); }

constexpr size_t MiB = 1u << 20;
constexpr size_t WS_CTL = 0, CTL_ZERO_BYTES = 1 * MiB;
constexpr size_t WS_WIN = 1 * MiB, WS_WRO = 19 * MiB, WS_WDO = 21 * MiB, WS_WOUT = 23 * MiB;
constexpr size_t WS_H = 25 * MiB, WS_QR = 57 * MiB, WS_KR = 73 * MiB, WS_VR = 89 * MiB, WS_SGR = 121 * MiB, WS_QD = 153 * MiB, WS_KD = 185 * MiB,
                 WS_VD = 217 * MiB, WS_SGD = 249 * MiB;
constexpr size_t WS_W1 = 281 * MiB;
constexpr size_t WS_END = 287 * MiB;
constexpr size_t WS_MBUF = 57 * MiB;
constexpr size_t WS_MBF = WS_VD;
constexpr size_t WS_SMGR = WS_QD, WS_SMGD = WS_KD;
constexpr int CW_BAR = 4096;

namespace pg8 {
constexpr int BM = 256, BK = 64, HALF = 128, HTB = HALF * BK * 2, STAGE_BYTES = 8 * HTB, NXCD = 8, WGM = 8;
__host__ __device__ __forceinline__ int lds_byte(int r, int c) { const int st = (r >> 4) * 2 + (c >> 5), rr = r & 15, cc = c & 31, ob = rr * 64 + cc * 2; return st * 1024 + (ob ^ (((ob >> 9) & 1) << 5)); }
__host__ __device__ __forceinline__ void stage_rc(int b, int& R, int& C) { const int st = b / 1024, sb = b % 1024, swz = sb ^ (((sb >> 9) & 1) << 5); R = (st >> 1) * 16 + swz / 64; C = (st & 1) * 32 + (swz % 64) / 2; }
__host__ __device__ __forceinline__ int perm32(int rho) { const int n = rho >> 4, i = rho & 15; return 8 * (i >> 2) + 4 * n + (i & 3); }

struct Unit { int pm, pn, kind; const char* a; const char* b; };

__device__ __forceinline__ void tile_of(int L, int nM, int nN, int& pm, int& pn) {
    const int nwg = nM * nN; int wgid = L;
    { const int q = nwg / NXCD, r = nwg % NXCD, xcd = wgid % NXCD, off = wgid / NXCD; wgid = (xcd < r ? xcd * (q + 1) : r * (q + 1) + (xcd - r) * q) + off; }
    const int nig = WGM * nN, gid = wgid / nig, fm = gid * WGM, gsz = (nM - fm) < WGM ? (nM - fm) : WGM;
    pm = fm + ((wgid % nig) % gsz); pn = (wgid % nig) / gsz;
}

template <class Epi, class Sched, bool ALIGN_EPI, bool SP2>
__device__ __forceinline__ void gemm_phase(LAS unsigned char* lds, const int K, const Sched& S, const Epi& E) {
    int tid_ = threadIdx.x; asm volatile("" : "+v"(tid_));
    const int tid = tid_, wid = __builtin_amdgcn_readfirstlane(tid >> 6), lane = tid & 63, wr = wid >> 2, wc = wid & 3, fr = lane & 15, fq = lane >> 4;
    const int nt = K / BK;
    unsigned voffA[2], voffB[2];
#pragma unroll
    for (int i = 0; i < 2; ++i) { int R, C; stage_rc(tid * 16 + i * 8192, R, C); const int Rb = (R >> 5) * 64 + perm32(R & 31);
        voffA[i] = (unsigned)(R * K + C) * 2u; voffB[i] = (unsigned)(Rb * K + C) * 2u; }
    const size_t kstep = (size_t)(BK * 2);
    const size_t hstep = (size_t)HALF * K * 2;
    const size_t hstepB = (size_t)32 * K * 2;
    const unsigned ldsw = (unsigned)wid * 1024u;
    const int aoff = lds_byte(wr * 64 + fr, fq * 8), boff = lds_byte(wc * 32 + fr, fq * 8);
#define PG8_SA(b, h) (((b) * 2 + (h)) * HTB)
#define PG8_SB(b, h) ((4 + (b) * 2 + (h)) * HTB)
#define PG8_STAGE(bufoff, gbase, voff) do { _Pragma("unroll") for (int _i = 0; _i < 2; ++_i) \
        __builtin_amdgcn_global_load_lds((const unsigned*)((const char*)(gbase) + (voff)[_i]), (LAS unsigned*)(lds + (bufoff) + ldsw + _i * 8192), 16, 0, 0); } while (0)
#define PG8_LDA(dst, b, h) do { _Pragma("unroll") for (int m = 0; m < 4; ++m) _Pragma("unroll") for (int k = 0; k < 2; ++k) dst[m][k] = *(const LAS bf16x8*)(lds + PG8_SA(b, h) + aoff + m * 2048 + k * 1024); } while (0)
#define PG8_LDB(dst, b, h) do { _Pragma("unroll") for (int n = 0; n < 2; ++n) _Pragma("unroll") for (int k = 0; k < 2; ++k) dst[n][k] = *(const LAS bf16x8*)(lds + PG8_SB(b, h) + boff + n * 2048 + k * 1024); } while (0)
#define PG8_MMA(ai, bj, At, Bt) do { __builtin_amdgcn_s_setprio(1); _Pragma("unroll") for (int m = 0; m < 4; ++m) _Pragma("unroll") for (int n = 0; n < 2; ++n) _Pragma("unroll") for (int k = 0; k < 2; ++k) \
        acc[ai][bj][m][n] = __builtin_amdgcn_mfma_f32_16x16x32_bf16(Bt[n][k], At[m][k], acc[ai][bj][m][n], 0, 0, 0); __builtin_amdgcn_s_setprio(0); } while (0)
#define PG8_WAIT_V(n) asm volatile("s_waitcnt vmcnt(" #n ")" ::: "memory")
#define PG8_WAIT_L(n) asm volatile("s_waitcnt lgkmcnt(" #n ")" ::: "memory")
#define PG8_BAR __builtin_amdgcn_s_barrier()
#define PG8_SCHED __builtin_amdgcn_sched_barrier(0)
    Unit cur, nxt; int ui = 0;
    if (!S.next(0, cur)) return;
    f32x4 acc[2][2][4][2];
#pragma unroll
    for (int a = 0; a < 2; ++a)
#pragma unroll
        for (int b = 0; b < 2; ++b)
#pragma unroll
            for (int m = 0; m < 4; ++m)
#pragma unroll
                for (int n = 0; n < 2; ++n) acc[a][b][m][n] = (f32x4){0.f, 0.f, 0.f, 0.f};
    bf16x8 At[4][2], B0[2][2], B1[2][2];
    const char* cA = cur.a; const char* cB = cur.b;
    if constexpr (SP2) {
        PG8_STAGE(PG8_SB(0, 0), cB, voffB); PG8_STAGE(PG8_SB(0, 1), cB + hstepB, voffB); PG8_STAGE(PG8_SA(0, 0), cA, voffA); PG8_STAGE(PG8_SA(0, 1), cA + hstep, voffA);
        if (wr == 1) PG8_BAR;
        PG8_WAIT_V(2); PG8_BAR;
        PG8_STAGE(PG8_SB(1, 0), cB + kstep, voffB); PG8_STAGE(PG8_SA(1, 0), cA + kstep, voffA); PG8_STAGE(PG8_SB(1, 1), cB + hstepB + kstep, voffB);
        PG8_WAIT_V(6); PG8_BAR;
    } else {
        PG8_STAGE(PG8_SB(0, 0), cB, voffB); PG8_STAGE(PG8_SA(0, 0), cA, voffA); PG8_STAGE(PG8_SB(0, 1), cB + hstepB, voffB); PG8_STAGE(PG8_SA(0, 1), cA + hstep, voffA);
        if (wr == 1) PG8_BAR;
        PG8_WAIT_V(4); PG8_BAR;
        PG8_STAGE(PG8_SB(1, 0), cB + kstep, voffB); PG8_STAGE(PG8_SA(1, 0), cA + kstep, voffA); PG8_STAGE(PG8_SB(1, 1), cB + hstepB + kstep, voffB);
        PG8_WAIT_V(6); PG8_BAR;
    }
    for (;;) {
        const bool has_next = S.next(ui + 1, nxt);
        const char* nA = has_next ? nxt.a : cA; const char* nB = has_next ? nxt.b : cB;
        for (int t = 0; t < nt; t += 2) {
            const bool last = (t == nt - 2);
            const char* a1 = cA + (size_t)(t + 1) * kstep;
            const char* a2 = last ? nA : cA + (size_t)(t + 2) * kstep; const char* b2 = last ? nB : cB + (size_t)(t + 2) * kstep;
            const char* a3 = a2 + kstep; const char* b3 = b2 + kstep;
            if constexpr (SP2) {
            PG8_LDB(B0, 0, 0); PG8_LDB(B1, 0, 1); PG8_SCHED; PG8_LDA(At, 0, 0); PG8_STAGE(PG8_SA(1, 1), a1 + hstep, voffA);
            PG8_WAIT_V(8); PG8_WAIT_L(0); PG8_BAR; PG8_MMA(0, 0, At, B0); PG8_MMA(0, 1, At, B1); PG8_BAR; PG8_SCHED;
            PG8_LDA(At, 0, 1); PG8_STAGE(PG8_SB(0, 0), b2, voffB); PG8_STAGE(PG8_SB(0, 1), b2 + hstepB, voffB); PG8_STAGE(PG8_SA(0, 0), a2, voffA);
            PG8_WAIT_V(8); PG8_WAIT_L(0); PG8_BAR; PG8_MMA(1, 0, At, B0); PG8_MMA(1, 1, At, B1); PG8_BAR; PG8_SCHED;
            PG8_LDB(B0, 1, 0); PG8_LDB(B1, 1, 1); PG8_SCHED; PG8_LDA(At, 1, 0); PG8_STAGE(PG8_SA(0, 1), a2 + hstep, voffA);
            PG8_WAIT_V(8); PG8_WAIT_L(0); PG8_BAR; PG8_MMA(0, 0, At, B0); PG8_MMA(0, 1, At, B1); PG8_BAR; PG8_SCHED;
            PG8_LDA(At, 1, 1); PG8_STAGE(PG8_SB(1, 0), b3, voffB); PG8_STAGE(PG8_SB(1, 1), b3 + hstepB, voffB); PG8_STAGE(PG8_SA(1, 0), a3, voffA);
            PG8_WAIT_V(8); PG8_WAIT_L(0); PG8_BAR; PG8_MMA(1, 0, At, B0); PG8_MMA(1, 1, At, B1); PG8_BAR; PG8_SCHED;
            } else {
            PG8_LDB(B0, 0, 0); PG8_SCHED; PG8_LDA(At, 0, 0); PG8_STAGE(PG8_SA(1, 1), a1 + hstep, voffA);
            PG8_WAIT_L(8); PG8_BAR; PG8_WAIT_L(0); PG8_MMA(0, 0, At, B0); PG8_BAR; PG8_SCHED;
            PG8_LDB(B1, 0, 1); PG8_STAGE(PG8_SB(0, 0), b2, voffB);
            PG8_BAR; PG8_WAIT_L(0); PG8_MMA(0, 1, At, B1); PG8_BAR;
            PG8_LDA(At, 0, 1); PG8_STAGE(PG8_SA(0, 0), a2, voffA);
            PG8_BAR; PG8_WAIT_L(0); PG8_MMA(1, 0, At, B0); PG8_BAR; PG8_SCHED;
            PG8_STAGE(PG8_SB(0, 1), b2 + hstepB, voffB);
            PG8_WAIT_V(6); PG8_BAR; PG8_MMA(1, 1, At, B1); PG8_BAR;
            PG8_LDB(B0, 1, 0); PG8_SCHED; PG8_LDA(At, 1, 0); PG8_STAGE(PG8_SA(0, 1), a2 + hstep, voffA);
            PG8_WAIT_L(8); PG8_BAR; PG8_WAIT_L(0); PG8_MMA(0, 0, At, B0); PG8_BAR; PG8_SCHED;
            PG8_LDB(B1, 1, 1); PG8_STAGE(PG8_SB(1, 0), b3, voffB);
            PG8_BAR; PG8_WAIT_L(0); PG8_MMA(0, 1, At, B1); PG8_BAR;
            PG8_LDA(At, 1, 1); PG8_STAGE(PG8_SA(1, 0), a3, voffA);
            PG8_BAR; PG8_WAIT_L(0); PG8_MMA(1, 0, At, B0); PG8_BAR; PG8_SCHED;
            PG8_STAGE(PG8_SB(1, 1), b3 + hstepB, voffB);
            PG8_WAIT_V(6); PG8_BAR; PG8_MMA(1, 1, At, B1); PG8_BAR;
            }
        }
        if constexpr (ALIGN_EPI) { if (wr == 0) PG8_BAR; }
        E(acc, cur, wr, wc, fr, fq);
        if (!has_next) break;
#pragma unroll
        for (int a = 0; a < 2; ++a)
#pragma unroll
            for (int b = 0; b < 2; ++b)
#pragma unroll
                for (int m = 0; m < 4; ++m)
#pragma unroll
                    for (int n = 0; n < 2; ++n) acc[a][b][m][n] = (f32x4){0.f, 0.f, 0.f, 0.f};
        cur = nxt; cA = nA; cB = nB; ++ui;
        if constexpr (ALIGN_EPI) { if (wr == 1) PG8_BAR; }
    }
    PG8_WAIT_V(0);
    if constexpr (!ALIGN_EPI) { if (wr == 0) PG8_BAR; }
    PG8_BAR;
#undef PG8_SA
#undef PG8_SB
#undef PG8_STAGE
#undef PG8_LDA
#undef PG8_LDB
#undef PG8_MMA
#undef PG8_WAIT_V
#undef PG8_WAIT_L
#undef PG8_BAR
#undef PG8_SCHED
}
}

enum { K_QR = 0, K_KR, K_VR, K_SGR, K_QD, K_KD, K_VD, K_SGD, K_MGR, K_YR, K_MGD, K_YD, K_OUT };
constexpr size_t TSTEP = (size_t)256 * DM * 2;

template <int PC  > struct Epi {
    unsigned char* ws; const float* xin; float* xout; const float* gq; const float* gk;
    __device__ __forceinline__ static void st8(bf16* p, const f32x4 a, const f32x4 b) {
        u32x4 w; w.x = cvt_pk_bf16(a[0], a[1]); w.y = cvt_pk_bf16(a[2], a[3]); w.z = cvt_pk_bf16(b[0], b[1]); w.w = cvt_pk_bf16(b[2], b[3]); *(u32x4*)p = w; }
    __device__ __forceinline__ void operator()(const f32x4 (&acc)[2][2][4][2], const pg8::Unit& u, int wr, int wc, int fr, int fq) const {
        const int row0 = u.pm * 256 + wr * 64 + fr;
        const int cl = wc * 64 + 8 * fq;
        const int kind = u.kind;
        bf16* const qr = (bf16*)(ws + WS_QR); bf16* const kr = (bf16*)(ws + WS_KR); bf16* const vr = (bf16*)(ws + WS_VR); bf16* const sgr = (bf16*)(ws + WS_SGR);
        bf16* const qd = (bf16*)(ws + WS_QD); bf16* const kd = (bf16*)(ws + WS_KD); bf16* const vd = (bf16*)(ws + WS_VD); bf16* const sgd = (bf16*)(ws + WS_SGD);
        bf16* const smgr = (bf16*)(ws + WS_SMGR); bf16* const smgd = (bf16*)(ws + WS_SMGD); bf16* const mbf = (bf16*)(ws + WS_MBF); float* const mbuf = (float*)(ws + WS_MBUF);
        if (PC == 0 && (kind == K_VR || kind == K_VD)) {
            bf16* base = (kind == K_VR ? vr : vd) + u.pn * 256 + cl;
#pragma unroll
            for (int ai = 0; ai < 2; ++ai)
#pragma unroll
                for (int m = 0; m < 4; ++m) { bf16* rp = base + (size_t)(row0 + ai * 128 + m * 16) * 1024;
#pragma unroll
                    for (int bj = 0; bj < 2; ++bj) st8(rp + 32 * bj, acc[ai][bj][m][0], acc[ai][bj][m][1]); }
        } else if (PC == 0 && (kind == K_SGR || kind == K_SGD)) {
            bf16* base = (kind == K_SGR ? sgr : sgd) + u.pn * 256 + cl;
#pragma unroll
            for (int ai = 0; ai < 2; ++ai)
#pragma unroll
                for (int m = 0; m < 4; ++m) { bf16* rp = base + (size_t)(row0 + ai * 128 + m * 16) * 1024;
#pragma unroll
                    for (int bj = 0; bj < 2; ++bj) { f32x4 a = acc[ai][bj][m][0], b = acc[ai][bj][m][1];
#pragma unroll
                        for (int i = 0; i < 4; ++i) { a[i] = a[i] * fast_sigmoid(a[i]); b[i] = b[i] * fast_sigmoid(b[i]); }
                        st8(rp + 32 * bj, a, b); } }
        } else if (PC == 1 && (kind == K_MGR || kind == K_MGD)) {
            bf16* base = (kind == K_MGR ? smgr : smgd) + u.pn * 256 + cl;
#pragma unroll
            for (int ai = 0; ai < 2; ++ai)
#pragma unroll
                for (int m = 0; m < 4; ++m) { bf16* rp = base + (size_t)(row0 + ai * 128 + m * 16) * 1024;
#pragma unroll
                    for (int bj = 0; bj < 2; ++bj) { f32x4 a = acc[ai][bj][m][0], b = acc[ai][bj][m][1];
#pragma unroll
                        for (int i = 0; i < 4; ++i) { a[i] = fast_sigmoid(a[i]); b[i] = fast_sigmoid(b[i]); }
                        st8(rp + 32 * bj, a, b); } }
        } else if (PC == 0 && (kind == K_QR || kind == K_KR)) {
            const int h = u.pn * 4 + wc; const float lg = __log2f(1.0f - __builtin_amdgcn_exp2f(-5.0f - (float)h));
            bf16* base = (kind == K_QR ? qr : kr) + u.pn * 256 + cl;
            const float sgn = (kind == K_QR) ? lg : -lg, mul = (kind == K_QR) ? 1.0f : 0.125f;
#pragma unroll
            for (int ai = 0; ai < 2; ++ai)
#pragma unroll
                for (int m = 0; m < 4; ++m) { const int row = row0 + ai * 128 + m * 16; bf16* rp = base + (size_t)row * 512;
                    const float f = mul * __builtin_amdgcn_exp2f((float)(row & 127) * sgn);
#pragma unroll
                    for (int bj = 0; bj < 2; ++bj) st8(rp + 32 * bj, acc[ai][bj][m][0] * f, acc[ai][bj][m][1] * f); }
        } else if (PC == 0 && (kind == K_QD || kind == K_KD)) {
            const float* g = (kind == K_QD) ? gq : gk; const float mul = (kind == K_QD) ? 0.125f * LOG2E : 1.0f;
            bf16* base = (kind == K_QD ? qd : kd) + u.pn * 256 + cl;
            f32x4 gv[2][2];
#pragma unroll
            for (int bj = 0; bj < 2; ++bj)
#pragma unroll
                for (int n = 0; n < 2; ++n) gv[bj][n] = *(const f32x4*)(g + 32 * bj + 8 * fq + 4 * n) * mul;
#pragma unroll
            for (int ai = 0; ai < 2; ++ai)
#pragma unroll
                for (int m = 0; m < 4; ++m) { bf16* rp = base + (size_t)(row0 + ai * 128 + m * 16) * 1024;
                    float ss = 0.f;
#pragma unroll
                    for (int bj = 0; bj < 2; ++bj)
#pragma unroll
                        for (int n = 0; n < 2; ++n) { const f32x4 x = acc[ai][bj][m][n]; ss += (x[0] * x[0] + x[1] * x[1]) + (x[2] * x[2] + x[3] * x[3]); }
                    ss += __shfl_xor(ss, 16); ss += __shfl_xor(ss, 32);
                    const float rs = __builtin_amdgcn_rsqf(ss * (1.0f / 64.0f) + EPS);
#pragma unroll
                    for (int bj = 0; bj < 2; ++bj) st8(rp + 32 * bj, acc[ai][bj][m][0] * gv[bj][0] * rs, acc[ai][bj][m][1] * gv[bj][1] * rs); }
        } else if (PC == 1 && kind == K_YR) {
            bf16* const yrb = (bf16*)mbuf + (size_t)u.pn * 256 + cl;
#pragma unroll
            for (int ai = 0; ai < 2; ++ai)
#pragma unroll
                for (int m = 0; m < 4; ++m) { bf16* rp = yrb + (size_t)(row0 + ai * 128 + m * 16) * 1024;
#pragma unroll
                    for (int bj = 0; bj < 2; ++bj) st8(rp + 32 * bj, acc[ai][bj][m][0], acc[ai][bj][m][1]); }
        } else if (PC == 1 && kind == K_YD) {
            const size_t cb = (size_t)u.pn * 256 + cl; const bf16* const yrb = (const bf16*)mbuf;
#pragma unroll
            for (int ai = 0; ai < 2; ++ai)
#pragma unroll
                for (int m = 0; m < 4; ++m) { const size_t ro = (size_t)(row0 + ai * 128 + m * 16) * 1024 + cb;
#pragma unroll
                    for (int bj = 0; bj < 2; ++bj) { const u32x4 sr = *(const u32x4*)(smgr + ro + 32 * bj), sd = *(const u32x4*)(smgd + ro + 32 * bj), yr = *(const u32x4*)(yrb + ro + 32 * bj);
                        const f32x4 a = acc[ai][bj][m][0], b = acc[ai][bj][m][1];
                        f32x4 o0, o1;
                        o0[0] = lo_bf(sr.x) * lo_bf(yr.x) + lo_bf(sd.x) * a[0]; o0[1] = hi_bf(sr.x) * hi_bf(yr.x) + hi_bf(sd.x) * a[1];
                        o0[2] = lo_bf(sr.y) * lo_bf(yr.y) + lo_bf(sd.y) * a[2]; o0[3] = hi_bf(sr.y) * hi_bf(yr.y) + hi_bf(sd.y) * a[3];
                        o1[0] = lo_bf(sr.z) * lo_bf(yr.z) + lo_bf(sd.z) * b[0]; o1[1] = hi_bf(sr.z) * hi_bf(yr.z) + hi_bf(sd.z) * b[1];
                        o1[2] = lo_bf(sr.w) * lo_bf(yr.w) + lo_bf(sd.w) * b[2]; o1[3] = hi_bf(sr.w) * hi_bf(yr.w) + hi_bf(sd.w) * b[3];
                        st8(mbf + ro + 32 * bj, o0, o1); }
                    asm volatile("" ::: "memory"); }
        } else if (PC == 2 && kind == K_OUT) {
            const size_t cb = (size_t)u.pn * 256 + cl;
#pragma unroll
            for (int ai = 0; ai < 2; ++ai) {
                f32x4 pre[4][2][2];
#pragma unroll
                for (int m = 0; m < 4; ++m) { const size_t ro = (size_t)(row0 + ai * 128 + m * 16) * 1024 + cb;
#pragma unroll
                    for (int bj = 0; bj < 2; ++bj) { pre[m][bj][0] = *(const f32x4*)(xin + ro + 32 * bj); pre[m][bj][1] = *(const f32x4*)(xin + ro + 32 * bj + 4); } }
#pragma unroll
                for (int m = 0; m < 4; ++m) { const size_t ro = (size_t)(row0 + ai * 128 + m * 16) * 1024 + cb;
#pragma unroll
                    for (int bj = 0; bj < 2; ++bj) { *(f32x4*)(xout + ro + 32 * bj) = pre[m][bj][0] + acc[ai][bj][m][0]; *(f32x4*)(xout + ro + 32 * bj + 4) = pre[m][bj][1] + acc[ai][bj][m][1]; } }
                asm volatile("" ::: "memory");
            }
        }
    }
};

struct SchedG1A {
    const char* A; const char* B; int G, c;
    __device__ __forceinline__ bool next(int i, pg8::Unit& u) const {
        const int L = i * G + c; if (L >= 64 * 28) return false;
        int pm, pg; pg8::tile_of(L, 64, 28, pm, pg);
        u.pm = pm; u.a = A + (size_t)pm * TSTEP; u.b = B + (size_t)pg * TSTEP;
        if (pg < 2) { u.kind = K_QR; u.pn = pg; } else if (pg < 4) { u.kind = K_KR; u.pn = pg - 2; } else if (pg < 8) { u.kind = K_VR; u.pn = pg - 4; } else if (pg < 12) { u.kind = K_SGR; u.pn = pg - 8; }
        else if (pg < 16) { u.kind = K_QD; u.pn = pg - 12; } else if (pg < 20) { u.kind = K_KD; u.pn = pg - 16; } else if (pg < 24) { u.kind = K_VD; u.pn = pg - 20; } else { u.kind = K_SGD; u.pn = pg - 24; }
        return true;
    }
};
struct SchedP34 {
    const char *ws, *Wro; int c;
    __device__ __forceinline__ bool next(int i, pg8::Unit& u) const {
        if (i >= 4) return false;
        const char* H = ws + WS_H; const char* OR = ws + WS_SGR; const char* OD = ws + WS_SGD; const char* Win = ws + WS_WIN; const char* Wdo = Wro + 2 * MiB;
        int pm, pn; pg8::tile_of(c, 64, 4, pm, pn); u.pm = pm; u.pn = pn;
        if (i == 0) { u.kind = K_MGR; u.a = H + (size_t)pm * TSTEP; u.b = Win + (size_t)(28 + pn) * TSTEP; }
        else if (i == 1) { u.kind = K_MGD; u.a = H + (size_t)pm * TSTEP; u.b = Win + (size_t)(32 + pn) * TSTEP; }
        else if (i == 2) { u.kind = K_YR; u.a = OR + (size_t)pm * TSTEP; u.b = Wro + (size_t)pn * TSTEP; }
        else { u.kind = K_YD; u.a = OD + (size_t)pm * TSTEP; u.b = Wdo + (size_t)pn * TSTEP; }
        return true;
    }
};
struct SchedG4 {
    const char *Mb, *Wout; int c;
    __device__ __forceinline__ bool next(int i, pg8::Unit& u) const {
        if (i >= 1) return false;
        int pm, pn; pg8::tile_of(c, 64, 4, pm, pn); u.pm = pm; u.pn = pn; u.kind = K_OUT; u.a = Mb + (size_t)pm * TSTEP; u.b = Wout + (size_t)pn * TSTEP; return true;
    }
};


namespace att {
typedef float f32x16 __attribute__((ext_vector_type(16)));
typedef short s16x4 __attribute__((ext_vector_type(4)));
typedef short v4i16_t __attribute__((ext_vector_type(4)));
constexpr int SLOT_OFF = 65536, SLOT_BYTES = 32768, V_OFF = 16384;
__device__ __forceinline__ int crow(int r, int hi) { return (r & 3) + 8 * (r >> 2) + 4 * hi; }
__device__ __forceinline__ s16x4 vtr(LAS const unsigned char* p) { return __builtin_bit_cast(s16x4, __builtin_amdgcn_ds_read_tr16_b64_v4i16((LAS v4i16_t*)p)); }
#define ATT_MFMA(a, b, c) __builtin_amdgcn_mfma_f32_32x32x16_bf16(a, b, c, 0, 0, 0)

__device__ __forceinline__ void attn_unit(LAS unsigned char* lds, const unsigned char* ws, const int b, const int h, const int qb, const float lam, const float omli, const float* __restrict__ gsub, const int win) {
    int tid_ = threadIdx.x; asm volatile("" : "+v"(tid_));
    const int tid = tid_, lane = tid & 63, r32 = lane & 31, hi = lane >> 5, w = __builtin_amdgcn_readfirstlane(tid >> 6), rg = w & 3, kg = w >> 2;
    const bf16* QD = (const bf16*)(ws + WS_QD); const bf16* KD = (const bf16*)(ws + WS_KD); const bf16* VD = (const bf16*)(ws + WS_VD); bf16* SGD = (bf16*)(ws + WS_SGD);
    const size_t tb = (size_t)b * SEQ; const int q0 = qb * 128, NT = (q0 + 128) / 64;
    const int T0 = (q0 > win ? q0 - win : 0) >> 6;
#pragma unroll
    for (int k = 0; k < 4; ++k) { const int p = 4 * kg + k; const bf16* src = QD + (tb + q0 + 32 * rg + r32) * 1024 + h * 128 + (p >> 2) * 64 + (p & 3) * 16 + hi * 8;
        __builtin_amdgcn_global_load_lds((const unsigned*)src, (LAS unsigned*)(lds + rg * 8192 + p * 1024), 16, 0, 0); }
    const bf16* ksrc = KD + (tb + lane) * 1024 + h * 128 + (w & 7) * 8;
    const bf16* vsrc = VD + (tb + 16 * (w & 3) + (lane >> 2)) * 1024 + h * 128 + (w >> 2) * 32 + (lane & 3) * 8;
#define ATT_STAGE(t, slot) do { _Pragma("unroll") for (int rr = 0; rr < 2; ++rr) { \
        __builtin_amdgcn_global_load_lds((const unsigned*)(ksrc + (size_t)(t) * 65536 + rr * 64), (LAS unsigned*)(lds + SLOT_OFF + (slot) * SLOT_BYTES + (rr * 8 + w) * 1024), 16, 0, 0); \
        __builtin_amdgcn_global_load_lds((const unsigned*)(vsrc + (size_t)(t) * 65536 + rr * 64), (LAS unsigned*)(lds + SLOT_OFF + (slot) * SLOT_BYTES + V_OFF + (rr * 8 + w) * 1024), 16, 0, 0); } } while (0)
    ATT_STAGE(T0, 0);
    __syncthreads();
    const float slope = __builtin_amdgcn_exp2f(-(float)(h + 1)) * LOG2E;
    const int n = q0 + 32 * rg + r32;
    f32x16 O[2][4];
#pragma unroll
    for (int j = 0; j < 2; ++j)
#pragma unroll
        for (int e = 0; e < 4; ++e)
#pragma unroll
            for (int r = 0; r < 16; ++r) O[j][e][r] = 0.f;
    float lsum[2] = {0.f, 0.f};
    const int qoff = rg * 8192 + lane * 16;
    const int koff = hi * 1024 + (32 * kg + r32) * 16;
    const int voff = V_OFF + 2 * kg * 1024 + ((lane >> 4) & 1) * 32 + (lane & 3) * 8 + (4 * hi + ((lane & 15) >> 2)) * 64;
    for (int t = T0; t < NT; ++t) {
        if (t + 1 < NT) ATT_STAGE(t + 1, (t + 1 - T0) & 1);
        const int k0 = t * 64 + 32 * kg;
        if (k0 <= q0 + 32 * rg + 31) {
            LAS const unsigned char* slot = lds + SLOT_OFF + ((t - T0) & 1) * SLOT_BYTES;
            float sl = slope; asm volatile("" : "+v"(sl));
            const int dn = n - k0 - 4 * hi; const float base = -sl * (float)dn;
            const bool diag = (k0 + 31 > q0 + 32 * rg);
#pragma unroll
            for (int j = 0; j < 2; ++j) {
                f32x16 p0;
#pragma unroll
                for (int r = 0; r < 16; ++r) { const int kc = (r & 3) + 8 * (r >> 2); p0[r] = __builtin_fmaf(sl, (float)kc, base); }
                if (diag) {
#pragma unroll
                    for (int r = 0; r < 16; ++r) { const int kc = (r & 3) + 8 * (r >> 2); if (kc > dn) p0[r] = -INFINITY; }
                }
#pragma unroll
                for (int d0 = 0; d0 < 4; ++d0) {
                    const bf16x8 kf0 = *(LAS const bf16x8*)(slot + koff + (j * 8 + 2 * d0) * 1024);
                    const bf16x8 qf = *(LAS const bf16x8*)(lds + qoff + (j * 4 + d0) * 1024);
                    p0 = ATT_MFMA(kf0, qf, p0);
                }
                float s = 0.f;
#pragma unroll
                for (int r = 0; r < 16; ++r) { p0[r] = __builtin_amdgcn_exp2f(p0[r]); s += p0[r]; }
                lsum[j] += s;
                u32x4 pw[2];
#pragma unroll
                for (int i = 0; i < 4; ++i) { pw[0][i] = cvt_pk_bf16(p0[2 * i], p0[2 * i + 1]); pw[1][i] = cvt_pk_bf16(p0[8 + 2 * i], p0[9 + 2 * i]); }
#pragma unroll
                for (int eb = 0; eb < 4; ++eb)
#pragma unroll
                    for (int ks = 0; ks < 2; ++ks) {
                        const s16x4 vlo = vtr(slot + voff + eb * 4096 + ks * 1024), vhi = vtr(slot + voff + eb * 4096 + ks * 1024 + 512);
                        const bf16x8 vf = (bf16x8){vlo[0], vlo[1], vlo[2], vlo[3], vhi[0], vhi[1], vhi[2], vhi[3]};
                        O[j][eb] = ATT_MFMA(__builtin_bit_cast(bf16x8, pw[ks]), vf, O[j][eb]);
                    }
            }
        }
        __syncthreads();
    }
    lsum[0] += __shfl_xor(lsum[0], 32); lsum[1] += __shfl_xor(lsum[1], 32);
    LAS float* dump = (LAS float*)(lds + rg * 32768);
    LAS float* lx = (LAS float*)(lds + 131072 + rg * 1024);
    if (kg == 1) {
#pragma unroll
        for (int j = 0; j < 2; ++j)
#pragma unroll
            for (int eb = 0; eb < 4; ++eb)
#pragma unroll
                for (int r = 0; r < 16; ++r) dump[((j * 4 + eb) * 16 + r) * 64 + lane] = O[j][eb][r];
        lx[lane] = lsum[0]; lx[64 + lane] = lsum[1];
    }
    asm volatile("s_waitcnt lgkmcnt(0)" ::: "memory");
    __syncthreads();
    if (kg == 0) {
#pragma unroll
        for (int j = 0; j < 2; ++j)
#pragma unroll
            for (int eb = 0; eb < 4; ++eb)
                {
#pragma unroll
                  for (int r = 0; r < 16; ++r) O[j][eb][r] += dump[((j * 4 + eb) * 16 + r) * 64 + lane];
                  asm volatile("s_waitcnt lgkmcnt(0)" : "+v"(O[j][eb]) :: "memory"); }
        lsum[0] += lx[lane]; lsum[1] += lx[64 + lane];
        asm volatile("s_waitcnt lgkmcnt(0)" ::: "memory");
        int r32e = r32; asm volatile("" : "+v"(r32e));
        LAS float* wsf = lx + 128;
        if (hi == 0) { wsf[r32] = 1.0f / lsum[0]; wsf[32 + r32] = lam / lsum[1]; }
        asm volatile("s_waitcnt lgkmcnt(0)" ::: "memory");
        float gv[4];
#pragma unroll
        for (int eb = 0; eb < 4; ++eb) gv[eb] = gsub[h * 128 + eb * 32 + r32e] * omli;
#pragma unroll
        for (int half = 0; half < 2; ++half) {
            bf16 gt[8][4];
#pragma unroll
            for (int r8 = 0; r8 < 8; ++r8) { const bf16* rowp = SGD + (tb + q0 + 32 * rg + crow(half * 8 + r8, hi)) * 1024 + h * 128 + r32e;
#pragma unroll
                for (int eb = 0; eb < 4; ++eb) gt[r8][eb] = rowp[eb * 32]; }
#pragma unroll
            for (int r8 = 0; r8 < 8; ++r8) { const int r = half * 8 + r8; const int qr = crow(r, hi); const float i0 = wsf[qr], i1 = wsf[32 + qr];
                float o[4], ss = 0.f;
#pragma unroll
                for (int eb = 0; eb < 4; ++eb) { o[eb] = O[0][eb][r] * i0 - O[1][eb][r] * i1; ss += o[eb] * o[eb]; }
                ss += __shfl_xor(ss, 1); ss += __shfl_xor(ss, 2); ss += __shfl_xor(ss, 4); ss += __shfl_xor(ss, 8); ss += __shfl_xor(ss, 16);
                const float rs = __builtin_amdgcn_rsqf(ss * (1.0f / 128.0f) + EPS);
                bf16* rowp = SGD + (tb + q0 + 32 * rg + qr) * 1024 + h * 128 + r32e;
#pragma unroll
                for (int eb = 0; eb < 4; ++eb) rowp[eb * 32] = f2bf(o[eb] * rs * gv[eb] * bf2f(gt[r8][eb]));
            }
            asm volatile("" ::: "memory");
        }
    }
    asm volatile("s_waitcnt lgkmcnt(0)" ::: "memory");
    __syncthreads();
#undef ATT_STAGE
}
}

namespace ret {
using att::f32x16; using att::s16x4; using att::crow; using att::vtr;
constexpr int SET = 49152, KT = 0, VI = 16384, OST = 98304, ST = 131072, RED = 147456;
__device__ __forceinline__ void ret_unit(LAS unsigned char* lds, const unsigned char* ws, const int b, const int h, const float* __restrict__ gn) {
    int tid_ = threadIdx.x; asm volatile("" : "+v"(tid_));
    const int tid = tid_, lane = tid & 63, r32 = lane & 31, hi = lane >> 5, w = __builtin_amdgcn_readfirstlane(tid >> 6);
    const int ib = w & 3, eh = w >> 2, dh = w & 1, ebo = w >> 1;
    const bf16* QR = (const bf16*)(ws + WS_QR); const bf16* KR = (const bf16*)(ws + WS_KR); const bf16* VR = (const bf16*)(ws + WS_VR); bf16* SGR = (bf16*)(ws + WS_SGR);
    const size_t tb = (size_t)b * SEQ;
    const float lg = __log2f(1.0f - __builtin_amdgcn_exp2f(-5.0f - (float)h)), gC = __builtin_amdgcn_exp2f(128.0f * lg);
    for (int i = tid; i < 16384 / 16; i += 512) *(LAS u32x4*)(lds + ST + i * 16) = (u32x4){0u, 0u, 0u, 0u};
    f32x16 sblk;
#pragma unroll
    for (int r = 0; r < 16; ++r) sblk[r] = 0.f;
    const int vpat = ((lane >> 4) & 1) * 32 + (lane & 3) * 8 + (4 * hi + ((lane & 15) >> 2)) * 64;
    const int prow = tid >> 4, pcol = (tid & 15) * 8;
    f32x4 gA = *(const f32x4*)(gn + h * 128 + pcol), gB = *(const f32x4*)(gn + h * 128 + pcol + 4);
#define RET_STAGE(c, s) do { const size_t t0_ = tb + (size_t)(c) * 128; LAS unsigned char* sb_ = lds + (s) * SET; \
        _Pragma("unroll") for (int k = 0; k < 2; ++k) { const int p = 2 * w + k, d2 = p >> 3, kg = p & 7; \
            __builtin_amdgcn_global_load_lds((const unsigned*)(KR + (t0_ + 16 * kg + (lane >> 2)) * 512 + h * 64 + d2 * 32 + (lane & 3) * 8), (LAS unsigned*)(sb_ + KT + p * 1024), 16, 0, 0); } \
        _Pragma("unroll") for (int k = 0; k < 4; ++k) { const int p = 4 * w + k, eg = p >> 3, kg = p & 7; \
            __builtin_amdgcn_global_load_lds((const unsigned*)(VR + (t0_ + 16 * kg + (lane >> 2)) * 1024 + h * 128 + eg * 32 + (lane & 3) * 8), (LAS unsigned*)(sb_ + VI + p * 1024), 16, 0, 0); } } while (0)
    RET_STAGE(0, 0);
    bf16x8 qn[4];
#pragma unroll
    for (int d0 = 0; d0 < 4; ++d0) qn[d0] = *(const bf16x8*)(QR + (tb + 32 * ib + r32) * 512 + h * 64 + d0 * 16 + hi * 8);
    for (int c = 0; c < SEQ / 128; ++c) {
        const size_t t0 = tb + (size_t)c * 128;
        __syncthreads();
        LAS const unsigned char* sb = lds + (c & 1) * SET;
        u32x4 gt[4];
#pragma unroll
        for (int k = 0; k < 4; ++k) gt[k] = *(const u32x4*)(SGR + (t0 + prow + 32 * k) * 1024 + h * 128 + pcol);
        bf16x8 qf[4];
#pragma unroll
        for (int d0 = 0; d0 < 4; ++d0) qf[d0] = qn[d0];
        if (c + 1 < SEQ / 128) { RET_STAGE(c + 1, (c + 1) & 1);
#pragma unroll
            for (int d0 = 0; d0 < 4; ++d0) qn[d0] = *(const bf16x8*)(QR + (t0 + 128 + 32 * ib + r32) * 512 + h * 64 + d0 * 16 + hi * 8); }
        f32x16 O[2];
#pragma unroll
        for (int eb = 0; eb < 2; ++eb)
#pragma unroll
            for (int r = 0; r < 16; ++r) O[eb][r] = 0.f;
#pragma unroll
        for (int jb = 0; jb < 4; ++jb) {
            if (jb <= ib) {
                f32x16 s;
#pragma unroll
                for (int r = 0; r < 16; ++r) s[r] = 0.f;
#pragma unroll
                for (int d0 = 0; d0 < 4; ++d0) { const bf16x8 kf = *(LAS const bf16x8*)(sb + KT + (d0 >> 1) * 8192 + (32 * jb + r32) * 64 + ((d0 & 1) * 16 + 8 * hi) * 2); s = ATT_MFMA(kf, qf[d0], s); }
                if (jb == ib) {
#pragma unroll
                    for (int r = 0; r < 16; ++r) if (crow(r, hi) > r32) s[r] = 0.f;
                }
                u32x4 pw[2];
#pragma unroll
                for (int i = 0; i < 4; ++i) { pw[0][i] = cvt_pk_bf16(s[2 * i], s[2 * i + 1]); pw[1][i] = cvt_pk_bf16(s[8 + 2 * i], s[9 + 2 * i]); }
#pragma unroll
                for (int eb = 0; eb < 2; ++eb)
#pragma unroll
                    for (int ks = 0; ks < 2; ++ks) { LAS const unsigned char* vp = sb + VI + (2 * eh + eb) * 8192 + (2 * jb + ks) * 1024 + vpat;
                        const s16x4 vlo = vtr(vp), vhi = vtr(vp + 512);
                        O[eb] = ATT_MFMA(__builtin_bit_cast(bf16x8, pw[ks]), ((bf16x8){vlo[0], vlo[1], vlo[2], vlo[3], vhi[0], vhi[1], vhi[2], vhi[3]}), O[eb]); }
            }
        }
#pragma unroll
        for (int eb = 0; eb < 2; ++eb)
#pragma unroll
            for (int d0 = 0; d0 < 4; ++d0) { const bf16x8 sf = *(LAS const bf16x8*)(lds + ST + (32 * (2 * eh + eb) + r32) * 128 + (16 * d0 + 8 * hi) * 2); O[eb] = ATT_MFMA(qf[d0], sf, O[eb]); }
        { f32x16 kv;
#pragma unroll
          for (int r = 0; r < 16; ++r) kv[r] = 0.f;
#pragma unroll
          for (int ks = 0; ks < 8; ++ks) { LAS const unsigned char* kp = sb + KT + dh * 8192 + ks * 1024 + vpat; LAS const unsigned char* vp = sb + VI + ebo * 8192 + ks * 1024 + vpat;
              const s16x4 klo = vtr(kp), khi = vtr(kp + 512), vlo = vtr(vp), vhi = vtr(vp + 512);
              kv = ATT_MFMA(((bf16x8){klo[0], klo[1], klo[2], klo[3], khi[0], khi[1], khi[2], khi[3]}), ((bf16x8){vlo[0], vlo[1], vlo[2], vlo[3], vhi[0], vhi[1], vhi[2], vhi[3]}), kv); }
#pragma unroll
          for (int r = 0; r < 16; ++r) sblk[r] = gC * (sblk[r] + kv[r]); }
        float ss[16];
#pragma unroll
        for (int r = 0; r < 16; ++r) { float s2 = O[0][r] * O[0][r] + O[1][r] * O[1][r];
            s2 += __shfl_xor(s2, 1); s2 += __shfl_xor(s2, 2); s2 += __shfl_xor(s2, 4); s2 += __shfl_xor(s2, 8); s2 += __shfl_xor(s2, 16); ss[r] = s2; }
        if (r32 == 0) {
#pragma unroll
            for (int r = 0; r < 16; ++r) ((LAS float*)(lds + RED))[(32 * ib + crow(r, hi)) * 2 + eh] = ss[r]; }
#pragma unroll
        for (int r = 0; r < 16; ++r) { LAS bf16* sp = (LAS bf16*)(lds + OST) + (32 * ib + crow(r, hi)) * 128 + 64 * eh + r32; sp[0] = f2bf(O[0][r]); sp[32] = f2bf(O[1][r]); }
        asm volatile("s_waitcnt lgkmcnt(0)" ::: "memory"); __builtin_amdgcn_s_barrier(); asm volatile("" ::: "memory");
#pragma unroll
        for (int g = 0; g < 4; ++g) { unsigned long long v = (unsigned long long)cvt_pk_bf16(sblk[4 * g], sblk[4 * g + 1]) | ((unsigned long long)cvt_pk_bf16(sblk[4 * g + 2], sblk[4 * g + 3]) << 32);
            *(LAS unsigned long long*)(lds + ST + (32 * ebo + r32) * 128 + (32 * dh + 8 * g + 4 * hi) * 2) = v; }
#pragma unroll
        for (int k = 0; k < 4; ++k) { const int row = prow + 32 * k; const LAS float* rp = (const LAS float*)(lds + RED) + row * 2;
            const float rs = __builtin_amdgcn_rsqf((rp[0] + rp[1]) * (1.0f / 128.0f) + EPS);
            const u32x4 ov = *(LAS const u32x4*)(lds + OST + row * 256 + pcol * 2); const u32x4 gg = gt[k];
            u32x4 res;
            res.x = cvt_pk_bf16(lo_bf(ov.x) * rs * gA[0] * lo_bf(gg.x), hi_bf(ov.x) * rs * gA[1] * hi_bf(gg.x));
            res.y = cvt_pk_bf16(lo_bf(ov.y) * rs * gA[2] * lo_bf(gg.y), hi_bf(ov.y) * rs * gA[3] * hi_bf(gg.y));
            res.z = cvt_pk_bf16(lo_bf(ov.z) * rs * gB[0] * lo_bf(gg.z), hi_bf(ov.z) * rs * gB[1] * hi_bf(gg.z));
            res.w = cvt_pk_bf16(lo_bf(ov.w) * rs * gB[2] * lo_bf(gg.w), hi_bf(ov.w) * rs * gB[3] * hi_bf(gg.w));
            *(u32x4*)(SGR + (t0 + row) * 1024 + h * 128 + pcol) = res; }
    }
    __syncthreads();
#undef RET_STAGE
}
}

__device__ const unsigned short att_order[1024] = {223, 255, 479, 511, 735, 767, 991, 1023, 222, 254, 478, 510, 734, 766, 990, 1022, 221, 253, 477, 509, 733, 765, 989, 1021, 220, 252, 476, 508, 732, 764, 988, 1020, 219, 251, 475, 507, 731, 763, 987, 1019, 218, 250, 474, 506, 730, 762, 986, 1018, 217, 249, 473, 505, 729, 761, 985, 1017, 216, 248, 472, 504, 728, 760, 984, 1016, 215, 247, 471, 503, 727, 759, 983, 1015, 214, 246, 470, 502, 726, 758, 982, 1014, 213, 245, 469, 501, 725, 757, 981, 1013, 212, 244, 468, 500, 724, 756, 980, 1012, 179, 180, 181, 182, 183, 184, 185, 186, 187, 188, 189, 190, 191, 211, 243, 435, 436, 437, 438, 439, 440, 441, 442, 443, 444, 445, 446, 447, 467, 499, 691, 692, 693, 694, 695, 696, 697, 698, 699, 700, 701, 702, 703, 723, 755, 947, 948, 949, 950, 951, 952, 953, 954, 955, 956, 957, 958, 959, 979, 1011, 178, 210, 242, 434, 466, 498, 690, 722, 754, 946, 978, 1010, 177, 209, 241, 433, 465, 497, 689, 721, 753, 945, 977, 1009, 176, 208, 240, 432, 464, 496, 688, 720, 752, 944, 976, 1008, 175, 207, 239, 431, 463, 495, 687, 719, 751, 943, 975, 1007, 174, 206, 238, 430, 462, 494, 686, 718, 750, 942, 974, 1006, 173, 205, 237, 429, 461, 493, 685, 717, 749, 941, 973, 1005, 172, 204, 236, 428, 460, 492, 684, 716, 748, 940, 972, 1004, 171, 203, 235, 427, 459, 491, 683, 715, 747, 939, 971, 1003, 170, 202, 234, 426, 458, 490, 682, 714, 746, 938, 970, 1002, 138, 139, 140, 141, 142, 143, 144, 145, 146, 147, 148, 149, 150, 151, 152, 153, 154, 155, 156, 157, 158, 159, 394, 395, 396, 397, 398, 399, 400, 401, 402, 403, 404, 405, 406, 407, 408, 409, 410, 411, 412, 413, 414, 415, 650, 651, 652, 653, 654, 655, 656, 657, 658, 659, 660, 661, 662, 663, 664, 665, 666, 667, 668, 669, 670, 671, 906, 907, 908, 909, 910, 911, 912, 913, 914, 915, 916, 917, 918, 919, 920, 921, 922, 923, 924, 925, 926, 927, 137, 169, 201, 233, 393, 425, 457, 489, 649, 681, 713, 745, 905, 937, 969, 1001, 136, 168, 200, 232, 392, 424, 456, 488, 648, 680, 712, 744, 904, 936, 968, 1000, 135, 167, 199, 231, 391, 423, 455, 487, 647, 679, 711, 743, 903, 935, 967, 999, 134, 166, 198, 230, 390, 422, 454, 486, 646, 678, 710, 742, 902, 934, 966, 998, 101, 102, 103, 104, 105, 106, 107, 108, 109, 110, 111, 112, 113, 114, 115, 116, 117, 118, 119, 120, 121, 122, 123, 124, 125, 126, 127, 133, 165, 197, 229, 357, 358, 359, 360, 361, 362, 363, 364, 365, 366, 367, 368, 369, 370, 371, 372, 373, 374, 375, 376, 377, 378, 379, 380, 381, 382, 383, 389, 421, 453, 485, 613, 614, 615, 616, 617, 618, 619, 620, 621, 622, 623, 624, 625, 626, 627, 628, 629, 630, 631, 632, 633, 634, 635, 636, 637, 638, 639, 645, 677, 709, 741, 869, 870, 871, 872, 873, 874, 875, 876, 877, 878, 879, 880, 881, 882, 883, 884, 885, 886, 887, 888, 889, 890, 891, 892, 893, 894, 895, 901, 933, 965, 997, 100, 132, 164, 196, 228, 356, 388, 420, 452, 484, 612, 644, 676, 708, 740, 868, 900, 932, 964, 996, 99, 131, 163, 195, 227, 355, 387, 419, 451, 483, 611, 643, 675, 707, 739, 867, 899, 931, 963, 995, 67, 68, 69, 70, 71, 72, 73, 74, 75, 76, 77, 78, 79, 80, 81, 82, 83, 84, 85, 86, 87, 88, 89, 90, 91, 92, 93, 94, 95, 323, 324, 325, 326, 327, 328, 329, 330, 331, 332, 333, 334, 335, 336, 337, 338, 339, 340, 341, 342, 343, 344, 345, 346, 347, 348, 349, 350, 351, 579, 580, 581, 582, 583, 584, 585, 586, 587, 588, 589, 590, 591, 592, 593, 594, 595, 596, 597, 598, 599, 600, 601, 602, 603, 604, 605, 606, 607, 835, 836, 837, 838, 839, 840, 841, 842, 843, 844, 845, 846, 847, 848, 849, 850, 851, 852, 853, 854, 855, 856, 857, 858, 859, 860, 861, 862, 863, 66, 98, 130, 162, 194, 226, 322, 354, 386, 418, 450, 482, 578, 610, 642, 674, 706, 738, 834, 866, 898, 930, 962, 994, 34, 35, 36, 37, 38, 39, 40, 41, 42, 43, 44, 45, 46, 47, 48, 49, 50, 51, 52, 53, 54, 55, 56, 57, 58, 59, 60, 61, 62, 63, 290, 291, 292, 293, 294, 295, 296, 297, 298, 299, 300, 301, 302, 303, 304, 305, 306, 307, 308, 309, 310, 311, 312, 313, 314, 315, 316, 317, 318, 319, 546, 547, 548, 549, 550, 551, 552, 553, 554, 555, 556, 557, 558, 559, 560, 561, 562, 563, 564, 565, 566, 567, 568, 569, 570, 571, 572, 573, 574, 575, 802, 803, 804, 805, 806, 807, 808, 809, 810, 811, 812, 813, 814, 815, 816, 817, 818, 819, 820, 821, 822, 823, 824, 825, 826, 827, 828, 829, 830, 831, 1, 2, 3, 4, 5, 6, 7, 8, 9, 10, 11, 12, 13, 14, 15, 16, 17, 18, 19, 20, 21, 22, 23, 24, 25, 26, 27, 28, 29, 30, 31, 33, 65, 97, 129, 161, 193, 225, 257, 258, 259, 260, 261, 262, 263, 264, 265, 266, 267, 268, 269, 270, 271, 272, 273, 274, 275, 276, 277, 278, 279, 280, 281, 282, 283, 284, 285, 286, 287, 289, 321, 353, 385, 417, 449, 481, 513, 514, 515, 516, 517, 518, 519, 520, 521, 522, 523, 524, 525, 526, 527, 528, 529, 530, 531, 532, 533, 534, 535, 536, 537, 538, 539, 540, 541, 542, 543, 545, 577, 609, 641, 673, 705, 737, 769, 770, 771, 772, 773, 774, 775, 776, 777, 778, 779, 780, 781, 782, 783, 784, 785, 786, 787, 788, 789, 790, 791, 792, 793, 794, 795, 796, 797, 798, 799, 801, 833, 865, 897, 929, 961, 993, 0, 32, 64, 96, 128, 160, 192, 224, 256, 288, 320, 352, 384, 416, 448, 480, 512, 544, 576, 608, 640, 672, 704, 736, 768, 800, 832, 864, 896, 928, 960, 992};
constexpr int CW_QUEUE = 2048;

#define XB_TMO      128
#define XB_XCNT(j)  (256  + 64 * (j))
#define XB_XSUB(j)  (1280 + 64 * (j))
#define XB_XGEN(j)  (2304 + 64 * (j))
#define XB_TOP      3328
#define XB_TOPGEN   3392
#define XCD_BAR_WORDS 3456
#define XB_SPIN_CAP (1u << 18)
__device__ __forceinline__ unsigned xb_ld(unsigned* p)              { return __hip_atomic_load(p, __ATOMIC_RELAXED, __HIP_MEMORY_SCOPE_AGENT); }
__device__ __forceinline__ unsigned xb_add(unsigned* p, unsigned v) { return __hip_atomic_fetch_add(p, v, __ATOMIC_RELAXED, __HIP_MEMORY_SCOPE_AGENT); }
__device__ __forceinline__ unsigned xb_xcc_id() { return (unsigned)__builtin_amdgcn_s_getreg((3 << 11) | 20) & 0xFu; }
#define XB_SPIN(cond, bar) do { unsigned _sp = 0; while (cond) { __builtin_amdgcn_s_sleep(1); \
    if ((++_sp & 255u) == 0u) { if (xb_ld(&(bar)[XB_TMO])) break; if (_sp > XB_SPIN_CAP) { atomicAdd(&(bar)[XB_TMO], 1u); break; } } } } while (0)
struct XcdBarrier { unsigned* bar; unsigned x; volatile LAS unsigned* st; };
__device__ __forceinline__ XcdBarrier xcd_barrier_post(unsigned* bar, volatile LAS unsigned* st) {
    XcdBarrier b; b.bar = bar; b.x = xb_xcc_id(); b.st = st;
    if (threadIdx.x == 0) (void)xb_add(&bar[XB_XCNT(b.x)], 1u);
    return b;
}
__device__ __forceinline__ void xcd_barrier_complete(unsigned* bar, unsigned x, unsigned& nloc, unsigned& nx) {
    const unsigned G = gridDim.x * gridDim.y * gridDim.z;
    unsigned sum, cnt, mine, sp = 0u;
    for (;;) {
        sum = 0u; cnt = 0u; mine = 0u;
#pragma unroll
        for (unsigned j = 0; j < 16; ++j) { const unsigned c = xb_ld(&bar[XB_XCNT(j)]); sum += c; cnt += (c > 0u) ? 1u : 0u; mine = (j == x) ? c : mine; }
        if (sum == G) break;
        __builtin_amdgcn_s_sleep(1);
        if ((++sp & 255u) == 0u) { if (xb_ld(&bar[XB_TMO])) break; if (sp > XB_SPIN_CAP) { atomicAdd(&bar[XB_TMO], 1u); break; } }
    }
    nloc = mine > 0u ? mine : 1u; nx = cnt > 0u ? cnt : 1u;
}
__device__ __forceinline__ void xcd_barrier(const XcdBarrier& b) {
    asm volatile("s_waitcnt vmcnt(0)" ::: "memory");
    __syncthreads();
    if (threadIdx.x == 0) {
        unsigned* bar = b.bar;
        __builtin_amdgcn_s_waitcnt(0);
        unsigned nloc = b.st[0], nx = b.st[1];
        if (nloc == 0u) { xcd_barrier_complete(bar, b.x, nloc, nx); b.st[0] = nloc; b.st[1] = nx; }
        const unsigned old = xb_add(&bar[XB_XSUB(b.x)], 1u);
        const unsigned gen = old / nloc;
        if (old + 1u == (gen + 1u) * nloc) {
            __builtin_amdgcn_fence(__ATOMIC_RELEASE, "agent");
            asm volatile("s_waitcnt vmcnt(0)" ::: "memory");
            const unsigned og = xb_add(&bar[XB_TOP], 1u);
            const unsigned tg = og / nx;
            if (og + 1u == (tg + 1u) * nx) xb_add(&bar[XB_TOPGEN], 1u);
            else XB_SPIN(xb_ld(&bar[XB_TOPGEN]) == tg, bar);
            __builtin_amdgcn_fence(__ATOMIC_ACQUIRE, "agent");
            xb_add(&bar[XB_XGEN(b.x)], 1u);
            asm volatile("s_waitcnt vmcnt(0)" ::: "memory");
        } else {
            XB_SPIN(xb_ld(&bar[XB_XGEN(b.x)]) == gen, bar);
            __builtin_amdgcn_fence(__ATOMIC_ACQUIRE, "agent");
            asm volatile("s_waitcnt vmcnt(0)" ::: "memory");
        }
    }
    __syncthreads();
}

#define LDS_WAIT() asm volatile("s_waitcnt lgkmcnt(0)" ::: "memory")
__device__ __forceinline__ float wave_sum(float v) {
#pragma unroll
    for (int o = 1; o < 64; o <<= 1) v += __shfl_xor(v, o);
    return v;
}
__device__ __forceinline__ void p0_transpose_item(const float* W, int K, int N, bf16* WT, LAS float* scr, int item, int lane) {
    const int nblk = N / 32, kb = item / nblk, nb = item % nblk, k0 = 64 * kb, n0 = 32 * nb;
#pragma unroll 8
    for (int i = 0; i < 32; ++i) { const int kk = 2 * i + (lane >> 5); scr[kk * 33 + (lane & 31)] = W[(size_t)(k0 + kk) * N + n0 + (lane & 31)]; }
    LDS_WAIT(); asm volatile("" ::: "memory");
    const int c = lane & 7;
#pragma unroll
    for (int j = 0; j < 4; ++j) { const int n = (lane >> 3) + 8 * j; const LAS float* s = scr + (8 * c) * 33 + n;
        u32x4 o; o.x = pk2(s[0 * 33], s[1 * 33]); o.y = pk2(s[2 * 33], s[3 * 33]); o.z = pk2(s[4 * 33], s[5 * 33]); o.w = pk2(s[6 * 33], s[7 * 33]);
        *(GAS u32x4*)(WT + (size_t)(n0 + n) * K + k0 + 8 * c) = o; }
    LDS_WAIT(); asm volatile("" ::: "memory");
}
__device__ __forceinline__ void rms_row_to_bf16(const float* xrow, const float* g, bf16* orow, int lane) {
    const GAS f32x4* xr = (const GAS f32x4*)xrow + lane; const GAS f32x4* gr = (const GAS f32x4*)g + lane;
    f32x4 v[4]; float s = 0.f;
#pragma unroll
    for (int j = 0; j < 4; ++j) { v[j] = xr[64 * j]; s += (v[j].x * v[j].x + v[j].y * v[j].y) + (v[j].z * v[j].z + v[j].w * v[j].w); }
    const float rs = 1.0f / sqrtf(wave_sum(s) * (1.f / DM) + EPS);
    GAS unsigned long long* o8 = (GAS unsigned long long*)orow + lane;
#pragma unroll
    for (int j = 0; j < 4; ++j) { const f32x4 gg = gr[64 * j];
        o8[64 * j] = (unsigned long long)pk2(v[j].x * rs * gg.x, v[j].y * rs * gg.y) | ((unsigned long long)pk2(v[j].z * rs * gg.z, v[j].w * rs * gg.w) << 32); }
}

__device__ __forceinline__ const float* in_ptr(int k) {
    typedef __attribute__((address_space(4))) const char* cptr4;
    cptr4 ka = (cptr4)__builtin_amdgcn_kernarg_segment_ptr(); cptr4 kb;
    asm volatile("s_mov_b64 %0, %1" : "=s"(kb) : "s"(ka));
    typedef const float* cfp; typedef __attribute__((address_space(4))) const cfp* cfp4;
    return *(cfp4)(kb + k * 8);
}
constexpr int NWAVES = 8;
constexpr int RING_BYTES = 131072, LDS_BYTES = 163840, LDSCTL_OFF = LDS_BYTES - 1024, MISC_OFF = LDSCTL_OFF + 320;
struct Args { const float* in[14]; float* out; unsigned char* ws; int ph_lo, ph_hi, li, pad; };
constexpr int N_PHASES = 10;

__global__ void __launch_bounds__(NWAVES * 64, 2) mk_fwd(Args args) {
    extern __shared__ __attribute__((aligned(16))) unsigned char lds_raw[];
    LAS unsigned char* lds = (LAS unsigned char*)lds_raw;
    volatile LAS unsigned* MISC = (volatile LAS unsigned*)(lds + MISC_OFF);
    const int tid = threadIdx.x, lane_k = tid & 63, wave = __builtin_amdgcn_readfirstlane(tid >> 6);
    const int G = gridDim.x, bx = blockIdx.x; const int vcu = (G % 8 == 0) ? (bx % 8) * (G / 8) + bx / 8 : bx;
    unsigned char* const ws_k = (unsigned char*)in_ptr(15);
    unsigned* ctl = (unsigned*)(ws_k + WS_CTL);
    for (int u = tid; u < (LDS_BYTES - LDSCTL_OFF) / 4; u += NWAVES * 64) ((LAS unsigned*)(lds + LDSCTL_OFF))[u] = 0u;
    __syncthreads();
    const int lo = args.ph_lo, hi = args.ph_hi;
    XcdBarrier bar; bar.bar = ctl + CW_BAR + args.li * XCD_BAR_WORDS; bar.x = 0; bar.st = nullptr;
    if (hi - lo > 1) bar = xcd_barrier_post(ctl + CW_BAR + args.li * XCD_BAR_WORDS, MISC + 8);
#define IN(k) (lo <= (k) && (k) < hi)
#define SEAM(k) do { if (IN(k) && IN((k) + 1)) xcd_barrier(bar); } while (0)

    if (IN(0)) {
        unsigned char* const ws = ws_k; int lane = lane_k; asm volatile("" : "+v"(lane));
        bf16* Wt_in = (bf16*)(ws + WS_WIN); bf16* H = (bf16*)(ws + WS_H);
        LAS float* scr = (LAS float*)(lds + wave * 16384);
        const int gw = vcu * NWAVES + wave, NGW = G * NWAVES;
        constexpr int I_IN = (DM / 64) * (NIN / 32), I_SQ = (DM / 64) * (DM / 32);
        for (int it = gw; it < I_IN + 6 * I_SQ; it += NGW) {
            int r = it;
            if (r < I_IN) { p0_transpose_item(in_ptr(2), DM, NIN, Wt_in, scr, r, lane); continue; } r -= I_IN;
            const int which = r / I_SQ, item = r % I_SQ, l = which / 3, w = which % 3;
            const float* src = (w == 0 ? in_ptr(4) : w == 1 ? in_ptr(12) : in_ptr(13)) + (size_t)l * DM * DM;
            bf16* dst = (bf16*)(ws + (l == 0 ? WS_WRO : WS_W1) + (size_t)w * 2 * MiB);
            p0_transpose_item(src, DM, DM, dst, scr, item, lane);
        }
        const float* x0 = in_ptr(0); const float* g0 = in_ptr(1);
        for (int m = gw; m < T; m += NGW) rms_row_to_bf16(x0 + (size_t)m * DM, g0, H + (size_t)m * DM, lane);
        LDS_WAIT(); __syncthreads();
    }
    SEAM(0);

#pragma unroll 1
    for (int l = 0; l < DEPTH; ++l) {
        const int pb = 1 + 5 * l;
        if (IN(pb)) {
            unsigned char* const ws = ws_k;
            Epi<0> E; E.ws = ws; E.xin = nullptr; E.xout = nullptr; E.gq = in_ptr(5) + l * 64; E.gk = in_ptr(6) + l * 64;
            SchedG1A S{(const char*)(ws + WS_H), (const char*)(ws + WS_WIN), G, bx};
            pg8::gemm_phase<Epi<0>, SchedG1A, true, true>(lds, DM, S, E);
        }
        SEAM(pb);
        if (IN(pb + 1)) {
            unsigned char* const ws = ws_k;
            float s1 = 0.f, s2 = 0.f; { const float* q1 = in_ptr(7) + l * 64; const float* k1 = in_ptr(8) + l * 64; const float* q2 = in_ptr(9) + l * 64; const float* k2 = in_ptr(10) + l * 64;
                for (int i = 0; i < 64; ++i) { s1 += q1[i] * k1[i]; s2 += q2[i] * k2[i]; } }
            const float lam_init = 0.8f - 0.6f * __expf(-0.3f * (float)l), lam = __expf(s1) - __expf(s2) + lam_init;
            const float* gsub = in_ptr(11) + l * 1024;
            float gqm = 0.f, gkm = 0.f; { const float* gq = in_ptr(5) + l * 64; const float* gk = in_ptr(6) + l * 64; for (int i = 0; i < 64; ++i) { gqm = fmaxf(gqm, fabsf(gq[i])); gkm = fmaxf(gkm, fabsf(gk[i])); } }
            const float Bnd = 1.02f * 8.0f * LOG2E * gqm * gkm;
            const float* gret = in_ptr(3) + l * 1024;
            unsigned* qhead = ctl + CW_QUEUE + 64 * l;
            for (;;) {
                if (tid == 0) MISC[16] = __hip_atomic_fetch_add(qhead, 1u, __ATOMIC_RELAXED, __HIP_MEMORY_SCOPE_AGENT);
                __syncthreads();
                const int item = (int)MISC[16];
                __syncthreads();
                if (item >= 32 + 1024) break;
                if (item < 32) ret::ret_unit(lds, ws, item >> 3, item & 7, gret);
                else { const int u = att_order[item - 32], bh = u >> 5, hh = bh & 7;
                    const float wf = (2.0f * Bnd + 28.0f) / (__builtin_amdgcn_exp2f(-(float)(hh + 1)) * LOG2E);
                    att::attn_unit(lds, ws, bh >> 3, hh, u & 31, lam, 1.0f - lam_init, gsub, wf < 8192.f ? (int)wf + 1 : 8192); }
            }
        }
        SEAM(pb + 1);
        if (IN(pb + 2)) {
            unsigned char* const ws = ws_k;
            Epi<1> E; E.ws = ws; E.xin = nullptr; E.xout = nullptr; E.gq = nullptr; E.gk = nullptr;
            SchedP34 S{(const char*)ws, (const char*)(ws + (l == 0 ? WS_WRO : WS_W1)), bx};
            pg8::gemm_phase<Epi<1>, SchedP34, true, true>(lds, DM, S, E);
        }
        SEAM(pb + 2);
        if (IN(pb + 3)) {
            unsigned char* const ws = ws_k;
            Epi<2> E; E.ws = ws; E.xin = (l == 0) ? in_ptr(0) : (const float*)in_ptr(14); E.xout = (float*)in_ptr(14); E.gq = nullptr; E.gk = nullptr;
            SchedG4 S{(const char*)(ws + WS_MBF), (const char*)(ws + (l == 0 ? WS_WRO : WS_W1) + 4 * MiB), bx};
            pg8::gemm_phase<Epi<2>, SchedG4, false, true>(lds, DM, S, E);
        }
        SEAM(pb + 3);
        if (l == 0) {
            if (IN(5)) {
                unsigned char* const ws = ws_k; int lane = lane_k; asm volatile("" : "+v"(lane));
                bf16* Wt_in = (bf16*)(ws + WS_WIN); bf16* H = (bf16*)(ws + WS_H);
                LAS float* scr = (LAS float*)(lds + wave * 16384);
                const int gw = vcu * NWAVES + wave, NGW = G * NWAVES;
                constexpr int I_IN = (DM / 64) * (NIN / 32);
                const float* w1 = in_ptr(2) + (size_t)DM * NIN;
                for (int it = gw; it < I_IN; it += NGW) p0_transpose_item(w1, DM, NIN, Wt_in, scr, it, lane);
                const float* x1 = in_ptr(14); const float* g1 = in_ptr(1) + DM;
                for (int m = gw; m < T; m += NGW) rms_row_to_bf16(x1 + (size_t)m * DM, g1, H + (size_t)m * DM, lane);
                LDS_WAIT(); __syncthreads();
            }
            SEAM(5);
        }
    }
#undef IN
#undef SEAM
}

__global__ void __launch_bounds__(128) k_ret_naive(const bf16* __restrict__ QR, const bf16* __restrict__ KR, const bf16* __restrict__ VR, bf16* SGR, const float* __restrict__ gn) {
    __shared__ float qs[16][64];
    __shared__ float ks[32][65];
    __shared__ float vs[32][128];
    __shared__ float ps[16][32];
    __shared__ float rsv[16];
    const int tid = threadIdx.x, qb = blockIdx.x & 255, bh = blockIdx.x >> 8, h = bh & 7, b = bh >> 3;
    const int n0 = qb * 16; const size_t tb = (size_t)b * SEQ;
    const float lg2 = log2f(1.0f - exp2f(-5.0f - (float)h));
    for (int i = tid; i < 16 * 64; i += 128) qs[i >> 6][i & 63] = bf2f(QR[(tb + n0 + (i >> 6)) * 512 + h * 64 + (i & 63)]);
    float acc[16];
#pragma unroll
    for (int r = 0; r < 16; ++r) acc[r] = 0.f;
    for (int k0 = 0; k0 < n0 + 16; k0 += 32) {
        __syncthreads();
        for (int i = tid; i < 32 * 64; i += 128) ks[i >> 6][i & 63] = bf2f(KR[(tb + k0 + (i >> 6)) * 512 + h * 64 + (i & 63)]);
        for (int i = tid; i < 32 * 128; i += 128) vs[i >> 7][i & 127] = bf2f(VR[(tb + k0 + (i >> 7)) * 1024 + h * 128 + (i & 127)]);
        __syncthreads();
        const float cf = exp2f(128.0f * (float)((n0 >> 7) - (k0 >> 7)) * lg2);
        for (int i = tid; i < 16 * 32; i += 128) { const int r = i >> 5, kk = i & 31; float d = 0.f;
            for (int c = 0; c < 64; ++c) d += qs[r][c] * ks[kk][c];
            const int dist = (n0 + r) - (k0 + kk);
            ps[r][kk] = dist >= 0 ? d * cf : 0.f; }
        __syncthreads();
#pragma unroll
        for (int r = 0; r < 16; ++r) { float a = acc[r];
            for (int kk = 0; kk < 32; ++kk) a += ps[r][kk] * vs[kk][tid];
            acc[r] = a; }
    }
    __syncthreads();
    for (int r = 0; r < 16; ++r) vs[r][tid] = acc[r];
    __syncthreads();
    if (tid < 16) { float s = 0.f; for (int e = 0; e < 128; ++e) s += vs[tid][e] * vs[tid][e]; rsv[tid] = 1.0f / sqrtf(s * (1.0f / 128.0f) + EPS); }
    __syncthreads();
    for (int r = 0; r < 16; ++r) { const size_t o = (tb + n0 + r) * 1024 + h * 128 + tid; SGR[o] = f2bf(acc[r] * rsv[r] * gn[h * 128 + tid] * bf2f(SGR[o])); }
}

__global__ void __launch_bounds__(128) k_attn_naive(const bf16* __restrict__ QD, const bf16* __restrict__ KD, const bf16* __restrict__ VD, bf16* SGD, const float* __restrict__ lq1, const float* __restrict__ lk1,
                                                    const float* __restrict__ lq2, const float* __restrict__ lk2, const float* __restrict__ gn, float lam_init) {
    __shared__ float qs[2][16][64];
    __shared__ float ks[2][32][65];
    __shared__ float vs[32][128];
    __shared__ float ps[2][16][32];
    __shared__ float mrow[2][16], lrow[2][16], arow[2][16], rsv[16];
    const int tid = threadIdx.x, qb = blockIdx.x & 255, bh = blockIdx.x >> 8, h = bh & 7, b = bh >> 3;
    const int n0 = qb * 16; const size_t tb = (size_t)b * SEQ;
    float s1 = 0.f, s2 = 0.f;
    for (int i = 0; i < 64; ++i) { s1 += lq1[i] * lk1[i]; s2 += lq2[i] * lk2[i]; }
    const float lam = expf(s1) - expf(s2) + lam_init;
    const float slope = exp2f(-(float)(h + 1)) * LOG2E;
    for (int i = tid; i < 2 * 16 * 64; i += 128) { const int j = i >> 10, r = (i >> 6) & 15, d = i & 63; qs[j][r][d] = bf2f(QD[(tb + n0 + r) * 1024 + h * 128 + j * 64 + d]); }
    if (tid < 32) { mrow[tid >> 4][tid & 15] = -INFINITY; lrow[tid >> 4][tid & 15] = 0.f; }
    float acc[2][16];
#pragma unroll
    for (int j = 0; j < 2; ++j)
#pragma unroll
        for (int r = 0; r < 16; ++r) acc[j][r] = 0.f;
    for (int k0 = 0; k0 < n0 + 16; k0 += 32) {
        __syncthreads();
        for (int i = tid; i < 2 * 32 * 64; i += 128) { const int j = i >> 11, kk = (i >> 6) & 31, d = i & 63; ks[j][kk][d] = bf2f(KD[(tb + k0 + kk) * 1024 + h * 128 + j * 64 + d]); }
        for (int i = tid; i < 32 * 128; i += 128) vs[i >> 7][i & 127] = bf2f(VD[(tb + k0 + (i >> 7)) * 1024 + h * 128 + (i & 127)]);
        __syncthreads();
        for (int i = tid; i < 2 * 16 * 32; i += 128) { const int j = i >> 9, r = (i >> 5) & 15, kk = i & 31; float d = 0.f;
            for (int c = 0; c < 64; ++c) d += qs[j][r][c] * ks[j][kk][c];
            const int dist = (n0 + r) - (k0 + kk);
            ps[j][r][kk] = dist >= 0 ? d - slope * (float)dist : -INFINITY; }
        __syncthreads();
        if (tid < 32) { const int j = tid >> 4, r = tid & 15; float mx = mrow[j][r];
            for (int kk = 0; kk < 32; ++kk) mx = fmaxf(mx, ps[j][r][kk]);
            const float al = exp2f(mrow[j][r] - mx); float sum = 0.f;
            for (int kk = 0; kk < 32; ++kk) { const float p = exp2f(ps[j][r][kk] - mx); ps[j][r][kk] = p; sum += p; }
            lrow[j][r] = lrow[j][r] * al + sum; arow[j][r] = al; mrow[j][r] = mx; }
        __syncthreads();
#pragma unroll
        for (int j = 0; j < 2; ++j)
#pragma unroll
            for (int r = 0; r < 16; ++r) { float a = acc[j][r] * arow[j][r];
                for (int kk = 0; kk < 32; ++kk) a += ps[j][r][kk] * vs[kk][tid];
                acc[j][r] = a; }
    }
    __syncthreads();
    float o[16];
#pragma unroll
    for (int r = 0; r < 16; ++r) { o[r] = acc[0][r] / lrow[0][r] - lam * acc[1][r] / lrow[1][r]; vs[r][tid] = o[r]; }
    __syncthreads();
    if (tid < 16) { float s = 0.f; for (int e = 0; e < 128; ++e) s += vs[tid][e] * vs[tid][e]; rsv[tid] = 1.0f / sqrtf(s * (1.0f / 128.0f) + EPS); }
    __syncthreads();
    for (int r = 0; r < 16; ++r) { const size_t oo = (tb + n0 + r) * 1024 + h * 128 + tid; SGD[oo] = f2bf(o[r] * rsv[r] * gn[h * 128 + tid] * (1.0f - lam_init) * bf2f(SGD[oo])); }
}


extern "C" void kernel_launch(void* const* d_in, const int* in_sizes, int n_in, void* d_out, int out_size, void* d_ws, size_t ws_size, hipStream_t stream) {
    static int ready = 0;
    if (ready == 0) {
        if (n_in != 14 || ws_size < WS_END || out_size != T * DM) { fprintf(stderr, "kernel_launch: unexpected problem (n_in %d, ws %zu, out %d)\n", n_in, ws_size, out_size); ready = -1; return; }
        if (hipFuncSetAttribute((const void*)mk_fwd, hipFuncAttributeMaxDynamicSharedMemorySize, LDS_BYTES) != hipSuccess) { fprintf(stderr, "kernel_launch: hipFuncSetAttribute failed\n"); ready = -1; return; }
        ready = 1;
    }
    if (ready < 0) return;
    (void)hipMemsetAsync((char*)d_ws + WS_CTL, 0, CTL_ZERO_BYTES, stream);
    Args a{};
    for (int i = 0; i < 14; ++i) a.in[i] = (const float*)d_in[i];
    a.out = (float*)d_out; a.ws = (unsigned char*)d_ws;
    char* ws = (char*)d_ws;
    const float* ret_norm_g = (const float*)d_in[3]; const float* sub_g = (const float*)d_in[11];
    const float* lq1 = (const float*)d_in[7]; const float* lk1 = (const float*)d_in[8]; const float* lq2 = (const float*)d_in[9]; const float* lk2 = (const float*)d_in[10];
    a.ph_lo = 0; a.ph_hi = N_PHASES; a.li = 0;
    hipLaunchKernelGGL(mk_fwd, dim3(256), dim3(NWAVES * 64), LDS_BYTES, stream, a);
}
```

```cpp
#include <hip/hip_runtime.h>
#include <cstdio>
#include <cstdint>
#include <cstddef>

constexpr int DM = 1024, BATCH = 4, SEQ = 4096, DEPTH = 2, T = BATCH * SEQ, NIN = 9216;
constexpr float EPS = 1e-6f;
constexpr float LOG2E = 1.4426950408889634f;

typedef unsigned short bf16;
typedef short bf16x8 __attribute__((ext_vector_type(8)));
typedef float f32x4 __attribute__((ext_vector_type(4)));
typedef unsigned u32x4 __attribute__((ext_vector_type(4)));
#define LAS __attribute__((address_space(3)))
#define GAS __attribute__((address_space(1)))

__device__ __forceinline__ float bf2f(bf16 v) { return __uint_as_float(((unsigned)v) << 16); }
__device__ __forceinline__ unsigned f2bf_u(float f) { unsigned u = __float_as_uint(f); return (u + 0x7fffu + ((u >> 16) & 1u)) >> 16; }
__device__ __forceinline__ bf16 f2bf(float f) { return (bf16)f2bf_u(f); }
__device__ __forceinline__ unsigned pk2(float lo, float hi) { return f2bf_u(lo) | (f2bf_u(hi) << 16); }
typedef float f32x2_t __attribute__((ext_vector_type(2))); typedef __bf16 bf16x2_t __attribute__((ext_vector_type(2)));
__device__ __forceinline__ unsigned cvt_pk_bf16(float lo, float hi) { f32x2_t v = {lo, hi}; bf16x2_t b = __builtin_convertvector(v, bf16x2_t); return __builtin_bit_cast(unsigned, b); }
__device__ __forceinline__ float fast_sigmoid(float v) { return __builtin_amdgcn_rcpf(1.0f + __builtin_amdgcn_exp2f(-v * LOG2E)); }
__device__ __forceinline__ float lo_bf(unsigned w) { return __uint_as_float(w << 16); }
__device__ __forceinline__ float hi_bf(unsigned w) { return __uint_as_float(w & 0xffff0000u); }

constexpr size_t MiB = 1u << 20;
constexpr size_t WS_CTL = 0, CTL_ZERO_BYTES = 1 * MiB;
constexpr size_t WS_WIN = 1 * MiB, WS_WRO = 19 * MiB, WS_WDO = 21 * MiB, WS_WOUT = 23 * MiB;
constexpr size_t WS_H = 25 * MiB, WS_QR = 57 * MiB, WS_KR = 73 * MiB, WS_VR = 89 * MiB, WS_SGR = 121 * MiB, WS_QD = 153 * MiB, WS_KD = 185 * MiB,
                 WS_VD = 217 * MiB, WS_SGD = 249 * MiB;
constexpr size_t WS_W1 = 281 * MiB;
constexpr size_t WS_END = 287 * MiB;
constexpr size_t WS_MBUF = 57 * MiB;
constexpr size_t WS_MBF = WS_VD;
constexpr size_t WS_SMGR = WS_QD, WS_SMGD = WS_KD;
constexpr int CW_BAR = 4096;

namespace pg8 {
constexpr int BM = 256, BK = 64, HALF = 128, HTB = HALF * BK * 2, STAGE_BYTES = 8 * HTB, NXCD = 8, WGM = 8;
__host__ __device__ __forceinline__ int lds_byte(int r, int c) { const int st = (r >> 4) * 2 + (c >> 5), rr = r & 15, cc = c & 31, ob = rr * 64 + cc * 2; return st * 1024 + (ob ^ (((ob >> 9) & 1) << 5)); }
__host__ __device__ __forceinline__ void stage_rc(int b, int& R, int& C) { const int st = b / 1024, sb = b % 1024, swz = sb ^ (((sb >> 9) & 1) << 5); R = (st >> 1) * 16 + swz / 64; C = (st & 1) * 32 + (swz % 64) / 2; }
__host__ __device__ __forceinline__ int perm32(int rho) { const int n = rho >> 4, i = rho & 15; return 8 * (i >> 2) + 4 * n + (i & 3); }

struct Unit { int pm, pn, kind; const char* a; const char* b; };

__device__ __forceinline__ void tile_of(int L, int nM, int nN, int& pm, int& pn) {
    const int nwg = nM * nN; int wgid = L;
    { const int q = nwg / NXCD, r = nwg % NXCD, xcd = wgid % NXCD, off = wgid / NXCD; wgid = (xcd < r ? xcd * (q + 1) : r * (q + 1) + (xcd - r) * q) + off; }
    const int nig = WGM * nN, gid = wgid / nig, fm = gid * WGM, gsz = (nM - fm) < WGM ? (nM - fm) : WGM;
    pm = fm + ((wgid % nig) % gsz); pn = (wgid % nig) / gsz;
}

template <class Epi, class Sched, bool ALIGN_EPI, bool SP2>
__device__ __forceinline__ void gemm_phase(LAS unsigned char* lds, const int K, const Sched& S, const Epi& E) {
    int tid_ = threadIdx.x; asm volatile("" : "+v"(tid_));
    const int tid = tid_, wid = __builtin_amdgcn_readfirstlane(tid >> 6), lane = tid & 63, wr = wid >> 2, wc = wid & 3, fr = lane & 15, fq = lane >> 4;
    const int nt = K / BK;
    unsigned voffA[2], voffB[2];
#pragma unroll
    for (int i = 0; i < 2; ++i) { int R, C; stage_rc(tid * 16 + i * 8192, R, C); const int Rb = (R >> 5) * 64 + perm32(R & 31);
        voffA[i] = (unsigned)(R * K + C) * 2u; voffB[i] = (unsigned)(Rb * K + C) * 2u; }
    const size_t kstep = (size_t)(BK * 2);
    const size_t hstep = (size_t)HALF * K * 2;
    const size_t hstepB = (size_t)32 * K * 2;
    const unsigned ldsw = (unsigned)wid * 1024u;
    const int aoff = lds_byte(wr * 64 + fr, fq * 8), boff = lds_byte(wc * 32 + fr, fq * 8);
#define PG8_SA(b, h) (((b) * 2 + (h)) * HTB)
#define PG8_SB(b, h) ((4 + (b) * 2 + (h)) * HTB)
#define PG8_STAGE(bufoff, gbase, voff) do { _Pragma("unroll") for (int _i = 0; _i < 2; ++_i) \
        __builtin_amdgcn_global_load_lds((const unsigned*)((const char*)(gbase) + (voff)[_i]), (LAS unsigned*)(lds + (bufoff) + ldsw + _i * 8192), 16, 0, 0); } while (0)
#define PG8_LDA(dst, b, h) do { _Pragma("unroll") for (int m = 0; m < 4; ++m) _Pragma("unroll") for (int k = 0; k < 2; ++k) dst[m][k] = *(const LAS bf16x8*)(lds + PG8_SA(b, h) + aoff + m * 2048 + k * 1024); } while (0)
#define PG8_LDB(dst, b, h) do { _Pragma("unroll") for (int n = 0; n < 2; ++n) _Pragma("unroll") for (int k = 0; k < 2; ++k) dst[n][k] = *(const LAS bf16x8*)(lds + PG8_SB(b, h) + boff + n * 2048 + k * 1024); } while (0)
#define PG8_MMA(ai, bj, At, Bt) do { __builtin_amdgcn_s_setprio(1); _Pragma("unroll") for (int m = 0; m < 4; ++m) _Pragma("unroll") for (int n = 0; n < 2; ++n) _Pragma("unroll") for (int k = 0; k < 2; ++k) \
        acc[ai][bj][m][n] = __builtin_amdgcn_mfma_f32_16x16x32_bf16(Bt[n][k], At[m][k], acc[ai][bj][m][n], 0, 0, 0); __builtin_amdgcn_s_setprio(0); } while (0)
#define PG8_WAIT_V(n) asm volatile("s_waitcnt vmcnt(" #n ")" ::: "memory")
#define PG8_WAIT_L(n) asm volatile("s_waitcnt lgkmcnt(" #n ")" ::: "memory")
#define PG8_BAR __builtin_amdgcn_s_barrier()
#define PG8_SCHED __builtin_amdgcn_sched_barrier(0)
    Unit cur, nxt; int ui = 0;
    if (!S.next(0, cur)) return;
    f32x4 acc[2][2][4][2];
#pragma unroll
    for (int a = 0; a < 2; ++a)
#pragma unroll
        for (int b = 0; b < 2; ++b)
#pragma unroll
            for (int m = 0; m < 4; ++m)
#pragma unroll
                for (int n = 0; n < 2; ++n) acc[a][b][m][n] = (f32x4){0.f, 0.f, 0.f, 0.f};
    bf16x8 At[4][2], B0[2][2], B1[2][2];
    const char* cA = cur.a; const char* cB = cur.b;
    if constexpr (SP2) {
        PG8_STAGE(PG8_SB(0, 0), cB, voffB); PG8_STAGE(PG8_SB(0, 1), cB + hstepB, voffB); PG8_STAGE(PG8_SA(0, 0), cA, voffA); PG8_STAGE(PG8_SA(0, 1), cA + hstep, voffA);
        if (wr == 1) PG8_BAR;
        PG8_WAIT_V(2); PG8_BAR;
        PG8_STAGE(PG8_SB(1, 0), cB + kstep, voffB); PG8_STAGE(PG8_SA(1, 0), cA + kstep, voffA); PG8_STAGE(PG8_SB(1, 1), cB + hstepB + kstep, voffB);
        PG8_WAIT_V(6); PG8_BAR;
    } else {
        PG8_STAGE(PG8_SB(0, 0), cB, voffB); PG8_STAGE(PG8_SA(0, 0), cA, voffA); PG8_STAGE(PG8_SB(0, 1), cB + hstepB, voffB); PG8_STAGE(PG8_SA(0, 1), cA + hstep, voffA);
        if (wr == 1) PG8_BAR;
        PG8_WAIT_V(4); PG8_BAR;
        PG8_STAGE(PG8_SB(1, 0), cB + kstep, voffB); PG8_STAGE(PG8_SA(1, 0), cA + kstep, voffA); PG8_STAGE(PG8_SB(1, 1), cB + hstepB + kstep, voffB);
        PG8_WAIT_V(6); PG8_BAR;
    }
    for (;;) {
        const bool has_next = S.next(ui + 1, nxt);
        const char* nA = has_next ? nxt.a : cA; const char* nB = has_next ? nxt.b : cB;
        for (int t = 0; t < nt; t += 2) {
            const bool last = (t == nt - 2);
            const char* a1 = cA + (size_t)(t + 1) * kstep;
            const char* a2 = last ? nA : cA + (size_t)(t + 2) * kstep; const char* b2 = last ? nB : cB + (size_t)(t + 2) * kstep;
            const char* a3 = a2 + kstep; const char* b3 = b2 + kstep;
            if constexpr (SP2) {
            PG8_LDB(B0, 0, 0); PG8_LDB(B1, 0, 1); PG8_SCHED; PG8_LDA(At, 0, 0); PG8_STAGE(PG8_SA(1, 1), a1 + hstep, voffA);
            PG8_WAIT_V(8); PG8_WAIT_L(0); PG8_BAR; PG8_MMA(0, 0, At, B0); PG8_MMA(0, 1, At, B1); PG8_BAR; PG8_SCHED;
            PG8_LDA(At, 0, 1); PG8_STAGE(PG8_SB(0, 0), b2, voffB); PG8_STAGE(PG8_SB(0, 1), b2 + hstepB, voffB); PG8_STAGE(PG8_SA(0, 0), a2, voffA);
            PG8_WAIT_V(8); PG8_WAIT_L(0); PG8_BAR; PG8_MMA(1, 0, At, B0); PG8_MMA(1, 1, At, B1); PG8_BAR; PG8_SCHED;
            PG8_LDB(B0, 1, 0); PG8_LDB(B1, 1, 1); PG8_SCHED; PG8_LDA(At, 1, 0); PG8_STAGE(PG8_SA(0, 1), a2 + hstep, voffA);
            PG8_WAIT_V(8); PG8_WAIT_L(0); PG8_BAR; PG8_MMA(0, 0, At, B0); PG8_MMA(0, 1, At, B1); PG8_BAR; PG8_SCHED;
            PG8_LDA(At, 1, 1); PG8_STAGE(PG8_SB(1, 0), b3, voffB); PG8_STAGE(PG8_SB(1, 1), b3 + hstepB, voffB); PG8_STAGE(PG8_SA(1, 0), a3, voffA);
            PG8_WAIT_V(8); PG8_WAIT_L(0); PG8_BAR; PG8_MMA(1, 0, At, B0); PG8_MMA(1, 1, At, B1); PG8_BAR; PG8_SCHED;
            } else {
            PG8_LDB(B0, 0, 0); PG8_SCHED; PG8_LDA(At, 0, 0); PG8_STAGE(PG8_SA(1, 1), a1 + hstep, voffA);
            PG8_WAIT_L(8); PG8_BAR; PG8_WAIT_L(0); PG8_MMA(0, 0, At, B0); PG8_BAR; PG8_SCHED;
            PG8_LDB(B1, 0, 1); PG8_STAGE(PG8_SB(0, 0), b2, voffB);
            PG8_BAR; PG8_WAIT_L(0); PG8_MMA(0, 1, At, B1); PG8_BAR;
            PG8_LDA(At, 0, 1); PG8_STAGE(PG8_SA(0, 0), a2, voffA);
            PG8_BAR; PG8_WAIT_L(0); PG8_MMA(1, 0, At, B0); PG8_BAR; PG8_SCHED;
            PG8_STAGE(PG8_SB(0, 1), b2 + hstepB, voffB);
            PG8_WAIT_V(6); PG8_BAR; PG8_MMA(1, 1, At, B1); PG8_BAR;
            PG8_LDB(B0, 1, 0); PG8_SCHED; PG8_LDA(At, 1, 0); PG8_STAGE(PG8_SA(0, 1), a2 + hstep, voffA);
            PG8_WAIT_L(8); PG8_BAR; PG8_WAIT_L(0); PG8_MMA(0, 0, At, B0); PG8_BAR; PG8_SCHED;
            PG8_LDB(B1, 1, 1); PG8_STAGE(PG8_SB(1, 0), b3, voffB);
            PG8_BAR; PG8_WAIT_L(0); PG8_MMA(0, 1, At, B1); PG8_BAR;
            PG8_LDA(At, 1, 1); PG8_STAGE(PG8_SA(1, 0), a3, voffA);
            PG8_BAR; PG8_WAIT_L(0); PG8_MMA(1, 0, At, B0); PG8_BAR; PG8_SCHED;
            PG8_STAGE(PG8_SB(1, 1), b3 + hstepB, voffB);
            PG8_WAIT_V(6); PG8_BAR; PG8_MMA(1, 1, At, B1); PG8_BAR;
            }
        }
        if constexpr (ALIGN_EPI) { if (wr == 0) PG8_BAR; }
        E(acc, cur, wr, wc, fr, fq);
        if (!has_next) break;
#pragma unroll
        for (int a = 0; a < 2; ++a)
#pragma unroll
            for (int b = 0; b < 2; ++b)
#pragma unroll
                for (int m = 0; m < 4; ++m)
#pragma unroll
                    for (int n = 0; n < 2; ++n) acc[a][b][m][n] = (f32x4){0.f, 0.f, 0.f, 0.f};
        cur = nxt; cA = nA; cB = nB; ++ui;
        if constexpr (ALIGN_EPI) { if (wr == 1) PG8_BAR; }
    }
    PG8_WAIT_V(0);
    if constexpr (!ALIGN_EPI) { if (wr == 0) PG8_BAR; }
    PG8_BAR;
#undef PG8_SA
#undef PG8_SB
#undef PG8_STAGE
#undef PG8_LDA
#undef PG8_LDB
#undef PG8_MMA
#undef PG8_WAIT_V
#undef PG8_WAIT_L
#undef PG8_BAR
#undef PG8_SCHED
}
}

enum { K_QR = 0, K_KR, K_VR, K_SGR, K_QD, K_KD, K_VD, K_SGD, K_MGR, K_YR, K_MGD, K_YD, K_OUT };
constexpr size_t TSTEP = (size_t)256 * DM * 2;

template <int PC  > struct Epi {
    unsigned char* ws; const float* xin; float* xout; const float* gq; const float* gk;
    __device__ __forceinline__ static void st8(bf16* p, const f32x4 a, const f32x4 b) {
        u32x4 w; w.x = cvt_pk_bf16(a[0], a[1]); w.y = cvt_pk_bf16(a[2], a[3]); w.z = cvt_pk_bf16(b[0], b[1]); w.w = cvt_pk_bf16(b[2], b[3]); *(u32x4*)p = w; }
    __device__ __forceinline__ void operator()(const f32x4 (&acc)[2][2][4][2], const pg8::Unit& u, int wr, int wc, int fr, int fq) const {
        const int row0 = u.pm * 256 + wr * 64 + fr;
        const int cl = wc * 64 + 8 * fq;
        const int kind = u.kind;
        bf16* const qr = (bf16*)(ws + WS_QR); bf16* const kr = (bf16*)(ws + WS_KR); bf16* const vr = (bf16*)(ws + WS_VR); bf16* const sgr = (bf16*)(ws + WS_SGR);
        bf16* const qd = (bf16*)(ws + WS_QD); bf16* const kd = (bf16*)(ws + WS_KD); bf16* const vd = (bf16*)(ws + WS_VD); bf16* const sgd = (bf16*)(ws + WS_SGD);
        bf16* const smgr = (bf16*)(ws + WS_SMGR); bf16* const smgd = (bf16*)(ws + WS_SMGD); bf16* const mbf = (bf16*)(ws + WS_MBF); float* const mbuf = (float*)(ws + WS_MBUF);
        if (PC == 0 && (kind == K_VR || kind == K_VD)) {
            bf16* base = (kind == K_VR ? vr : vd) + u.pn * 256 + cl;
#pragma unroll
            for (int ai = 0; ai < 2; ++ai)
#pragma unroll
                for (int m = 0; m < 4; ++m) { bf16* rp = base + (size_t)(row0 + ai * 128 + m * 16) * 1024;
#pragma unroll
                    for (int bj = 0; bj < 2; ++bj) st8(rp + 32 * bj, acc[ai][bj][m][0], acc[ai][bj][m][1]); }
        } else if (PC == 0 && (kind == K_SGR || kind == K_SGD)) {
            bf16* base = (kind == K_SGR ? sgr : sgd) + u.pn * 256 + cl;
#pragma unroll
            for (int ai = 0; ai < 2; ++ai)
#pragma unroll
                for (int m = 0; m < 4; ++m) { bf16* rp = base + (size_t)(row0 + ai * 128 + m * 16) * 1024;
#pragma unroll
                    for (int bj = 0; bj < 2; ++bj) { f32x4 a = acc[ai][bj][m][0], b = acc[ai][bj][m][1];
#pragma unroll
                        for (int i = 0; i < 4; ++i) { a[i] = a[i] * fast_sigmoid(a[i]); b[i] = b[i] * fast_sigmoid(b[i]); }
                        st8(rp + 32 * bj, a, b); } }
        } else if (PC == 1 && (kind == K_MGR || kind == K_MGD)) {
            bf16* base = (kind == K_MGR ? smgr : smgd) + u.pn * 256 + cl;
#pragma unroll
            for (int ai = 0; ai < 2; ++ai)
#pragma unroll
                for (int m = 0; m < 4; ++m) { bf16* rp = base + (size_t)(row0 + ai * 128 + m * 16) * 1024;
#pragma unroll
                    for (int bj = 0; bj < 2; ++bj) { f32x4 a = acc[ai][bj][m][0], b = acc[ai][bj][m][1];
#pragma unroll
                        for (int i = 0; i < 4; ++i) { a[i] = fast_sigmoid(a[i]); b[i] = fast_sigmoid(b[i]); }
                        st8(rp + 32 * bj, a, b); } }
        } else if (PC == 0 && (kind == K_QR || kind == K_KR)) {
            const int h = u.pn * 4 + wc; const float lg = __log2f(1.0f - __builtin_amdgcn_exp2f(-5.0f - (float)h));
            bf16* base = (kind == K_QR ? qr : kr) + u.pn * 256 + cl;
            const float sgn = (kind == K_QR) ? lg : -lg, mul = (kind == K_QR) ? 1.0f : 0.125f;
#pragma unroll
            for (int ai = 0; ai < 2; ++ai)
#pragma unroll
                for (int m = 0; m < 4; ++m) { const int row = row0 + ai * 128 + m * 16; bf16* rp = base + (size_t)row * 512;
                    const float f = mul * __builtin_amdgcn_exp2f((float)(row & 127) * sgn);
#pragma unroll
                    for (int bj = 0; bj < 2; ++bj) st8(rp + 32 * bj, acc[ai][bj][m][0] * f, acc[ai][bj][m][1] * f); }
        } else if (PC == 0 && (kind == K_QD || kind == K_KD)) {
            const float* g = (kind == K_QD) ? gq : gk; const float mul = (kind == K_QD) ? 0.125f * LOG2E : 1.0f;
            bf16* base = (kind == K_QD ? qd : kd) + u.pn * 256 + cl;
            f32x4 gv[2][2];
#pragma unroll
            for (int bj = 0; bj < 2; ++bj)
#pragma unroll
                for (int n = 0; n < 2; ++n) gv[bj][n] = *(const f32x4*)(g + 32 * bj + 8 * fq + 4 * n) * mul;
#pragma unroll
            for (int ai = 0; ai < 2; ++ai)
#pragma unroll
                for (int m = 0; m < 4; ++m) { bf16* rp = base + (size_t)(row0 + ai * 128 + m * 16) * 1024;
                    float ss = 0.f;
#pragma unroll
                    for (int bj = 0; bj < 2; ++bj)
#pragma unroll
                        for (int n = 0; n < 2; ++n) { const f32x4 x = acc[ai][bj][m][n]; ss += (x[0] * x[0] + x[1] * x[1]) + (x[2] * x[2] + x[3] * x[3]); }
                    ss += __shfl_xor(ss, 16); ss += __shfl_xor(ss, 32);
                    const float rs = __builtin_amdgcn_rsqf(ss * (1.0f / 64.0f) + EPS);
#pragma unroll
                    for (int bj = 0; bj < 2; ++bj) st8(rp + 32 * bj, acc[ai][bj][m][0] * gv[bj][0] * rs, acc[ai][bj][m][1] * gv[bj][1] * rs); }
        } else if (PC == 1 && kind == K_YR) {
            bf16* const yrb = (bf16*)mbuf + (size_t)u.pn * 256 + cl;
#pragma unroll
            for (int ai = 0; ai < 2; ++ai)
#pragma unroll
                for (int m = 0; m < 4; ++m) { bf16* rp = yrb + (size_t)(row0 + ai * 128 + m * 16) * 1024;
#pragma unroll
                    for (int bj = 0; bj < 2; ++bj) st8(rp + 32 * bj, acc[ai][bj][m][0], acc[ai][bj][m][1]); }
        } else if (PC == 1 && kind == K_YD) {
            const size_t cb = (size_t)u.pn * 256 + cl; const bf16* const yrb = (const bf16*)mbuf;
#pragma unroll
            for (int ai = 0; ai < 2; ++ai)
#pragma unroll
                for (int m = 0; m < 4; ++m) { const size_t ro = (size_t)(row0 + ai * 128 + m * 16) * 1024 + cb;
#pragma unroll
                    for (int bj = 0; bj < 2; ++bj) { const u32x4 sr = *(const u32x4*)(smgr + ro + 32 * bj), sd = *(const u32x4*)(smgd + ro + 32 * bj), yr = *(const u32x4*)(yrb + ro + 32 * bj);
                        const f32x4 a = acc[ai][bj][m][0], b = acc[ai][bj][m][1];
                        f32x4 o0, o1;
                        o0[0] = lo_bf(sr.x) * lo_bf(yr.x) + lo_bf(sd.x) * a[0]; o0[1] = hi_bf(sr.x) * hi_bf(yr.x) + hi_bf(sd.x) * a[1];
                        o0[2] = lo_bf(sr.y) * lo_bf(yr.y) + lo_bf(sd.y) * a[2]; o0[3] = hi_bf(sr.y) * hi_bf(yr.y) + hi_bf(sd.y) * a[3];
                        o1[0] = lo_bf(sr.z) * lo_bf(yr.z) + lo_bf(sd.z) * b[0]; o1[1] = hi_bf(sr.z) * hi_bf(yr.z) + hi_bf(sd.z) * b[1];
                        o1[2] = lo_bf(sr.w) * lo_bf(yr.w) + lo_bf(sd.w) * b[2]; o1[3] = hi_bf(sr.w) * hi_bf(yr.w) + hi_bf(sd.w) * b[3];
                        st8(mbf + ro + 32 * bj, o0, o1); }
                    asm volatile("" ::: "memory"); }
        } else if (PC == 2 && kind == K_OUT) {
            const size_t cb = (size_t)u.pn * 256 + cl;
#pragma unroll
            for (int ai = 0; ai < 2; ++ai) {
                f32x4 pre[4][2][2];
#pragma unroll
                for (int m = 0; m < 4; ++m) { const size_t ro = (size_t)(row0 + ai * 128 + m * 16) * 1024 + cb;
#pragma unroll
                    for (int bj = 0; bj < 2; ++bj) { pre[m][bj][0] = *(const f32x4*)(xin + ro + 32 * bj); pre[m][bj][1] = *(const f32x4*)(xin + ro + 32 * bj + 4); } }
#pragma unroll
                for (int m = 0; m < 4; ++m) { const size_t ro = (size_t)(row0 + ai * 128 + m * 16) * 1024 + cb;
#pragma unroll
                    for (int bj = 0; bj < 2; ++bj) { *(f32x4*)(xout + ro + 32 * bj) = pre[m][bj][0] + acc[ai][bj][m][0]; *(f32x4*)(xout + ro + 32 * bj + 4) = pre[m][bj][1] + acc[ai][bj][m][1]; } }
                asm volatile("" ::: "memory");
            }
        }
    }
};

struct SchedG1A {
    const char* A; const char* B; int G, c;
    __device__ __forceinline__ bool next(int i, pg8::Unit& u) const {
        const int L = i * G + c; if (L >= 64 * 28) return false;
        int pm, pg; pg8::tile_of(L, 64, 28, pm, pg);
        u.pm = pm; u.a = A + (size_t)pm * TSTEP; u.b = B + (size_t)pg * TSTEP;
        if (pg < 2) { u.kind = K_QR; u.pn = pg; } else if (pg < 4) { u.kind = K_KR; u.pn = pg - 2; } else if (pg < 8) { u.kind = K_VR; u.pn = pg - 4; } else if (pg < 12) { u.kind = K_SGR; u.pn = pg - 8; }
        else if (pg < 16) { u.kind = K_QD; u.pn = pg - 12; } else if (pg < 20) { u.kind = K_KD; u.pn = pg - 16; } else if (pg < 24) { u.kind = K_VD; u.pn = pg - 20; } else { u.kind = K_SGD; u.pn = pg - 24; }
        return true;
    }
};
struct SchedP34 {
    const char *ws, *Wro; int c;
    __device__ __forceinline__ bool next(int i, pg8::Unit& u) const {
        if (i >= 4) return false;
        const char* H = ws + WS_H; const char* OR = ws + WS_SGR; const char* OD = ws + WS_SGD; const char* Win = ws + WS_WIN; const char* Wdo = Wro + 2 * MiB;
        int pm, pn; pg8::tile_of(c, 64, 4, pm, pn); u.pm = pm; u.pn = pn;
        if (i == 0) { u.kind = K_MGR; u.a = H + (size_t)pm * TSTEP; u.b = Win + (size_t)(28 + pn) * TSTEP; }
        else if (i == 1) { u.kind = K_MGD; u.a = H + (size_t)pm * TSTEP; u.b = Win + (size_t)(32 + pn) * TSTEP; }
        else if (i == 2) { u.kind = K_YR; u.a = OR + (size_t)pm * TSTEP; u.b = Wro + (size_t)pn * TSTEP; }
        else { u.kind = K_YD; u.a = OD + (size_t)pm * TSTEP; u.b = Wdo + (size_t)pn * TSTEP; }
        return true;
    }
};
struct SchedG4 {
    const char *Mb, *Wout; int c;
    __device__ __forceinline__ bool next(int i, pg8::Unit& u) const {
        if (i >= 1) return false;
        int pm, pn; pg8::tile_of(c, 64, 4, pm, pn); u.pm = pm; u.pn = pn; u.kind = K_OUT; u.a = Mb + (size_t)pm * TSTEP; u.b = Wout + (size_t)pn * TSTEP; return true;
    }
};


namespace att {
typedef float f32x16 __attribute__((ext_vector_type(16)));
typedef short s16x4 __attribute__((ext_vector_type(4)));
typedef short v4i16_t __attribute__((ext_vector_type(4)));
constexpr int SLOT_OFF = 65536, SLOT_BYTES = 32768, V_OFF = 16384;
__device__ __forceinline__ int crow(int r, int hi) { return (r & 3) + 8 * (r >> 2) + 4 * hi; }
__device__ __forceinline__ s16x4 vtr(LAS const unsigned char* p) { return __builtin_bit_cast(s16x4, __builtin_amdgcn_ds_read_tr16_b64_v4i16((LAS v4i16_t*)p)); }
#define ATT_MFMA(a, b, c) __builtin_amdgcn_mfma_f32_32x32x16_bf16(a, b, c, 0, 0, 0)

__device__ __forceinline__ void attn_unit(LAS unsigned char* lds, const unsigned char* ws, const int b, const int h, const int qb, const float lam, const float omli, const float* __restrict__ gsub, const int win) {
    int tid_ = threadIdx.x; asm volatile("" : "+v"(tid_));
    const int tid = tid_, lane = tid & 63, r32 = lane & 31, hi = lane >> 5, w = __builtin_amdgcn_readfirstlane(tid >> 6), rg = w & 3, kg = w >> 2;
    const bf16* QD = (const bf16*)(ws + WS_QD); const bf16* KD = (const bf16*)(ws + WS_KD); const bf16* VD = (const bf16*)(ws + WS_VD); bf16* SGD = (bf16*)(ws + WS_SGD);
    const size_t tb = (size_t)b * SEQ; const int q0 = qb * 128, NT = (q0 + 128) / 64;
    const int T0 = (q0 > win ? q0 - win : 0) >> 6;
#pragma unroll
    for (int k = 0; k < 4; ++k) { const int p = 4 * kg + k; const bf16* src = QD + (tb + q0 + 32 * rg + r32) * 1024 + h * 128 + (p >> 2) * 64 + (p & 3) * 16 + hi * 8;
        __builtin_amdgcn_global_load_lds((const unsigned*)src, (LAS unsigned*)(lds + rg * 8192 + p * 1024), 16, 0, 0); }
    const bf16* ksrc = KD + (tb + lane) * 1024 + h * 128 + (w & 7) * 8;
    const bf16* vsrc = VD + (tb + 16 * (w & 3) + (lane >> 2)) * 1024 + h * 128 + (w >> 2) * 32 + (lane & 3) * 8;
#define ATT_STAGE(t, slot) do { _Pragma("unroll") for (int rr = 0; rr < 2; ++rr) { \
        __builtin_amdgcn_global_load_lds((const unsigned*)(ksrc + (size_t)(t) * 65536 + rr * 64), (LAS unsigned*)(lds + SLOT_OFF + (slot) * SLOT_BYTES + (rr * 8 + w) * 1024), 16, 0, 0); \
        __builtin_amdgcn_global_load_lds((const unsigned*)(vsrc + (size_t)(t) * 65536 + rr * 64), (LAS unsigned*)(lds + SLOT_OFF + (slot) * SLOT_BYTES + V_OFF + (rr * 8 + w) * 1024), 16, 0, 0); } } while (0)
    ATT_STAGE(T0, 0);
    __syncthreads();
    const float slope = __builtin_amdgcn_exp2f(-(float)(h + 1)) * LOG2E;
    const int n = q0 + 32 * rg + r32;
    f32x16 O[2][4];
#pragma unroll
    for (int j = 0; j < 2; ++j)
#pragma unroll
        for (int e = 0; e < 4; ++e)
#pragma unroll
            for (int r = 0; r < 16; ++r) O[j][e][r] = 0.f;
    float lsum[2] = {0.f, 0.f};
    const int qoff = rg * 8192 + lane * 16;
    const int koff = hi * 1024 + (32 * kg + r32) * 16;
    const int voff = V_OFF + 2 * kg * 1024 + ((lane >> 4) & 1) * 32 + (lane & 3) * 8 + (4 * hi + ((lane & 15) >> 2)) * 64;
    for (int t = T0; t < NT; ++t) {
        if (t + 1 < NT) ATT_STAGE(t + 1, (t + 1 - T0) & 1);
        const int k0 = t * 64 + 32 * kg;
        if (k0 <= q0 + 32 * rg + 31) {
            LAS const unsigned char* slot = lds + SLOT_OFF + ((t - T0) & 1) * SLOT_BYTES;
            float sl = slope; asm volatile("" : "+v"(sl));
            const int dn = n - k0 - 4 * hi; const float base = -sl * (float)dn;
            const bool diag = (k0 + 31 > q0 + 32 * rg);
            f32x16 pA, pB;
#pragma unroll
            for (int r = 0; r < 16; ++r) { const int kc = (r & 3) + 8 * (r >> 2); pA[r] = __builtin_fmaf(sl, (float)kc, base); }
            if (diag) {
#pragma unroll
                for (int r = 0; r < 16; ++r) { const int kc = (r & 3) + 8 * (r >> 2); if (kc > dn) pA[r] = -INFINITY; }
            }
            pB = pA;
#pragma unroll
            for (int d0 = 0; d0 < 4; ++d0) {
                const bf16x8 kfa = *(LAS const bf16x8*)(slot + koff + (2 * d0) * 1024), kfb = *(LAS const bf16x8*)(slot + koff + (8 + 2 * d0) * 1024);
                const bf16x8 qfa = *(LAS const bf16x8*)(lds + qoff + d0 * 1024), qfb = *(LAS const bf16x8*)(lds + qoff + (4 + d0) * 1024);
                pA = ATT_MFMA(kfa, qfa, pA); pB = ATT_MFMA(kfb, qfb, pB);
            }
            bf16x8 vf[4][2];
#pragma unroll
            for (int eb = 0; eb < 4; ++eb)
#pragma unroll
                for (int ks = 0; ks < 2; ++ks) { const s16x4 vlo = vtr(slot + voff + eb * 4096 + ks * 1024), vhi = vtr(slot + voff + eb * 4096 + ks * 1024 + 512);
                    vf[eb][ks] = (bf16x8){vlo[0], vlo[1], vlo[2], vlo[3], vhi[0], vhi[1], vhi[2], vhi[3]}; }
            u32x4 pwA[2], pwB[2];
            { float s = 0.f;
#pragma unroll
              for (int r = 0; r < 16; ++r) { pA[r] = __builtin_amdgcn_exp2f(pA[r]); s += pA[r]; }
              lsum[0] += s;
#pragma unroll
              for (int i = 0; i < 4; ++i) { pwA[0][i] = cvt_pk_bf16(pA[2 * i], pA[2 * i + 1]); pwA[1][i] = cvt_pk_bf16(pA[8 + 2 * i], pA[9 + 2 * i]); } }
            { float s = 0.f;
#pragma unroll
              for (int r = 0; r < 16; ++r) { pB[r] = __builtin_amdgcn_exp2f(pB[r]); s += pB[r]; }
              lsum[1] += s;
#pragma unroll
              for (int i = 0; i < 4; ++i) { pwB[0][i] = cvt_pk_bf16(pB[2 * i], pB[2 * i + 1]); pwB[1][i] = cvt_pk_bf16(pB[8 + 2 * i], pB[9 + 2 * i]); } }
#pragma unroll
            for (int eb = 0; eb < 4; ++eb)
#pragma unroll
                for (int ks = 0; ks < 2; ++ks) {
                    O[0][eb] = ATT_MFMA(vf[eb][ks], __builtin_bit_cast(bf16x8, pwA[ks]), O[0][eb]);
                    O[1][eb] = ATT_MFMA(vf[eb][ks], __builtin_bit_cast(bf16x8, pwB[ks]), O[1][eb]);
                }
        }
        __syncthreads();
    }
    lsum[0] += __shfl_xor(lsum[0], 32); lsum[1] += __shfl_xor(lsum[1], 32);
    LAS float* dump = (LAS float*)(lds + rg * 32768);
    LAS float* lx = (LAS float*)(lds + 131072 + rg * 1024);
    if (kg == 1) {
#pragma unroll
        for (int j = 0; j < 2; ++j)
#pragma unroll
            for (int eb = 0; eb < 4; ++eb)
#pragma unroll
                for (int r = 0; r < 16; ++r) dump[((j * 4 + eb) * 16 + r) * 64 + lane] = O[j][eb][r];
        lx[lane] = lsum[0]; lx[64 + lane] = lsum[1];
    }
    asm volatile("s_waitcnt lgkmcnt(0)" ::: "memory");
    __syncthreads();
    if (kg == 0) {
#pragma unroll
        for (int j = 0; j < 2; ++j)
#pragma unroll
            for (int eb = 0; eb < 4; ++eb)
                {
#pragma unroll
                  for (int r = 0; r < 16; ++r) O[j][eb][r] += dump[((j * 4 + eb) * 16 + r) * 64 + lane];
                  asm volatile("s_waitcnt lgkmcnt(0)" : "+v"(O[j][eb]) :: "memory"); }
        lsum[0] += lx[lane]; lsum[1] += lx[64 + lane];
        asm volatile("s_waitcnt lgkmcnt(0)" ::: "memory");
        int r32e = r32; asm volatile("" : "+v"(r32e));
        const float i0 = 1.0f / lsum[0], i1 = lam / lsum[1];
        float ss = 0.f;
#pragma unroll
        for (int eb = 0; eb < 4; ++eb)
#pragma unroll
            for (int r = 0; r < 16; ++r) { const float o = O[0][eb][r] * i0 - O[1][eb][r] * i1; O[0][eb][r] = o; ss += o * o; }
        ss += __shfl_xor(ss, 32);
        const float rs = __builtin_amdgcn_rsqf(ss * (1.0f / 128.0f) + EPS) * omli;
        bf16* rowp = SGD + (tb + q0 + 32 * rg + r32e) * 1024 + h * 128 + 4 * hi;
        const float* gp = gsub + h * 128 + 4 * hi;
#pragma unroll
        for (int eb = 0; eb < 4; ++eb) {
            unsigned long long gt[4];
#pragma unroll
            for (int g = 0; g < 4; ++g) gt[g] = *(const unsigned long long*)(rowp + 32 * eb + 8 * g);
#pragma unroll
            for (int g = 0; g < 4; ++g) { const f32x4 gg = *(const f32x4*)(gp + 32 * eb + 8 * g); const unsigned glo = (unsigned)gt[g], ghi = (unsigned)(gt[g] >> 32);
                const unsigned w0 = cvt_pk_bf16(O[0][eb][4 * g] * rs * gg[0] * lo_bf(glo), O[0][eb][4 * g + 1] * rs * gg[1] * hi_bf(glo));
                const unsigned w1 = cvt_pk_bf16(O[0][eb][4 * g + 2] * rs * gg[2] * lo_bf(ghi), O[0][eb][4 * g + 3] * rs * gg[3] * hi_bf(ghi));
                *(unsigned long long*)(rowp + 32 * eb + 8 * g) = (unsigned long long)w0 | ((unsigned long long)w1 << 32); }
            asm volatile("" ::: "memory");
        }
    }
    asm volatile("s_waitcnt lgkmcnt(0)" ::: "memory");
    __syncthreads();
#undef ATT_STAGE
}
}

namespace ret {
using att::f32x16; using att::s16x4; using att::crow; using att::vtr;
constexpr int SET = 49152, KT = 0, VI = 16384, OST = 98304, ST = 131072, RED = 147456;
__device__ __forceinline__ void ret_unit(LAS unsigned char* lds, const unsigned char* ws, const int b, const int h, const float* __restrict__ gn, const int c0, const int c1) {
    int tid_ = threadIdx.x; asm volatile("" : "+v"(tid_));
    const int tid = tid_, lane = tid & 63, r32 = lane & 31, hi = lane >> 5, w = __builtin_amdgcn_readfirstlane(tid >> 6);
    const int ib = w & 3, eh = w >> 2, dh = w & 1, ebo = w >> 1;
    const bf16* QR = (const bf16*)(ws + WS_QR); const bf16* KR = (const bf16*)(ws + WS_KR); const bf16* VR = (const bf16*)(ws + WS_VR); bf16* SGR = (bf16*)(ws + WS_SGR);
    const size_t tb = (size_t)b * SEQ;
    const float lg = __log2f(1.0f - __builtin_amdgcn_exp2f(-5.0f - (float)h)), gC = __builtin_amdgcn_exp2f(128.0f * lg);
    for (int i = tid; i < 16384 / 16; i += 512) *(LAS u32x4*)(lds + ST + i * 16) = (u32x4){0u, 0u, 0u, 0u};
    f32x16 sblk;
#pragma unroll
    for (int r = 0; r < 16; ++r) sblk[r] = 0.f;
    const int vpat = ((lane >> 4) & 1) * 32 + (lane & 3) * 8 + (4 * hi + ((lane & 15) >> 2)) * 64;
    const int prow = tid >> 4, pcol = (tid & 15) * 8;
    f32x4 gA = *(const f32x4*)(gn + h * 128 + pcol), gB = *(const f32x4*)(gn + h * 128 + pcol + 4);
#define RET_STAGE(c, s) do { const size_t t0_ = tb + (size_t)(c) * 128; LAS unsigned char* sb_ = lds + (s) * SET; \
        _Pragma("unroll") for (int k = 0; k < 2; ++k) { const int p = 2 * w + k, d2 = p >> 3, kg = p & 7; \
            __builtin_amdgcn_global_load_lds((const unsigned*)(KR + (t0_ + 16 * kg + (lane >> 2)) * 512 + h * 64 + d2 * 32 + (lane & 3) * 8), (LAS unsigned*)(sb_ + KT + p * 1024), 16, 0, 0); } \
        _Pragma("unroll") for (int k = 0; k < 4; ++k) { const int p = 4 * w + k, eg = p >> 3, kg = p & 7; \
            __builtin_amdgcn_global_load_lds((const unsigned*)(VR + (t0_ + 16 * kg + (lane >> 2)) * 1024 + h * 128 + eg * 32 + (lane & 3) * 8), (LAS unsigned*)(sb_ + VI + p * 1024), 16, 0, 0); } } while (0)
    if (c0 > 0) {
        RET_STAGE(0, 0);
        for (int c = 0; c < c0; ++c) {
            __syncthreads();
            if (c + 1 < c0) RET_STAGE(c + 1, (c + 1) & 1);
            LAS const unsigned char* sb = lds + (c & 1) * SET;
            f32x16 kv;
#pragma unroll
            for (int r = 0; r < 16; ++r) kv[r] = 0.f;
#pragma unroll
            for (int ks = 0; ks < 8; ++ks) { LAS const unsigned char* kp = sb + KT + dh * 8192 + ks * 1024 + vpat; LAS const unsigned char* vp = sb + VI + ebo * 8192 + ks * 1024 + vpat;
                const s16x4 klo = vtr(kp), khi = vtr(kp + 512), vlo = vtr(vp), vhi = vtr(vp + 512);
                kv = ATT_MFMA(((bf16x8){klo[0], klo[1], klo[2], klo[3], khi[0], khi[1], khi[2], khi[3]}), ((bf16x8){vlo[0], vlo[1], vlo[2], vlo[3], vhi[0], vhi[1], vhi[2], vhi[3]}), kv); }
#pragma unroll
            for (int r = 0; r < 16; ++r) sblk[r] = gC * (sblk[r] + kv[r]);
        }
        __syncthreads();
#pragma unroll
        for (int g = 0; g < 4; ++g) { unsigned long long v = (unsigned long long)cvt_pk_bf16(sblk[4 * g], sblk[4 * g + 1]) | ((unsigned long long)cvt_pk_bf16(sblk[4 * g + 2], sblk[4 * g + 3]) << 32);
            *(LAS unsigned long long*)(lds + ST + (32 * ebo + r32) * 128 + (32 * dh + 8 * g + 4 * hi) * 2) = v; }
    }
    RET_STAGE(c0, c0 & 1);
    bf16x8 qn[4];
#pragma unroll
    for (int d0 = 0; d0 < 4; ++d0) qn[d0] = *(const bf16x8*)(QR + (tb + (size_t)c0 * 128 + 32 * ib + r32) * 512 + h * 64 + d0 * 16 + hi * 8);
    for (int c = c0; c < c1; ++c) {
        const size_t t0 = tb + (size_t)c * 128;
        __syncthreads();
        LAS const unsigned char* sb = lds + (c & 1) * SET;
        u32x4 gt[4];
#pragma unroll
        for (int k = 0; k < 4; ++k) gt[k] = *(const u32x4*)(SGR + (t0 + prow + 32 * k) * 1024 + h * 128 + pcol);
        bf16x8 qf[4];
#pragma unroll
        for (int d0 = 0; d0 < 4; ++d0) qf[d0] = qn[d0];
        if (c + 1 < c1) { RET_STAGE(c + 1, (c + 1) & 1);
#pragma unroll
            for (int d0 = 0; d0 < 4; ++d0) qn[d0] = *(const bf16x8*)(QR + (t0 + 128 + 32 * ib + r32) * 512 + h * 64 + d0 * 16 + hi * 8); }
        f32x16 O[2];
#pragma unroll
        for (int eb = 0; eb < 2; ++eb)
#pragma unroll
            for (int r = 0; r < 16; ++r) O[eb][r] = 0.f;
#pragma unroll
        for (int jb = 0; jb < 4; ++jb) {
            if (jb <= ib) {
                f32x16 s;
#pragma unroll
                for (int r = 0; r < 16; ++r) s[r] = 0.f;
#pragma unroll
                for (int d0 = 0; d0 < 4; ++d0) { const bf16x8 kf = *(LAS const bf16x8*)(sb + KT + (d0 >> 1) * 8192 + (32 * jb + r32) * 64 + ((d0 & 1) * 16 + 8 * hi) * 2); s = ATT_MFMA(kf, qf[d0], s); }
                if (jb == ib) {
#pragma unroll
                    for (int r = 0; r < 16; ++r) if (crow(r, hi) > r32) s[r] = 0.f;
                }
                u32x4 pw[2];
#pragma unroll
                for (int i = 0; i < 4; ++i) { pw[0][i] = cvt_pk_bf16(s[2 * i], s[2 * i + 1]); pw[1][i] = cvt_pk_bf16(s[8 + 2 * i], s[9 + 2 * i]); }
#pragma unroll
                for (int eb = 0; eb < 2; ++eb)
#pragma unroll
                    for (int ks = 0; ks < 2; ++ks) { LAS const unsigned char* vp = sb + VI + (2 * eh + eb) * 8192 + (2 * jb + ks) * 1024 + vpat;
                        const s16x4 vlo = vtr(vp), vhi = vtr(vp + 512);
                        O[eb] = ATT_MFMA(((bf16x8){vlo[0], vlo[1], vlo[2], vlo[3], vhi[0], vhi[1], vhi[2], vhi[3]}), __builtin_bit_cast(bf16x8, pw[ks]), O[eb]); }
            }
        }
#pragma unroll
        for (int eb = 0; eb < 2; ++eb)
#pragma unroll
            for (int d0 = 0; d0 < 4; ++d0) { const bf16x8 sf = *(LAS const bf16x8*)(lds + ST + (32 * (2 * eh + eb) + r32) * 128 + (16 * d0 + 8 * hi) * 2); O[eb] = ATT_MFMA(sf, qf[d0], O[eb]); }
        { f32x16 kv;
#pragma unroll
          for (int r = 0; r < 16; ++r) kv[r] = 0.f;
#pragma unroll
          for (int ks = 0; ks < 8; ++ks) { LAS const unsigned char* kp = sb + KT + dh * 8192 + ks * 1024 + vpat; LAS const unsigned char* vp = sb + VI + ebo * 8192 + ks * 1024 + vpat;
              const s16x4 klo = vtr(kp), khi = vtr(kp + 512), vlo = vtr(vp), vhi = vtr(vp + 512);
              kv = ATT_MFMA(((bf16x8){klo[0], klo[1], klo[2], klo[3], khi[0], khi[1], khi[2], khi[3]}), ((bf16x8){vlo[0], vlo[1], vlo[2], vlo[3], vhi[0], vhi[1], vhi[2], vhi[3]}), kv); }
#pragma unroll
          for (int r = 0; r < 16; ++r) sblk[r] = gC * (sblk[r] + kv[r]); }
        { float s2 = 0.f;
#pragma unroll
          for (int eb = 0; eb < 2; ++eb)
#pragma unroll
              for (int r = 0; r < 16; ++r) s2 += O[eb][r] * O[eb][r];
          s2 += __shfl_xor(s2, 32);
          if (hi == 0) ((LAS float*)(lds + RED))[(32 * ib + r32) * 2 + eh] = s2; }
#pragma unroll
        for (int eb = 0; eb < 2; ++eb)
#pragma unroll
            for (int g = 0; g < 4; ++g) *(LAS unsigned long long*)(lds + OST + (32 * ib + r32) * 256 + (64 * eh + 32 * eb + 8 * g + 4 * hi) * 2) =
                (unsigned long long)cvt_pk_bf16(O[eb][4 * g], O[eb][4 * g + 1]) | ((unsigned long long)cvt_pk_bf16(O[eb][4 * g + 2], O[eb][4 * g + 3]) << 32);
        asm volatile("s_waitcnt lgkmcnt(0)" ::: "memory"); __builtin_amdgcn_s_barrier(); asm volatile("" ::: "memory");
#pragma unroll
        for (int g = 0; g < 4; ++g) { unsigned long long v = (unsigned long long)cvt_pk_bf16(sblk[4 * g], sblk[4 * g + 1]) | ((unsigned long long)cvt_pk_bf16(sblk[4 * g + 2], sblk[4 * g + 3]) << 32);
            *(LAS unsigned long long*)(lds + ST + (32 * ebo + r32) * 128 + (32 * dh + 8 * g + 4 * hi) * 2) = v; }
#pragma unroll
        for (int k = 0; k < 4; ++k) { const int row = prow + 32 * k; const LAS float* rp = (const LAS float*)(lds + RED) + row * 2;
            const float rs = __builtin_amdgcn_rsqf((rp[0] + rp[1]) * (1.0f / 128.0f) + EPS);
            const u32x4 ov = *(LAS const u32x4*)(lds + OST + row * 256 + pcol * 2); const u32x4 gg = gt[k];
            u32x4 res;
            res.x = cvt_pk_bf16(lo_bf(ov.x) * rs * gA[0] * lo_bf(gg.x), hi_bf(ov.x) * rs * gA[1] * hi_bf(gg.x));
            res.y = cvt_pk_bf16(lo_bf(ov.y) * rs * gA[2] * lo_bf(gg.y), hi_bf(ov.y) * rs * gA[3] * hi_bf(gg.y));
            res.z = cvt_pk_bf16(lo_bf(ov.z) * rs * gB[0] * lo_bf(gg.z), hi_bf(ov.z) * rs * gB[1] * hi_bf(gg.z));
            res.w = cvt_pk_bf16(lo_bf(ov.w) * rs * gB[2] * lo_bf(gg.w), hi_bf(ov.w) * rs * gB[3] * hi_bf(gg.w));
            *(u32x4*)(SGR + (t0 + row) * 1024 + h * 128 + pcol) = res; }
    }
    __syncthreads();
#undef RET_STAGE
}
}

__device__ const unsigned short att_order[1024] = {223, 255, 479, 511, 735, 767, 991, 1023, 222, 254, 478, 510, 734, 766, 990, 1022, 221, 253, 477, 509, 733, 765, 989, 1021, 220, 252, 476, 508, 732, 764, 988, 1020, 219, 251, 475, 507, 731, 763, 987, 1019, 218, 250, 474, 506, 730, 762, 986, 1018, 217, 249, 473, 505, 729, 761, 985, 1017, 216, 248, 472, 504, 728, 760, 984, 1016, 215, 247, 471, 503, 727, 759, 983, 1015, 214, 246, 470, 502, 726, 758, 982, 1014, 213, 245, 469, 501, 725, 757, 981, 1013, 212, 244, 468, 500, 724, 756, 980, 1012, 179, 180, 181, 182, 183, 184, 185, 186, 187, 188, 189, 190, 191, 211, 243, 435, 436, 437, 438, 439, 440, 441, 442, 443, 444, 445, 446, 447, 467, 499, 691, 692, 693, 694, 695, 696, 697, 698, 699, 700, 701, 702, 703, 723, 755, 947, 948, 949, 950, 951, 952, 953, 954, 955, 956, 957, 958, 959, 979, 1011, 178, 210, 242, 434, 466, 498, 690, 722, 754, 946, 978, 1010, 177, 209, 241, 433, 465, 497, 689, 721, 753, 945, 977, 1009, 176, 208, 240, 432, 464, 496, 688, 720, 752, 944, 976, 1008, 175, 207, 239, 431, 463, 495, 687, 719, 751, 943, 975, 1007, 174, 206, 238, 430, 462, 494, 686, 718, 750, 942, 974, 1006, 173, 205, 237, 429, 461, 493, 685, 717, 749, 941, 973, 1005, 172, 204, 236, 428, 460, 492, 684, 716, 748, 940, 972, 1004, 171, 203, 235, 427, 459, 491, 683, 715, 747, 939, 971, 1003, 170, 202, 234, 426, 458, 490, 682, 714, 746, 938, 970, 1002, 138, 139, 140, 141, 142, 143, 144, 145, 146, 147, 148, 149, 150, 151, 152, 153, 154, 155, 156, 157, 158, 159, 394, 395, 396, 397, 398, 399, 400, 401, 402, 403, 404, 405, 406, 407, 408, 409, 410, 411, 412, 413, 414, 415, 650, 651, 652, 653, 654, 655, 656, 657, 658, 659, 660, 661, 662, 663, 664, 665, 666, 667, 668, 669, 670, 671, 906, 907, 908, 909, 910, 911, 912, 913, 914, 915, 916, 917, 918, 919, 920, 921, 922, 923, 924, 925, 926, 927, 137, 169, 201, 233, 393, 425, 457, 489, 649, 681, 713, 745, 905, 937, 969, 1001, 136, 168, 200, 232, 392, 424, 456, 488, 648, 680, 712, 744, 904, 936, 968, 1000, 135, 167, 199, 231, 391, 423, 455, 487, 647, 679, 711, 743, 903, 935, 967, 999, 134, 166, 198, 230, 390, 422, 454, 486, 646, 678, 710, 742, 902, 934, 966, 998, 101, 102, 103, 104, 105, 106, 107, 108, 109, 110, 111, 112, 113, 114, 115, 116, 117, 118, 119, 120, 121, 122, 123, 124, 125, 126, 127, 133, 165, 197, 229, 357, 358, 359, 360, 361, 362, 363, 364, 365, 366, 367, 368, 369, 370, 371, 372, 373, 374, 375, 376, 377, 378, 379, 380, 381, 382, 383, 389, 421, 453, 485, 613, 614, 615, 616, 617, 618, 619, 620, 621, 622, 623, 624, 625, 626, 627, 628, 629, 630, 631, 632, 633, 634, 635, 636, 637, 638, 639, 645, 677, 709, 741, 869, 870, 871, 872, 873, 874, 875, 876, 877, 878, 879, 880, 881, 882, 883, 884, 885, 886, 887, 888, 889, 890, 891, 892, 893, 894, 895, 901, 933, 965, 997, 100, 132, 164, 196, 228, 356, 388, 420, 452, 484, 612, 644, 676, 708, 740, 868, 900, 932, 964, 996, 99, 131, 163, 195, 227, 355, 387, 419, 451, 483, 611, 643, 675, 707, 739, 867, 899, 931, 963, 995, 67, 68, 69, 70, 71, 72, 73, 74, 75, 76, 77, 78, 79, 80, 81, 82, 83, 84, 85, 86, 87, 88, 89, 90, 91, 92, 93, 94, 95, 323, 324, 325, 326, 327, 328, 329, 330, 331, 332, 333, 334, 335, 336, 337, 338, 339, 340, 341, 342, 343, 344, 345, 346, 347, 348, 349, 350, 351, 579, 580, 581, 582, 583, 584, 585, 586, 587, 588, 589, 590, 591, 592, 593, 594, 595, 596, 597, 598, 599, 600, 601, 602, 603, 604, 605, 606, 607, 835, 836, 837, 838, 839, 840, 841, 842, 843, 844, 845, 846, 847, 848, 849, 850, 851, 852, 853, 854, 855, 856, 857, 858, 859, 860, 861, 862, 863, 66, 98, 130, 162, 194, 226, 322, 354, 386, 418, 450, 482, 578, 610, 642, 674, 706, 738, 834, 866, 898, 930, 962, 994, 34, 35, 36, 37, 38, 39, 40, 41, 42, 43, 44, 45, 46, 47, 48, 49, 50, 51, 52, 53, 54, 55, 56, 57, 58, 59, 60, 61, 62, 63, 290, 291, 292, 293, 294, 295, 296, 297, 298, 299, 300, 301, 302, 303, 304, 305, 306, 307, 308, 309, 310, 311, 312, 313, 314, 315, 316, 317, 318, 319, 546, 547, 548, 549, 550, 551, 552, 553, 554, 555, 556, 557, 558, 559, 560, 561, 562, 563, 564, 565, 566, 567, 568, 569, 570, 571, 572, 573, 574, 575, 802, 803, 804, 805, 806, 807, 808, 809, 810, 811, 812, 813, 814, 815, 816, 817, 818, 819, 820, 821, 822, 823, 824, 825, 826, 827, 828, 829, 830, 831, 1, 2, 3, 4, 5, 6, 7, 8, 9, 10, 11, 12, 13, 14, 15, 16, 17, 18, 19, 20, 21, 22, 23, 24, 25, 26, 27, 28, 29, 30, 31, 33, 65, 97, 129, 161, 193, 225, 257, 258, 259, 260, 261, 262, 263, 264, 265, 266, 267, 268, 269, 270, 271, 272, 273, 274, 275, 276, 277, 278, 279, 280, 281, 282, 283, 284, 285, 286, 287, 289, 321, 353, 385, 417, 449, 481, 513, 514, 515, 516, 517, 518, 519, 520, 521, 522, 523, 524, 525, 526, 527, 528, 529, 530, 531, 532, 533, 534, 535, 536, 537, 538, 539, 540, 541, 542, 543, 545, 577, 609, 641, 673, 705, 737, 769, 770, 771, 772, 773, 774, 775, 776, 777, 778, 779, 780, 781, 782, 783, 784, 785, 786, 787, 788, 789, 790, 791, 792, 793, 794, 795, 796, 797, 798, 799, 801, 833, 865, 897, 929, 961, 993, 0, 32, 64, 96, 128, 160, 192, 224, 256, 288, 320, 352, 384, 416, 448, 480, 512, 544, 576, 608, 640, 672, 704, 736, 768, 800, 832, 864, 896, 928, 960, 992};
constexpr int CW_QUEUE = 2048;

#define XB_TMO      128
#define XB_XCNT(j)  (256  + 64 * (j))
#define XB_XSUB(j)  (1280 + 64 * (j))
#define XB_XGEN(j)  (2304 + 64 * (j))
#define XB_TOP      3328
#define XB_TOPGEN   3392
#define XCD_BAR_WORDS 3456
#define XB_SPIN_CAP (1u << 18)
__device__ __forceinline__ unsigned xb_ld(unsigned* p)              { return __hip_atomic_load(p, __ATOMIC_RELAXED, __HIP_MEMORY_SCOPE_AGENT); }
__device__ __forceinline__ unsigned xb_add(unsigned* p, unsigned v) { return __hip_atomic_fetch_add(p, v, __ATOMIC_RELAXED, __HIP_MEMORY_SCOPE_AGENT); }
__device__ __forceinline__ unsigned xb_xcc_id() { return (unsigned)__builtin_amdgcn_s_getreg((3 << 11) | 20) & 0xFu; }
#define XB_SPIN(cond, bar) do { unsigned _sp = 0; while (cond) { __builtin_amdgcn_s_sleep(1); \
    if ((++_sp & 255u) == 0u) { if (xb_ld(&(bar)[XB_TMO])) break; if (_sp > XB_SPIN_CAP) { atomicAdd(&(bar)[XB_TMO], 1u); break; } } } } while (0)
struct XcdBarrier { unsigned* bar; unsigned x; volatile LAS unsigned* st; };
__device__ __forceinline__ XcdBarrier xcd_barrier_post(unsigned* bar, volatile LAS unsigned* st) {
    XcdBarrier b; b.bar = bar; b.x = xb_xcc_id(); b.st = st;
    if (threadIdx.x == 0) (void)xb_add(&bar[XB_XCNT(b.x)], 1u);
    return b;
}
__device__ __forceinline__ void xcd_barrier_complete(unsigned* bar, unsigned x, unsigned& nloc, unsigned& nx) {
    const unsigned G = gridDim.x * gridDim.y * gridDim.z;
    unsigned sum, cnt, mine, sp = 0u;
    for (;;) {
        sum = 0u; cnt = 0u; mine = 0u;
#pragma unroll
        for (unsigned j = 0; j < 16; ++j) { const unsigned c = xb_ld(&bar[XB_XCNT(j)]); sum += c; cnt += (c > 0u) ? 1u : 0u; mine = (j == x) ? c : mine; }
        if (sum == G) break;
        __builtin_amdgcn_s_sleep(1);
        if ((++sp & 255u) == 0u) { if (xb_ld(&bar[XB_TMO])) break; if (sp > XB_SPIN_CAP) { atomicAdd(&bar[XB_TMO], 1u); break; } }
    }
    nloc = mine > 0u ? mine : 1u; nx = cnt > 0u ? cnt : 1u;
}
__device__ __forceinline__ void xcd_barrier(const XcdBarrier& b) {
    asm volatile("s_waitcnt vmcnt(0)" ::: "memory");
    __syncthreads();
    if (threadIdx.x == 0) {
        unsigned* bar = b.bar;
        __builtin_amdgcn_s_waitcnt(0);
        unsigned nloc = b.st[0], nx = b.st[1];
        if (nloc == 0u) { xcd_barrier_complete(bar, b.x, nloc, nx); b.st[0] = nloc; b.st[1] = nx; }
        const unsigned old = xb_add(&bar[XB_XSUB(b.x)], 1u);
        const unsigned gen = old / nloc;
        if (old + 1u == (gen + 1u) * nloc) {
            __builtin_amdgcn_fence(__ATOMIC_RELEASE, "agent");
            asm volatile("s_waitcnt vmcnt(0)" ::: "memory");
            const unsigned og = xb_add(&bar[XB_TOP], 1u);
            const unsigned tg = og / nx;
            if (og + 1u == (tg + 1u) * nx) xb_add(&bar[XB_TOPGEN], 1u);
            else XB_SPIN(xb_ld(&bar[XB_TOPGEN]) == tg, bar);
            __builtin_amdgcn_fence(__ATOMIC_ACQUIRE, "agent");
            xb_add(&bar[XB_XGEN(b.x)], 1u);
            asm volatile("s_waitcnt vmcnt(0)" ::: "memory");
        } else {
            XB_SPIN(xb_ld(&bar[XB_XGEN(b.x)]) == gen, bar);
            __builtin_amdgcn_fence(__ATOMIC_ACQUIRE, "agent");
            asm volatile("s_waitcnt vmcnt(0)" ::: "memory");
        }
    }
    __syncthreads();
}

#define LDS_WAIT() asm volatile("s_waitcnt lgkmcnt(0)" ::: "memory")
__device__ __forceinline__ float wave_sum(float v) {
#pragma unroll
    for (int o = 1; o < 64; o <<= 1) v += __shfl_xor(v, o);
    return v;
}
__device__ __forceinline__ void p0_transpose_item(const float* W, int K, int N, bf16* WT, LAS float* scr, int item, int lane) {
    const int nblk = N / 32, kb = item / nblk, nb = item % nblk, k0 = 64 * kb, n0 = 32 * nb;
#pragma unroll 8
    for (int i = 0; i < 32; ++i) { const int kk = 2 * i + (lane >> 5); scr[kk * 33 + (lane & 31)] = W[(size_t)(k0 + kk) * N + n0 + (lane & 31)]; }
    LDS_WAIT(); asm volatile("" ::: "memory");
    const int c = lane & 7;
#pragma unroll
    for (int j = 0; j < 4; ++j) { const int n = (lane >> 3) + 8 * j; const LAS float* s = scr + (8 * c) * 33 + n;
        u32x4 o; o.x = pk2(s[0 * 33], s[1 * 33]); o.y = pk2(s[2 * 33], s[3 * 33]); o.z = pk2(s[4 * 33], s[5 * 33]); o.w = pk2(s[6 * 33], s[7 * 33]);
        *(GAS u32x4*)(WT + (size_t)(n0 + n) * K + k0 + 8 * c) = o; }
    LDS_WAIT(); asm volatile("" ::: "memory");
}
__device__ __forceinline__ void rms_row_to_bf16(const float* xrow, const float* g, bf16* orow, int lane) {
    const GAS f32x4* xr = (const GAS f32x4*)xrow + lane; const GAS f32x4* gr = (const GAS f32x4*)g + lane;
    f32x4 v[4]; float s = 0.f;
#pragma unroll
    for (int j = 0; j < 4; ++j) { v[j] = xr[64 * j]; s += (v[j].x * v[j].x + v[j].y * v[j].y) + (v[j].z * v[j].z + v[j].w * v[j].w); }
    const float rs = 1.0f / sqrtf(wave_sum(s) * (1.f / DM) + EPS);
    GAS unsigned long long* o8 = (GAS unsigned long long*)orow + lane;
#pragma unroll
    for (int j = 0; j < 4; ++j) { const f32x4 gg = gr[64 * j];
        o8[64 * j] = (unsigned long long)pk2(v[j].x * rs * gg.x, v[j].y * rs * gg.y) | ((unsigned long long)pk2(v[j].z * rs * gg.z, v[j].w * rs * gg.w) << 32); }
}

__device__ __forceinline__ const float* in_ptr(int k) {
    typedef __attribute__((address_space(4))) const char* cptr4;
    cptr4 ka = (cptr4)__builtin_amdgcn_kernarg_segment_ptr(); cptr4 kb;
    asm volatile("s_mov_b64 %0, %1" : "=s"(kb) : "s"(ka));
    typedef const float* cfp; typedef __attribute__((address_space(4))) const cfp* cfp4;
    return *(cfp4)(kb + k * 8);
}
constexpr int NWAVES = 8;
constexpr int RING_BYTES = 131072, LDS_BYTES = 163840, LDSCTL_OFF = LDS_BYTES - 1024, MISC_OFF = LDSCTL_OFF + 320;
struct Args { const float* in[14]; float* out; unsigned char* ws; int ph_lo, ph_hi, li, pad; };
constexpr int N_PHASES = 10;

__global__ void __launch_bounds__(NWAVES * 64, 2) mk_fwd(Args args) {
    extern __shared__ __attribute__((aligned(16))) unsigned char lds_raw[];
    LAS unsigned char* lds = (LAS unsigned char*)lds_raw;
    volatile LAS unsigned* MISC = (volatile LAS unsigned*)(lds + MISC_OFF);
    const int tid = threadIdx.x, lane_k = tid & 63, wave = __builtin_amdgcn_readfirstlane(tid >> 6);
    const int G = gridDim.x, bx = blockIdx.x; const int vcu = (G % 8 == 0) ? (bx % 8) * (G / 8) + bx / 8 : bx;
    unsigned char* const ws_k = (unsigned char*)in_ptr(15);
    unsigned* ctl = (unsigned*)(ws_k + WS_CTL);
    for (int u = tid; u < (LDS_BYTES - LDSCTL_OFF) / 4; u += NWAVES * 64) ((LAS unsigned*)(lds + LDSCTL_OFF))[u] = 0u;
    __syncthreads();
    const int lo = args.ph_lo, hi = args.ph_hi;
    XcdBarrier bar; bar.bar = ctl + CW_BAR + args.li * XCD_BAR_WORDS; bar.x = 0; bar.st = nullptr;
    if (hi - lo > 1) bar = xcd_barrier_post(ctl + CW_BAR + args.li * XCD_BAR_WORDS, MISC + 8);
#define IN(k) (lo <= (k) && (k) < hi)
#define SEAM(k) do { if (IN(k) && IN((k) + 1)) xcd_barrier(bar); } while (0)

    if (IN(0)) {
        unsigned char* const ws = ws_k; int lane = lane_k; asm volatile("" : "+v"(lane));
        bf16* Wt_in = (bf16*)(ws + WS_WIN); bf16* H = (bf16*)(ws + WS_H);
        LAS float* scr = (LAS float*)(lds + wave * 16384);
        const int gw = vcu * NWAVES + wave, NGW = G * NWAVES;
        constexpr int I_IN = (DM / 64) * (NIN / 32), I_SQ = (DM / 64) * (DM / 32);
        for (int it = gw; it < I_IN + 6 * I_SQ; it += NGW) {
            int r = it;
            if (r < I_IN) { p0_transpose_item(in_ptr(2), DM, NIN, Wt_in, scr, r, lane); continue; } r -= I_IN;
            const int which = r / I_SQ, item = r % I_SQ, l = which / 3, w = which % 3;
            const float* src = (w == 0 ? in_ptr(4) : w == 1 ? in_ptr(12) : in_ptr(13)) + (size_t)l * DM * DM;
            bf16* dst = (bf16*)(ws + (l == 0 ? WS_WRO : WS_W1) + (size_t)w * 2 * MiB);
            p0_transpose_item(src, DM, DM, dst, scr, item, lane);
        }
        const float* x0 = in_ptr(0); const float* g0 = in_ptr(1);
        for (int m = gw; m < T; m += NGW) rms_row_to_bf16(x0 + (size_t)m * DM, g0, H + (size_t)m * DM, lane);
        LDS_WAIT(); __syncthreads();
    }
    SEAM(0);

#pragma unroll 1
    for (int l = 0; l < DEPTH; ++l) {
        const int pb = 1 + 5 * l;
        if (IN(pb)) {
            unsigned char* const ws = ws_k;
            Epi<0> E; E.ws = ws; E.xin = nullptr; E.xout = nullptr; E.gq = in_ptr(5) + l * 64; E.gk = in_ptr(6) + l * 64;
            SchedG1A S{(const char*)(ws + WS_H), (const char*)(ws + WS_WIN), G, bx};
            pg8::gemm_phase<Epi<0>, SchedG1A, true, true>(lds, DM, S, E);
        }
        SEAM(pb);
        if (IN(pb + 1)) {
            unsigned char* const ws = ws_k;
            float s1 = 0.f, s2 = 0.f; { const float* q1 = in_ptr(7) + l * 64; const float* k1 = in_ptr(8) + l * 64; const float* q2 = in_ptr(9) + l * 64; const float* k2 = in_ptr(10) + l * 64;
                for (int i = 0; i < 64; ++i) { s1 += q1[i] * k1[i]; s2 += q2[i] * k2[i]; } }
            const float lam_init = 0.8f - 0.6f * __expf(-0.3f * (float)l), lam = __expf(s1) - __expf(s2) + lam_init;
            const float* gsub = in_ptr(11) + l * 1024;
            float gqm = 0.f, gkm = 0.f; { const float* gq = in_ptr(5) + l * 64; const float* gk = in_ptr(6) + l * 64; for (int i = 0; i < 64; ++i) { gqm = fmaxf(gqm, fabsf(gq[i])); gkm = fmaxf(gkm, fabsf(gk[i])); } }
            const float Bnd = 1.02f * 8.0f * LOG2E * gqm * gkm;
            const float* gret = in_ptr(3) + l * 1024;
            unsigned* qhead = ctl + CW_QUEUE + 64 * l;
            for (;;) {
                if (tid == 0) MISC[16] = __hip_atomic_fetch_add(qhead, 1u, __ATOMIC_RELAXED, __HIP_MEMORY_SCOPE_AGENT);
                __syncthreads();
                const int item = (int)MISC[16];
                __syncthreads();
                if (item >= 128 + 1024) break;
                if (item < 128) { const int qt = 3 - (item >> 5), bh2 = item & 31; ret::ret_unit(lds, ws, bh2 >> 3, bh2 & 7, gret, 8 * qt, 8 * qt + 8); }
                else { const int u = att_order[item - 128], bh = u >> 5, hh = bh & 7;
                    const float wf = (2.0f * Bnd + 28.0f) / (__builtin_amdgcn_exp2f(-(float)(hh + 1)) * LOG2E);
                    att::attn_unit(lds, ws, bh >> 3, hh, u & 31, lam, 1.0f - lam_init, gsub, wf < 8192.f ? (int)wf + 1 : 8192); }
            }
        }
        SEAM(pb + 1);
        if (IN(pb + 2)) {
            unsigned char* const ws = ws_k;
            Epi<1> E; E.ws = ws; E.xin = nullptr; E.xout = nullptr; E.gq = nullptr; E.gk = nullptr;
            SchedP34 S{(const char*)ws, (const char*)(ws + (l == 0 ? WS_WRO : WS_W1)), bx};
            pg8::gemm_phase<Epi<1>, SchedP34, true, true>(lds, DM, S, E);
        }
        SEAM(pb + 2);
        if (IN(pb + 3)) {
            unsigned char* const ws = ws_k;
            Epi<2> E; E.ws = ws; E.xin = (l == 0) ? in_ptr(0) : (const float*)in_ptr(14); E.xout = (float*)in_ptr(14); E.gq = nullptr; E.gk = nullptr;
            SchedG4 S{(const char*)(ws + WS_MBF), (const char*)(ws + (l == 0 ? WS_WRO : WS_W1) + 4 * MiB), bx};
            pg8::gemm_phase<Epi<2>, SchedG4, false, true>(lds, DM, S, E);
        }
        SEAM(pb + 3);
        if (l == 0) {
            if (IN(5)) {
                unsigned char* const ws = ws_k; int lane = lane_k; asm volatile("" : "+v"(lane));
                bf16* Wt_in = (bf16*)(ws + WS_WIN); bf16* H = (bf16*)(ws + WS_H);
                LAS float* scr = (LAS float*)(lds + wave * 16384);
                const int gw = vcu * NWAVES + wave, NGW = G * NWAVES;
                constexpr int I_IN = (DM / 64) * (NIN / 32);
                const float* w1 = in_ptr(2) + (size_t)DM * NIN;
                for (int it = gw; it < I_IN; it += NGW) p0_transpose_item(w1, DM, NIN, Wt_in, scr, it, lane);
                const float* x1 = in_ptr(14); const float* g1 = in_ptr(1) + DM;
                for (int m = gw; m < T; m += NGW) rms_row_to_bf16(x1 + (size_t)m * DM, g1, H + (size_t)m * DM, lane);
                LDS_WAIT(); __syncthreads();
            }
            SEAM(5);
        }
    }
#undef IN
#undef SEAM
}

__global__ void __launch_bounds__(128) k_ret_naive(const bf16* __restrict__ QR, const bf16* __restrict__ KR, const bf16* __restrict__ VR, bf16* SGR, const float* __restrict__ gn) {
    __shared__ float qs[16][64];
    __shared__ float ks[32][65];
    __shared__ float vs[32][128];
    __shared__ float ps[16][32];
    __shared__ float rsv[16];
    const int tid = threadIdx.x, qb = blockIdx.x & 255, bh = blockIdx.x >> 8, h = bh & 7, b = bh >> 3;
    const int n0 = qb * 16; const size_t tb = (size_t)b * SEQ;
    const float lg2 = log2f(1.0f - exp2f(-5.0f - (float)h));
    for (int i = tid; i < 16 * 64; i += 128) qs[i >> 6][i & 63] = bf2f(QR[(tb + n0 + (i >> 6)) * 512 + h * 64 + (i & 63)]);
    float acc[16];
#pragma unroll
    for (int r = 0; r < 16; ++r) acc[r] = 0.f;
    for (int k0 = 0; k0 < n0 + 16; k0 += 32) {
        __syncthreads();
        for (int i = tid; i < 32 * 64; i += 128) ks[i >> 6][i & 63] = bf2f(KR[(tb + k0 + (i >> 6)) * 512 + h * 64 + (i & 63)]);
        for (int i = tid; i < 32 * 128; i += 128) vs[i >> 7][i & 127] = bf2f(VR[(tb + k0 + (i >> 7)) * 1024 + h * 128 + (i & 127)]);
        __syncthreads();
        const float cf = exp2f(128.0f * (float)((n0 >> 7) - (k0 >> 7)) * lg2);
        for (int i = tid; i < 16 * 32; i += 128) { const int r = i >> 5, kk = i & 31; float d = 0.f;
            for (int c = 0; c < 64; ++c) d += qs[r][c] * ks[kk][c];
            const int dist = (n0 + r) - (k0 + kk);
            ps[r][kk] = dist >= 0 ? d * cf : 0.f; }
        __syncthreads();
#pragma unroll
        for (int r = 0; r < 16; ++r) { float a = acc[r];
            for (int kk = 0; kk < 32; ++kk) a += ps[r][kk] * vs[kk][tid];
            acc[r] = a; }
    }
    __syncthreads();
    for (int r = 0; r < 16; ++r) vs[r][tid] = acc[r];
    __syncthreads();
    if (tid < 16) { float s = 0.f; for (int e = 0; e < 128; ++e) s += vs[tid][e] * vs[tid][e]; rsv[tid] = 1.0f / sqrtf(s * (1.0f / 128.0f) + EPS); }
    __syncthreads();
    for (int r = 0; r < 16; ++r) { const size_t o = (tb + n0 + r) * 1024 + h * 128 + tid; SGR[o] = f2bf(acc[r] * rsv[r] * gn[h * 128 + tid] * bf2f(SGR[o])); }
}

__global__ void __launch_bounds__(128) k_attn_naive(const bf16* __restrict__ QD, const bf16* __restrict__ KD, const bf16* __restrict__ VD, bf16* SGD, const float* __restrict__ lq1, const float* __restrict__ lk1,
                                                    const float* __restrict__ lq2, const float* __restrict__ lk2, const float* __restrict__ gn, float lam_init) {
    __shared__ float qs[2][16][64];
    __shared__ float ks[2][32][65];
    __shared__ float vs[32][128];
    __shared__ float ps[2][16][32];
    __shared__ float mrow[2][16], lrow[2][16], arow[2][16], rsv[16];
    const int tid = threadIdx.x, qb = blockIdx.x & 255, bh = blockIdx.x >> 8, h = bh & 7, b = bh >> 3;
    const int n0 = qb * 16; const size_t tb = (size_t)b * SEQ;
    float s1 = 0.f, s2 = 0.f;
    for (int i = 0; i < 64; ++i) { s1 += lq1[i] * lk1[i]; s2 += lq2[i] * lk2[i]; }
    const float lam = expf(s1) - expf(s2) + lam_init;
    const float slope = exp2f(-(float)(h + 1)) * LOG2E;
    for (int i = tid; i < 2 * 16 * 64; i += 128) { const int j = i >> 10, r = (i >> 6) & 15, d = i & 63; qs[j][r][d] = bf2f(QD[(tb + n0 + r) * 1024 + h * 128 + j * 64 + d]); }
    if (tid < 32) { mrow[tid >> 4][tid & 15] = -INFINITY; lrow[tid >> 4][tid & 15] = 0.f; }
    float acc[2][16];
#pragma unroll
    for (int j = 0; j < 2; ++j)
#pragma unroll
        for (int r = 0; r < 16; ++r) acc[j][r] = 0.f;
    for (int k0 = 0; k0 < n0 + 16; k0 += 32) {
        __syncthreads();
        for (int i = tid; i < 2 * 32 * 64; i += 128) { const int j = i >> 11, kk = (i >> 6) & 31, d = i & 63; ks[j][kk][d] = bf2f(KD[(tb + k0 + kk) * 1024 + h * 128 + j * 64 + d]); }
        for (int i = tid; i < 32 * 128; i += 128) vs[i >> 7][i & 127] = bf2f(VD[(tb + k0 + (i >> 7)) * 1024 + h * 128 + (i & 127)]);
        __syncthreads();
        for (int i = tid; i < 2 * 16 * 32; i += 128) { const int j = i >> 9, r = (i >> 5) & 15, kk = i & 31; float d = 0.f;
            for (int c = 0; c < 64; ++c) d += qs[j][r][c] * ks[j][kk][c];
            const int dist = (n0 + r) - (k0 + kk);
            ps[j][r][kk] = dist >= 0 ? d - slope * (float)dist : -INFINITY; }
        __syncthreads();
        if (tid < 32) { const int j = tid >> 4, r = tid & 15; float mx = mrow[j][r];
            for (int kk = 0; kk < 32; ++kk) mx = fmaxf(mx, ps[j][r][kk]);
            const float al = exp2f(mrow[j][r] - mx); float sum = 0.f;
            for (int kk = 0; kk < 32; ++kk) { const float p = exp2f(ps[j][r][kk] - mx); ps[j][r][kk] = p; sum += p; }
            lrow[j][r] = lrow[j][r] * al + sum; arow[j][r] = al; mrow[j][r] = mx; }
        __syncthreads();
#pragma unroll
        for (int j = 0; j < 2; ++j)
#pragma unroll
            for (int r = 0; r < 16; ++r) { float a = acc[j][r] * arow[j][r];
                for (int kk = 0; kk < 32; ++kk) a += ps[j][r][kk] * vs[kk][tid];
                acc[j][r] = a; }
    }
    __syncthreads();
    float o[16];
#pragma unroll
    for (int r = 0; r < 16; ++r) { o[r] = acc[0][r] / lrow[0][r] - lam * acc[1][r] / lrow[1][r]; vs[r][tid] = o[r]; }
    __syncthreads();
    if (tid < 16) { float s = 0.f; for (int e = 0; e < 128; ++e) s += vs[tid][e] * vs[tid][e]; rsv[tid] = 1.0f / sqrtf(s * (1.0f / 128.0f) + EPS); }
    __syncthreads();
    for (int r = 0; r < 16; ++r) { const size_t oo = (tb + n0 + r) * 1024 + h * 128 + tid; SGD[oo] = f2bf(o[r] * rsv[r] * gn[h * 128 + tid] * (1.0f - lam_init) * bf2f(SGD[oo])); }
}


extern "C" void kernel_launch(void* const* d_in, const int* in_sizes, int n_in, void* d_out, int out_size, void* d_ws, size_t ws_size, hipStream_t stream) {
    static int ready = 0;
    if (ready == 0) {
        if (n_in != 14 || ws_size < WS_END || out_size != T * DM) { fprintf(stderr, "kernel_launch: unexpected problem (n_in %d, ws %zu, out %d)\n", n_in, ws_size, out_size); ready = -1; return; }
        if (hipFuncSetAttribute((const void*)mk_fwd, hipFuncAttributeMaxDynamicSharedMemorySize, LDS_BYTES) != hipSuccess) { fprintf(stderr, "kernel_launch: hipFuncSetAttribute failed\n"); ready = -1; return; }
        ready = 1;
    }
    if (ready < 0) return;
    (void)hipMemsetAsync((char*)d_ws + WS_CTL, 0, CTL_ZERO_BYTES, stream);
    Args a{};
    for (int i = 0; i < 14; ++i) a.in[i] = (const float*)d_in[i];
    a.out = (float*)d_out; a.ws = (unsigned char*)d_ws;
    char* ws = (char*)d_ws;
    const float* ret_norm_g = (const float*)d_in[3]; const float* sub_g = (const float*)d_in[11];
    const float* lq1 = (const float*)d_in[7]; const float* lk1 = (const float*)d_in[8]; const float* lq2 = (const float*)d_in[9]; const float* lk2 = (const float*)d_in[10];
    a.ph_lo = 0; a.ph_hi = N_PHASES; a.li = 0;
    hipLaunchKernelGGL(mk_fwd, dim3(256), dim3(NWAVES * 64), LDS_BYTES, stream, a);
}
```

```cpp
#include <hip/hip_runtime.h>
#include <cstdio>
#include <cstdint>
#include <cstddef>

constexpr int DM = 1024, BATCH = 4, SEQ = 4096, DEPTH = 2, T = BATCH * SEQ, NIN = 9216;
constexpr float EPS = 1e-6f;
constexpr float LOG2E = 1.4426950408889634f;

typedef unsigned short bf16;
typedef short bf16x8 __attribute__((ext_vector_type(8)));
typedef float f32x4 __attribute__((ext_vector_type(4)));
typedef unsigned u32x4 __attribute__((ext_vector_type(4)));
#define LAS __attribute__((address_space(3)))
#define GAS __attribute__((address_space(1)))

__device__ __forceinline__ float bf2f(bf16 v) { return __uint_as_float(((unsigned)v) << 16); }
__device__ __forceinline__ unsigned f2bf_u(float f) { unsigned u = __float_as_uint(f); return (u + 0x7fffu + ((u >> 16) & 1u)) >> 16; }
__device__ __forceinline__ bf16 f2bf(float f) { return (bf16)f2bf_u(f); }
__device__ __forceinline__ unsigned pk2(float lo, float hi) { return f2bf_u(lo) | (f2bf_u(hi) << 16); }
typedef float f32x2_t __attribute__((ext_vector_type(2))); typedef __bf16 bf16x2_t __attribute__((ext_vector_type(2)));
__device__ __forceinline__ unsigned cvt_pk_bf16(float lo, float hi) { f32x2_t v = {lo, hi}; bf16x2_t b = __builtin_convertvector(v, bf16x2_t); return __builtin_bit_cast(unsigned, b); }
__device__ __forceinline__ float fast_sigmoid(float v) { return __builtin_amdgcn_rcpf(1.0f + __builtin_amdgcn_exp2f(-v * LOG2E)); }
__device__ __forceinline__ float lo_bf(unsigned w) { return __uint_as_float(w << 16); }
__device__ __forceinline__ float hi_bf(unsigned w) { return __uint_as_float(w & 0xffff0000u); }

constexpr size_t MiB = 1u << 20;
constexpr size_t WS_CTL = 0, CTL_ZERO_BYTES = 64 * 1024;
constexpr size_t WS_WIN = 1 * MiB, WS_WRO = 19 * MiB, WS_WDO = 21 * MiB, WS_WOUT = 23 * MiB;
constexpr size_t WS_H = 25 * MiB, WS_QR = 57 * MiB, WS_KR = 73 * MiB, WS_VR = 89 * MiB, WS_SGR = 121 * MiB, WS_QD = 153 * MiB, WS_KD = 185 * MiB,
                 WS_VD = 217 * MiB, WS_SGD = 249 * MiB;
constexpr size_t WS_W1 = 281 * MiB;
constexpr size_t WS_END = 287 * MiB;
constexpr size_t WS_MBUF = 57 * MiB;
constexpr size_t WS_MBF = WS_VD;
constexpr size_t WS_SMGR = WS_QD, WS_SMGD = WS_KD;
constexpr int CW_BAR = 4096;

namespace pg8 {
constexpr int BM = 256, BK = 64, HALF = 128, HTB = HALF * BK * 2, STAGE_BYTES = 8 * HTB, NXCD = 8, WGM = 8;
__host__ __device__ __forceinline__ int lds_byte(int r, int c) { const int st = (r >> 4) * 2 + (c >> 5), rr = r & 15, cc = c & 31, ob = rr * 64 + cc * 2; return st * 1024 + (ob ^ (((ob >> 9) & 1) << 5)); }
__host__ __device__ __forceinline__ void stage_rc(int b, int& R, int& C) { const int st = b / 1024, sb = b % 1024, swz = sb ^ (((sb >> 9) & 1) << 5); R = (st >> 1) * 16 + swz / 64; C = (st & 1) * 32 + (swz % 64) / 2; }
__host__ __device__ __forceinline__ int perm32(int rho) { const int n = rho >> 4, i = rho & 15; return 8 * (i >> 2) + 4 * n + (i & 3); }

struct Unit { int pm, pn, kind; const char* a; const char* b; };

__device__ __forceinline__ void tile_of(int L, int nM, int nN, int& pm, int& pn) {
    const int nwg = nM * nN; int wgid = L;
    { const int q = nwg / NXCD, r = nwg % NXCD, xcd = wgid % NXCD, off = wgid / NXCD; wgid = (xcd < r ? xcd * (q + 1) : r * (q + 1) + (xcd - r) * q) + off; }
    const int nig = WGM * nN, gid = wgid / nig, fm = gid * WGM, gsz = (nM - fm) < WGM ? (nM - fm) : WGM;
    pm = fm + ((wgid % nig) % gsz); pn = (wgid % nig) / gsz;
}

template <class Epi, class Sched, bool ALIGN_EPI, bool SP2>
__device__ __forceinline__ void gemm_phase(LAS unsigned char* lds, const int K, const Sched& S, const Epi& E) {
    int tid_ = threadIdx.x; asm volatile("" : "+v"(tid_));
    const int tid = tid_, wid = __builtin_amdgcn_readfirstlane(tid >> 6), lane = tid & 63, wr = wid >> 2, wc = wid & 3, fr = lane & 15, fq = lane >> 4;
    const int nt = K / BK;
    unsigned voffA[2], voffB[2];
#pragma unroll
    for (int i = 0; i < 2; ++i) { int R, C; stage_rc(tid * 16 + i * 8192, R, C); const int Rb = (R >> 5) * 64 + perm32(R & 31);
        voffA[i] = (unsigned)(R * K + C) * 2u; voffB[i] = (unsigned)(Rb * K + C) * 2u; }
    const size_t kstep = (size_t)(BK * 2);
    const size_t hstep = (size_t)HALF * K * 2;
    const size_t hstepB = (size_t)32 * K * 2;
    const unsigned ldsw = (unsigned)wid * 1024u;
    const int aoff = lds_byte(wr * 64 + fr, fq * 8), boff = lds_byte(wc * 32 + fr, fq * 8);
#define PG8_SA(b, h) (((b) * 2 + (h)) * HTB)
#define PG8_SB(b, h) ((4 + (b) * 2 + (h)) * HTB)
#define PG8_STAGE(bufoff, gbase, voff) do { _Pragma("unroll") for (int _i = 0; _i < 2; ++_i) \
        __builtin_amdgcn_global_load_lds((const unsigned*)((const char*)(gbase) + (voff)[_i]), (LAS unsigned*)(lds + (bufoff) + ldsw + _i * 8192), 16, 0, 0); } while (0)
#define PG8_LDA(dst, b, h) do { _Pragma("unroll") for (int m = 0; m < 4; ++m) _Pragma("unroll") for (int k = 0; k < 2; ++k) dst[m][k] = *(const LAS bf16x8*)(lds + PG8_SA(b, h) + aoff + m * 2048 + k * 1024); } while (0)
#define PG8_LDB(dst, b, h) do { _Pragma("unroll") for (int n = 0; n < 2; ++n) _Pragma("unroll") for (int k = 0; k < 2; ++k) dst[n][k] = *(const LAS bf16x8*)(lds + PG8_SB(b, h) + boff + n * 2048 + k * 1024); } while (0)
#define PG8_MMA(ai, bj, At, Bt) do { __builtin_amdgcn_s_setprio(1); _Pragma("unroll") for (int m = 0; m < 4; ++m) _Pragma("unroll") for (int n = 0; n < 2; ++n) _Pragma("unroll") for (int k = 0; k < 2; ++k) \
        acc[ai][bj][m][n] = __builtin_amdgcn_mfma_f32_16x16x32_bf16(Bt[n][k], At[m][k], acc[ai][bj][m][n], 0, 0, 0); __builtin_amdgcn_s_setprio(0); } while (0)
#define PG8_WAIT_V(n) asm volatile("s_waitcnt vmcnt(" #n ")" ::: "memory")
#define PG8_WAIT_L(n) asm volatile("s_waitcnt lgkmcnt(" #n ")" ::: "memory")
#define PG8_BAR __builtin_amdgcn_s_barrier()
#define PG8_SCHED __builtin_amdgcn_sched_barrier(0)
    Unit cur, nxt; int ui = 0;
    if (!S.next(0, cur)) return;
    f32x4 acc[2][2][4][2];
#pragma unroll
    for (int a = 0; a < 2; ++a)
#pragma unroll
        for (int b = 0; b < 2; ++b)
#pragma unroll
            for (int m = 0; m < 4; ++m)
#pragma unroll
                for (int n = 0; n < 2; ++n) acc[a][b][m][n] = (f32x4){0.f, 0.f, 0.f, 0.f};
    bf16x8 At[4][2], B0[2][2], B1[2][2];
    const char* cA = cur.a; const char* cB = cur.b;
    if constexpr (SP2) {
        PG8_STAGE(PG8_SB(0, 0), cB, voffB); PG8_STAGE(PG8_SB(0, 1), cB + hstepB, voffB); PG8_STAGE(PG8_SA(0, 0), cA, voffA); PG8_STAGE(PG8_SA(0, 1), cA + hstep, voffA);
        if (wr == 1) PG8_BAR;
        PG8_WAIT_V(2); PG8_BAR;
        PG8_STAGE(PG8_SB(1, 0), cB + kstep, voffB); PG8_STAGE(PG8_SA(1, 0), cA + kstep, voffA); PG8_STAGE(PG8_SB(1, 1), cB + hstepB + kstep, voffB);
        PG8_WAIT_V(6); PG8_BAR;
    } else {
        PG8_STAGE(PG8_SB(0, 0), cB, voffB); PG8_STAGE(PG8_SA(0, 0), cA, voffA); PG8_STAGE(PG8_SB(0, 1), cB + hstepB, voffB); PG8_STAGE(PG8_SA(0, 1), cA + hstep, voffA);
        if (wr == 1) PG8_BAR;
        PG8_WAIT_V(4); PG8_BAR;
        PG8_STAGE(PG8_SB(1, 0), cB + kstep, voffB); PG8_STAGE(PG8_SA(1, 0), cA + kstep, voffA); PG8_STAGE(PG8_SB(1, 1), cB + hstepB + kstep, voffB);
        PG8_WAIT_V(6); PG8_BAR;
    }
    for (;;) {
        const bool has_next = S.next(ui + 1, nxt);
        const char* nA = has_next ? nxt.a : cA; const char* nB = has_next ? nxt.b : cB;
        for (int t = 0; t < nt; t += 2) {
            const bool last = (t == nt - 2);
            const char* a1 = cA + (size_t)(t + 1) * kstep;
            const char* a2 = last ? nA : cA + (size_t)(t + 2) * kstep; const char* b2 = last ? nB : cB + (size_t)(t + 2) * kstep;
            const char* a3 = a2 + kstep; const char* b3 = b2 + kstep;
            if constexpr (SP2) {
            PG8_LDB(B0, 0, 0); PG8_LDB(B1, 0, 1); PG8_SCHED; PG8_LDA(At, 0, 0); PG8_STAGE(PG8_SA(1, 1), a1 + hstep, voffA);
            PG8_WAIT_V(8); PG8_WAIT_L(0); PG8_BAR; PG8_MMA(0, 0, At, B0); PG8_MMA(0, 1, At, B1); PG8_BAR; PG8_SCHED;
            PG8_LDA(At, 0, 1); PG8_STAGE(PG8_SB(0, 0), b2, voffB); PG8_STAGE(PG8_SB(0, 1), b2 + hstepB, voffB); PG8_STAGE(PG8_SA(0, 0), a2, voffA);
            PG8_WAIT_V(8); PG8_WAIT_L(0); PG8_BAR; PG8_MMA(1, 0, At, B0); PG8_MMA(1, 1, At, B1); PG8_BAR; PG8_SCHED;
            PG8_LDB(B0, 1, 0); PG8_LDB(B1, 1, 1); PG8_SCHED; PG8_LDA(At, 1, 0); PG8_STAGE(PG8_SA(0, 1), a2 + hstep, voffA);
            PG8_WAIT_V(8); PG8_WAIT_L(0); PG8_BAR; PG8_MMA(0, 0, At, B0); PG8_MMA(0, 1, At, B1); PG8_BAR; PG8_SCHED;
            PG8_LDA(At, 1, 1); PG8_STAGE(PG8_SB(1, 0), b3, voffB); PG8_STAGE(PG8_SB(1, 1), b3 + hstepB, voffB); PG8_STAGE(PG8_SA(1, 0), a3, voffA);
            PG8_WAIT_V(8); PG8_WAIT_L(0); PG8_BAR; PG8_MMA(1, 0, At, B0); PG8_MMA(1, 1, At, B1); PG8_BAR; PG8_SCHED;
            } else {
            PG8_LDB(B0, 0, 0); PG8_SCHED; PG8_LDA(At, 0, 0); PG8_STAGE(PG8_SA(1, 1), a1 + hstep, voffA);
            PG8_WAIT_L(8); PG8_BAR; PG8_WAIT_L(0); PG8_MMA(0, 0, At, B0); PG8_BAR; PG8_SCHED;
            PG8_LDB(B1, 0, 1); PG8_STAGE(PG8_SB(0, 0), b2, voffB);
            PG8_BAR; PG8_WAIT_L(0); PG8_MMA(0, 1, At, B1); PG8_BAR;
            PG8_LDA(At, 0, 1); PG8_STAGE(PG8_SA(0, 0), a2, voffA);
            PG8_BAR; PG8_WAIT_L(0); PG8_MMA(1, 0, At, B0); PG8_BAR; PG8_SCHED;
            PG8_STAGE(PG8_SB(0, 1), b2 + hstepB, voffB);
            PG8_WAIT_V(6); PG8_BAR; PG8_MMA(1, 1, At, B1); PG8_BAR;
            PG8_LDB(B0, 1, 0); PG8_SCHED; PG8_LDA(At, 1, 0); PG8_STAGE(PG8_SA(0, 1), a2 + hstep, voffA);
            PG8_WAIT_L(8); PG8_BAR; PG8_WAIT_L(0); PG8_MMA(0, 0, At, B0); PG8_BAR; PG8_SCHED;
            PG8_LDB(B1, 1, 1); PG8_STAGE(PG8_SB(1, 0), b3, voffB);
            PG8_BAR; PG8_WAIT_L(0); PG8_MMA(0, 1, At, B1); PG8_BAR;
            PG8_LDA(At, 1, 1); PG8_STAGE(PG8_SA(1, 0), a3, voffA);
            PG8_BAR; PG8_WAIT_L(0); PG8_MMA(1, 0, At, B0); PG8_BAR; PG8_SCHED;
            PG8_STAGE(PG8_SB(1, 1), b3 + hstepB, voffB);
            PG8_WAIT_V(6); PG8_BAR; PG8_MMA(1, 1, At, B1); PG8_BAR;
            }
        }
        if constexpr (ALIGN_EPI) { if (wr == 0) PG8_BAR; }
        E(acc, cur, wr, wc, fr, fq);
        if (!has_next) break;
#pragma unroll
        for (int a = 0; a < 2; ++a)
#pragma unroll
            for (int b = 0; b < 2; ++b)
#pragma unroll
                for (int m = 0; m < 4; ++m)
#pragma unroll
                    for (int n = 0; n < 2; ++n) acc[a][b][m][n] = (f32x4){0.f, 0.f, 0.f, 0.f};
        cur = nxt; cA = nA; cB = nB; ++ui;
        if constexpr (ALIGN_EPI) { if (wr == 1) PG8_BAR; }
    }
    PG8_WAIT_V(0);
    if constexpr (!ALIGN_EPI) { if (wr == 0) PG8_BAR; }
    PG8_BAR;
#undef PG8_SA
#undef PG8_SB
#undef PG8_STAGE
#undef PG8_LDA
#undef PG8_LDB
#undef PG8_MMA
#undef PG8_WAIT_V
#undef PG8_WAIT_L
#undef PG8_BAR
#undef PG8_SCHED
}
}

enum { K_QR = 0, K_KR, K_VR, K_SGR, K_QD, K_KD, K_VD, K_SGD, K_MGR, K_YR, K_MGD, K_YD, K_OUT };
constexpr size_t TSTEP = (size_t)256 * DM * 2;

template <int PC  > struct Epi {
    unsigned char* ws; const float* xin; float* xout; const float* gq; const float* gk;
    __device__ __forceinline__ static void st8(bf16* p, const f32x4 a, const f32x4 b) {
        u32x4 w; w.x = cvt_pk_bf16(a[0], a[1]); w.y = cvt_pk_bf16(a[2], a[3]); w.z = cvt_pk_bf16(b[0], b[1]); w.w = cvt_pk_bf16(b[2], b[3]); *(u32x4*)p = w; }
    __device__ __forceinline__ void operator()(const f32x4 (&acc)[2][2][4][2], const pg8::Unit& u, int wr, int wc, int fr, int fq) const {
        const int row0 = u.pm * 256 + wr * 64 + fr;
        const int cl = wc * 64 + 8 * fq;
        const int kind = u.kind;
        bf16* const qr = (bf16*)(ws + WS_QR); bf16* const kr = (bf16*)(ws + WS_KR); bf16* const vr = (bf16*)(ws + WS_VR); bf16* const sgr = (bf16*)(ws + WS_SGR);
        bf16* const qd = (bf16*)(ws + WS_QD); bf16* const kd = (bf16*)(ws + WS_KD); bf16* const vd = (bf16*)(ws + WS_VD); bf16* const sgd = (bf16*)(ws + WS_SGD);
        bf16* const smgr = (bf16*)(ws + WS_SMGR); bf16* const smgd = (bf16*)(ws + WS_SMGD); bf16* const mbf = (bf16*)(ws + WS_MBF); float* const mbuf = (float*)(ws + WS_MBUF);
        if (PC == 0 && (kind == K_VR || kind == K_VD)) {
            bf16* base = (kind == K_VR ? vr : vd) + u.pn * 256 + cl;
#pragma unroll
            for (int ai = 0; ai < 2; ++ai)
#pragma unroll
                for (int m = 0; m < 4; ++m) { bf16* rp = base + (size_t)(row0 + ai * 128 + m * 16) * 1024;
#pragma unroll
                    for (int bj = 0; bj < 2; ++bj) st8(rp + 32 * bj, acc[ai][bj][m][0], acc[ai][bj][m][1]); }
        } else if (PC == 0 && (kind == K_SGR || kind == K_SGD)) {
            bf16* base = (kind == K_SGR ? sgr : sgd) + u.pn * 256 + cl;
#pragma unroll
            for (int ai = 0; ai < 2; ++ai)
#pragma unroll
                for (int m = 0; m < 4; ++m) { bf16* rp = base + (size_t)(row0 + ai * 128 + m * 16) * 1024;
#pragma unroll
                    for (int bj = 0; bj < 2; ++bj) { f32x4 a = acc[ai][bj][m][0], b = acc[ai][bj][m][1];
#pragma unroll
                        for (int i = 0; i < 4; ++i) { a[i] = a[i] * fast_sigmoid(a[i]); b[i] = b[i] * fast_sigmoid(b[i]); }
                        st8(rp + 32 * bj, a, b); } }
        } else if (PC == 1 && (kind == K_MGR || kind == K_MGD)) {
            bf16* base = (kind == K_MGR ? smgr : smgd) + u.pn * 256 + cl;
#pragma unroll
            for (int ai = 0; ai < 2; ++ai)
#pragma unroll
                for (int m = 0; m < 4; ++m) { bf16* rp = base + (size_t)(row0 + ai * 128 + m * 16) * 1024;
#pragma unroll
                    for (int bj = 0; bj < 2; ++bj) { f32x4 a = acc[ai][bj][m][0], b = acc[ai][bj][m][1];
#pragma unroll
                        for (int i = 0; i < 4; ++i) { a[i] = fast_sigmoid(a[i]); b[i] = fast_sigmoid(b[i]); }
                        st8(rp + 32 * bj, a, b); } }
        } else if (PC == 0 && (kind == K_QR || kind == K_KR)) {
            const int h = u.pn * 4 + wc; const float lg = __log2f(1.0f - __builtin_amdgcn_exp2f(-5.0f - (float)h));
            bf16* base = (kind == K_QR ? qr : kr) + u.pn * 256 + cl;
            const float sgn = (kind == K_QR) ? lg : -lg, mul = (kind == K_QR) ? 1.0f : 0.125f;
#pragma unroll
            for (int ai = 0; ai < 2; ++ai)
#pragma unroll
                for (int m = 0; m < 4; ++m) { const int row = row0 + ai * 128 + m * 16; bf16* rp = base + (size_t)row * 512;
                    const float f = mul * __builtin_amdgcn_exp2f((float)(row & 127) * sgn);
#pragma unroll
                    for (int bj = 0; bj < 2; ++bj) st8(rp + 32 * bj, acc[ai][bj][m][0] * f, acc[ai][bj][m][1] * f); }
        } else if (PC == 0 && (kind == K_QD || kind == K_KD)) {
            const float* g = (kind == K_QD) ? gq : gk; const float mul = (kind == K_QD) ? 0.125f * LOG2E : 1.0f;
            bf16* base = (kind == K_QD ? qd : kd) + u.pn * 256 + cl;
            f32x4 gv[2][2];
#pragma unroll
            for (int bj = 0; bj < 2; ++bj)
#pragma unroll
                for (int n = 0; n < 2; ++n) gv[bj][n] = *(const f32x4*)(g + 32 * bj + 8 * fq + 4 * n) * mul;
#pragma unroll
            for (int ai = 0; ai < 2; ++ai)
#pragma unroll
                for (int m = 0; m < 4; ++m) { bf16* rp = base + (size_t)(row0 + ai * 128 + m * 16) * 1024;
                    float ss = 0.f;
#pragma unroll
                    for (int bj = 0; bj < 2; ++bj)
#pragma unroll
                        for (int n = 0; n < 2; ++n) { const f32x4 x = acc[ai][bj][m][n]; ss += (x[0] * x[0] + x[1] * x[1]) + (x[2] * x[2] + x[3] * x[3]); }
                    ss += __shfl_xor(ss, 16); ss += __shfl_xor(ss, 32);
                    const float rs = __builtin_amdgcn_rsqf(ss * (1.0f / 64.0f) + EPS);
#pragma unroll
                    for (int bj = 0; bj < 2; ++bj) st8(rp + 32 * bj, acc[ai][bj][m][0] * gv[bj][0] * rs, acc[ai][bj][m][1] * gv[bj][1] * rs); }
        } else if (PC == 1 && kind == K_YR) {
            bf16* const yrb = (bf16*)mbuf + (size_t)u.pn * 256 + cl;
#pragma unroll
            for (int ai = 0; ai < 2; ++ai)
#pragma unroll
                for (int m = 0; m < 4; ++m) { bf16* rp = yrb + (size_t)(row0 + ai * 128 + m * 16) * 1024;
#pragma unroll
                    for (int bj = 0; bj < 2; ++bj) st8(rp + 32 * bj, acc[ai][bj][m][0], acc[ai][bj][m][1]); }
        } else if (PC == 1 && kind == K_YD) {
            const size_t cb = (size_t)u.pn * 256 + cl; const bf16* const yrb = (const bf16*)mbuf;
#pragma unroll
            for (int ai = 0; ai < 2; ++ai)
#pragma unroll
                for (int m = 0; m < 4; ++m) { const size_t ro = (size_t)(row0 + ai * 128 + m * 16) * 1024 + cb;
#pragma unroll
                    for (int bj = 0; bj < 2; ++bj) { const u32x4 sr = *(const u32x4*)(smgr + ro + 32 * bj), sd = *(const u32x4*)(smgd + ro + 32 * bj), yr = *(const u32x4*)(yrb + ro + 32 * bj);
                        const f32x4 a = acc[ai][bj][m][0], b = acc[ai][bj][m][1];
                        f32x4 o0, o1;
                        o0[0] = lo_bf(sr.x) * lo_bf(yr.x) + lo_bf(sd.x) * a[0]; o0[1] = hi_bf(sr.x) * hi_bf(yr.x) + hi_bf(sd.x) * a[1];
                        o0[2] = lo_bf(sr.y) * lo_bf(yr.y) + lo_bf(sd.y) * a[2]; o0[3] = hi_bf(sr.y) * hi_bf(yr.y) + hi_bf(sd.y) * a[3];
                        o1[0] = lo_bf(sr.z) * lo_bf(yr.z) + lo_bf(sd.z) * b[0]; o1[1] = hi_bf(sr.z) * hi_bf(yr.z) + hi_bf(sd.z) * b[1];
                        o1[2] = lo_bf(sr.w) * lo_bf(yr.w) + lo_bf(sd.w) * b[2]; o1[3] = hi_bf(sr.w) * hi_bf(yr.w) + hi_bf(sd.w) * b[3];
                        st8(mbf + ro + 32 * bj, o0, o1); }
                    asm volatile("" ::: "memory"); }
        } else if (PC == 2 && kind == K_OUT) {
            const size_t cb = (size_t)u.pn * 256 + cl;
#pragma unroll
            for (int ai = 0; ai < 2; ++ai) {
                f32x4 pre[4][2][2];
#pragma unroll
                for (int m = 0; m < 4; ++m) { const size_t ro = (size_t)(row0 + ai * 128 + m * 16) * 1024 + cb;
#pragma unroll
                    for (int bj = 0; bj < 2; ++bj) { pre[m][bj][0] = *(const f32x4*)(xin + ro + 32 * bj); pre[m][bj][1] = *(const f32x4*)(xin + ro + 32 * bj + 4); } }
#pragma unroll
                for (int m = 0; m < 4; ++m) { const size_t ro = (size_t)(row0 + ai * 128 + m * 16) * 1024 + cb;
#pragma unroll
                    for (int bj = 0; bj < 2; ++bj) { *(f32x4*)(xout + ro + 32 * bj) = pre[m][bj][0] + acc[ai][bj][m][0]; *(f32x4*)(xout + ro + 32 * bj + 4) = pre[m][bj][1] + acc[ai][bj][m][1]; } }
                asm volatile("" ::: "memory");
            }
        }
    }
};

struct SchedG1A {
    const char* A; const char* B; int G, c;
    __device__ __forceinline__ bool next(int i, pg8::Unit& u) const {
        const int L = i * G + c; if (L >= 64 * 28) return false;
        int pm, pg; pg8::tile_of(L, 64, 28, pm, pg);
        u.pm = pm; u.a = A + (size_t)pm * TSTEP; u.b = B + (size_t)pg * TSTEP;
        if (pg < 2) { u.kind = K_QR; u.pn = pg; } else if (pg < 4) { u.kind = K_KR; u.pn = pg - 2; } else if (pg < 8) { u.kind = K_VR; u.pn = pg - 4; } else if (pg < 12) { u.kind = K_SGR; u.pn = pg - 8; }
        else if (pg < 16) { u.kind = K_QD; u.pn = pg - 12; } else if (pg < 20) { u.kind = K_KD; u.pn = pg - 16; } else if (pg < 24) { u.kind = K_VD; u.pn = pg - 20; } else { u.kind = K_SGD; u.pn = pg - 24; }
        return true;
    }
};
struct SchedP34 {
    const char *ws, *Wro; int c;
    __device__ __forceinline__ bool next(int i, pg8::Unit& u) const {
        if (i >= 4) return false;
        const char* H = ws + WS_H; const char* OR = ws + WS_SGR; const char* OD = ws + WS_SGD; const char* Win = ws + WS_WIN; const char* Wdo = Wro + 2 * MiB;
        int pm, pn; pg8::tile_of(c, 64, 4, pm, pn); u.pm = pm; u.pn = pn;
        if (i == 0) { u.kind = K_MGR; u.a = H + (size_t)pm * TSTEP; u.b = Win + (size_t)(28 + pn) * TSTEP; }
        else if (i == 1) { u.kind = K_MGD; u.a = H + (size_t)pm * TSTEP; u.b = Win + (size_t)(32 + pn) * TSTEP; }
        else if (i == 2) { u.kind = K_YR; u.a = OR + (size_t)pm * TSTEP; u.b = Wro + (size_t)pn * TSTEP; }
        else { u.kind = K_YD; u.a = OD + (size_t)pm * TSTEP; u.b = Wdo + (size_t)pn * TSTEP; }
        return true;
    }
};
struct SchedG4 {
    const char *Mb, *Wout; int c;
    __device__ __forceinline__ bool next(int i, pg8::Unit& u) const {
        if (i >= 1) return false;
        int pm, pn; pg8::tile_of(c, 64, 4, pm, pn); u.pm = pm; u.pn = pn; u.kind = K_OUT; u.a = Mb + (size_t)pm * TSTEP; u.b = Wout + (size_t)pn * TSTEP; return true;
    }
};


namespace att {
typedef float f32x16 __attribute__((ext_vector_type(16)));
typedef short s16x4 __attribute__((ext_vector_type(4)));
typedef short v4i16_t __attribute__((ext_vector_type(4)));
constexpr int SLOT_OFF = 65536, SLOT_BYTES = 32768, V_OFF = 16384;
__device__ __forceinline__ int crow(int r, int hi) { return (r & 3) + 8 * (r >> 2) + 4 * hi; }
__device__ __forceinline__ s16x4 vtr(LAS const unsigned char* p) { return __builtin_bit_cast(s16x4, __builtin_amdgcn_ds_read_tr16_b64_v4i16((LAS v4i16_t*)p)); }
#define ATT_MFMA(a, b, c) __builtin_amdgcn_mfma_f32_32x32x16_bf16(a, b, c, 0, 0, 0)

__device__ __forceinline__ void attn_unit(LAS unsigned char* lds, const unsigned char* ws, const int b, const int h, const int qb, const float lam, const float omli, const float* __restrict__ gsub, const int win) {
    int tid_ = threadIdx.x; asm volatile("" : "+v"(tid_));
    const int tid = tid_, lane = tid & 63, r32 = lane & 31, hi = lane >> 5, w = __builtin_amdgcn_readfirstlane(tid >> 6), rg = w & 3, kg = w >> 2;
    const bf16* QD = (const bf16*)(ws + WS_QD); const bf16* KD = (const bf16*)(ws + WS_KD); const bf16* VD = (const bf16*)(ws + WS_VD); bf16* SGD = (bf16*)(ws + WS_SGD);
    const size_t tb = (size_t)b * SEQ; const int q0 = qb * 128, NT = (q0 + 128) / 64;
    const int T0 = (q0 > win ? q0 - win : 0) >> 6;
#pragma unroll
    for (int k = 0; k < 4; ++k) { const int p = 4 * kg + k; const bf16* src = QD + (tb + q0 + 32 * rg + r32) * 1024 + h * 128 + (p >> 2) * 64 + (p & 3) * 16 + hi * 8;
        __builtin_amdgcn_global_load_lds((const unsigned*)src, (LAS unsigned*)(lds + rg * 8192 + p * 1024), 16, 0, 0); }
    const bf16* ksrc = KD + (tb + lane) * 1024 + h * 128 + (w & 7) * 8;
    const bf16* vsrc = VD + (tb + 16 * (w & 3) + (lane >> 2)) * 1024 + h * 128 + (w >> 2) * 32 + (lane & 3) * 8;
#define ATT_STAGE(t, slot) do { _Pragma("unroll") for (int rr = 0; rr < 2; ++rr) { \
        __builtin_amdgcn_global_load_lds((const unsigned*)(ksrc + (size_t)(t) * 65536 + rr * 64), (LAS unsigned*)(lds + SLOT_OFF + (slot) * SLOT_BYTES + (rr * 8 + w) * 1024), 16, 0, 0); \
        __builtin_amdgcn_global_load_lds((const unsigned*)(vsrc + (size_t)(t) * 65536 + rr * 64), (LAS unsigned*)(lds + SLOT_OFF + (slot) * SLOT_BYTES + V_OFF + (rr * 8 + w) * 1024), 16, 0, 0); } } while (0)
    ATT_STAGE(T0, 0);
    __syncthreads();
    const float slope = __builtin_amdgcn_exp2f(-(float)(h + 1)) * LOG2E;
    const int n = q0 + 32 * rg + r32;
    f32x16 O[2][4];
#pragma unroll
    for (int j = 0; j < 2; ++j)
#pragma unroll
        for (int e = 0; e < 4; ++e)
#pragma unroll
            for (int r = 0; r < 16; ++r) O[j][e][r] = 0.f;
    float lsum[2] = {0.f, 0.f};
    const int qoff = rg * 8192 + lane * 16;
    const int koff = hi * 1024 + (32 * kg + r32) * 16;
    const int voff = V_OFF + 2 * kg * 1024 + ((lane >> 4) & 1) * 32 + (lane & 3) * 8 + (4 * hi + ((lane & 15) >> 2)) * 64;
    for (int t = T0; t < NT; ++t) {
        if (t + 1 < NT) ATT_STAGE(t + 1, (t + 1 - T0) & 1);
        const int k0 = t * 64 + 32 * kg;
        if (k0 <= q0 + 32 * rg + 31) {
            LAS const unsigned char* slot = lds + SLOT_OFF + ((t - T0) & 1) * SLOT_BYTES;
            float sl = slope; asm volatile("" : "+v"(sl));
            const int dn = n - k0 - 4 * hi; const float base = -sl * (float)dn;
            const bool diag = (k0 + 31 > q0 + 32 * rg);
            f32x16 pA, pB;
#pragma unroll
            for (int r = 0; r < 16; ++r) { const int kc = (r & 3) + 8 * (r >> 2); pA[r] = __builtin_fmaf(sl, (float)kc, base); }
            if (diag) {
#pragma unroll
                for (int r = 0; r < 16; ++r) { const int kc = (r & 3) + 8 * (r >> 2); if (kc > dn) pA[r] = -INFINITY; }
            }
            pB = pA;
#pragma unroll
            for (int d0 = 0; d0 < 4; ++d0) {
                const bf16x8 kfa = *(LAS const bf16x8*)(slot + koff + (2 * d0) * 1024), kfb = *(LAS const bf16x8*)(slot + koff + (8 + 2 * d0) * 1024);
                const bf16x8 qfa = *(LAS const bf16x8*)(lds + qoff + d0 * 1024), qfb = *(LAS const bf16x8*)(lds + qoff + (4 + d0) * 1024);
                pA = ATT_MFMA(kfa, qfa, pA); pB = ATT_MFMA(kfb, qfb, pB);
            }
            bf16x8 vf[4][2];
#pragma unroll
            for (int eb = 0; eb < 4; ++eb)
#pragma unroll
                for (int ks = 0; ks < 2; ++ks) { const s16x4 vlo = vtr(slot + voff + eb * 4096 + ks * 1024), vhi = vtr(slot + voff + eb * 4096 + ks * 1024 + 512);
                    vf[eb][ks] = (bf16x8){vlo[0], vlo[1], vlo[2], vlo[3], vhi[0], vhi[1], vhi[2], vhi[3]}; }
            u32x4 pwA[2], pwB[2];
            { float s = 0.f;
#pragma unroll
              for (int r = 0; r < 16; ++r) { pA[r] = __builtin_amdgcn_exp2f(pA[r]); s += pA[r]; }
              lsum[0] += s;
#pragma unroll
              for (int i = 0; i < 4; ++i) { pwA[0][i] = cvt_pk_bf16(pA[2 * i], pA[2 * i + 1]); pwA[1][i] = cvt_pk_bf16(pA[8 + 2 * i], pA[9 + 2 * i]); } }
            { float s = 0.f;
#pragma unroll
              for (int r = 0; r < 16; ++r) { pB[r] = __builtin_amdgcn_exp2f(pB[r]); s += pB[r]; }
              lsum[1] += s;
#pragma unroll
              for (int i = 0; i < 4; ++i) { pwB[0][i] = cvt_pk_bf16(pB[2 * i], pB[2 * i + 1]); pwB[1][i] = cvt_pk_bf16(pB[8 + 2 * i], pB[9 + 2 * i]); } }
#pragma unroll
            for (int eb = 0; eb < 4; ++eb)
#pragma unroll
                for (int ks = 0; ks < 2; ++ks) {
                    O[0][eb] = ATT_MFMA(vf[eb][ks], __builtin_bit_cast(bf16x8, pwA[ks]), O[0][eb]);
                    O[1][eb] = ATT_MFMA(vf[eb][ks], __builtin_bit_cast(bf16x8, pwB[ks]), O[1][eb]);
                }
        }
        __syncthreads();
    }
    lsum[0] += __shfl_xor(lsum[0], 32); lsum[1] += __shfl_xor(lsum[1], 32);
    LAS float* dump = (LAS float*)(lds + rg * 32768);
    LAS float* lx = (LAS float*)(lds + 131072 + rg * 1024);
    if (kg == 1) {
#pragma unroll
        for (int j = 0; j < 2; ++j)
#pragma unroll
            for (int eb = 0; eb < 4; ++eb)
#pragma unroll
                for (int r = 0; r < 16; ++r) dump[((j * 4 + eb) * 16 + r) * 64 + lane] = O[j][eb][r];
        lx[lane] = lsum[0]; lx[64 + lane] = lsum[1];
    }
    asm volatile("s_waitcnt lgkmcnt(0)" ::: "memory");
    __syncthreads();
    if (kg == 0) {
#pragma unroll
        for (int j = 0; j < 2; ++j)
#pragma unroll
            for (int eb = 0; eb < 4; ++eb)
                {
#pragma unroll
                  for (int r = 0; r < 16; ++r) O[j][eb][r] += dump[((j * 4 + eb) * 16 + r) * 64 + lane];
                  asm volatile("s_waitcnt lgkmcnt(0)" : "+v"(O[j][eb]) :: "memory"); }
        lsum[0] += lx[lane]; lsum[1] += lx[64 + lane];
        asm volatile("s_waitcnt lgkmcnt(0)" ::: "memory");
        int r32e = r32; asm volatile("" : "+v"(r32e));
        const float i0 = 1.0f / lsum[0], i1 = lam / lsum[1];
        float ss = 0.f;
#pragma unroll
        for (int eb = 0; eb < 4; ++eb)
#pragma unroll
            for (int r = 0; r < 16; ++r) { const float o = O[0][eb][r] * i0 - O[1][eb][r] * i1; O[0][eb][r] = o; ss += o * o; }
        ss += __shfl_xor(ss, 32);
        const float rs = __builtin_amdgcn_rsqf(ss * (1.0f / 128.0f) + EPS) * omli;
        bf16* rowp = SGD + (tb + q0 + 32 * rg + r32e) * 1024 + h * 128 + 4 * hi;
        const float* gp = gsub + h * 128 + 4 * hi;
#pragma unroll
        for (int eb = 0; eb < 4; ++eb) {
            unsigned long long gt[4];
#pragma unroll
            for (int g = 0; g < 4; ++g) gt[g] = *(const unsigned long long*)(rowp + 32 * eb + 8 * g);
#pragma unroll
            for (int g = 0; g < 4; ++g) { const f32x4 gg = *(const f32x4*)(gp + 32 * eb + 8 * g); const unsigned glo = (unsigned)gt[g], ghi = (unsigned)(gt[g] >> 32);
                const unsigned w0 = cvt_pk_bf16(O[0][eb][4 * g] * rs * gg[0] * lo_bf(glo), O[0][eb][4 * g + 1] * rs * gg[1] * hi_bf(glo));
                const unsigned w1 = cvt_pk_bf16(O[0][eb][4 * g + 2] * rs * gg[2] * lo_bf(ghi), O[0][eb][4 * g + 3] * rs * gg[3] * hi_bf(ghi));
                *(unsigned long long*)(rowp + 32 * eb + 8 * g) = (unsigned long long)w0 | ((unsigned long long)w1 << 32); }
            asm volatile("" ::: "memory");
        }
    }
    asm volatile("s_waitcnt lgkmcnt(0)" ::: "memory");
    __syncthreads();
#undef ATT_STAGE
}
}

namespace ret {
using att::f32x16; using att::s16x4; using att::crow; using att::vtr;
constexpr int SET = 49152, KT = 0, VI = 16384, OST = 98304, ST = 131072, RED = 147456;
__device__ __forceinline__ void ret_unit(LAS unsigned char* lds, const unsigned char* ws, const int b, const int h, const float* __restrict__ gn, const int c0, const int c1) {
    int tid_ = threadIdx.x; asm volatile("" : "+v"(tid_));
    const int tid = tid_, lane = tid & 63, r32 = lane & 31, hi = lane >> 5, w = __builtin_amdgcn_readfirstlane(tid >> 6);
    const int ib = w & 3, eh = w >> 2, dh = w & 1, ebo = w >> 1;
    const bf16* QR = (const bf16*)(ws + WS_QR); const bf16* KR = (const bf16*)(ws + WS_KR); const bf16* VR = (const bf16*)(ws + WS_VR); bf16* SGR = (bf16*)(ws + WS_SGR);
    const size_t tb = (size_t)b * SEQ;
    const float lg = __log2f(1.0f - __builtin_amdgcn_exp2f(-5.0f - (float)h)), gC = __builtin_amdgcn_exp2f(128.0f * lg);
    for (int i = tid; i < 16384 / 16; i += 512) *(LAS u32x4*)(lds + ST + i * 16) = (u32x4){0u, 0u, 0u, 0u};
    f32x16 sblk;
#pragma unroll
    for (int r = 0; r < 16; ++r) sblk[r] = 0.f;
    const int vpat = ((lane >> 4) & 1) * 32 + (lane & 3) * 8 + (4 * hi + ((lane & 15) >> 2)) * 64;
    const int prow = tid >> 4, pcol = (tid & 15) * 8;
    f32x4 gA = *(const f32x4*)(gn + h * 128 + pcol), gB = *(const f32x4*)(gn + h * 128 + pcol + 4);
#define RET_STAGE(c, s) do { const size_t t0_ = tb + (size_t)(c) * 128; LAS unsigned char* sb_ = lds + (s) * SET; \
        _Pragma("unroll") for (int k = 0; k < 2; ++k) { const int p = 2 * w + k, d2 = p >> 3, kg = p & 7; \
            __builtin_amdgcn_global_load_lds((const unsigned*)(KR + (t0_ + 16 * kg + (lane >> 2)) * 512 + h * 64 + d2 * 32 + (lane & 3) * 8), (LAS unsigned*)(sb_ + KT + p * 1024), 16, 0, 0); } \
        _Pragma("unroll") for (int k = 0; k < 4; ++k) { const int p = 4 * w + k, eg = p >> 3, kg = p & 7; \
            __builtin_amdgcn_global_load_lds((const unsigned*)(VR + (t0_ + 16 * kg + (lane >> 2)) * 1024 + h * 128 + eg * 32 + (lane & 3) * 8), (LAS unsigned*)(sb_ + VI + p * 1024), 16, 0, 0); } } while (0)
    if (c0 > 0) {
        RET_STAGE(0, 0);
        for (int c = 0; c < c0; ++c) {
            __syncthreads();
            if (c + 1 < c0) RET_STAGE(c + 1, (c + 1) & 1);
            LAS const unsigned char* sb = lds + (c & 1) * SET;
            f32x16 kv;
#pragma unroll
            for (int r = 0; r < 16; ++r) kv[r] = 0.f;
#pragma unroll
            for (int ks = 0; ks < 8; ++ks) { LAS const unsigned char* kp = sb + KT + dh * 8192 + ks * 1024 + vpat; LAS const unsigned char* vp = sb + VI + ebo * 8192 + ks * 1024 + vpat;
                const s16x4 klo = vtr(kp), khi = vtr(kp + 512), vlo = vtr(vp), vhi = vtr(vp + 512);
                kv = ATT_MFMA(((bf16x8){klo[0], klo[1], klo[2], klo[3], khi[0], khi[1], khi[2], khi[3]}), ((bf16x8){vlo[0], vlo[1], vlo[2], vlo[3], vhi[0], vhi[1], vhi[2], vhi[3]}), kv); }
#pragma unroll
            for (int r = 0; r < 16; ++r) sblk[r] = gC * (sblk[r] + kv[r]);
        }
        __syncthreads();
#pragma unroll
        for (int g = 0; g < 4; ++g) { unsigned long long v = (unsigned long long)cvt_pk_bf16(sblk[4 * g], sblk[4 * g + 1]) | ((unsigned long long)cvt_pk_bf16(sblk[4 * g + 2], sblk[4 * g + 3]) << 32);
            *(LAS unsigned long long*)(lds + ST + (32 * ebo + r32) * 128 + (32 * dh + 8 * g + 4 * hi) * 2) = v; }
    }
    RET_STAGE(c0, c0 & 1);
    bf16x8 qn[4];
#pragma unroll
    for (int d0 = 0; d0 < 4; ++d0) qn[d0] = *(const bf16x8*)(QR + (tb + (size_t)c0 * 128 + 32 * ib + r32) * 512 + h * 64 + d0 * 16 + hi * 8);
    for (int c = c0; c < c1; ++c) {
        const size_t t0 = tb + (size_t)c * 128;
        __syncthreads();
        LAS const unsigned char* sb = lds + (c & 1) * SET;
        u32x4 gt[4];
#pragma unroll
        for (int k = 0; k < 4; ++k) gt[k] = *(const u32x4*)(SGR + (t0 + prow + 32 * k) * 1024 + h * 128 + pcol);
        bf16x8 qf[4];
#pragma unroll
        for (int d0 = 0; d0 < 4; ++d0) qf[d0] = qn[d0];
        if (c + 1 < c1) { RET_STAGE(c + 1, (c + 1) & 1);
#pragma unroll
            for (int d0 = 0; d0 < 4; ++d0) qn[d0] = *(const bf16x8*)(QR + (t0 + 128 + 32 * ib + r32) * 512 + h * 64 + d0 * 16 + hi * 8); }
        f32x16 O[2];
#pragma unroll
        for (int eb = 0; eb < 2; ++eb)
#pragma unroll
            for (int r = 0; r < 16; ++r) O[eb][r] = 0.f;
#pragma unroll
        for (int jb = 0; jb < 4; ++jb) {
            if (jb <= ib) {
                f32x16 s;
#pragma unroll
                for (int r = 0; r < 16; ++r) s[r] = 0.f;
#pragma unroll
                for (int d0 = 0; d0 < 4; ++d0) { const bf16x8 kf = *(LAS const bf16x8*)(sb + KT + (d0 >> 1) * 8192 + (32 * jb + r32) * 64 + ((d0 & 1) * 16 + 8 * hi) * 2); s = ATT_MFMA(kf, qf[d0], s); }
                if (jb == ib) {
#pragma unroll
                    for (int r = 0; r < 16; ++r) if (crow(r, hi) > r32) s[r] = 0.f;
                }
                u32x4 pw[2];
#pragma unroll
                for (int i = 0; i < 4; ++i) { pw[0][i] = cvt_pk_bf16(s[2 * i], s[2 * i + 1]); pw[1][i] = cvt_pk_bf16(s[8 + 2 * i], s[9 + 2 * i]); }
#pragma unroll
                for (int eb = 0; eb < 2; ++eb)
#pragma unroll
                    for (int ks = 0; ks < 2; ++ks) { LAS const unsigned char* vp = sb + VI + (2 * eh + eb) * 8192 + (2 * jb + ks) * 1024 + vpat;
                        const s16x4 vlo = vtr(vp), vhi = vtr(vp + 512);
                        O[eb] = ATT_MFMA(((bf16x8){vlo[0], vlo[1], vlo[2], vlo[3], vhi[0], vhi[1], vhi[2], vhi[3]}), __builtin_bit_cast(bf16x8, pw[ks]), O[eb]); }
            }
        }
#pragma unroll
        for (int eb = 0; eb < 2; ++eb)
#pragma unroll
            for (int d0 = 0; d0 < 4; ++d0) { const bf16x8 sf = *(LAS const bf16x8*)(lds + ST + (32 * (2 * eh + eb) + r32) * 128 + (16 * d0 + 8 * hi) * 2); O[eb] = ATT_MFMA(sf, qf[d0], O[eb]); }
        { f32x16 kv;
#pragma unroll
          for (int r = 0; r < 16; ++r) kv[r] = 0.f;
#pragma unroll
          for (int ks = 0; ks < 8; ++ks) { LAS const unsigned char* kp = sb + KT + dh * 8192 + ks * 1024 + vpat; LAS const unsigned char* vp = sb + VI + ebo * 8192 + ks * 1024 + vpat;
              const s16x4 klo = vtr(kp), khi = vtr(kp + 512), vlo = vtr(vp), vhi = vtr(vp + 512);
              kv = ATT_MFMA(((bf16x8){klo[0], klo[1], klo[2], klo[3], khi[0], khi[1], khi[2], khi[3]}), ((bf16x8){vlo[0], vlo[1], vlo[2], vlo[3], vhi[0], vhi[1], vhi[2], vhi[3]}), kv); }
#pragma unroll
          for (int r = 0; r < 16; ++r) sblk[r] = gC * (sblk[r] + kv[r]); }
        { float s2 = 0.f;
#pragma unroll
          for (int eb = 0; eb < 2; ++eb)
#pragma unroll
              for (int r = 0; r < 16; ++r) s2 += O[eb][r] * O[eb][r];
          s2 += __shfl_xor(s2, 32);
          if (hi == 0) ((LAS float*)(lds + RED))[(32 * ib + r32) * 2 + eh] = s2; }
#pragma unroll
        for (int eb = 0; eb < 2; ++eb)
#pragma unroll
            for (int g = 0; g < 4; ++g) *(LAS unsigned long long*)(lds + OST + (32 * ib + r32) * 256 + (64 * eh + 32 * eb + 8 * g + 4 * hi) * 2) =
                (unsigned long long)cvt_pk_bf16(O[eb][4 * g], O[eb][4 * g + 1]) | ((unsigned long long)cvt_pk_bf16(O[eb][4 * g + 2], O[eb][4 * g + 3]) << 32);
        asm volatile("s_waitcnt lgkmcnt(0)" ::: "memory"); __builtin_amdgcn_s_barrier(); asm volatile("" ::: "memory");
#pragma unroll
        for (int g = 0; g < 4; ++g) { unsigned long long v = (unsigned long long)cvt_pk_bf16(sblk[4 * g], sblk[4 * g + 1]) | ((unsigned long long)cvt_pk_bf16(sblk[4 * g + 2], sblk[4 * g + 3]) << 32);
            *(LAS unsigned long long*)(lds + ST + (32 * ebo + r32) * 128 + (32 * dh + 8 * g + 4 * hi) * 2) = v; }
#pragma unroll
        for (int k = 0; k < 4; ++k) { const int row = prow + 32 * k; const LAS float* rp = (const LAS float*)(lds + RED) + row * 2;
            const float rs = __builtin_amdgcn_rsqf((rp[0] + rp[1]) * (1.0f / 128.0f) + EPS);
            const u32x4 ov = *(LAS const u32x4*)(lds + OST + row * 256 + pcol * 2); const u32x4 gg = gt[k];
            u32x4 res;
            res.x = cvt_pk_bf16(lo_bf(ov.x) * rs * gA[0] * lo_bf(gg.x), hi_bf(ov.x) * rs * gA[1] * hi_bf(gg.x));
            res.y = cvt_pk_bf16(lo_bf(ov.y) * rs * gA[2] * lo_bf(gg.y), hi_bf(ov.y) * rs * gA[3] * hi_bf(gg.y));
            res.z = cvt_pk_bf16(lo_bf(ov.z) * rs * gB[0] * lo_bf(gg.z), hi_bf(ov.z) * rs * gB[1] * hi_bf(gg.z));
            res.w = cvt_pk_bf16(lo_bf(ov.w) * rs * gB[2] * lo_bf(gg.w), hi_bf(ov.w) * rs * gB[3] * hi_bf(gg.w));
            *(u32x4*)(SGR + (t0 + row) * 1024 + h * 128 + pcol) = res; }
    }
    __syncthreads();
#undef RET_STAGE
}
}

__device__ const unsigned short att_order[1024] = {223, 255, 479, 511, 735, 767, 991, 1023, 222, 254, 478, 510, 734, 766, 990, 1022, 221, 253, 477, 509, 733, 765, 989, 1021, 220, 252, 476, 508, 732, 764, 988, 1020, 219, 251, 475, 507, 731, 763, 987, 1019, 218, 250, 474, 506, 730, 762, 986, 1018, 217, 249, 473, 505, 729, 761, 985, 1017, 216, 248, 472, 504, 728, 760, 984, 1016, 215, 247, 471, 503, 727, 759, 983, 1015, 214, 246, 470, 502, 726, 758, 982, 1014, 213, 245, 469, 501, 725, 757, 981, 1013, 212, 244, 468, 500, 724, 756, 980, 1012, 179, 180, 181, 182, 183, 184, 185, 186, 187, 188, 189, 190, 191, 211, 243, 435, 436, 437, 438, 439, 440, 441, 442, 443, 444, 445, 446, 447, 467, 499, 691, 692, 693, 694, 695, 696, 697, 698, 699, 700, 701, 702, 703, 723, 755, 947, 948, 949, 950, 951, 952, 953, 954, 955, 956, 957, 958, 959, 979, 1011, 178, 210, 242, 434, 466, 498, 690, 722, 754, 946, 978, 1010, 177, 209, 241, 433, 465, 497, 689, 721, 753, 945, 977, 1009, 176, 208, 240, 432, 464, 496, 688, 720, 752, 944, 976, 1008, 175, 207, 239, 431, 463, 495, 687, 719, 751, 943, 975, 1007, 174, 206, 238, 430, 462, 494, 686, 718, 750, 942, 974, 1006, 173, 205, 237, 429, 461, 493, 685, 717, 749, 941, 973, 1005, 172, 204, 236, 428, 460, 492, 684, 716, 748, 940, 972, 1004, 171, 203, 235, 427, 459, 491, 683, 715, 747, 939, 971, 1003, 170, 202, 234, 426, 458, 490, 682, 714, 746, 938, 970, 1002, 138, 139, 140, 141, 142, 143, 144, 145, 146, 147, 148, 149, 150, 151, 152, 153, 154, 155, 156, 157, 158, 159, 394, 395, 396, 397, 398, 399, 400, 401, 402, 403, 404, 405, 406, 407, 408, 409, 410, 411, 412, 413, 414, 415, 650, 651, 652, 653, 654, 655, 656, 657, 658, 659, 660, 661, 662, 663, 664, 665, 666, 667, 668, 669, 670, 671, 906, 907, 908, 909, 910, 911, 912, 913, 914, 915, 916, 917, 918, 919, 920, 921, 922, 923, 924, 925, 926, 927, 137, 169, 201, 233, 393, 425, 457, 489, 649, 681, 713, 745, 905, 937, 969, 1001, 136, 168, 200, 232, 392, 424, 456, 488, 648, 680, 712, 744, 904, 936, 968, 1000, 135, 167, 199, 231, 391, 423, 455, 487, 647, 679, 711, 743, 903, 935, 967, 999, 134, 166, 198, 230, 390, 422, 454, 486, 646, 678, 710, 742, 902, 934, 966, 998, 101, 102, 103, 104, 105, 106, 107, 108, 109, 110, 111, 112, 113, 114, 115, 116, 117, 118, 119, 120, 121, 122, 123, 124, 125, 126, 127, 133, 165, 197, 229, 357, 358, 359, 360, 361, 362, 363, 364, 365, 366, 367, 368, 369, 370, 371, 372, 373, 374, 375, 376, 377, 378, 379, 380, 381, 382, 383, 389, 421, 453, 485, 613, 614, 615, 616, 617, 618, 619, 620, 621, 622, 623, 624, 625, 626, 627, 628, 629, 630, 631, 632, 633, 634, 635, 636, 637, 638, 639, 645, 677, 709, 741, 869, 870, 871, 872, 873, 874, 875, 876, 877, 878, 879, 880, 881, 882, 883, 884, 885, 886, 887, 888, 889, 890, 891, 892, 893, 894, 895, 901, 933, 965, 997, 100, 132, 164, 196, 228, 356, 388, 420, 452, 484, 612, 644, 676, 708, 740, 868, 900, 932, 964, 996, 99, 131, 163, 195, 227, 355, 387, 419, 451, 483, 611, 643, 675, 707, 739, 867, 899, 931, 963, 995, 67, 68, 69, 70, 71, 72, 73, 74, 75, 76, 77, 78, 79, 80, 81, 82, 83, 84, 85, 86, 87, 88, 89, 90, 91, 92, 93, 94, 95, 323, 324, 325, 326, 327, 328, 329, 330, 331, 332, 333, 334, 335, 336, 337, 338, 339, 340, 341, 342, 343, 344, 345, 346, 347, 348, 349, 350, 351, 579, 580, 581, 582, 583, 584, 585, 586, 587, 588, 589, 590, 591, 592, 593, 594, 595, 596, 597, 598, 599, 600, 601, 602, 603, 604, 605, 606, 607, 835, 836, 837, 838, 839, 840, 841, 842, 843, 844, 845, 846, 847, 848, 849, 850, 851, 852, 853, 854, 855, 856, 857, 858, 859, 860, 861, 862, 863, 66, 98, 130, 162, 194, 226, 322, 354, 386, 418, 450, 482, 578, 610, 642, 674, 706, 738, 834, 866, 898, 930, 962, 994, 34, 35, 36, 37, 38, 39, 40, 41, 42, 43, 44, 45, 46, 47, 48, 49, 50, 51, 52, 53, 54, 55, 56, 57, 58, 59, 60, 61, 62, 63, 290, 291, 292, 293, 294, 295, 296, 297, 298, 299, 300, 301, 302, 303, 304, 305, 306, 307, 308, 309, 310, 311, 312, 313, 314, 315, 316, 317, 318, 319, 546, 547, 548, 549, 550, 551, 552, 553, 554, 555, 556, 557, 558, 559, 560, 561, 562, 563, 564, 565, 566, 567, 568, 569, 570, 571, 572, 573, 574, 575, 802, 803, 804, 805, 806, 807, 808, 809, 810, 811, 812, 813, 814, 815, 816, 817, 818, 819, 820, 821, 822, 823, 824, 825, 826, 827, 828, 829, 830, 831, 1, 2, 3, 4, 5, 6, 7, 8, 9, 10, 11, 12, 13, 14, 15, 16, 17, 18, 19, 20, 21, 22, 23, 24, 25, 26, 27, 28, 29, 30, 31, 33, 65, 97, 129, 161, 193, 225, 257, 258, 259, 260, 261, 262, 263, 264, 265, 266, 267, 268, 269, 270, 271, 272, 273, 274, 275, 276, 277, 278, 279, 280, 281, 282, 283, 284, 285, 286, 287, 289, 321, 353, 385, 417, 449, 481, 513, 514, 515, 516, 517, 518, 519, 520, 521, 522, 523, 524, 525, 526, 527, 528, 529, 530, 531, 532, 533, 534, 535, 536, 537, 538, 539, 540, 541, 542, 543, 545, 577, 609, 641, 673, 705, 737, 769, 770, 771, 772, 773, 774, 775, 776, 777, 778, 779, 780, 781, 782, 783, 784, 785, 786, 787, 788, 789, 790, 791, 792, 793, 794, 795, 796, 797, 798, 799, 801, 833, 865, 897, 929, 961, 993, 0, 32, 64, 96, 128, 160, 192, 224, 256, 288, 320, 352, 384, 416, 448, 480, 512, 544, 576, 608, 640, 672, 704, 736, 768, 800, 832, 864, 896, 928, 960, 992};
constexpr int CW_QUEUE = 2048;

#define XB_TMO      128
#define XB_XCNT(j)  (256  + 64 * (j))
#define XB_XSUB(j)  (1280 + 64 * (j))
#define XB_XGEN(j)  (2304 + 64 * (j))
#define XB_TOP      3328
#define XB_TOPGEN   3392
#define XCD_BAR_WORDS 3456
#define XB_SPIN_CAP (1u << 18)
__device__ __forceinline__ unsigned xb_ld(unsigned* p)              { return __hip_atomic_load(p, __ATOMIC_RELAXED, __HIP_MEMORY_SCOPE_AGENT); }
__device__ __forceinline__ unsigned xb_add(unsigned* p, unsigned v) { return __hip_atomic_fetch_add(p, v, __ATOMIC_RELAXED, __HIP_MEMORY_SCOPE_AGENT); }
__device__ __forceinline__ unsigned xb_xcc_id() { return (unsigned)__builtin_amdgcn_s_getreg((3 << 11) | 20) & 0xFu; }
#define XB_SPIN(cond, bar) do { unsigned _sp = 0; while (cond) { __builtin_amdgcn_s_sleep(1); \
    if ((++_sp & 255u) == 0u) { if (xb_ld(&(bar)[XB_TMO])) break; if (_sp > XB_SPIN_CAP) { atomicAdd(&(bar)[XB_TMO], 1u); break; } } } } while (0)
struct XcdBarrier { unsigned* bar; unsigned x; volatile LAS unsigned* st; };
__device__ __forceinline__ XcdBarrier xcd_barrier_post(unsigned* bar, volatile LAS unsigned* st) {
    XcdBarrier b; b.bar = bar; b.x = xb_xcc_id(); b.st = st;
    if (threadIdx.x == 0) (void)xb_add(&bar[XB_XCNT(b.x)], 1u);
    return b;
}
__device__ __forceinline__ void xcd_barrier_complete(unsigned* bar, unsigned x, unsigned& nloc, unsigned& nx) {
    const unsigned G = gridDim.x * gridDim.y * gridDim.z;
    unsigned sum, cnt, mine, sp = 0u;
    for (;;) {
        sum = 0u; cnt = 0u; mine = 0u;
#pragma unroll
        for (unsigned j = 0; j < 16; ++j) { const unsigned c = xb_ld(&bar[XB_XCNT(j)]); sum += c; cnt += (c > 0u) ? 1u : 0u; mine = (j == x) ? c : mine; }
        if (sum == G) break;
        __builtin_amdgcn_s_sleep(1);
        if ((++sp & 255u) == 0u) { if (xb_ld(&bar[XB_TMO])) break; if (sp > XB_SPIN_CAP) { atomicAdd(&bar[XB_TMO], 1u); break; } }
    }
    nloc = mine > 0u ? mine : 1u; nx = cnt > 0u ? cnt : 1u;
}
__device__ __forceinline__ void xcd_barrier(const XcdBarrier& b) {
    asm volatile("s_waitcnt vmcnt(0)" ::: "memory");
    __syncthreads();
    if (threadIdx.x == 0) {
        unsigned* bar = b.bar;
        __builtin_amdgcn_s_waitcnt(0);
        unsigned nloc = b.st[0], nx = b.st[1];
        if (nloc == 0u) { xcd_barrier_complete(bar, b.x, nloc, nx); b.st[0] = nloc; b.st[1] = nx; }
        const unsigned old = xb_add(&bar[XB_XSUB(b.x)], 1u);
        const unsigned gen = old / nloc;
        if (old + 1u == (gen + 1u) * nloc) {
            __builtin_amdgcn_fence(__ATOMIC_RELEASE, "agent");
            asm volatile("s_waitcnt vmcnt(0)" ::: "memory");
            const unsigned og = xb_add(&bar[XB_TOP], 1u);
            const unsigned tg = og / nx;
            if (og + 1u == (tg + 1u) * nx) xb_add(&bar[XB_TOPGEN], 1u);
            else XB_SPIN(xb_ld(&bar[XB_TOPGEN]) == tg, bar);
            __builtin_amdgcn_fence(__ATOMIC_ACQUIRE, "agent");
            xb_add(&bar[XB_XGEN(b.x)], 1u);
            asm volatile("s_waitcnt vmcnt(0)" ::: "memory");
        } else {
            XB_SPIN(xb_ld(&bar[XB_XGEN(b.x)]) == gen, bar);
            __builtin_amdgcn_fence(__ATOMIC_ACQUIRE, "agent");
            asm volatile("s_waitcnt vmcnt(0)" ::: "memory");
        }
    }
    __syncthreads();
}

#define LDS_WAIT() asm volatile("s_waitcnt lgkmcnt(0)" ::: "memory")
__device__ __forceinline__ float wave_sum(float v) {
#pragma unroll
    for (int o = 1; o < 64; o <<= 1) v += __shfl_xor(v, o);
    return v;
}
__device__ __forceinline__ void p0_transpose_item(const float* W, int K, int N, bf16* WT, LAS float* scr, int item, int lane) {
    const int nblk = N / 32, kb = item / nblk, nb = item % nblk, k0 = 64 * kb, n0 = 32 * nb;
#pragma unroll 8
    for (int i = 0; i < 32; ++i) { const int kk = 2 * i + (lane >> 5); scr[kk * 33 + (lane & 31)] = W[(size_t)(k0 + kk) * N + n0 + (lane & 31)]; }
    LDS_WAIT(); asm volatile("" ::: "memory");
    const int c = lane & 7;
#pragma unroll
    for (int j = 0; j < 4; ++j) { const int n = (lane >> 3) + 8 * j; const LAS float* s = scr + (8 * c) * 33 + n;
        u32x4 o; o.x = pk2(s[0 * 33], s[1 * 33]); o.y = pk2(s[2 * 33], s[3 * 33]); o.z = pk2(s[4 * 33], s[5 * 33]); o.w = pk2(s[6 * 33], s[7 * 33]);
        *(GAS u32x4*)(WT + (size_t)(n0 + n) * K + k0 + 8 * c) = o; }
    LDS_WAIT(); asm volatile("" ::: "memory");
}
__device__ __forceinline__ void rms_row_to_bf16(const float* xrow, const float* g, bf16* orow, int lane) {
    const GAS f32x4* xr = (const GAS f32x4*)xrow + lane; const GAS f32x4* gr = (const GAS f32x4*)g + lane;
    f32x4 v[4]; float s = 0.f;
#pragma unroll
    for (int j = 0; j < 4; ++j) { v[j] = xr[64 * j]; s += (v[j].x * v[j].x + v[j].y * v[j].y) + (v[j].z * v[j].z + v[j].w * v[j].w); }
    const float rs = 1.0f / sqrtf(wave_sum(s) * (1.f / DM) + EPS);
    GAS unsigned long long* o8 = (GAS unsigned long long*)orow + lane;
#pragma unroll
    for (int j = 0; j < 4; ++j) { const f32x4 gg = gr[64 * j];
        o8[64 * j] = (unsigned long long)pk2(v[j].x * rs * gg.x, v[j].y * rs * gg.y) | ((unsigned long long)pk2(v[j].z * rs * gg.z, v[j].w * rs * gg.w) << 32); }
}

__device__ __forceinline__ const float* in_ptr(int k) {
    typedef __attribute__((address_space(4))) const char* cptr4;
    cptr4 ka = (cptr4)__builtin_amdgcn_kernarg_segment_ptr(); cptr4 kb;
    asm volatile("s_mov_b64 %0, %1" : "=s"(kb) : "s"(ka));
    typedef const float* cfp; typedef __attribute__((address_space(4))) const cfp* cfp4;
    return *(cfp4)(kb + k * 8);
}
constexpr int NWAVES = 8;
constexpr int RING_BYTES = 131072, LDS_BYTES = 163840, LDSCTL_OFF = LDS_BYTES - 1024, MISC_OFF = LDSCTL_OFF + 320;
struct Args { const float* in[14]; float* out; unsigned char* ws; int ph_lo, ph_hi, li, pad; };
constexpr int N_PHASES = 10;

__global__ void __launch_bounds__(NWAVES * 64, 2) mk_fwd(Args args) {
    extern __shared__ __attribute__((aligned(16))) unsigned char lds_raw[];
    LAS unsigned char* lds = (LAS unsigned char*)lds_raw;
    volatile LAS unsigned* MISC = (volatile LAS unsigned*)(lds + MISC_OFF);
    const int tid = threadIdx.x, lane_k = tid & 63, wave = __builtin_amdgcn_readfirstlane(tid >> 6);
    const int G = gridDim.x, bx = blockIdx.x; const int vcu = (G % 8 == 0) ? (bx % 8) * (G / 8) + bx / 8 : bx;
    unsigned char* const ws_k = (unsigned char*)in_ptr(15);
    unsigned* ctl = (unsigned*)(ws_k + WS_CTL);
    for (int u = tid; u < (LDS_BYTES - LDSCTL_OFF) / 4; u += NWAVES * 64) ((LAS unsigned*)(lds + LDSCTL_OFF))[u] = 0u;
    __syncthreads();
    const int lo = args.ph_lo, hi = args.ph_hi;
    XcdBarrier bar; bar.bar = ctl + CW_BAR + args.li * XCD_BAR_WORDS; bar.x = 0; bar.st = nullptr;
    if (hi - lo > 1) bar = xcd_barrier_post(ctl + CW_BAR + args.li * XCD_BAR_WORDS, MISC + 8);
#define IN(k) (lo <= (k) && (k) < hi)
#define SEAM(k) do { if (IN(k) && IN((k) + 1)) xcd_barrier(bar); } while (0)

    if (IN(0)) {
        unsigned char* const ws = ws_k; int lane = lane_k; asm volatile("" : "+v"(lane));
        bf16* Wt_in = (bf16*)(ws + WS_WIN); bf16* H = (bf16*)(ws + WS_H);
        LAS float* scr = (LAS float*)(lds + wave * 16384);
        const int gw = vcu * NWAVES + wave, NGW = G * NWAVES;
        constexpr int I_IN = (DM / 64) * (NIN / 32), I_SQ = (DM / 64) * (DM / 32);
        for (int it = gw; it < I_IN + 6 * I_SQ; it += NGW) {
            int r = it;
            if (r < I_IN) { p0_transpose_item(in_ptr(2), DM, NIN, Wt_in, scr, r, lane); continue; } r -= I_IN;
            const int which = r / I_SQ, item = r % I_SQ, l = which / 3, w = which % 3;
            const float* src = (w == 0 ? in_ptr(4) : w == 1 ? in_ptr(12) : in_ptr(13)) + (size_t)l * DM * DM;
            bf16* dst = (bf16*)(ws + (l == 0 ? WS_WRO : WS_W1) + (size_t)w * 2 * MiB);
            p0_transpose_item(src, DM, DM, dst, scr, item, lane);
        }
        const float* x0 = in_ptr(0); const float* g0 = in_ptr(1);
        for (int m = gw; m < T; m += NGW) rms_row_to_bf16(x0 + (size_t)m * DM, g0, H + (size_t)m * DM, lane);
        LDS_WAIT(); __syncthreads();
    }
    SEAM(0);

#pragma unroll 1
    for (int l = 0; l < DEPTH; ++l) {
        const int pb = 1 + 5 * l;
        if (IN(pb)) {
            unsigned char* const ws = ws_k;
            Epi<0> E; E.ws = ws; E.xin = nullptr; E.xout = nullptr; E.gq = in_ptr(5) + l * 64; E.gk = in_ptr(6) + l * 64;
            SchedG1A S{(const char*)(ws + WS_H), (const char*)(ws + WS_WIN), G, bx};
            pg8::gemm_phase<Epi<0>, SchedG1A, true, true>(lds, DM, S, E);
        }
        SEAM(pb);
        if (IN(pb + 1)) {
            unsigned char* const ws = ws_k;
            float s1 = 0.f, s2 = 0.f; { const float* q1 = in_ptr(7) + l * 64; const float* k1 = in_ptr(8) + l * 64; const float* q2 = in_ptr(9) + l * 64; const float* k2 = in_ptr(10) + l * 64;
                for (int i = 0; i < 64; ++i) { s1 += q1[i] * k1[i]; s2 += q2[i] * k2[i]; } }
            const float lam_init = 0.8f - 0.6f * __expf(-0.3f * (float)l), lam = __expf(s1) - __expf(s2) + lam_init;
            const float* gsub = in_ptr(11) + l * 1024;
            float gqm = 0.f, gkm = 0.f; { const float* gq = in_ptr(5) + l * 64; const float* gk = in_ptr(6) + l * 64; for (int i = 0; i < 64; ++i) { gqm = fmaxf(gqm, fabsf(gq[i])); gkm = fmaxf(gkm, fabsf(gk[i])); } }
            const float Bnd = 1.02f * 8.0f * LOG2E * gqm * gkm;
            const float* gret = in_ptr(3) + l * 1024;
            unsigned* qhead = ctl + CW_QUEUE + 64 * l;
            for (;;) {
                if (tid == 0) MISC[16] = __hip_atomic_fetch_add(qhead, 1u, __ATOMIC_RELAXED, __HIP_MEMORY_SCOPE_AGENT);
                __syncthreads();
                const int item = (int)MISC[16];
                __syncthreads();
                if (item >= 128 + 1024) break;
                if (item < 128) { const int qt = 3 - (item >> 5), bh2 = item & 31; ret::ret_unit(lds, ws, bh2 >> 3, bh2 & 7, gret, 8 * qt, 8 * qt + 8); }
                else { const int u = att_order[item - 128], bh = u >> 5, hh = bh & 7;
                    const float wf = (2.0f * Bnd + 28.0f) / (__builtin_amdgcn_exp2f(-(float)(hh + 1)) * LOG2E);
                    att::attn_unit(lds, ws, bh >> 3, hh, u & 31, lam, 1.0f - lam_init, gsub, wf < 8192.f ? (int)wf + 1 : 8192); }
            }
        }
        SEAM(pb + 1);
        if (IN(pb + 2)) {
            unsigned char* const ws = ws_k;
            Epi<1> E; E.ws = ws; E.xin = nullptr; E.xout = nullptr; E.gq = nullptr; E.gk = nullptr;
            SchedP34 S{(const char*)ws, (const char*)(ws + (l == 0 ? WS_WRO : WS_W1)), bx};
            pg8::gemm_phase<Epi<1>, SchedP34, true, true>(lds, DM, S, E);
        }
        SEAM(pb + 2);
        if (IN(pb + 3)) {
            unsigned char* const ws = ws_k;
            Epi<2> E; E.ws = ws; E.xin = (l == 0) ? in_ptr(0) : (const float*)in_ptr(14); E.xout = (float*)in_ptr(14); E.gq = nullptr; E.gk = nullptr;
            SchedG4 S{(const char*)(ws + WS_MBF), (const char*)(ws + (l == 0 ? WS_WRO : WS_W1) + 4 * MiB), bx};
            pg8::gemm_phase<Epi<2>, SchedG4, false, true>(lds, DM, S, E);
        }
        SEAM(pb + 3);
        if (l == 0) {
            if (IN(5)) {
                unsigned char* const ws = ws_k; int lane = lane_k; asm volatile("" : "+v"(lane));
                bf16* Wt_in = (bf16*)(ws + WS_WIN); bf16* H = (bf16*)(ws + WS_H);
                LAS float* scr = (LAS float*)(lds + wave * 16384);
                const int gw = vcu * NWAVES + wave, NGW = G * NWAVES;
                constexpr int I_IN = (DM / 64) * (NIN / 32);
                const float* w1 = in_ptr(2) + (size_t)DM * NIN;
                for (int it = gw; it < I_IN; it += NGW) p0_transpose_item(w1, DM, NIN, Wt_in, scr, it, lane);
                const float* x1 = in_ptr(14); const float* g1 = in_ptr(1) + DM;
                for (int m = gw; m < T; m += NGW) rms_row_to_bf16(x1 + (size_t)m * DM, g1, H + (size_t)m * DM, lane);
                LDS_WAIT(); __syncthreads();
            }
            SEAM(5);
        }
    }
#undef IN
#undef SEAM
}

extern "C" void kernel_launch(void* const* d_in, const int* in_sizes, int n_in, void* d_out, int out_size, void* d_ws, size_t ws_size, hipStream_t stream) {
    static int ready = 0;
    if (ready == 0) {
        if (n_in != 14 || ws_size < WS_END || out_size != T * DM) { fprintf(stderr, "kernel_launch: unexpected problem (n_in %d, ws %zu, out %d)\n", n_in, ws_size, out_size); ready = -1; return; }
        if (hipFuncSetAttribute((const void*)mk_fwd, hipFuncAttributeMaxDynamicSharedMemorySize, LDS_BYTES) != hipSuccess) { fprintf(stderr, "kernel_launch: hipFuncSetAttribute failed\n"); ready = -1; return; }
        ready = 1;
    }
    if (ready < 0) return;
    (void)hipMemsetAsync((char*)d_ws + WS_CTL, 0, CTL_ZERO_BYTES, stream);
    Args a{};
    for (int i = 0; i < 14; ++i) a.in[i] = (const float*)d_in[i];
    a.out = (float*)d_out; a.ws = (unsigned char*)d_ws;
    a.ph_lo = 0; a.ph_hi = N_PHASES; a.li = 0;
    hipLaunchKernelGGL(mk_fwd, dim3(256), dim3(NWAVES * 64), LDS_BYTES, stream, a);
}
```

```cpp
#include <hip/hip_runtime.h>
#include <cstdio>
#include <cstdint>
#include <cstddef>

constexpr int DM = 1024, BATCH = 4, SEQ = 4096, DEPTH = 2, T = BATCH * SEQ, NIN = 9216;
constexpr float EPS = 1e-6f;
constexpr float LOG2E = 1.4426950408889634f;

typedef unsigned short bf16;
typedef short bf16x8 __attribute__((ext_vector_type(8)));
typedef float f32x4 __attribute__((ext_vector_type(4)));
typedef unsigned u32x4 __attribute__((ext_vector_type(4)));
#define LAS __attribute__((address_space(3)))
#define GAS __attribute__((address_space(1)))

__device__ __forceinline__ float bf2f(bf16 v) { return __uint_as_float(((unsigned)v) << 16); }
__device__ __forceinline__ unsigned f2bf_u(float f) { unsigned u = __float_as_uint(f); return (u + 0x7fffu + ((u >> 16) & 1u)) >> 16; }
__device__ __forceinline__ bf16 f2bf(float f) { return (bf16)f2bf_u(f); }
__device__ __forceinline__ unsigned pk2(float lo, float hi) { return f2bf_u(lo) | (f2bf_u(hi) << 16); }
typedef float f32x2_t __attribute__((ext_vector_type(2))); typedef __bf16 bf16x2_t __attribute__((ext_vector_type(2)));
__device__ __forceinline__ unsigned cvt_pk_bf16(float lo, float hi) { f32x2_t v = {lo, hi}; bf16x2_t b = __builtin_convertvector(v, bf16x2_t); return __builtin_bit_cast(unsigned, b); }
__device__ __forceinline__ float fast_sigmoid(float v) { return __builtin_amdgcn_rcpf(1.0f + __builtin_amdgcn_exp2f(-v * LOG2E)); }
__device__ __forceinline__ float lo_bf(unsigned w) { return __uint_as_float(w << 16); }
__device__ __forceinline__ float hi_bf(unsigned w) { return __uint_as_float(w & 0xffff0000u); }

constexpr size_t MiB = 1u << 20;
constexpr size_t WS_CTL = 0, CTL_ZERO_BYTES = 64 * 1024;
constexpr size_t WS_WIN = 1 * MiB, WS_WRO = 19 * MiB, WS_WDO = 21 * MiB, WS_WOUT = 23 * MiB;
constexpr size_t WS_H = 25 * MiB, WS_QR = 57 * MiB, WS_KR = 73 * MiB, WS_VR = 89 * MiB, WS_SGR = 121 * MiB, WS_QD = 153 * MiB, WS_KD = 185 * MiB,
                 WS_VD = 217 * MiB, WS_SGD = 249 * MiB;
constexpr size_t WS_WIN0 = WS_H;
constexpr size_t WS_W1 = 281 * MiB;
constexpr size_t WS_END = 287 * MiB;
constexpr size_t WS_MBUF = 57 * MiB;
constexpr size_t WS_MBF = WS_VD;
constexpr size_t WS_SMGR = WS_QD, WS_SMGD = WS_KD;
constexpr int CW_BAR = 4096;

namespace pg8 {
constexpr int BM = 256, BK = 64, HALF = 128, HTB = HALF * BK * 2, STAGE_BYTES = 8 * HTB, NXCD = 8, WGM = 8;
__host__ __device__ __forceinline__ int lds_byte(int r, int c) { const int st = (r >> 4) * 2 + (c >> 5), rr = r & 15, cc = c & 31, ob = rr * 64 + cc * 2; return st * 1024 + (ob ^ (((ob >> 9) & 1) << 5)); }
__host__ __device__ __forceinline__ void stage_rc(int b, int& R, int& C) { const int st = b / 1024, sb = b % 1024, swz = sb ^ (((sb >> 9) & 1) << 5); R = (st >> 1) * 16 + swz / 64; C = (st & 1) * 32 + (swz % 64) / 2; }
__host__ __device__ __forceinline__ int perm32(int rho) { const int n = rho >> 4, i = rho & 15; return 8 * (i >> 2) + 4 * n + (i & 3); }

struct Unit { int pm, pn, kind; const char* a; const char* b; };

__device__ __forceinline__ void tile_of(int L, int nM, int nN, int& pm, int& pn) {
    const int nwg = nM * nN; int wgid = L;
    { const int q = nwg / NXCD, r = nwg % NXCD, xcd = wgid % NXCD, off = wgid / NXCD; wgid = (xcd < r ? xcd * (q + 1) : r * (q + 1) + (xcd - r) * q) + off; }
    const int nig = WGM * nN, gid = wgid / nig, fm = gid * WGM, gsz = (nM - fm) < WGM ? (nM - fm) : WGM;
    pm = fm + ((wgid % nig) % gsz); pn = (wgid % nig) / gsz;
}

template <class Epi, class Sched, bool ALIGN_EPI, bool SP2>
__device__ __forceinline__ void gemm_phase(LAS unsigned char* lds, const int K, const Sched& S, const Epi& E) {
    int tid_ = threadIdx.x; asm volatile("" : "+v"(tid_));
    const int tid = tid_, wid = __builtin_amdgcn_readfirstlane(tid >> 6), lane = tid & 63, wr = wid >> 2, wc = wid & 3, fr = lane & 15, fq = lane >> 4;
    const int nt = K / BK;
    unsigned voffA[2], voffB[2];
#pragma unroll
    for (int i = 0; i < 2; ++i) { int R, C; stage_rc(tid * 16 + i * 8192, R, C); const int Rb = (R >> 5) * 64 + perm32(R & 31);
        voffA[i] = (unsigned)(R * K + C) * 2u; voffB[i] = (unsigned)(Rb * K + C) * 2u; }
    const size_t kstep = (size_t)(BK * 2);
    const size_t hstep = (size_t)HALF * K * 2;
    const size_t hstepB = (size_t)32 * K * 2;
    const unsigned ldsw = (unsigned)wid * 1024u;
    const int aoff = lds_byte(wr * 64 + fr, fq * 8), boff = lds_byte(wc * 32 + fr, fq * 8);
#define PG8_SA(b, h) (((b) * 2 + (h)) * HTB)
#define PG8_SB(b, h) ((4 + (b) * 2 + (h)) * HTB)
#define PG8_STAGE(bufoff, gbase, voff) do { _Pragma("unroll") for (int _i = 0; _i < 2; ++_i) \
        __builtin_amdgcn_global_load_lds((const unsigned*)((const char*)(gbase) + (voff)[_i]), (LAS unsigned*)(lds + (bufoff) + ldsw + _i * 8192), 16, 0, 0); } while (0)
#define PG8_LDA(dst, b, h) do { _Pragma("unroll") for (int m = 0; m < 4; ++m) _Pragma("unroll") for (int k = 0; k < 2; ++k) dst[m][k] = *(const LAS bf16x8*)(lds + PG8_SA(b, h) + aoff + m * 2048 + k * 1024); } while (0)
#define PG8_LDB(dst, b, h) do { _Pragma("unroll") for (int n = 0; n < 2; ++n) _Pragma("unroll") for (int k = 0; k < 2; ++k) dst[n][k] = *(const LAS bf16x8*)(lds + PG8_SB(b, h) + boff + n * 2048 + k * 1024); } while (0)
#define PG8_MMA(ai, bj, At, Bt) do { __builtin_amdgcn_s_setprio(1); _Pragma("unroll") for (int m = 0; m < 4; ++m) _Pragma("unroll") for (int n = 0; n < 2; ++n) _Pragma("unroll") for (int k = 0; k < 2; ++k) \
        acc[ai][bj][m][n] = __builtin_amdgcn_mfma_f32_16x16x32_bf16(Bt[n][k], At[m][k], acc[ai][bj][m][n], 0, 0, 0); __builtin_amdgcn_s_setprio(0); } while (0)
#define PG8_WAIT_V(n) asm volatile("s_waitcnt vmcnt(" #n ")" ::: "memory")
#define PG8_WAIT_L(n) asm volatile("s_waitcnt lgkmcnt(" #n ")" ::: "memory")
#define PG8_BAR __builtin_amdgcn_s_barrier()
#define PG8_SCHED __builtin_amdgcn_sched_barrier(0)
    Unit cur, nxt; int ui = 0;
    if (!S.next(0, cur)) return;
    f32x4 acc[2][2][4][2];
#pragma unroll
    for (int a = 0; a < 2; ++a)
#pragma unroll
        for (int b = 0; b < 2; ++b)
#pragma unroll
            for (int m = 0; m < 4; ++m)
#pragma unroll
                for (int n = 0; n < 2; ++n) acc[a][b][m][n] = (f32x4){0.f, 0.f, 0.f, 0.f};
    bf16x8 At[4][2], B0[2][2], B1[2][2];
    const char* cA = cur.a; const char* cB = cur.b;
    if constexpr (SP2) {
        PG8_STAGE(PG8_SB(0, 0), cB, voffB); PG8_STAGE(PG8_SB(0, 1), cB + hstepB, voffB); PG8_STAGE(PG8_SA(0, 0), cA, voffA); PG8_STAGE(PG8_SA(0, 1), cA + hstep, voffA);
        if (wr == 1) PG8_BAR;
        PG8_WAIT_V(2); PG8_BAR;
        PG8_STAGE(PG8_SB(1, 0), cB + kstep, voffB); PG8_STAGE(PG8_SA(1, 0), cA + kstep, voffA); PG8_STAGE(PG8_SB(1, 1), cB + hstepB + kstep, voffB);
        PG8_WAIT_V(6); PG8_BAR;
    } else {
        PG8_STAGE(PG8_SB(0, 0), cB, voffB); PG8_STAGE(PG8_SA(0, 0), cA, voffA); PG8_STAGE(PG8_SB(0, 1), cB + hstepB, voffB); PG8_STAGE(PG8_SA(0, 1), cA + hstep, voffA);
        if (wr == 1) PG8_BAR;
        PG8_WAIT_V(4); PG8_BAR;
        PG8_STAGE(PG8_SB(1, 0), cB + kstep, voffB); PG8_STAGE(PG8_SA(1, 0), cA + kstep, voffA); PG8_STAGE(PG8_SB(1, 1), cB + hstepB + kstep, voffB);
        PG8_WAIT_V(6); PG8_BAR;
    }
    for (;;) {
        const bool has_next = S.next(ui + 1, nxt);
        const char* nA = has_next ? nxt.a : cA; const char* nB = has_next ? nxt.b : cB;
        for (int t = 0; t < nt; t += 2) {
            const bool last = (t == nt - 2);
            const char* a1 = cA + (size_t)(t + 1) * kstep;
            const char* a2 = last ? nA : cA + (size_t)(t + 2) * kstep; const char* b2 = last ? nB : cB + (size_t)(t + 2) * kstep;
            const char* a3 = a2 + kstep; const char* b3 = b2 + kstep;
            if constexpr (SP2) {
            PG8_LDB(B0, 0, 0); PG8_LDB(B1, 0, 1); PG8_SCHED; PG8_LDA(At, 0, 0); PG8_STAGE(PG8_SA(1, 1), a1 + hstep, voffA);
            PG8_WAIT_V(8); PG8_WAIT_L(0); PG8_BAR; PG8_MMA(0, 0, At, B0); PG8_MMA(0, 1, At, B1); PG8_BAR; PG8_SCHED;
            PG8_LDA(At, 0, 1); PG8_STAGE(PG8_SB(0, 0), b2, voffB); PG8_STAGE(PG8_SB(0, 1), b2 + hstepB, voffB); PG8_STAGE(PG8_SA(0, 0), a2, voffA);
            PG8_WAIT_V(8); PG8_WAIT_L(0); PG8_BAR; PG8_MMA(1, 0, At, B0); PG8_MMA(1, 1, At, B1); PG8_BAR; PG8_SCHED;
            PG8_LDB(B0, 1, 0); PG8_LDB(B1, 1, 1); PG8_SCHED; PG8_LDA(At, 1, 0); PG8_STAGE(PG8_SA(0, 1), a2 + hstep, voffA);
            PG8_WAIT_V(8); PG8_WAIT_L(0); PG8_BAR; PG8_MMA(0, 0, At, B0); PG8_MMA(0, 1, At, B1); PG8_BAR; PG8_SCHED;
            PG8_LDA(At, 1, 1); PG8_STAGE(PG8_SB(1, 0), b3, voffB); PG8_STAGE(PG8_SB(1, 1), b3 + hstepB, voffB); PG8_STAGE(PG8_SA(1, 0), a3, voffA);
            PG8_WAIT_V(8); PG8_WAIT_L(0); PG8_BAR; PG8_MMA(1, 0, At, B0); PG8_MMA(1, 1, At, B1); PG8_BAR; PG8_SCHED;
            } else {
            PG8_LDB(B0, 0, 0); PG8_SCHED; PG8_LDA(At, 0, 0); PG8_STAGE(PG8_SA(1, 1), a1 + hstep, voffA);
            PG8_WAIT_L(8); PG8_BAR; PG8_WAIT_L(0); PG8_MMA(0, 0, At, B0); PG8_BAR; PG8_SCHED;
            PG8_LDB(B1, 0, 1); PG8_STAGE(PG8_SB(0, 0), b2, voffB);
            PG8_BAR; PG8_WAIT_L(0); PG8_MMA(0, 1, At, B1); PG8_BAR;
            PG8_LDA(At, 0, 1); PG8_STAGE(PG8_SA(0, 0), a2, voffA);
            PG8_BAR; PG8_WAIT_L(0); PG8_MMA(1, 0, At, B0); PG8_BAR; PG8_SCHED;
            PG8_STAGE(PG8_SB(0, 1), b2 + hstepB, voffB);
            PG8_WAIT_V(6); PG8_BAR; PG8_MMA(1, 1, At, B1); PG8_BAR;
            PG8_LDB(B0, 1, 0); PG8_SCHED; PG8_LDA(At, 1, 0); PG8_STAGE(PG8_SA(0, 1), a2 + hstep, voffA);
            PG8_WAIT_L(8); PG8_BAR; PG8_WAIT_L(0); PG8_MMA(0, 0, At, B0); PG8_BAR; PG8_SCHED;
            PG8_LDB(B1, 1, 1); PG8_STAGE(PG8_SB(1, 0), b3, voffB);
            PG8_BAR; PG8_WAIT_L(0); PG8_MMA(0, 1, At, B1); PG8_BAR;
            PG8_LDA(At, 1, 1); PG8_STAGE(PG8_SA(1, 0), a3, voffA);
            PG8_BAR; PG8_WAIT_L(0); PG8_MMA(1, 0, At, B0); PG8_BAR; PG8_SCHED;
            PG8_STAGE(PG8_SB(1, 1), b3 + hstepB, voffB);
            PG8_WAIT_V(6); PG8_BAR; PG8_MMA(1, 1, At, B1); PG8_BAR;
            }
        }
        if constexpr (ALIGN_EPI) { if (wr == 0) PG8_BAR; }
        E(acc, cur, wr, wc, fr, fq);
        if (!has_next) break;
#pragma unroll
        for (int a = 0; a < 2; ++a)
#pragma unroll
            for (int b = 0; b < 2; ++b)
#pragma unroll
                for (int m = 0; m < 4; ++m)
#pragma unroll
                    for (int n = 0; n < 2; ++n) acc[a][b][m][n] = (f32x4){0.f, 0.f, 0.f, 0.f};
        cur = nxt; cA = nA; cB = nB; ++ui;
        if constexpr (ALIGN_EPI) { if (wr == 1) PG8_BAR; }
    }
    PG8_WAIT_V(0);
    if constexpr (!ALIGN_EPI) { if (wr == 0) PG8_BAR; }
    PG8_BAR;
#undef PG8_SA
#undef PG8_SB
#undef PG8_STAGE
#undef PG8_LDA
#undef PG8_LDB
#undef PG8_MMA
#undef PG8_WAIT_V
#undef PG8_WAIT_L
#undef PG8_BAR
#undef PG8_SCHED
}
}

enum { K_QR = 0, K_KR, K_VR, K_SGR, K_QD, K_KD, K_VD, K_SGD, K_MGR, K_YR, K_MGD, K_YD, K_OUT };
constexpr size_t TSTEP = (size_t)256 * DM * 2;

template <int PC  > struct Epi {
    unsigned char* ws; const float* xin; float* xout; const float* gq; const float* gk;
    __device__ __forceinline__ static void st8(bf16* p, const f32x4 a, const f32x4 b) {
        u32x4 w; w.x = cvt_pk_bf16(a[0], a[1]); w.y = cvt_pk_bf16(a[2], a[3]); w.z = cvt_pk_bf16(b[0], b[1]); w.w = cvt_pk_bf16(b[2], b[3]); *(u32x4*)p = w; }
    __device__ __forceinline__ void operator()(const f32x4 (&acc)[2][2][4][2], const pg8::Unit& u, int wr, int wc, int fr, int fq) const {
        const int row0 = u.pm * 256 + wr * 64 + fr;
        const int cl = wc * 64 + 8 * fq;
        const int kind = u.kind;
        bf16* const qr = (bf16*)(ws + WS_QR); bf16* const kr = (bf16*)(ws + WS_KR); bf16* const vr = (bf16*)(ws + WS_VR); bf16* const sgr = (bf16*)(ws + WS_SGR);
        bf16* const qd = (bf16*)(ws + WS_QD); bf16* const kd = (bf16*)(ws + WS_KD); bf16* const vd = (bf16*)(ws + WS_VD); bf16* const sgd = (bf16*)(ws + WS_SGD);
        bf16* const smgr = (bf16*)(ws + WS_SMGR); bf16* const smgd = (bf16*)(ws + WS_SMGD); bf16* const mbf = (bf16*)(ws + WS_MBF); float* const mbuf = (float*)(ws + WS_MBUF);
        if (PC == 0 && (kind == K_VR || kind == K_VD)) {
            bf16* base = (kind == K_VR ? vr : vd) + u.pn * 256 + cl;
#pragma unroll
            for (int ai = 0; ai < 2; ++ai)
#pragma unroll
                for (int m = 0; m < 4; ++m) { bf16* rp = base + (size_t)(row0 + ai * 128 + m * 16) * 1024;
#pragma unroll
                    for (int bj = 0; bj < 2; ++bj) st8(rp + 32 * bj, acc[ai][bj][m][0], acc[ai][bj][m][1]); }
        } else if (PC == 0 && (kind == K_SGR || kind == K_SGD)) {
            bf16* base = (kind == K_SGR ? sgr : sgd) + u.pn * 256 + cl;
#pragma unroll
            for (int ai = 0; ai < 2; ++ai)
#pragma unroll
                for (int m = 0; m < 4; ++m) { bf16* rp = base + (size_t)(row0 + ai * 128 + m * 16) * 1024;
#pragma unroll
                    for (int bj = 0; bj < 2; ++bj) { f32x4 a = acc[ai][bj][m][0], b = acc[ai][bj][m][1];
#pragma unroll
                        for (int i = 0; i < 4; ++i) { a[i] = a[i] * fast_sigmoid(a[i]); b[i] = b[i] * fast_sigmoid(b[i]); }
                        st8(rp + 32 * bj, a, b); } }
        } else if (PC == 1 && (kind == K_MGR || kind == K_MGD)) {
            bf16* base = (kind == K_MGR ? smgr : smgd) + u.pn * 256 + cl;
#pragma unroll
            for (int ai = 0; ai < 2; ++ai)
#pragma unroll
                for (int m = 0; m < 4; ++m) { bf16* rp = base + (size_t)(row0 + ai * 128 + m * 16) * 1024;
#pragma unroll
                    for (int bj = 0; bj < 2; ++bj) { f32x4 a = acc[ai][bj][m][0], b = acc[ai][bj][m][1];
#pragma unroll
                        for (int i = 0; i < 4; ++i) { a[i] = fast_sigmoid(a[i]); b[i] = fast_sigmoid(b[i]); }
                        st8(rp + 32 * bj, a, b); } }
        } else if (PC == 0 && (kind == K_QR || kind == K_KR)) {
            const int h = u.pn * 4 + wc; const float lg = __log2f(1.0f - __builtin_amdgcn_exp2f(-5.0f - (float)h));
            bf16* base = (kind == K_QR ? qr : kr) + u.pn * 256 + cl;
            const float sgn = (kind == K_QR) ? lg : -lg, mul = (kind == K_QR) ? 1.0f : 0.125f;
#pragma unroll
            for (int ai = 0; ai < 2; ++ai)
#pragma unroll
                for (int m = 0; m < 4; ++m) { const int row = row0 + ai * 128 + m * 16; bf16* rp = base + (size_t)row * 512;
                    const float f = mul * __builtin_amdgcn_exp2f((float)(row & 127) * sgn);
#pragma unroll
                    for (int bj = 0; bj < 2; ++bj) st8(rp + 32 * bj, acc[ai][bj][m][0] * f, acc[ai][bj][m][1] * f); }
        } else if (PC == 0 && (kind == K_QD || kind == K_KD)) {
            const float* g = (kind == K_QD) ? gq : gk; const float mul = (kind == K_QD) ? 0.125f * LOG2E : 1.0f;
            bf16* base = (kind == K_QD ? qd : kd) + u.pn * 256 + cl;
            f32x4 gv[2][2];
#pragma unroll
            for (int bj = 0; bj < 2; ++bj)
#pragma unroll
                for (int n = 0; n < 2; ++n) gv[bj][n] = *(const f32x4*)(g + 32 * bj + 8 * fq + 4 * n) * mul;
#pragma unroll
            for (int ai = 0; ai < 2; ++ai)
#pragma unroll
                for (int m = 0; m < 4; ++m) { bf16* rp = base + (size_t)(row0 + ai * 128 + m * 16) * 1024;
                    float ss = 0.f;
#pragma unroll
                    for (int bj = 0; bj < 2; ++bj)
#pragma unroll
                        for (int n = 0; n < 2; ++n) { const f32x4 x = acc[ai][bj][m][n]; ss += (x[0] * x[0] + x[1] * x[1]) + (x[2] * x[2] + x[3] * x[3]); }
                    ss += __shfl_xor(ss, 16); ss += __shfl_xor(ss, 32);
                    const float rs = __builtin_amdgcn_rsqf(ss * (1.0f / 64.0f) + EPS);
#pragma unroll
                    for (int bj = 0; bj < 2; ++bj) st8(rp + 32 * bj, acc[ai][bj][m][0] * gv[bj][0] * rs, acc[ai][bj][m][1] * gv[bj][1] * rs); }
        } else if (PC == 1 && kind == K_YR) {
            bf16* const yrb = (bf16*)mbuf + (size_t)u.pn * 256 + cl;
#pragma unroll
            for (int ai = 0; ai < 2; ++ai)
#pragma unroll
                for (int m = 0; m < 4; ++m) { bf16* rp = yrb + (size_t)(row0 + ai * 128 + m * 16) * 1024;
#pragma unroll
                    for (int bj = 0; bj < 2; ++bj) st8(rp + 32 * bj, acc[ai][bj][m][0], acc[ai][bj][m][1]); }
        } else if (PC == 1 && kind == K_YD) {
            const size_t cb = (size_t)u.pn * 256 + cl; const bf16* const yrb = (const bf16*)mbuf;
#pragma unroll
            for (int ai = 0; ai < 2; ++ai)
#pragma unroll
                for (int m = 0; m < 4; ++m) { const size_t ro = (size_t)(row0 + ai * 128 + m * 16) * 1024 + cb;
#pragma unroll
                    for (int bj = 0; bj < 2; ++bj) { const u32x4 sr = *(const u32x4*)(smgr + ro + 32 * bj), sd = *(const u32x4*)(smgd + ro + 32 * bj), yr = *(const u32x4*)(yrb + ro + 32 * bj);
                        const f32x4 a = acc[ai][bj][m][0], b = acc[ai][bj][m][1];
                        f32x4 o0, o1;
                        o0[0] = lo_bf(sr.x) * lo_bf(yr.x) + lo_bf(sd.x) * a[0]; o0[1] = hi_bf(sr.x) * hi_bf(yr.x) + hi_bf(sd.x) * a[1];
                        o0[2] = lo_bf(sr.y) * lo_bf(yr.y) + lo_bf(sd.y) * a[2]; o0[3] = hi_bf(sr.y) * hi_bf(yr.y) + hi_bf(sd.y) * a[3];
                        o1[0] = lo_bf(sr.z) * lo_bf(yr.z) + lo_bf(sd.z) * b[0]; o1[1] = hi_bf(sr.z) * hi_bf(yr.z) + hi_bf(sd.z) * b[1];
                        o1[2] = lo_bf(sr.w) * lo_bf(yr.w) + lo_bf(sd.w) * b[2]; o1[3] = hi_bf(sr.w) * hi_bf(yr.w) + hi_bf(sd.w) * b[3];
                        st8(mbf + ro + 32 * bj, o0, o1); }
                    asm volatile("" ::: "memory"); }
        } else if (PC == 2 && kind == K_OUT) {
            const size_t cb = (size_t)u.pn * 256 + cl;
#pragma unroll
            for (int ai = 0; ai < 2; ++ai) {
                f32x4 pre[4][2][2];
#pragma unroll
                for (int m = 0; m < 4; ++m) { const size_t ro = (size_t)(row0 + ai * 128 + m * 16) * 1024 + cb;
#pragma unroll
                    for (int bj = 0; bj < 2; ++bj) { pre[m][bj][0] = *(const f32x4*)(xin + ro + 32 * bj); pre[m][bj][1] = *(const f32x4*)(xin + ro + 32 * bj + 4); } }
#pragma unroll
                for (int m = 0; m < 4; ++m) { const size_t ro = (size_t)(row0 + ai * 128 + m * 16) * 1024 + cb;
#pragma unroll
                    for (int bj = 0; bj < 2; ++bj) { *(f32x4*)(xout + ro + 32 * bj) = pre[m][bj][0] + acc[ai][bj][m][0]; *(f32x4*)(xout + ro + 32 * bj + 4) = pre[m][bj][1] + acc[ai][bj][m][1]; } }
                asm volatile("" ::: "memory");
            }
        }
    }
};

struct SchedG1A {
    const char* A; const char* B; int G, c;
    __device__ __forceinline__ bool next(int i, pg8::Unit& u) const {
        const int L = i * G + c; if (L >= 64 * 28) return false;
        int pm, pg; pg8::tile_of(L, 64, 28, pm, pg);
        u.pm = pm; u.a = A + (size_t)pm * TSTEP; u.b = B + (size_t)pg * TSTEP;
        if (pg < 2) { u.kind = K_QR; u.pn = pg; } else if (pg < 4) { u.kind = K_KR; u.pn = pg - 2; } else if (pg < 8) { u.kind = K_VR; u.pn = pg - 4; } else if (pg < 12) { u.kind = K_SGR; u.pn = pg - 8; }
        else if (pg < 16) { u.kind = K_QD; u.pn = pg - 12; } else if (pg < 20) { u.kind = K_KD; u.pn = pg - 16; } else if (pg < 24) { u.kind = K_VD; u.pn = pg - 20; } else { u.kind = K_SGD; u.pn = pg - 24; }
        return true;
    }
};
struct SchedP34 {
    const char *ws, *Wro, *H, *Win; int c;
    __device__ __forceinline__ bool next(int i, pg8::Unit& u) const {
        if (i >= 4) return false;
        const char* OR = ws + WS_SGR; const char* OD = ws + WS_SGD; const char* Wdo = Wro + 2 * MiB;
        int pm, pn; pg8::tile_of(c, 64, 4, pm, pn); u.pm = pm; u.pn = pn;
        if (i == 0) { u.kind = K_MGR; u.a = H + (size_t)pm * TSTEP; u.b = Win + (size_t)(28 + pn) * TSTEP; }
        else if (i == 1) { u.kind = K_MGD; u.a = H + (size_t)pm * TSTEP; u.b = Win + (size_t)(32 + pn) * TSTEP; }
        else if (i == 2) { u.kind = K_YR; u.a = OR + (size_t)pm * TSTEP; u.b = Wro + (size_t)pn * TSTEP; }
        else { u.kind = K_YD; u.a = OD + (size_t)pm * TSTEP; u.b = Wdo + (size_t)pn * TSTEP; }
        return true;
    }
};
struct SchedG4 {
    const char *Mb, *Wout; int c;
    __device__ __forceinline__ bool next(int i, pg8::Unit& u) const {
        if (i >= 1) return false;
        int pm, pn; pg8::tile_of(c, 64, 4, pm, pn); u.pm = pm; u.pn = pn; u.kind = K_OUT; u.a = Mb + (size_t)pm * TSTEP; u.b = Wout + (size_t)pn * TSTEP; return true;
    }
};


namespace att {
typedef float f32x16 __attribute__((ext_vector_type(16)));
typedef short s16x4 __attribute__((ext_vector_type(4)));
typedef short v4i16_t __attribute__((ext_vector_type(4)));
constexpr int SLOT_OFF = 65536, SLOT_BYTES = 32768, V_OFF = 16384;
__device__ __forceinline__ int crow(int r, int hi) { return (r & 3) + 8 * (r >> 2) + 4 * hi; }
__device__ __forceinline__ s16x4 vtr(LAS const unsigned char* p) { return __builtin_bit_cast(s16x4, __builtin_amdgcn_ds_read_tr16_b64_v4i16((LAS v4i16_t*)p)); }
#define ATT_MFMA(a, b, c) __builtin_amdgcn_mfma_f32_32x32x16_bf16(a, b, c, 0, 0, 0)

__device__ __forceinline__ void attn_unit(LAS unsigned char* lds, const unsigned char* ws, const int b, const int h, const int qb, const float lam, const float omli, const float* __restrict__ gsub, const int win) {
    int tid_ = threadIdx.x; asm volatile("" : "+v"(tid_));
    const int tid = tid_, lane = tid & 63, r32 = lane & 31, hi = lane >> 5, w = __builtin_amdgcn_readfirstlane(tid >> 6), rg = w & 3, kg = w >> 2;
    const bf16* QD = (const bf16*)(ws + WS_QD); const bf16* KD = (const bf16*)(ws + WS_KD); const bf16* VD = (const bf16*)(ws + WS_VD); bf16* SGD = (bf16*)(ws + WS_SGD);
    const size_t tb = (size_t)b * SEQ; const int q0 = qb * 128, NT = (q0 + 128) / 64;
    const int T0 = (q0 > win ? q0 - win : 0) >> 6;
#pragma unroll
    for (int k = 0; k < 4; ++k) { const int p = 4 * kg + k; const bf16* src = QD + (tb + q0 + 32 * rg + r32) * 1024 + h * 128 + (p >> 2) * 64 + (p & 3) * 16 + hi * 8;
        __builtin_amdgcn_global_load_lds((const unsigned*)src, (LAS unsigned*)(lds + rg * 8192 + p * 1024), 16, 0, 0); }
    const bf16* ksrc = KD + (tb + lane) * 1024 + h * 128 + (w & 7) * 8;
    const bf16* vsrc = VD + (tb + 16 * (w & 3) + (lane >> 2)) * 1024 + h * 128 + (w >> 2) * 32 + (lane & 3) * 8;
#define ATT_STAGE(t, slot) do { _Pragma("unroll") for (int rr = 0; rr < 2; ++rr) { \
        __builtin_amdgcn_global_load_lds((const unsigned*)(ksrc + (size_t)(t) * 65536 + rr * 64), (LAS unsigned*)(lds + SLOT_OFF + (slot) * SLOT_BYTES + (rr * 8 + w) * 1024), 16, 0, 0); \
        __builtin_amdgcn_global_load_lds((const unsigned*)(vsrc + (size_t)(t) * 65536 + rr * 64), (LAS unsigned*)(lds + SLOT_OFF + (slot) * SLOT_BYTES + V_OFF + (rr * 8 + w) * 1024), 16, 0, 0); } } while (0)
    ATT_STAGE(T0, 0);
    __syncthreads();
    const float slope = __builtin_amdgcn_exp2f(-(float)(h + 1)) * LOG2E;
    const int n = q0 + 32 * rg + r32;
    f32x16 O[2][4];
#pragma unroll
    for (int j = 0; j < 2; ++j)
#pragma unroll
        for (int e = 0; e < 4; ++e)
#pragma unroll
            for (int r = 0; r < 16; ++r) O[j][e][r] = 0.f;
    float lsum[2] = {0.f, 0.f};
    const int qoff = rg * 8192 + lane * 16;
    const int koff = hi * 1024 + (32 * kg + r32) * 16;
    const int voff = V_OFF + 2 * kg * 1024 + ((lane >> 4) & 1) * 32 + (lane & 3) * 8 + (4 * hi + ((lane & 15) >> 2)) * 64;
    for (int t = T0; t < NT; ++t) {
        if (t + 1 < NT) ATT_STAGE(t + 1, (t + 1 - T0) & 1);
        const int k0 = t * 64 + 32 * kg;
        if (k0 <= q0 + 32 * rg + 31) {
            LAS const unsigned char* slot = lds + SLOT_OFF + ((t - T0) & 1) * SLOT_BYTES;
            float sl = slope; asm volatile("" : "+v"(sl));
            const int dn = n - k0 - 4 * hi; const float base = -sl * (float)dn;
            const bool diag = (k0 + 31 > q0 + 32 * rg);
            f32x16 pA, pB;
#pragma unroll
            for (int r = 0; r < 16; ++r) { const int kc = (r & 3) + 8 * (r >> 2); pA[r] = __builtin_fmaf(sl, (float)kc, base); }
            if (diag) {
#pragma unroll
                for (int r = 0; r < 16; ++r) { const int kc = (r & 3) + 8 * (r >> 2); if (kc > dn) pA[r] = -INFINITY; }
            }
            pB = pA;
#pragma unroll
            for (int d0 = 0; d0 < 4; ++d0) {
                const bf16x8 kfa = *(LAS const bf16x8*)(slot + koff + (2 * d0) * 1024), kfb = *(LAS const bf16x8*)(slot + koff + (8 + 2 * d0) * 1024);
                const bf16x8 qfa = *(LAS const bf16x8*)(lds + qoff + d0 * 1024), qfb = *(LAS const bf16x8*)(lds + qoff + (4 + d0) * 1024);
                pA = ATT_MFMA(kfa, qfa, pA); pB = ATT_MFMA(kfb, qfb, pB);
            }
            bf16x8 vf[4][2];
#pragma unroll
            for (int eb = 0; eb < 4; ++eb)
#pragma unroll
                for (int ks = 0; ks < 2; ++ks) { const s16x4 vlo = vtr(slot + voff + eb * 4096 + ks * 1024), vhi = vtr(slot + voff + eb * 4096 + ks * 1024 + 512);
                    vf[eb][ks] = (bf16x8){vlo[0], vlo[1], vlo[2], vlo[3], vhi[0], vhi[1], vhi[2], vhi[3]}; }
            u32x4 pwA[2], pwB[2];
            { float s = 0.f;
#pragma unroll
              for (int r = 0; r < 16; ++r) { pA[r] = __builtin_amdgcn_exp2f(pA[r]); s += pA[r]; }
              lsum[0] += s;
#pragma unroll
              for (int i = 0; i < 4; ++i) { pwA[0][i] = cvt_pk_bf16(pA[2 * i], pA[2 * i + 1]); pwA[1][i] = cvt_pk_bf16(pA[8 + 2 * i], pA[9 + 2 * i]); } }
            { float s = 0.f;
#pragma unroll
              for (int r = 0; r < 16; ++r) { pB[r] = __builtin_amdgcn_exp2f(pB[r]); s += pB[r]; }
              lsum[1] += s;
#pragma unroll
              for (int i = 0; i < 4; ++i) { pwB[0][i] = cvt_pk_bf16(pB[2 * i], pB[2 * i + 1]); pwB[1][i] = cvt_pk_bf16(pB[8 + 2 * i], pB[9 + 2 * i]); } }
            __builtin_amdgcn_s_setprio(1);
#pragma unroll
            for (int eb = 0; eb < 4; ++eb)
#pragma unroll
                for (int ks = 0; ks < 2; ++ks) {
                    O[0][eb] = ATT_MFMA(vf[eb][ks], __builtin_bit_cast(bf16x8, pwA[ks]), O[0][eb]);
                    O[1][eb] = ATT_MFMA(vf[eb][ks], __builtin_bit_cast(bf16x8, pwB[ks]), O[1][eb]);
                }
            __builtin_amdgcn_s_setprio(0);
        }
        __syncthreads();
    }
    lsum[0] += __shfl_xor(lsum[0], 32); lsum[1] += __shfl_xor(lsum[1], 32);
    LAS float* dump = (LAS float*)(lds + rg * 32768);
    LAS float* lx = (LAS float*)(lds + 131072 + rg * 1024);
    if (kg == 1) {
#pragma unroll
        for (int j = 0; j < 2; ++j)
#pragma unroll
            for (int eb = 0; eb < 4; ++eb)
#pragma unroll
                for (int r = 0; r < 16; ++r) dump[((j * 4 + eb) * 16 + r) * 64 + lane] = O[j][eb][r];
        lx[lane] = lsum[0]; lx[64 + lane] = lsum[1];
    }
    asm volatile("s_waitcnt lgkmcnt(0)" ::: "memory");
    __syncthreads();
    if (kg == 0) {
#pragma unroll
        for (int j = 0; j < 2; ++j)
#pragma unroll
            for (int eb = 0; eb < 4; ++eb)
                {
#pragma unroll
                  for (int r = 0; r < 16; ++r) O[j][eb][r] += dump[((j * 4 + eb) * 16 + r) * 64 + lane];
                  asm volatile("s_waitcnt lgkmcnt(0)" : "+v"(O[j][eb]) :: "memory"); }
        lsum[0] += lx[lane]; lsum[1] += lx[64 + lane];
        asm volatile("s_waitcnt lgkmcnt(0)" ::: "memory");
        int r32e = r32; asm volatile("" : "+v"(r32e));
        const float i0 = 1.0f / lsum[0], i1 = lam / lsum[1];
        float ss = 0.f;
#pragma unroll
        for (int eb = 0; eb < 4; ++eb)
#pragma unroll
            for (int r = 0; r < 16; ++r) { const float o = O[0][eb][r] * i0 - O[1][eb][r] * i1; O[0][eb][r] = o; ss += o * o; }
        ss += __shfl_xor(ss, 32);
        const float rs = __builtin_amdgcn_rsqf(ss * (1.0f / 128.0f) + EPS) * omli;
        bf16* rowp = SGD + (tb + q0 + 32 * rg + r32e) * 1024 + h * 128 + 4 * hi;
        const float* gp = gsub + h * 128 + 4 * hi;
#pragma unroll
        for (int eb = 0; eb < 4; ++eb) {
            unsigned long long gt[4];
#pragma unroll
            for (int g = 0; g < 4; ++g) gt[g] = *(const unsigned long long*)(rowp + 32 * eb + 8 * g);
#pragma unroll
            for (int g = 0; g < 4; ++g) { const f32x4 gg = *(const f32x4*)(gp + 32 * eb + 8 * g); const unsigned glo = (unsigned)gt[g], ghi = (unsigned)(gt[g] >> 32);
                const unsigned w0 = cvt_pk_bf16(O[0][eb][4 * g] * rs * gg[0] * lo_bf(glo), O[0][eb][4 * g + 1] * rs * gg[1] * hi_bf(glo));
                const unsigned w1 = cvt_pk_bf16(O[0][eb][4 * g + 2] * rs * gg[2] * lo_bf(ghi), O[0][eb][4 * g + 3] * rs * gg[3] * hi_bf(ghi));
                *(unsigned long long*)(rowp + 32 * eb + 8 * g) = (unsigned long long)w0 | ((unsigned long long)w1 << 32); }
            asm volatile("" ::: "memory");
        }
    }
    asm volatile("s_waitcnt lgkmcnt(0)" ::: "memory");
    __syncthreads();
#undef ATT_STAGE
}
}

namespace ret {
using att::f32x16; using att::s16x4; using att::crow; using att::vtr;
constexpr int SET = 49152, KT = 0, VI = 16384, OST = 98304, ST = 131072, RED = 147456;
__device__ __forceinline__ void ret_unit(LAS unsigned char* lds, const unsigned char* ws, const int b, const int h, const float* __restrict__ gn, const int c0, const int c1) {
    int tid_ = threadIdx.x; asm volatile("" : "+v"(tid_));
    const int tid = tid_, lane = tid & 63, r32 = lane & 31, hi = lane >> 5, w = __builtin_amdgcn_readfirstlane(tid >> 6);
    const int ib = w & 3, eh = w >> 2, dh = w & 1, ebo = w >> 1;
    const bf16* QR = (const bf16*)(ws + WS_QR); const bf16* KR = (const bf16*)(ws + WS_KR); const bf16* VR = (const bf16*)(ws + WS_VR); bf16* SGR = (bf16*)(ws + WS_SGR);
    const size_t tb = (size_t)b * SEQ;
    const float lg = __log2f(1.0f - __builtin_amdgcn_exp2f(-5.0f - (float)h)), gC = __builtin_amdgcn_exp2f(128.0f * lg);
    for (int i = tid; i < 16384 / 16; i += 512) *(LAS u32x4*)(lds + ST + i * 16) = (u32x4){0u, 0u, 0u, 0u};
    f32x16 sblk;
#pragma unroll
    for (int r = 0; r < 16; ++r) sblk[r] = 0.f;
    const int vpat = ((lane >> 4) & 1) * 32 + (lane & 3) * 8 + (4 * hi + ((lane & 15) >> 2)) * 64;
    const int prow = tid >> 4, pcol = (tid & 15) * 8;
    f32x4 gA = *(const f32x4*)(gn + h * 128 + pcol), gB = *(const f32x4*)(gn + h * 128 + pcol + 4);
#define RET_STAGE(c, s) do { const size_t t0_ = tb + (size_t)(c) * 128; LAS unsigned char* sb_ = lds + (s) * SET; \
        _Pragma("unroll") for (int k = 0; k < 2; ++k) { const int p = 2 * w + k, d2 = p >> 3, kg = p & 7; \
            __builtin_amdgcn_global_load_lds((const unsigned*)(KR + (t0_ + 16 * kg + (lane >> 2)) * 512 + h * 64 + d2 * 32 + (lane & 3) * 8), (LAS unsigned*)(sb_ + KT + p * 1024), 16, 0, 0); } \
        _Pragma("unroll") for (int k = 0; k < 4; ++k) { const int p = 4 * w + k, eg = p >> 3, kg = p & 7; \
            __builtin_amdgcn_global_load_lds((const unsigned*)(VR + (t0_ + 16 * kg + (lane >> 2)) * 1024 + h * 128 + eg * 32 + (lane & 3) * 8), (LAS unsigned*)(sb_ + VI + p * 1024), 16, 0, 0); } } while (0)
    if (c0 > 0) {
        RET_STAGE(0, 0);
        for (int c = 0; c < c0; ++c) {
            __syncthreads();
            if (c + 1 < c0) RET_STAGE(c + 1, (c + 1) & 1);
            LAS const unsigned char* sb = lds + (c & 1) * SET;
            f32x16 kv;
#pragma unroll
            for (int r = 0; r < 16; ++r) kv[r] = 0.f;
#pragma unroll
            for (int ks = 0; ks < 8; ++ks) { LAS const unsigned char* kp = sb + KT + dh * 8192 + ks * 1024 + vpat; LAS const unsigned char* vp = sb + VI + ebo * 8192 + ks * 1024 + vpat;
                const s16x4 klo = vtr(kp), khi = vtr(kp + 512), vlo = vtr(vp), vhi = vtr(vp + 512);
                kv = ATT_MFMA(((bf16x8){klo[0], klo[1], klo[2], klo[3], khi[0], khi[1], khi[2], khi[3]}), ((bf16x8){vlo[0], vlo[1], vlo[2], vlo[3], vhi[0], vhi[1], vhi[2], vhi[3]}), kv); }
#pragma unroll
            for (int r = 0; r < 16; ++r) sblk[r] = gC * (sblk[r] + kv[r]);
        }
        __syncthreads();
#pragma unroll
        for (int g = 0; g < 4; ++g) { unsigned long long v = (unsigned long long)cvt_pk_bf16(sblk[4 * g], sblk[4 * g + 1]) | ((unsigned long long)cvt_pk_bf16(sblk[4 * g + 2], sblk[4 * g + 3]) << 32);
            *(LAS unsigned long long*)(lds + ST + (32 * ebo + r32) * 128 + (32 * dh + 8 * g + 4 * hi) * 2) = v; }
    }
    RET_STAGE(c0, c0 & 1);
    bf16x8 qn[4];
#pragma unroll
    for (int d0 = 0; d0 < 4; ++d0) qn[d0] = *(const bf16x8*)(QR + (tb + (size_t)c0 * 128 + 32 * ib + r32) * 512 + h * 64 + d0 * 16 + hi * 8);
    for (int c = c0; c < c1; ++c) {
        const size_t t0 = tb + (size_t)c * 128;
        __syncthreads();
        LAS const unsigned char* sb = lds + (c & 1) * SET;
        u32x4 gt[4];
#pragma unroll
        for (int k = 0; k < 4; ++k) gt[k] = *(const u32x4*)(SGR + (t0 + prow + 32 * k) * 1024 + h * 128 + pcol);
        bf16x8 qf[4];
#pragma unroll
        for (int d0 = 0; d0 < 4; ++d0) qf[d0] = qn[d0];
        if (c + 1 < c1) { RET_STAGE(c + 1, (c + 1) & 1);
#pragma unroll
            for (int d0 = 0; d0 < 4; ++d0) qn[d0] = *(const bf16x8*)(QR + (t0 + 128 + 32 * ib + r32) * 512 + h * 64 + d0 * 16 + hi * 8); }
        f32x16 O[2];
#pragma unroll
        for (int eb = 0; eb < 2; ++eb)
#pragma unroll
            for (int r = 0; r < 16; ++r) O[eb][r] = 0.f;
#pragma unroll
        for (int jb = 0; jb < 4; ++jb) {
            if (jb <= ib) {
                f32x16 s;
#pragma unroll
                for (int r = 0; r < 16; ++r) s[r] = 0.f;
#pragma unroll
                for (int d0 = 0; d0 < 4; ++d0) { const bf16x8 kf = *(LAS const bf16x8*)(sb + KT + (d0 >> 1) * 8192 + (32 * jb + r32) * 64 + ((d0 & 1) * 16 + 8 * hi) * 2); s = ATT_MFMA(kf, qf[d0], s); }
                if (jb == ib) {
#pragma unroll
                    for (int r = 0; r < 16; ++r) if (crow(r, hi) > r32) s[r] = 0.f;
                }
                u32x4 pw[2];
#pragma unroll
                for (int i = 0; i < 4; ++i) { pw[0][i] = cvt_pk_bf16(s[2 * i], s[2 * i + 1]); pw[1][i] = cvt_pk_bf16(s[8 + 2 * i], s[9 + 2 * i]); }
#pragma unroll
                for (int eb = 0; eb < 2; ++eb)
#pragma unroll
                    for (int ks = 0; ks < 2; ++ks) { LAS const unsigned char* vp = sb + VI + (2 * eh + eb) * 8192 + (2 * jb + ks) * 1024 + vpat;
                        const s16x4 vlo = vtr(vp), vhi = vtr(vp + 512);
                        O[eb] = ATT_MFMA(((bf16x8){vlo[0], vlo[1], vlo[2], vlo[3], vhi[0], vhi[1], vhi[2], vhi[3]}), __builtin_bit_cast(bf16x8, pw[ks]), O[eb]); }
            }
        }
#pragma unroll
        for (int eb = 0; eb < 2; ++eb)
#pragma unroll
            for (int d0 = 0; d0 < 4; ++d0) { const bf16x8 sf = *(LAS const bf16x8*)(lds + ST + (32 * (2 * eh + eb) + r32) * 128 + (16 * d0 + 8 * hi) * 2); O[eb] = ATT_MFMA(sf, qf[d0], O[eb]); }
        { f32x16 kv;
#pragma unroll
          for (int r = 0; r < 16; ++r) kv[r] = 0.f;
#pragma unroll
          for (int ks = 0; ks < 8; ++ks) { LAS const unsigned char* kp = sb + KT + dh * 8192 + ks * 1024 + vpat; LAS const unsigned char* vp = sb + VI + ebo * 8192 + ks * 1024 + vpat;
              const s16x4 klo = vtr(kp), khi = vtr(kp + 512), vlo = vtr(vp), vhi = vtr(vp + 512);
              kv = ATT_MFMA(((bf16x8){klo[0], klo[1], klo[2], klo[3], khi[0], khi[1], khi[2], khi[3]}), ((bf16x8){vlo[0], vlo[1], vlo[2], vlo[3], vhi[0], vhi[1], vhi[2], vhi[3]}), kv); }
#pragma unroll
          for (int r = 0; r < 16; ++r) sblk[r] = gC * (sblk[r] + kv[r]); }
        { float s2 = 0.f;
#pragma unroll
          for (int eb = 0; eb < 2; ++eb)
#pragma unroll
              for (int r = 0; r < 16; ++r) s2 += O[eb][r] * O[eb][r];
          s2 += __shfl_xor(s2, 32);
          if (hi == 0) ((LAS float*)(lds + RED))[(32 * ib + r32) * 2 + eh] = s2; }
#pragma unroll
        for (int eb = 0; eb < 2; ++eb)
#pragma unroll
            for (int g = 0; g < 4; ++g) *(LAS unsigned long long*)(lds + OST + (32 * ib + r32) * 256 + (64 * eh + 32 * eb + 8 * g + 4 * hi) * 2) =
                (unsigned long long)cvt_pk_bf16(O[eb][4 * g], O[eb][4 * g + 1]) | ((unsigned long long)cvt_pk_bf16(O[eb][4 * g + 2], O[eb][4 * g + 3]) << 32);
        asm volatile("s_waitcnt lgkmcnt(0)" ::: "memory"); __builtin_amdgcn_s_barrier(); asm volatile("" ::: "memory");
#pragma unroll
        for (int g = 0; g < 4; ++g) { unsigned long long v = (unsigned long long)cvt_pk_bf16(sblk[4 * g], sblk[4 * g + 1]) | ((unsigned long long)cvt_pk_bf16(sblk[4 * g + 2], sblk[4 * g + 3]) << 32);
            *(LAS unsigned long long*)(lds + ST + (32 * ebo + r32) * 128 + (32 * dh + 8 * g + 4 * hi) * 2) = v; }
#pragma unroll
        for (int k = 0; k < 4; ++k) { const int row = prow + 32 * k; const LAS float* rp = (const LAS float*)(lds + RED) + row * 2;
            const float rs = __builtin_amdgcn_rsqf((rp[0] + rp[1]) * (1.0f / 128.0f) + EPS);
            const u32x4 ov = *(LAS const u32x4*)(lds + OST + row * 256 + pcol * 2); const u32x4 gg = gt[k];
            u32x4 res;
            res.x = cvt_pk_bf16(lo_bf(ov.x) * rs * gA[0] * lo_bf(gg.x), hi_bf(ov.x) * rs * gA[1] * hi_bf(gg.x));
            res.y = cvt_pk_bf16(lo_bf(ov.y) * rs * gA[2] * lo_bf(gg.y), hi_bf(ov.y) * rs * gA[3] * hi_bf(gg.y));
            res.z = cvt_pk_bf16(lo_bf(ov.z) * rs * gB[0] * lo_bf(gg.z), hi_bf(ov.z) * rs * gB[1] * hi_bf(gg.z));
            res.w = cvt_pk_bf16(lo_bf(ov.w) * rs * gB[2] * lo_bf(gg.w), hi_bf(ov.w) * rs * gB[3] * hi_bf(gg.w));
            *(u32x4*)(SGR + (t0 + row) * 1024 + h * 128 + pcol) = res; }
    }
    __syncthreads();
#undef RET_STAGE
}
}

constexpr int MIX_LIST_ITEMS = 16 + 4 * 32;
constexpr int CW_QUEUE = 2048;

#define XB_TMO      128
#define XB_XCNT(j)  (256  + 64 * (j))
#define XB_XSUB(j)  (1280 + 64 * (j))
#define XB_XGEN(j)  (2304 + 64 * (j))
#define XB_TOP      3328
#define XB_TOPGEN   3392
#define XCD_BAR_WORDS 3456
#define XB_SPIN_CAP (1u << 18)
__device__ __forceinline__ unsigned xb_ld(unsigned* p)              { return __hip_atomic_load(p, __ATOMIC_RELAXED, __HIP_MEMORY_SCOPE_AGENT); }
__device__ __forceinline__ unsigned xb_add(unsigned* p, unsigned v) { return __hip_atomic_fetch_add(p, v, __ATOMIC_RELAXED, __HIP_MEMORY_SCOPE_AGENT); }
__device__ __forceinline__ unsigned xb_xcc_id() { return (unsigned)__builtin_amdgcn_s_getreg((3 << 11) | 20) & 0xFu; }
#define XB_SPIN(cond, bar) do { unsigned _sp = 0; while (cond) { __builtin_amdgcn_s_sleep(1); \
    if ((++_sp & 255u) == 0u) { if (xb_ld(&(bar)[XB_TMO])) break; if (_sp > XB_SPIN_CAP) { atomicAdd(&(bar)[XB_TMO], 1u); break; } } } } while (0)
struct XcdBarrier { unsigned* bar; unsigned x; volatile LAS unsigned* st; };
__device__ __forceinline__ XcdBarrier xcd_barrier_post(unsigned* bar, volatile LAS unsigned* st) {
    XcdBarrier b; b.bar = bar; b.x = xb_xcc_id(); b.st = st;
    if (threadIdx.x == 0) (void)xb_add(&bar[XB_XCNT(b.x)], 1u);
    return b;
}
__device__ __forceinline__ void xcd_barrier_complete(unsigned* bar, unsigned x, unsigned& nloc, unsigned& nx) {
    const unsigned G = gridDim.x * gridDim.y * gridDim.z;
    unsigned sum, cnt, mine, sp = 0u;
    for (;;) {
        sum = 0u; cnt = 0u; mine = 0u;
#pragma unroll
        for (unsigned j = 0; j < 16; ++j) { const unsigned c = xb_ld(&bar[XB_XCNT(j)]); sum += c; cnt += (c > 0u) ? 1u : 0u; mine = (j == x) ? c : mine; }
        if (sum == G) break;
        __builtin_amdgcn_s_sleep(1);
        if ((++sp & 255u) == 0u) { if (xb_ld(&bar[XB_TMO])) break; if (sp > XB_SPIN_CAP) { atomicAdd(&bar[XB_TMO], 1u); break; } }
    }
    nloc = mine > 0u ? mine : 1u; nx = cnt > 0u ? cnt : 1u;
}
__device__ __forceinline__ void xcd_barrier(const XcdBarrier& b) {
    asm volatile("s_waitcnt vmcnt(0)" ::: "memory");
    __syncthreads();
    if (threadIdx.x == 0) {
        unsigned* bar = b.bar;
        __builtin_amdgcn_s_waitcnt(0);
        unsigned nloc = b.st[0], nx = b.st[1];
        if (nloc == 0u) { xcd_barrier_complete(bar, b.x, nloc, nx); b.st[0] = nloc; b.st[1] = nx; }
        const unsigned old = xb_add(&bar[XB_XSUB(b.x)], 1u);
        const unsigned gen = old / nloc;
        if (old + 1u == (gen + 1u) * nloc) {
            __builtin_amdgcn_fence(__ATOMIC_RELEASE, "agent");
            asm volatile("s_waitcnt vmcnt(0)" ::: "memory");
            const unsigned og = xb_add(&bar[XB_TOP], 1u);
            const unsigned tg = og / nx;
            if (og + 1u == (tg + 1u) * nx) xb_add(&bar[XB_TOPGEN], 1u);
            else XB_SPIN(xb_ld(&bar[XB_TOPGEN]) == tg, bar);
            __builtin_amdgcn_fence(__ATOMIC_ACQUIRE, "agent");
            xb_add(&bar[XB_XGEN(b.x)], 1u);
            asm volatile("s_waitcnt vmcnt(0)" ::: "memory");
        } else {
            XB_SPIN(xb_ld(&bar[XB_XGEN(b.x)]) == gen, bar);
            __builtin_amdgcn_fence(__ATOMIC_ACQUIRE, "agent");
            asm volatile("s_waitcnt vmcnt(0)" ::: "memory");
        }
    }
    __syncthreads();
}

#define LDS_WAIT() asm volatile("s_waitcnt lgkmcnt(0)" ::: "memory")
__device__ __forceinline__ float wave_sum(float v) {
#pragma unroll
    for (int o = 1; o < 64; o <<= 1) v += __shfl_xor(v, o);
    return v;
}
constexpr int P0_SCR_BYTES = 64 * 65 * 4;
__device__ __forceinline__ void p0_transpose_item(const float* W, int K, int N, bf16* WT, LAS float* scr, int item, int lane) {
    const int nblk = N / 64, kb = item / nblk, nb = item % nblk, k0 = 64 * kb, n0 = 64 * nb;
    const int lr = lane >> 4, lc = (lane & 15) * 4;
    const GAS f32x4* src = (const GAS f32x4*)(W + (size_t)(k0 + lr) * N + n0 + lc);
    f32x4 v[16];
#pragma unroll
    for (int i = 0; i < 16; ++i) v[i] = src[(size_t)i * N];
#pragma unroll
    for (int i = 0; i < 16; ++i) { LAS float* d = scr + (4 * i + lr) * 65 + lc; d[0] = v[i].x; d[1] = v[i].y; d[2] = v[i].z; d[3] = v[i].w; }
    LDS_WAIT(); asm volatile("" ::: "memory");
    const int c = lane & 7;
#pragma unroll
    for (int j = 0; j < 8; ++j) { const int n = (lane >> 3) + 8 * j; const LAS float* q = scr + (8 * c) * 65 + n;
        u32x4 o; o.x = pk2(q[0 * 65], q[1 * 65]); o.y = pk2(q[2 * 65], q[3 * 65]); o.z = pk2(q[4 * 65], q[5 * 65]); o.w = pk2(q[6 * 65], q[7 * 65]);
        *(GAS u32x4*)(WT + (size_t)(n0 + n) * K + k0 + 8 * c) = o; }
    LDS_WAIT(); asm volatile("" ::: "memory");
}
__device__ __forceinline__ void rms_rows4_to_bf16(const float* xrow, const float* g, bf16* orow, int lane) {
    const GAS f32x4* xr = (const GAS f32x4*)xrow + lane; const GAS f32x4* gr = (const GAS f32x4*)g + lane;
    f32x4 v[4][4];
#pragma unroll
    for (int r = 0; r < 4; ++r)
#pragma unroll
        for (int j = 0; j < 4; ++j) v[r][j] = xr[256 * r + 64 * j];
    f32x4 gg[4];
#pragma unroll
    for (int j = 0; j < 4; ++j) gg[j] = gr[64 * j];
    GAS unsigned long long* o8 = (GAS unsigned long long*)orow + lane;
#pragma unroll
    for (int r = 0; r < 4; ++r) { float s = 0.f;
#pragma unroll
        for (int j = 0; j < 4; ++j) s += (v[r][j].x * v[r][j].x + v[r][j].y * v[r][j].y) + (v[r][j].z * v[r][j].z + v[r][j].w * v[r][j].w);
        const float rs = 1.0f / sqrtf(wave_sum(s) * (1.f / DM) + EPS);
#pragma unroll
        for (int j = 0; j < 4; ++j)
            o8[256 * r + 64 * j] = (unsigned long long)pk2(v[r][j].x * rs * gg[j].x, v[r][j].y * rs * gg[j].y) | ((unsigned long long)pk2(v[r][j].z * rs * gg[j].z, v[r][j].w * rs * gg[j].w) << 32); }
}

__device__ __forceinline__ const float* in_ptr(int k) {
    typedef __attribute__((address_space(4))) const char* cptr4;
    cptr4 ka = (cptr4)__builtin_amdgcn_kernarg_segment_ptr(); cptr4 kb;
    asm volatile("s_mov_b64 %0, %1" : "=s"(kb) : "s"(ka));
    typedef const float* cfp; typedef __attribute__((address_space(4))) const cfp* cfp4;
    return *(cfp4)(kb + k * 8);
}
constexpr int NWAVES = 8;
constexpr int RING_BYTES = 131072, LDS_BYTES = 163840, LDSCTL_OFF = LDS_BYTES - 1024, MISC_OFF = LDSCTL_OFF + 320;
struct Args { const float* in[14]; float* out; unsigned char* ws; int ph_lo, ph_hi, li, pad; };
constexpr int N_PHASES = 10;

__global__ void __launch_bounds__(NWAVES * 64, 2) mk_fwd(Args args) {
    extern __shared__ __attribute__((aligned(16))) unsigned char lds_raw[];
    LAS unsigned char* lds = (LAS unsigned char*)lds_raw;
    volatile LAS unsigned* MISC = (volatile LAS unsigned*)(lds + MISC_OFF);
    const int tid = threadIdx.x, lane_k = tid & 63, wave = __builtin_amdgcn_readfirstlane(tid >> 6);
    const int G = gridDim.x, bx = blockIdx.x; const int vcu = (G % 8 == 0) ? (bx % 8) * (G / 8) + bx / 8 : bx;
    unsigned char* const ws_k = (unsigned char*)in_ptr(15);
    unsigned* ctl = (unsigned*)(ws_k + WS_CTL);
    for (int u = tid; u < (LDS_BYTES - LDSCTL_OFF) / 4; u += NWAVES * 64) ((LAS unsigned*)(lds + LDSCTL_OFF))[u] = 0u;
    __syncthreads();
    const int lo = args.ph_lo, hi = args.ph_hi;
    XcdBarrier bar; bar.bar = ctl + CW_BAR + args.li * XCD_BAR_WORDS; bar.x = 0; bar.st = nullptr;
    if (hi - lo > 1) bar = xcd_barrier_post(ctl + CW_BAR + args.li * XCD_BAR_WORDS, MISC + 8);
#define IN(k) (lo <= (k) && (k) < hi)
#define SEAM(k) do { if (IN(k) && IN((k) + 1)) xcd_barrier(bar); } while (0)

    if (IN(0)) {
        unsigned char* const ws = ws_k; int lane = lane_k; asm volatile("" : "+v"(lane));
        LAS float* scr = (LAS float*)(lds + wave * P0_SCR_BYTES);
        const int gw = vcu * NWAVES + wave, NGW = G * NWAVES;
        constexpr int I_IN = (DM / 64) * (NIN / 64), I_SQ = (DM / 64) * (DM / 64);
        for (int it = gw; it < 2 * I_IN + 6 * I_SQ; it += NGW) {
            int r = it;
            if (r < 2 * I_IN) { const int l = r / I_IN; p0_transpose_item(in_ptr(2) + (size_t)l * DM * NIN, DM, NIN, (bf16*)(ws + (l == 0 ? WS_WIN0 : WS_WIN)), scr, r % I_IN, lane); continue; } r -= 2 * I_IN;
            const int which = r / I_SQ, item = r % I_SQ, l = which / 3, w = which % 3;
            const float* src = (w == 0 ? in_ptr(4) : w == 1 ? in_ptr(12) : in_ptr(13)) + (size_t)l * DM * DM;
            bf16* dst = (bf16*)(ws + (l == 0 ? WS_WRO : WS_W1) + (size_t)w * 2 * MiB);
            p0_transpose_item(src, DM, DM, dst, scr, item, lane);
        }
        const float* x0 = in_ptr(0); const float* g0 = in_ptr(1); bf16* H = (bf16*)in_ptr(14);
        for (int m = 4 * gw; m < T; m += 4 * NGW) rms_rows4_to_bf16(x0 + (size_t)m * DM, g0, H + (size_t)m * DM, lane);
        LDS_WAIT(); __syncthreads();
    }
    SEAM(0);

#pragma unroll 1
    for (int l = 0; l < DEPTH; ++l) {
        const int pb = 1 + 5 * l;
        if (IN(pb)) {
            unsigned char* const ws = ws_k;
            Epi<0> E; E.ws = ws; E.xin = nullptr; E.xout = nullptr; E.gq = in_ptr(5) + l * 64; E.gk = in_ptr(6) + l * 64;
            SchedG1A S{l == 0 ? (const char*)in_ptr(14) : (const char*)(ws + WS_H), (const char*)(ws + (l == 0 ? WS_WIN0 : WS_WIN)), G, bx};
            pg8::gemm_phase<Epi<0>, SchedG1A, true, true>(lds, DM, S, E);
        }
        SEAM(pb);
        if (IN(pb + 1)) {
            unsigned char* const ws = ws_k;
            float s1 = 0.f, s2 = 0.f; { const float* q1 = in_ptr(7) + l * 64; const float* k1 = in_ptr(8) + l * 64; const float* q2 = in_ptr(9) + l * 64; const float* k2 = in_ptr(10) + l * 64;
                for (int i = 0; i < 64; ++i) { s1 += q1[i] * k1[i]; s2 += q2[i] * k2[i]; } }
            const float lam_init = 0.8f - 0.6f * __expf(-0.3f * (float)l), lam = __expf(s1) - __expf(s2) + lam_init;
            const float* gsub = in_ptr(11) + l * 1024;
            float gqm = 0.f, gkm = 0.f; { const float* gq = in_ptr(5) + l * 64; const float* gk = in_ptr(6) + l * 64; for (int i = 0; i < 64; ++i) { gqm = fmaxf(gqm, fabsf(gq[i])); gkm = fmaxf(gkm, fabsf(gk[i])); } }
            const float Bnd = 1.02f * 8.0f * LOG2E * gqm * gkm;
            const float* gret = in_ptr(3) + l * 1024;
            unsigned* qbase = ctl + CW_QUEUE + 512 * l;
            int lst = (int)(xb_xcc_id() & 7u), tried = 0;
            for (;;) {
                if (tid == 0) {
                    unsigned it = 0xffffffffu;
                    while (tried < 8) { it = __hip_atomic_fetch_add(qbase + 32 * lst, 1u, __ATOMIC_RELAXED, __HIP_MEMORY_SCOPE_AGENT); if (it < (unsigned)MIX_LIST_ITEMS) break; it = 0xffffffffu; lst = (lst + 1) & 7; ++tried; }
                    MISC[16] = it; MISC[17] = (unsigned)lst;
                }
                __syncthreads();
                const unsigned item = MISC[16]; const int li_ = (int)MISC[17];
                __syncthreads();
                if (item == 0xffffffffu) break;
                const int bb = li_ >> 1; const unsigned htab = (li_ & 1) ? 0x0156u : 0x2347u;
                if (item < 16u) { const int hh = (int)((htab >> (4 * (item & 3u))) & 7u), qt = 3 - (int)(item >> 2); ret::ret_unit(lds, ws, bb, hh, gret, 8 * qt, 8 * qt + 8); }
                else { const unsigned a_ = item - 16u; const int hh = (int)((htab >> (4 * (a_ >> 5))) & 7u), qb = 31 - (int)(a_ & 31u);
                    const float wf = (2.0f * Bnd + 28.0f) / (__builtin_amdgcn_exp2f(-(float)(hh + 1)) * LOG2E);
                    att::attn_unit(lds, ws, bb, hh, qb, lam, 1.0f - lam_init, gsub, wf < 8192.f ? (int)wf + 1 : 8192); }
            }
        }
        SEAM(pb + 1);
        if (IN(pb + 2)) {
            unsigned char* const ws = ws_k;
            Epi<1> E; E.ws = ws; E.xin = nullptr; E.xout = nullptr; E.gq = nullptr; E.gk = nullptr;
            SchedP34 S{(const char*)ws, (const char*)(ws + (l == 0 ? WS_WRO : WS_W1)), l == 0 ? (const char*)in_ptr(14) : (const char*)(ws + WS_H), (const char*)(ws + (l == 0 ? WS_WIN0 : WS_WIN)), bx};
            pg8::gemm_phase<Epi<1>, SchedP34, true, true>(lds, DM, S, E);
        }
        SEAM(pb + 2);
        if (IN(pb + 3)) {
            unsigned char* const ws = ws_k;
            Epi<2> E; E.ws = ws; E.xin = (l == 0) ? in_ptr(0) : (const float*)in_ptr(14); E.xout = (float*)in_ptr(14); E.gq = nullptr; E.gk = nullptr;
            SchedG4 S{(const char*)(ws + WS_MBF), (const char*)(ws + (l == 0 ? WS_WRO : WS_W1) + 4 * MiB), bx};
            pg8::gemm_phase<Epi<2>, SchedG4, false, true>(lds, DM, S, E);
        }
        SEAM(pb + 3);
        if (l == 0) {
            if (IN(5)) {
                unsigned char* const ws = ws_k; int lane = lane_k; asm volatile("" : "+v"(lane));
                bf16* H = (bf16*)(ws + WS_H);
                const int gw = vcu * NWAVES + wave, NGW = G * NWAVES;
                const float* x1 = in_ptr(14); const float* g1 = in_ptr(1) + DM;
                for (int m = 4 * gw; m < T; m += 4 * NGW) rms_rows4_to_bf16(x1 + (size_t)m * DM, g1, H + (size_t)m * DM, lane);
                __syncthreads();
            }
            SEAM(5);
        }
    }
#undef IN
#undef SEAM
}

extern "C" void kernel_launch(void* const* d_in, const int* in_sizes, int n_in, void* d_out, int out_size, void* d_ws, size_t ws_size, hipStream_t stream) {
    static int ready = 0;
    if (ready == 0) {
        if (n_in != 14 || ws_size < WS_END || out_size != T * DM) { fprintf(stderr, "kernel_launch: unexpected problem (n_in %d, ws %zu, out %d)\n", n_in, ws_size, out_size); ready = -1; return; }
        if (hipFuncSetAttribute((const void*)mk_fwd, hipFuncAttributeMaxDynamicSharedMemorySize, LDS_BYTES) != hipSuccess) { fprintf(stderr, "kernel_launch: hipFuncSetAttribute failed\n"); ready = -1; return; }
        ready = 1;
    }
    if (ready < 0) return;
    (void)hipMemsetAsync((char*)d_ws + WS_CTL, 0, CTL_ZERO_BYTES, stream);
    Args a{};
    for (int i = 0; i < 14; ++i) a.in[i] = (const float*)d_in[i];
    a.out = (float*)d_out; a.ws = (unsigned char*)d_ws;
    a.ph_lo = 0; a.ph_hi = N_PHASES; a.li = 0;
    hipLaunchKernelGGL(mk_fwd, dim3(256), dim3(NWAVES * 64), LDS_BYTES, stream, a);
}
```

```cpp
#include <hip/hip_runtime.h>
#include <cstdio>
#include <cstdint>
#include <cstddef>

constexpr int DM = 1024, BATCH = 4, SEQ = 4096, DEPTH = 2, T = BATCH * SEQ, NIN = 9216;
constexpr float EPS = 1e-6f;
constexpr float LOG2E = 1.4426950408889634f;

typedef unsigned short bf16;
typedef short bf16x8 __attribute__((ext_vector_type(8)));
typedef float f32x4 __attribute__((ext_vector_type(4)));
typedef unsigned u32x4 __attribute__((ext_vector_type(4)));
#define LAS __attribute__((address_space(3)))
#define GAS __attribute__((address_space(1)))

__device__ __forceinline__ float bf2f(bf16 v) { return __uint_as_float(((unsigned)v) << 16); }
__device__ __forceinline__ unsigned f2bf_u(float f) { unsigned u = __float_as_uint(f); return (u + 0x7fffu + ((u >> 16) & 1u)) >> 16; }
__device__ __forceinline__ bf16 f2bf(float f) { return (bf16)f2bf_u(f); }
__device__ __forceinline__ unsigned pk2(float lo, float hi) { return f2bf_u(lo) | (f2bf_u(hi) << 16); }
typedef float f32x2_t __attribute__((ext_vector_type(2))); typedef __bf16 bf16x2_t __attribute__((ext_vector_type(2)));
__device__ __forceinline__ unsigned cvt_pk_bf16(float lo, float hi) { f32x2_t v = {lo, hi}; bf16x2_t b = __builtin_convertvector(v, bf16x2_t); return __builtin_bit_cast(unsigned, b); }
__device__ __forceinline__ float fast_sigmoid(float v) { return __builtin_amdgcn_rcpf(1.0f + __builtin_amdgcn_exp2f(-v * LOG2E)); }
__device__ __forceinline__ float lo_bf(unsigned w) { return __uint_as_float(w << 16); }
__device__ __forceinline__ float hi_bf(unsigned w) { return __uint_as_float(w & 0xffff0000u); }

constexpr size_t MiB = 1u << 20;
constexpr size_t WS_CTL = 0, CTL_ZERO_BYTES = 64 * 1024;
constexpr size_t WS_WIN = 1 * MiB, WS_WRO = 19 * MiB, WS_WDO = 21 * MiB, WS_WOUT = 23 * MiB;
constexpr size_t WS_H = 25 * MiB, WS_QR = 57 * MiB, WS_KR = 73 * MiB, WS_VR = 89 * MiB, WS_SGR = 121 * MiB, WS_QD = 153 * MiB, WS_KD = 185 * MiB,
                 WS_VD = 217 * MiB, WS_SGD = 249 * MiB;
constexpr size_t WS_WIN0 = WS_H;
constexpr size_t WS_W1 = 281 * MiB;
constexpr size_t WS_END = 287 * MiB;
constexpr size_t WS_MBUF = 57 * MiB;
constexpr size_t WS_MBF = WS_VD;
constexpr size_t WS_SMGR = WS_QD, WS_SMGD = WS_KD;
constexpr int CW_BAR = 4096;

namespace pg8 {
constexpr int BM = 256, BK = 64, HALF = 128, HTB = HALF * BK * 2, STAGE_BYTES = 8 * HTB, NXCD = 8, WGM = 8;
__host__ __device__ __forceinline__ int lds_byte(int r, int c) { const int st = (r >> 4) * 2 + (c >> 5), rr = r & 15, cc = c & 31, ob = rr * 64 + cc * 2; return st * 1024 + (ob ^ (((ob >> 9) & 1) << 5)); }
__host__ __device__ __forceinline__ void stage_rc(int b, int& R, int& C) { const int st = b / 1024, sb = b % 1024, swz = sb ^ (((sb >> 9) & 1) << 5); R = (st >> 1) * 16 + swz / 64; C = (st & 1) * 32 + (swz % 64) / 2; }
__host__ __device__ __forceinline__ int perm32(int rho) { const int n = rho >> 4, i = rho & 15; return 8 * (i >> 2) + 4 * n + (i & 3); }

struct Unit { int pm, pn, kind; const char* a; const char* b; };

__device__ __forceinline__ void tile_of(int L, int nM, int nN, int& pm, int& pn) {
    const int nwg = nM * nN; int wgid = L;
    { const int q = nwg / NXCD, r = nwg % NXCD, xcd = wgid % NXCD, off = wgid / NXCD; wgid = (xcd < r ? xcd * (q + 1) : r * (q + 1) + (xcd - r) * q) + off; }
    const int nig = WGM * nN, gid = wgid / nig, fm = gid * WGM, gsz = (nM - fm) < WGM ? (nM - fm) : WGM;
    pm = fm + ((wgid % nig) % gsz); pn = (wgid % nig) / gsz;
}

template <class Epi, class Sched, bool ALIGN_EPI, bool SP2>
__device__ __forceinline__ void gemm_phase(LAS unsigned char* lds, const int K, const Sched& S, const Epi& E) {
    int tid_ = threadIdx.x; asm volatile("" : "+v"(tid_));
    const int tid = tid_, wid = __builtin_amdgcn_readfirstlane(tid >> 6), lane = tid & 63, wr = wid >> 2, wc = wid & 3, fr = lane & 15, fq = lane >> 4;
    const int nt = K / BK;
    unsigned voffA[2], voffB[2];
#pragma unroll
    for (int i = 0; i < 2; ++i) { int R, C; stage_rc(tid * 16 + i * 8192, R, C); const int Rb = (R >> 5) * 64 + perm32(R & 31);
        voffA[i] = (unsigned)(R * K + C) * 2u; voffB[i] = (unsigned)(Rb * K + C) * 2u; }
    const size_t kstep = (size_t)(BK * 2);
    const size_t hstep = (size_t)HALF * K * 2;
    const size_t hstepB = (size_t)32 * K * 2;
    const unsigned ldsw = (unsigned)wid * 1024u;
    const int aoff = lds_byte(wr * 64 + fr, fq * 8), boff = lds_byte(wc * 32 + fr, fq * 8);
#define PG8_SA(b, h) (((b) * 2 + (h)) * HTB)
#define PG8_SB(b, h) ((4 + (b) * 2 + (h)) * HTB)
#define PG8_STAGE(bufoff, gbase, voff) do { _Pragma("unroll") for (int _i = 0; _i < 2; ++_i) \
        __builtin_amdgcn_global_load_lds((const unsigned*)((const char*)(gbase) + (voff)[_i]), (LAS unsigned*)(lds + (bufoff) + ldsw + _i * 8192), 16, 0, 0); } while (0)
#define PG8_LDA(dst, b, h) do { _Pragma("unroll") for (int m = 0; m < 4; ++m) _Pragma("unroll") for (int k = 0; k < 2; ++k) dst[m][k] = *(const LAS bf16x8*)(lds + PG8_SA(b, h) + aoff + m * 2048 + k * 1024); } while (0)
#define PG8_LDB(dst, b, h) do { _Pragma("unroll") for (int n = 0; n < 2; ++n) _Pragma("unroll") for (int k = 0; k < 2; ++k) dst[n][k] = *(const LAS bf16x8*)(lds + PG8_SB(b, h) + boff + n * 2048 + k * 1024); } while (0)
#define PG8_MMA(ai, bj, At, Bt) do { __builtin_amdgcn_s_setprio(1); _Pragma("unroll") for (int m = 0; m < 4; ++m) _Pragma("unroll") for (int n = 0; n < 2; ++n) _Pragma("unroll") for (int k = 0; k < 2; ++k) \
        acc[ai][bj][m][n] = __builtin_amdgcn_mfma_f32_16x16x32_bf16(Bt[n][k], At[m][k], acc[ai][bj][m][n], 0, 0, 0); __builtin_amdgcn_s_setprio(0); } while (0)
#define PG8_WAIT_V(n) asm volatile("s_waitcnt vmcnt(" #n ")" ::: "memory")
#define PG8_WAIT_L(n) asm volatile("s_waitcnt lgkmcnt(" #n ")" ::: "memory")
#define PG8_BAR __builtin_amdgcn_s_barrier()
#define PG8_SCHED __builtin_amdgcn_sched_barrier(0)
    Unit cur, nxt; int ui = 0;
    if (!S.next(0, cur)) return;
    f32x4 acc[2][2][4][2];
#pragma unroll
    for (int a = 0; a < 2; ++a)
#pragma unroll
        for (int b = 0; b < 2; ++b)
#pragma unroll
            for (int m = 0; m < 4; ++m)
#pragma unroll
                for (int n = 0; n < 2; ++n) acc[a][b][m][n] = (f32x4){0.f, 0.f, 0.f, 0.f};
    bf16x8 At[4][2], B0[2][2], B1[2][2];
    const char* cA = cur.a; const char* cB = cur.b;
    if constexpr (SP2) {
        PG8_STAGE(PG8_SB(0, 0), cB, voffB); PG8_STAGE(PG8_SB(0, 1), cB + hstepB, voffB); PG8_STAGE(PG8_SA(0, 0), cA, voffA); PG8_STAGE(PG8_SA(0, 1), cA + hstep, voffA);
        if (wr == 1) PG8_BAR;
        PG8_WAIT_V(2); PG8_BAR;
        PG8_STAGE(PG8_SB(1, 0), cB + kstep, voffB); PG8_STAGE(PG8_SA(1, 0), cA + kstep, voffA); PG8_STAGE(PG8_SB(1, 1), cB + hstepB + kstep, voffB);
        PG8_WAIT_V(6); PG8_BAR;
    } else {
        PG8_STAGE(PG8_SB(0, 0), cB, voffB); PG8_STAGE(PG8_SA(0, 0), cA, voffA); PG8_STAGE(PG8_SB(0, 1), cB + hstepB, voffB); PG8_STAGE(PG8_SA(0, 1), cA + hstep, voffA);
        if (wr == 1) PG8_BAR;
        PG8_WAIT_V(4); PG8_BAR;
        PG8_STAGE(PG8_SB(1, 0), cB + kstep, voffB); PG8_STAGE(PG8_SA(1, 0), cA + kstep, voffA); PG8_STAGE(PG8_SB(1, 1), cB + hstepB + kstep, voffB);
        PG8_WAIT_V(6); PG8_BAR;
    }
    for (;;) {
        const bool has_next = S.next(ui + 1, nxt);
        const char* nA = has_next ? nxt.a : cA; const char* nB = has_next ? nxt.b : cB;
        for (int t = 0; t < nt; t += 2) {
            const bool last = (t == nt - 2);
            const char* a1 = cA + (size_t)(t + 1) * kstep;
            const char* a2 = last ? nA : cA + (size_t)(t + 2) * kstep; const char* b2 = last ? nB : cB + (size_t)(t + 2) * kstep;
            const char* a3 = a2 + kstep; const char* b3 = b2 + kstep;
            if constexpr (SP2) {
            PG8_LDB(B0, 0, 0); PG8_LDB(B1, 0, 1); PG8_SCHED; PG8_LDA(At, 0, 0); PG8_STAGE(PG8_SA(1, 1), a1 + hstep, voffA);
            PG8_WAIT_V(8); PG8_WAIT_L(0); PG8_BAR; PG8_MMA(0, 0, At, B0); PG8_MMA(0, 1, At, B1); PG8_BAR; PG8_SCHED;
            PG8_LDA(At, 0, 1); PG8_STAGE(PG8_SB(0, 0), b2, voffB); PG8_STAGE(PG8_SB(0, 1), b2 + hstepB, voffB); PG8_STAGE(PG8_SA(0, 0), a2, voffA);
            PG8_WAIT_V(8); PG8_WAIT_L(0); PG8_BAR; PG8_MMA(1, 0, At, B0); PG8_MMA(1, 1, At, B1); PG8_BAR; PG8_SCHED;
            PG8_LDB(B0, 1, 0); PG8_LDB(B1, 1, 1); PG8_SCHED; PG8_LDA(At, 1, 0); PG8_STAGE(PG8_SA(0, 1), a2 + hstep, voffA);
            PG8_WAIT_V(8); PG8_WAIT_L(0); PG8_BAR; PG8_MMA(0, 0, At, B0); PG8_MMA(0, 1, At, B1); PG8_BAR; PG8_SCHED;
            PG8_LDA(At, 1, 1); PG8_STAGE(PG8_SB(1, 0), b3, voffB); PG8_STAGE(PG8_SB(1, 1), b3 + hstepB, voffB); PG8_STAGE(PG8_SA(1, 0), a3, voffA);
            PG8_WAIT_V(8); PG8_WAIT_L(0); PG8_BAR; PG8_MMA(1, 0, At, B0); PG8_MMA(1, 1, At, B1); PG8_BAR; PG8_SCHED;
            } else {
            PG8_LDB(B0, 0, 0); PG8_SCHED; PG8_LDA(At, 0, 0); PG8_STAGE(PG8_SA(1, 1), a1 + hstep, voffA);
            PG8_WAIT_L(8); PG8_BAR; PG8_WAIT_L(0); PG8_MMA(0, 0, At, B0); PG8_BAR; PG8_SCHED;
            PG8_LDB(B1, 0, 1); PG8_STAGE(PG8_SB(0, 0), b2, voffB);
            PG8_BAR; PG8_WAIT_L(0); PG8_MMA(0, 1, At, B1); PG8_BAR;
            PG8_LDA(At, 0, 1); PG8_STAGE(PG8_SA(0, 0), a2, voffA);
            PG8_BAR; PG8_WAIT_L(0); PG8_MMA(1, 0, At, B0); PG8_BAR; PG8_SCHED;
            PG8_STAGE(PG8_SB(0, 1), b2 + hstepB, voffB);
            PG8_WAIT_V(6); PG8_BAR; PG8_MMA(1, 1, At, B1); PG8_BAR;
            PG8_LDB(B0, 1, 0); PG8_SCHED; PG8_LDA(At, 1, 0); PG8_STAGE(PG8_SA(0, 1), a2 + hstep, voffA);
            PG8_WAIT_L(8); PG8_BAR; PG8_WAIT_L(0); PG8_MMA(0, 0, At, B0); PG8_BAR; PG8_SCHED;
            PG8_LDB(B1, 1, 1); PG8_STAGE(PG8_SB(1, 0), b3, voffB);
            PG8_BAR; PG8_WAIT_L(0); PG8_MMA(0, 1, At, B1); PG8_BAR;
            PG8_LDA(At, 1, 1); PG8_STAGE(PG8_SA(1, 0), a3, voffA);
            PG8_BAR; PG8_WAIT_L(0); PG8_MMA(1, 0, At, B0); PG8_BAR; PG8_SCHED;
            PG8_STAGE(PG8_SB(1, 1), b3 + hstepB, voffB);
            PG8_WAIT_V(6); PG8_BAR; PG8_MMA(1, 1, At, B1); PG8_BAR;
            }
        }
        if constexpr (ALIGN_EPI) { if (wr == 0) PG8_BAR; }
        E(acc, cur, wr, wc, fr, fq);
        if (!has_next) break;
#pragma unroll
        for (int a = 0; a < 2; ++a)
#pragma unroll
            for (int b = 0; b < 2; ++b)
#pragma unroll
                for (int m = 0; m < 4; ++m)
#pragma unroll
                    for (int n = 0; n < 2; ++n) acc[a][b][m][n] = (f32x4){0.f, 0.f, 0.f, 0.f};
        cur = nxt; cA = nA; cB = nB; ++ui;
        if constexpr (ALIGN_EPI) { if (wr == 1) PG8_BAR; }
    }
    PG8_WAIT_V(0);
    if constexpr (!ALIGN_EPI) { if (wr == 0) PG8_BAR; }
    PG8_BAR;
#undef PG8_SA
#undef PG8_SB
#undef PG8_STAGE
#undef PG8_LDA
#undef PG8_LDB
#undef PG8_MMA
#undef PG8_WAIT_V
#undef PG8_WAIT_L
#undef PG8_BAR
#undef PG8_SCHED
}
}

enum { K_QR = 0, K_KR, K_VR, K_SGR, K_QD, K_KD, K_VD, K_SGD, K_MGR, K_YR, K_MGD, K_YD, K_OUT };
constexpr size_t TSTEP = (size_t)256 * DM * 2;

template <int PC  > struct Epi {
    unsigned char* ws; const float* xin; float* xout; const float* gq; const float* gk;
    __device__ __forceinline__ static void st8(bf16* p, const f32x4 a, const f32x4 b) {
        u32x4 w; w.x = cvt_pk_bf16(a[0], a[1]); w.y = cvt_pk_bf16(a[2], a[3]); w.z = cvt_pk_bf16(b[0], b[1]); w.w = cvt_pk_bf16(b[2], b[3]); *(u32x4*)p = w; }
    __device__ __forceinline__ void operator()(const f32x4 (&acc)[2][2][4][2], const pg8::Unit& u, int wr, int wc, int fr, int fq) const {
        const int row0 = u.pm * 256 + wr * 64 + fr;
        const int cl = wc * 64 + 8 * fq;
        const int kind = u.kind;
        bf16* const qr = (bf16*)(ws + WS_QR); bf16* const kr = (bf16*)(ws + WS_KR); bf16* const vr = (bf16*)(ws + WS_VR); bf16* const sgr = (bf16*)(ws + WS_SGR);
        bf16* const qd = (bf16*)(ws + WS_QD); bf16* const kd = (bf16*)(ws + WS_KD); bf16* const vd = (bf16*)(ws + WS_VD); bf16* const sgd = (bf16*)(ws + WS_SGD);
        bf16* const smgr = (bf16*)(ws + WS_SMGR); bf16* const smgd = (bf16*)(ws + WS_SMGD); bf16* const mbf = (bf16*)(ws + WS_MBF); float* const mbuf = (float*)(ws + WS_MBUF);
        if (PC == 0 && (kind == K_VR || kind == K_VD)) {
            bf16* base = (kind == K_VR ? vr : vd) + u.pn * 256 + cl;
#pragma unroll
            for (int ai = 0; ai < 2; ++ai)
#pragma unroll
                for (int m = 0; m < 4; ++m) { bf16* rp = base + (size_t)(row0 + ai * 128 + m * 16) * 1024;
#pragma unroll
                    for (int bj = 0; bj < 2; ++bj) st8(rp + 32 * bj, acc[ai][bj][m][0], acc[ai][bj][m][1]); }
        } else if (PC == 0 && (kind == K_SGR || kind == K_SGD)) {
            bf16* base = (kind == K_SGR ? sgr : sgd) + u.pn * 256 + cl;
#pragma unroll
            for (int ai = 0; ai < 2; ++ai)
#pragma unroll
                for (int m = 0; m < 4; ++m) { bf16* rp = base + (size_t)(row0 + ai * 128 + m * 16) * 1024;
#pragma unroll
                    for (int bj = 0; bj < 2; ++bj) { f32x4 a = acc[ai][bj][m][0], b = acc[ai][bj][m][1];
#pragma unroll
                        for (int i = 0; i < 4; ++i) { a[i] = a[i] * fast_sigmoid(a[i]); b[i] = b[i] * fast_sigmoid(b[i]); }
                        st8(rp + 32 * bj, a, b); } }
        } else if (PC == 1 && (kind == K_MGR || kind == K_MGD)) {
            bf16* base = (kind == K_MGR ? smgr : smgd) + u.pn * 256 + cl;
#pragma unroll
            for (int ai = 0; ai < 2; ++ai)
#pragma unroll
                for (int m = 0; m < 4; ++m) { bf16* rp = base + (size_t)(row0 + ai * 128 + m * 16) * 1024;
#pragma unroll
                    for (int bj = 0; bj < 2; ++bj) { f32x4 a = acc[ai][bj][m][0], b = acc[ai][bj][m][1];
#pragma unroll
                        for (int i = 0; i < 4; ++i) { a[i] = fast_sigmoid(a[i]); b[i] = fast_sigmoid(b[i]); }
                        st8(rp + 32 * bj, a, b); } }
        } else if (PC == 0 && (kind == K_QR || kind == K_KR)) {
            const int h = u.pn * 4 + wc; const float lg = __log2f(1.0f - __builtin_amdgcn_exp2f(-5.0f - (float)h));
            bf16* base = (kind == K_QR ? qr : kr) + u.pn * 256 + cl;
            const float sgn = (kind == K_QR) ? lg : -lg, mul = (kind == K_QR) ? 1.0f : 0.125f;
#pragma unroll
            for (int ai = 0; ai < 2; ++ai)
#pragma unroll
                for (int m = 0; m < 4; ++m) { const int row = row0 + ai * 128 + m * 16; bf16* rp = base + (size_t)row * 512;
                    const float f = mul * __builtin_amdgcn_exp2f((float)(row & 127) * sgn);
#pragma unroll
                    for (int bj = 0; bj < 2; ++bj) st8(rp + 32 * bj, acc[ai][bj][m][0] * f, acc[ai][bj][m][1] * f); }
        } else if (PC == 0 && (kind == K_QD || kind == K_KD)) {
            const float* g = (kind == K_QD) ? gq : gk; const float mul = (kind == K_QD) ? 0.125f * LOG2E : 1.0f;
            bf16* base = (kind == K_QD ? qd : kd) + u.pn * 256 + cl;
            f32x4 gv[2][2];
#pragma unroll
            for (int bj = 0; bj < 2; ++bj)
#pragma unroll
                for (int n = 0; n < 2; ++n) gv[bj][n] = *(const f32x4*)(g + 32 * bj + 8 * fq + 4 * n) * mul;
#pragma unroll
            for (int ai = 0; ai < 2; ++ai)
#pragma unroll
                for (int m = 0; m < 4; ++m) { bf16* rp = base + (size_t)(row0 + ai * 128 + m * 16) * 1024;
                    float ss = 0.f;
#pragma unroll
                    for (int bj = 0; bj < 2; ++bj)
#pragma unroll
                        for (int n = 0; n < 2; ++n) { const f32x4 x = acc[ai][bj][m][n]; ss += (x[0] * x[0] + x[1] * x[1]) + (x[2] * x[2] + x[3] * x[3]); }
                    ss += __shfl_xor(ss, 16); ss += __shfl_xor(ss, 32);
                    const float rs = __builtin_amdgcn_rsqf(ss * (1.0f / 64.0f) + EPS);
#pragma unroll
                    for (int bj = 0; bj < 2; ++bj) st8(rp + 32 * bj, acc[ai][bj][m][0] * gv[bj][0] * rs, acc[ai][bj][m][1] * gv[bj][1] * rs); }
        } else if (PC == 1 && kind == K_YR) {
            bf16* const yrb = (bf16*)mbuf + (size_t)u.pn * 256 + cl;
#pragma unroll
            for (int ai = 0; ai < 2; ++ai)
#pragma unroll
                for (int m = 0; m < 4; ++m) { bf16* rp = yrb + (size_t)(row0 + ai * 128 + m * 16) * 1024;
#pragma unroll
                    for (int bj = 0; bj < 2; ++bj) st8(rp + 32 * bj, acc[ai][bj][m][0], acc[ai][bj][m][1]); }
        } else if (PC == 1 && kind == K_YD) {
            const size_t cb = (size_t)u.pn * 256 + cl; const bf16* const yrb = (const bf16*)mbuf;
#pragma unroll
            for (int ai = 0; ai < 2; ++ai)
#pragma unroll
                for (int m = 0; m < 4; ++m) { const size_t ro = (size_t)(row0 + ai * 128 + m * 16) * 1024 + cb;
#pragma unroll
                    for (int bj = 0; bj < 2; ++bj) { const u32x4 sr = *(const u32x4*)(smgr + ro + 32 * bj), sd = *(const u32x4*)(smgd + ro + 32 * bj), yr = *(const u32x4*)(yrb + ro + 32 * bj);
                        const f32x4 a = acc[ai][bj][m][0], b = acc[ai][bj][m][1];
                        f32x4 o0, o1;
                        o0[0] = lo_bf(sr.x) * lo_bf(yr.x) + lo_bf(sd.x) * a[0]; o0[1] = hi_bf(sr.x) * hi_bf(yr.x) + hi_bf(sd.x) * a[1];
                        o0[2] = lo_bf(sr.y) * lo_bf(yr.y) + lo_bf(sd.y) * a[2]; o0[3] = hi_bf(sr.y) * hi_bf(yr.y) + hi_bf(sd.y) * a[3];
                        o1[0] = lo_bf(sr.z) * lo_bf(yr.z) + lo_bf(sd.z) * b[0]; o1[1] = hi_bf(sr.z) * hi_bf(yr.z) + hi_bf(sd.z) * b[1];
                        o1[2] = lo_bf(sr.w) * lo_bf(yr.w) + lo_bf(sd.w) * b[2]; o1[3] = hi_bf(sr.w) * hi_bf(yr.w) + hi_bf(sd.w) * b[3];
                        st8(mbf + ro + 32 * bj, o0, o1); }
                    asm volatile("" ::: "memory"); }
        } else if (PC == 2 && kind == K_OUT) {
            const size_t cb = (size_t)u.pn * 256 + cl;
#pragma unroll
            for (int ai = 0; ai < 2; ++ai) {
                f32x4 pre[4][2][2];
#pragma unroll
                for (int m = 0; m < 4; ++m) { const size_t ro = (size_t)(row0 + ai * 128 + m * 16) * 1024 + cb;
#pragma unroll
                    for (int bj = 0; bj < 2; ++bj) { pre[m][bj][0] = *(const f32x4*)(xin + ro + 32 * bj); pre[m][bj][1] = *(const f32x4*)(xin + ro + 32 * bj + 4); } }
#pragma unroll
                for (int m = 0; m < 4; ++m) { const size_t ro = (size_t)(row0 + ai * 128 + m * 16) * 1024 + cb;
#pragma unroll
                    for (int bj = 0; bj < 2; ++bj) { *(f32x4*)(xout + ro + 32 * bj) = pre[m][bj][0] + acc[ai][bj][m][0]; *(f32x4*)(xout + ro + 32 * bj + 4) = pre[m][bj][1] + acc[ai][bj][m][1]; } }
                asm volatile("" ::: "memory");
            }
        }
    }
};

struct SchedG1A {
    const char* A; const char* B; int G, c;
    __device__ __forceinline__ bool next(int i, pg8::Unit& u) const {
        const int L = i * G + c; if (L >= 64 * 28) return false;
        int pm, pg; pg8::tile_of(L, 64, 28, pm, pg);
        u.pm = pm; u.a = A + (size_t)pm * TSTEP; u.b = B + (size_t)pg * TSTEP;
        if (pg < 2) { u.kind = K_QR; u.pn = pg; } else if (pg < 4) { u.kind = K_KR; u.pn = pg - 2; } else if (pg < 8) { u.kind = K_VR; u.pn = pg - 4; } else if (pg < 12) { u.kind = K_SGR; u.pn = pg - 8; }
        else if (pg < 16) { u.kind = K_QD; u.pn = pg - 12; } else if (pg < 20) { u.kind = K_KD; u.pn = pg - 16; } else if (pg < 24) { u.kind = K_VD; u.pn = pg - 20; } else { u.kind = K_SGD; u.pn = pg - 24; }
        return true;
    }
};
struct SchedP34 {
    const char *ws, *Wro, *H, *Win; int c;
    __device__ __forceinline__ bool next(int i, pg8::Unit& u) const {
        if (i >= 4) return false;
        const char* OR = ws + WS_SGR; const char* OD = ws + WS_SGD; const char* Wdo = Wro + 2 * MiB;
        int pm, pn; pg8::tile_of(c, 64, 4, pm, pn); u.pm = pm; u.pn = pn;
        if (i == 0) { u.kind = K_MGR; u.a = H + (size_t)pm * TSTEP; u.b = Win + (size_t)(28 + pn) * TSTEP; }
        else if (i == 1) { u.kind = K_MGD; u.a = H + (size_t)pm * TSTEP; u.b = Win + (size_t)(32 + pn) * TSTEP; }
        else if (i == 2) { u.kind = K_YR; u.a = OR + (size_t)pm * TSTEP; u.b = Wro + (size_t)pn * TSTEP; }
        else { u.kind = K_YD; u.a = OD + (size_t)pm * TSTEP; u.b = Wdo + (size_t)pn * TSTEP; }
        return true;
    }
};
struct SchedG4 {
    const char *Mb, *Wout; int c;
    __device__ __forceinline__ bool next(int i, pg8::Unit& u) const {
        if (i >= 1) return false;
        int pm, pn; pg8::tile_of(c, 64, 4, pm, pn); u.pm = pm; u.pn = pn; u.kind = K_OUT; u.a = Mb + (size_t)pm * TSTEP; u.b = Wout + (size_t)pn * TSTEP; return true;
    }
};


namespace att {
typedef float f32x16 __attribute__((ext_vector_type(16)));
typedef short s16x4 __attribute__((ext_vector_type(4)));
typedef short v4i16_t __attribute__((ext_vector_type(4)));
constexpr int SLOT_OFF = 65536, SLOT_BYTES = 32768, V_OFF = 16384;
__device__ __forceinline__ int crow(int r, int hi) { return (r & 3) + 8 * (r >> 2) + 4 * hi; }
__device__ __forceinline__ s16x4 vtr(LAS const unsigned char* p) { return __builtin_bit_cast(s16x4, __builtin_amdgcn_ds_read_tr16_b64_v4i16((LAS v4i16_t*)p)); }
#define ATT_MFMA(a, b, c) __builtin_amdgcn_mfma_f32_32x32x16_bf16(a, b, c, 0, 0, 0)

__device__ __forceinline__ void attn_unit(LAS unsigned char* lds, const unsigned char* ws, const int b, const int h, const int qb, const float lam, const float omli, const float* __restrict__ gsub, const int win) {
    int tid_ = threadIdx.x; asm volatile("" : "+v"(tid_));
    const int tid = tid_, lane = tid & 63, r32 = lane & 31, hi = lane >> 5, w = __builtin_amdgcn_readfirstlane(tid >> 6), rg = w & 3, kg = w >> 2;
    const bf16* QD = (const bf16*)(ws + WS_QD); const bf16* KD = (const bf16*)(ws + WS_KD); const bf16* VD = (const bf16*)(ws + WS_VD); bf16* SGD = (bf16*)(ws + WS_SGD);
    const size_t tb = (size_t)b * SEQ; const int q0 = qb * 128, NT = (q0 + 128) / 64;
    const int T0 = (q0 > win ? q0 - win : 0) >> 6;
#pragma unroll
    for (int k = 0; k < 4; ++k) { const int p = 4 * kg + k; const bf16* src = QD + (tb + q0 + 32 * rg + r32) * 1024 + h * 128 + (p >> 2) * 64 + (p & 3) * 16 + hi * 8;
        __builtin_amdgcn_global_load_lds((const unsigned*)src, (LAS unsigned*)(lds + rg * 8192 + p * 1024), 16, 0, 0); }
    const bf16* ksrc = KD + (tb + lane) * 1024 + h * 128 + (w & 7) * 8;
    const bf16* vsrc = VD + (tb + 16 * (w & 3) + (lane >> 2)) * 1024 + h * 128 + (w >> 2) * 32 + (lane & 3) * 8;
#define ATT_STAGE(t, slot) do { _Pragma("unroll") for (int rr = 0; rr < 2; ++rr) { \
        __builtin_amdgcn_global_load_lds((const unsigned*)(ksrc + (size_t)(t) * 65536 + rr * 64), (LAS unsigned*)(lds + SLOT_OFF + (slot) * SLOT_BYTES + (rr * 8 + w) * 1024), 16, 0, 0); \
        __builtin_amdgcn_global_load_lds((const unsigned*)(vsrc + (size_t)(t) * 65536 + rr * 64), (LAS unsigned*)(lds + SLOT_OFF + (slot) * SLOT_BYTES + V_OFF + (rr * 8 + w) * 1024), 16, 0, 0); } } while (0)
    ATT_STAGE(T0, 0);
    __syncthreads();
    const float slope = __builtin_amdgcn_exp2f(-(float)(h + 1)) * LOG2E;
    const int n = q0 + 32 * rg + r32;
    f32x16 O[2][4];
#pragma unroll
    for (int j = 0; j < 2; ++j)
#pragma unroll
        for (int e = 0; e < 4; ++e)
#pragma unroll
            for (int r = 0; r < 16; ++r) O[j][e][r] = 0.f;
    float lsum[2] = {0.f, 0.f};
    const int qoff = rg * 8192 + lane * 16;
    const int koff = hi * 1024 + (32 * kg + r32) * 16;
    const int voff = V_OFF + 2 * kg * 1024 + ((lane >> 4) & 1) * 32 + (lane & 3) * 8 + (4 * hi + ((lane & 15) >> 2)) * 64;
    for (int t = T0; t < NT; ++t) {
        if (t + 1 < NT) ATT_STAGE(t + 1, (t + 1 - T0) & 1);
        const int k0 = t * 64 + 32 * kg;
        if (k0 <= q0 + 32 * rg + 31) {
            LAS const unsigned char* slot = lds + SLOT_OFF + ((t - T0) & 1) * SLOT_BYTES;
            float sl = slope; asm volatile("" : "+v"(sl));
            const int dn = n - k0 - 4 * hi; const float base = -sl * (float)dn;
            const bool diag = (k0 + 31 > q0 + 32 * rg);
            f32x16 pA, pB;
#pragma unroll
            for (int r = 0; r < 16; ++r) { const int kc = (r & 3) + 8 * (r >> 2); pA[r] = __builtin_fmaf(sl, (float)kc, base); }
            if (diag) {
#pragma unroll
                for (int r = 0; r < 16; ++r) { const int kc = (r & 3) + 8 * (r >> 2); if (kc > dn) pA[r] = -INFINITY; }
            }
            pB = pA;
#pragma unroll
            for (int d0 = 0; d0 < 4; ++d0) {
                const bf16x8 kfa = *(LAS const bf16x8*)(slot + koff + (2 * d0) * 1024), kfb = *(LAS const bf16x8*)(slot + koff + (8 + 2 * d0) * 1024);
                const bf16x8 qfa = *(LAS const bf16x8*)(lds + qoff + d0 * 1024), qfb = *(LAS const bf16x8*)(lds + qoff + (4 + d0) * 1024);
                pA = ATT_MFMA(kfa, qfa, pA); pB = ATT_MFMA(kfb, qfb, pB);
            }
            bf16x8 vf[4][2];
#pragma unroll
            for (int eb = 0; eb < 4; ++eb)
#pragma unroll
                for (int ks = 0; ks < 2; ++ks) { const s16x4 vlo = vtr(slot + voff + eb * 4096 + ks * 1024), vhi = vtr(slot + voff + eb * 4096 + ks * 1024 + 512);
                    vf[eb][ks] = (bf16x8){vlo[0], vlo[1], vlo[2], vlo[3], vhi[0], vhi[1], vhi[2], vhi[3]}; }
            u32x4 pwA[2], pwB[2];
            { float s = 0.f;
#pragma unroll
              for (int r = 0; r < 16; ++r) { pA[r] = __builtin_amdgcn_exp2f(pA[r]); s += pA[r]; }
              lsum[0] += s;
#pragma unroll
              for (int i = 0; i < 4; ++i) { pwA[0][i] = cvt_pk_bf16(pA[2 * i], pA[2 * i + 1]); pwA[1][i] = cvt_pk_bf16(pA[8 + 2 * i], pA[9 + 2 * i]); } }
            { float s = 0.f;
#pragma unroll
              for (int r = 0; r < 16; ++r) { pB[r] = __builtin_amdgcn_exp2f(pB[r]); s += pB[r]; }
              lsum[1] += s;
#pragma unroll
              for (int i = 0; i < 4; ++i) { pwB[0][i] = cvt_pk_bf16(pB[2 * i], pB[2 * i + 1]); pwB[1][i] = cvt_pk_bf16(pB[8 + 2 * i], pB[9 + 2 * i]); } }
#pragma unroll
            for (int eb = 0; eb < 4; ++eb)
#pragma unroll
                for (int ks = 0; ks < 2; ++ks) {
                    O[0][eb] = ATT_MFMA(vf[eb][ks], __builtin_bit_cast(bf16x8, pwA[ks]), O[0][eb]);
                    O[1][eb] = ATT_MFMA(vf[eb][ks], __builtin_bit_cast(bf16x8, pwB[ks]), O[1][eb]);
                }
        }
        __syncthreads();
    }
    lsum[0] += __shfl_xor(lsum[0], 32); lsum[1] += __shfl_xor(lsum[1], 32);
    LAS float* dump = (LAS float*)(lds + rg * 32768);
    LAS float* lx = (LAS float*)(lds + 131072 + rg * 1024);
    if (kg == 1) {
#pragma unroll
        for (int j = 0; j < 2; ++j)
#pragma unroll
            for (int eb = 0; eb < 4; ++eb)
#pragma unroll
                for (int r = 0; r < 16; ++r) dump[((j * 4 + eb) * 16 + r) * 64 + lane] = O[j][eb][r];
        lx[lane] = lsum[0]; lx[64 + lane] = lsum[1];
    }
    asm volatile("s_waitcnt lgkmcnt(0)" ::: "memory");
    __syncthreads();
    if (kg == 0) {
#pragma unroll
        for (int j = 0; j < 2; ++j)
#pragma unroll
            for (int eb = 0; eb < 4; ++eb)
                {
#pragma unroll
                  for (int r = 0; r < 16; ++r) O[j][eb][r] += dump[((j * 4 + eb) * 16 + r) * 64 + lane];
                  asm volatile("s_waitcnt lgkmcnt(0)" : "+v"(O[j][eb]) :: "memory"); }
        lsum[0] += lx[lane]; lsum[1] += lx[64 + lane];
        asm volatile("s_waitcnt lgkmcnt(0)" ::: "memory");
        int r32e = r32; asm volatile("" : "+v"(r32e));
        const float i0 = 1.0f / lsum[0], i1 = lam / lsum[1];
        float ss = 0.f;
#pragma unroll
        for (int eb = 0; eb < 4; ++eb)
#pragma unroll
            for (int r = 0; r < 16; ++r) { const float o = O[0][eb][r] * i0 - O[1][eb][r] * i1; O[0][eb][r] = o; ss += o * o; }
        ss += __shfl_xor(ss, 32);
        const float rs = __builtin_amdgcn_rsqf(ss * (1.0f / 128.0f) + EPS) * omli;
        bf16* rowp = SGD + (tb + q0 + 32 * rg + r32e) * 1024 + h * 128 + 4 * hi;
        const float* gp = gsub + h * 128 + 4 * hi;
#pragma unroll
        for (int eb = 0; eb < 4; ++eb) {
            unsigned long long gt[4];
#pragma unroll
            for (int g = 0; g < 4; ++g) gt[g] = *(const unsigned long long*)(rowp + 32 * eb + 8 * g);
#pragma unroll
            for (int g = 0; g < 4; ++g) { const f32x4 gg = *(const f32x4*)(gp + 32 * eb + 8 * g); const unsigned glo = (unsigned)gt[g], ghi = (unsigned)(gt[g] >> 32);
                const unsigned w0 = cvt_pk_bf16(O[0][eb][4 * g] * rs * gg[0] * lo_bf(glo), O[0][eb][4 * g + 1] * rs * gg[1] * hi_bf(glo));
                const unsigned w1 = cvt_pk_bf16(O[0][eb][4 * g + 2] * rs * gg[2] * lo_bf(ghi), O[0][eb][4 * g + 3] * rs * gg[3] * hi_bf(ghi));
                *(unsigned long long*)(rowp + 32 * eb + 8 * g) = (unsigned long long)w0 | ((unsigned long long)w1 << 32); }
            asm volatile("" ::: "memory");
        }
    }
    asm volatile("s_waitcnt lgkmcnt(0)" ::: "memory");
    __syncthreads();
#undef ATT_STAGE
}
}

namespace ret {
using att::f32x16; using att::s16x4; using att::crow; using att::vtr;
constexpr int SET = 49152, KT = 0, VI = 16384, OST = 98304, ST = 131072, RED = 147456;
__device__ __forceinline__ void ret_unit(LAS unsigned char* lds, const unsigned char* ws, const int b, const int h, const float* __restrict__ gn, const int c0, const int c1) {
    int tid_ = threadIdx.x; asm volatile("" : "+v"(tid_));
    const int tid = tid_, lane = tid & 63, r32 = lane & 31, hi = lane >> 5, w = __builtin_amdgcn_readfirstlane(tid >> 6);
    const int ib = w & 3, eh = w >> 2, dh = w & 1, ebo = w >> 1;
    const bf16* QR = (const bf16*)(ws + WS_QR); const bf16* KR = (const bf16*)(ws + WS_KR); const bf16* VR = (const bf16*)(ws + WS_VR); bf16* SGR = (bf16*)(ws + WS_SGR);
    const size_t tb = (size_t)b * SEQ;
    const float lg = __log2f(1.0f - __builtin_amdgcn_exp2f(-5.0f - (float)h)), gC = __builtin_amdgcn_exp2f(128.0f * lg);
    for (int i = tid; i < 16384 / 16; i += 512) *(LAS u32x4*)(lds + ST + i * 16) = (u32x4){0u, 0u, 0u, 0u};
    f32x16 sblk;
#pragma unroll
    for (int r = 0; r < 16; ++r) sblk[r] = 0.f;
    const int vpat = ((lane >> 4) & 1) * 32 + (lane & 3) * 8 + (4 * hi + ((lane & 15) >> 2)) * 64;
    const int prow = tid >> 4, pcol = (tid & 15) * 8;
    f32x4 gA = *(const f32x4*)(gn + h * 128 + pcol), gB = *(const f32x4*)(gn + h * 128 + pcol + 4);
#define RET_STAGE(c, s) do { const size_t t0_ = tb + (size_t)(c) * 128; LAS unsigned char* sb_ = lds + (s) * SET; \
        _Pragma("unroll") for (int k = 0; k < 2; ++k) { const int p = 2 * w + k, d2 = p >> 3, kg = p & 7; \
            __builtin_amdgcn_global_load_lds((const unsigned*)(KR + (t0_ + 16 * kg + (lane >> 2)) * 512 + h * 64 + d2 * 32 + (lane & 3) * 8), (LAS unsigned*)(sb_ + KT + p * 1024), 16, 0, 0); } \
        _Pragma("unroll") for (int k = 0; k < 4; ++k) { const int p = 4 * w + k, eg = p >> 3, kg = p & 7; \
            __builtin_amdgcn_global_load_lds((const unsigned*)(VR + (t0_ + 16 * kg + (lane >> 2)) * 1024 + h * 128 + eg * 32 + (lane & 3) * 8), (LAS unsigned*)(sb_ + VI + p * 1024), 16, 0, 0); } } while (0)
    if (c0 > 0) {
        RET_STAGE(0, 0);
        for (int c = 0; c < c0; ++c) {
            __syncthreads();
            if (c + 1 < c0) RET_STAGE(c + 1, (c + 1) & 1);
            LAS const unsigned char* sb = lds + (c & 1) * SET;
            f32x16 kv;
#pragma unroll
            for (int r = 0; r < 16; ++r) kv[r] = 0.f;
#pragma unroll
            for (int ks = 0; ks < 8; ++ks) { LAS const unsigned char* kp = sb + KT + dh * 8192 + ks * 1024 + vpat; LAS const unsigned char* vp = sb + VI + ebo * 8192 + ks * 1024 + vpat;
                const s16x4 klo = vtr(kp), khi = vtr(kp + 512), vlo = vtr(vp), vhi = vtr(vp + 512);
                kv = ATT_MFMA(((bf16x8){klo[0], klo[1], klo[2], klo[3], khi[0], khi[1], khi[2], khi[3]}), ((bf16x8){vlo[0], vlo[1], vlo[2], vlo[3], vhi[0], vhi[1], vhi[2], vhi[3]}), kv); }
#pragma unroll
            for (int r = 0; r < 16; ++r) sblk[r] = gC * (sblk[r] + kv[r]);
        }
        __syncthreads();
#pragma unroll
        for (int g = 0; g < 4; ++g) { unsigned long long v = (unsigned long long)cvt_pk_bf16(sblk[4 * g], sblk[4 * g + 1]) | ((unsigned long long)cvt_pk_bf16(sblk[4 * g + 2], sblk[4 * g + 3]) << 32);
            *(LAS unsigned long long*)(lds + ST + (32 * ebo + r32) * 128 + (32 * dh + 8 * g + 4 * hi) * 2) = v; }
    }
    RET_STAGE(c0, c0 & 1);
    bf16x8 qn[4];
#pragma unroll
    for (int d0 = 0; d0 < 4; ++d0) qn[d0] = *(const bf16x8*)(QR + (tb + (size_t)c0 * 128 + 32 * ib + r32) * 512 + h * 64 + d0 * 16 + hi * 8);
    for (int c = c0; c < c1; ++c) {
        const size_t t0 = tb + (size_t)c * 128;
        __syncthreads();
        LAS const unsigned char* sb = lds + (c & 1) * SET;
        u32x4 gt[4];
#pragma unroll
        for (int k = 0; k < 4; ++k) gt[k] = *(const u32x4*)(SGR + (t0 + prow + 32 * k) * 1024 + h * 128 + pcol);
        bf16x8 qf[4];
#pragma unroll
        for (int d0 = 0; d0 < 4; ++d0) qf[d0] = qn[d0];
        if (c + 1 < c1) { RET_STAGE(c + 1, (c + 1) & 1);
#pragma unroll
            for (int d0 = 0; d0 < 4; ++d0) qn[d0] = *(const bf16x8*)(QR + (t0 + 128 + 32 * ib + r32) * 512 + h * 64 + d0 * 16 + hi * 8); }
        f32x16 O[2];
#pragma unroll
        for (int eb = 0; eb < 2; ++eb)
#pragma unroll
            for (int r = 0; r < 16; ++r) O[eb][r] = 0.f;
#pragma unroll
        for (int jb = 0; jb < 4; ++jb) {
            if (jb <= ib) {
                f32x16 s;
#pragma unroll
                for (int r = 0; r < 16; ++r) s[r] = 0.f;
#pragma unroll
                for (int d0 = 0; d0 < 4; ++d0) { const bf16x8 kf = *(LAS const bf16x8*)(sb + KT + (d0 >> 1) * 8192 + (32 * jb + r32) * 64 + ((d0 & 1) * 16 + 8 * hi) * 2); s = ATT_MFMA(kf, qf[d0], s); }
                if (jb == ib) {
#pragma unroll
                    for (int r = 0; r < 16; ++r) if (crow(r, hi) > r32) s[r] = 0.f;
                }
                u32x4 pw[2];
#pragma unroll
                for (int i = 0; i < 4; ++i) { pw[0][i] = cvt_pk_bf16(s[2 * i], s[2 * i + 1]); pw[1][i] = cvt_pk_bf16(s[8 + 2 * i], s[9 + 2 * i]); }
#pragma unroll
                for (int eb = 0; eb < 2; ++eb)
#pragma unroll
                    for (int ks = 0; ks < 2; ++ks) { LAS const unsigned char* vp = sb + VI + (2 * eh + eb) * 8192 + (2 * jb + ks) * 1024 + vpat;
                        const s16x4 vlo = vtr(vp), vhi = vtr(vp + 512);
                        O[eb] = ATT_MFMA(((bf16x8){vlo[0], vlo[1], vlo[2], vlo[3], vhi[0], vhi[1], vhi[2], vhi[3]}), __builtin_bit_cast(bf16x8, pw[ks]), O[eb]); }
            }
        }
#pragma unroll
        for (int eb = 0; eb < 2; ++eb)
#pragma unroll
            for (int d0 = 0; d0 < 4; ++d0) { const bf16x8 sf = *(LAS const bf16x8*)(lds + ST + (32 * (2 * eh + eb) + r32) * 128 + (16 * d0 + 8 * hi) * 2); O[eb] = ATT_MFMA(sf, qf[d0], O[eb]); }
        { f32x16 kv;
#pragma unroll
          for (int r = 0; r < 16; ++r) kv[r] = 0.f;
#pragma unroll
          for (int ks = 0; ks < 8; ++ks) { LAS const unsigned char* kp = sb + KT + dh * 8192 + ks * 1024 + vpat; LAS const unsigned char* vp = sb + VI + ebo * 8192 + ks * 1024 + vpat;
              const s16x4 klo = vtr(kp), khi = vtr(kp + 512), vlo = vtr(vp), vhi = vtr(vp + 512);
              kv = ATT_MFMA(((bf16x8){klo[0], klo[1], klo[2], klo[3], khi[0], khi[1], khi[2], khi[3]}), ((bf16x8){vlo[0], vlo[1], vlo[2], vlo[3], vhi[0], vhi[1], vhi[2], vhi[3]}), kv); }
#pragma unroll
          for (int r = 0; r < 16; ++r) sblk[r] = gC * (sblk[r] + kv[r]); }
        { float s2 = 0.f;
#pragma unroll
          for (int eb = 0; eb < 2; ++eb)
#pragma unroll
              for (int r = 0; r < 16; ++r) s2 += O[eb][r] * O[eb][r];
          s2 += __shfl_xor(s2, 32);
          if (hi == 0) ((LAS float*)(lds + RED))[(32 * ib + r32) * 2 + eh] = s2; }
#pragma unroll
        for (int eb = 0; eb < 2; ++eb)
#pragma unroll
            for (int g = 0; g < 4; ++g) *(LAS unsigned long long*)(lds + OST + (32 * ib + r32) * 256 + (64 * eh + 32 * eb + 8 * g + 4 * hi) * 2) =
                (unsigned long long)cvt_pk_bf16(O[eb][4 * g], O[eb][4 * g + 1]) | ((unsigned long long)cvt_pk_bf16(O[eb][4 * g + 2], O[eb][4 * g + 3]) << 32);
        asm volatile("s_waitcnt lgkmcnt(0)" ::: "memory"); __builtin_amdgcn_s_barrier(); asm volatile("" ::: "memory");
#pragma unroll
        for (int g = 0; g < 4; ++g) { unsigned long long v = (unsigned long long)cvt_pk_bf16(sblk[4 * g], sblk[4 * g + 1]) | ((unsigned long long)cvt_pk_bf16(sblk[4 * g + 2], sblk[4 * g + 3]) << 32);
            *(LAS unsigned long long*)(lds + ST + (32 * ebo + r32) * 128 + (32 * dh + 8 * g + 4 * hi) * 2) = v; }
#pragma unroll
        for (int k = 0; k < 4; ++k) { const int row = prow + 32 * k; const LAS float* rp = (const LAS float*)(lds + RED) + row * 2;
            const float rs = __builtin_amdgcn_rsqf((rp[0] + rp[1]) * (1.0f / 128.0f) + EPS);
            const u32x4 ov = *(LAS const u32x4*)(lds + OST + row * 256 + pcol * 2); const u32x4 gg = gt[k];
            u32x4 res;
            res.x = cvt_pk_bf16(lo_bf(ov.x) * rs * gA[0] * lo_bf(gg.x), hi_bf(ov.x) * rs * gA[1] * hi_bf(gg.x));
            res.y = cvt_pk_bf16(lo_bf(ov.y) * rs * gA[2] * lo_bf(gg.y), hi_bf(ov.y) * rs * gA[3] * hi_bf(gg.y));
            res.z = cvt_pk_bf16(lo_bf(ov.z) * rs * gB[0] * lo_bf(gg.z), hi_bf(ov.z) * rs * gB[1] * hi_bf(gg.z));
            res.w = cvt_pk_bf16(lo_bf(ov.w) * rs * gB[2] * lo_bf(gg.w), hi_bf(ov.w) * rs * gB[3] * hi_bf(gg.w));
            *(u32x4*)(SGR + (t0 + row) * 1024 + h * 128 + pcol) = res; }
    }
    __syncthreads();
#undef RET_STAGE
}
}

constexpr int MIX_LIST_ITEMS = 16 + 4 * 32;
constexpr int CW_QUEUE = 2048;

#define XB_TMO      128
#define XB_XCNT(j)  (256  + 64 * (j))
#define XB_XSUB(j)  (1280 + 64 * (j))
#define XB_XGEN(j)  (2304 + 64 * (j))
#define XB_TOP      3328
#define XB_TOPGEN   3392
#define XCD_BAR_WORDS 3456
#define XB_SPIN_CAP (1u << 18)
__device__ __forceinline__ unsigned xb_ld(unsigned* p)              { return __hip_atomic_load(p, __ATOMIC_RELAXED, __HIP_MEMORY_SCOPE_AGENT); }
__device__ __forceinline__ unsigned xb_add(unsigned* p, unsigned v) { return __hip_atomic_fetch_add(p, v, __ATOMIC_RELAXED, __HIP_MEMORY_SCOPE_AGENT); }
__device__ __forceinline__ unsigned xb_xcc_id() { return (unsigned)__builtin_amdgcn_s_getreg((3 << 11) | 20) & 0xFu; }
#define XB_SPIN(cond, bar) do { unsigned _sp = 0; while (cond) { __builtin_amdgcn_s_sleep(1); \
    if ((++_sp & 255u) == 0u) { if (xb_ld(&(bar)[XB_TMO])) break; if (_sp > XB_SPIN_CAP) { atomicAdd(&(bar)[XB_TMO], 1u); break; } } } } while (0)
struct XcdBarrier { unsigned* bar; unsigned x; volatile LAS unsigned* st; };
__device__ __forceinline__ XcdBarrier xcd_barrier_post(unsigned* bar, volatile LAS unsigned* st) {
    XcdBarrier b; b.bar = bar; b.x = xb_xcc_id(); b.st = st;
    if (threadIdx.x == 0) (void)xb_add(&bar[XB_XCNT(b.x)], 1u);
    return b;
}
__device__ __forceinline__ void xcd_barrier_complete(unsigned* bar, unsigned x, unsigned& nloc, unsigned& nx) {
    const unsigned G = gridDim.x * gridDim.y * gridDim.z;
    unsigned sum, cnt, mine, sp = 0u;
    for (;;) {
        sum = 0u; cnt = 0u; mine = 0u;
#pragma unroll
        for (unsigned j = 0; j < 16; ++j) { const unsigned c = xb_ld(&bar[XB_XCNT(j)]); sum += c; cnt += (c > 0u) ? 1u : 0u; mine = (j == x) ? c : mine; }
        if (sum == G) break;
        __builtin_amdgcn_s_sleep(1);
        if ((++sp & 255u) == 0u) { if (xb_ld(&bar[XB_TMO])) break; if (sp > XB_SPIN_CAP) { atomicAdd(&bar[XB_TMO], 1u); break; } }
    }
    nloc = mine > 0u ? mine : 1u; nx = cnt > 0u ? cnt : 1u;
}
__device__ __forceinline__ void xcd_barrier(const XcdBarrier& b) {
    asm volatile("s_waitcnt vmcnt(0)" ::: "memory");
    __syncthreads();
    if (threadIdx.x == 0) {
        unsigned* bar = b.bar;
        __builtin_amdgcn_s_waitcnt(0);
        unsigned nloc = b.st[0], nx = b.st[1];
        if (nloc == 0u) { xcd_barrier_complete(bar, b.x, nloc, nx); b.st[0] = nloc; b.st[1] = nx; }
        const unsigned old = xb_add(&bar[XB_XSUB(b.x)], 1u);
        const unsigned gen = old / nloc;
        if (old + 1u == (gen + 1u) * nloc) {
            __builtin_amdgcn_fence(__ATOMIC_RELEASE, "agent");
            asm volatile("s_waitcnt vmcnt(0)" ::: "memory");
            const unsigned og = xb_add(&bar[XB_TOP], 1u);
            const unsigned tg = og / nx;
            if (og + 1u == (tg + 1u) * nx) xb_add(&bar[XB_TOPGEN], 1u);
            else XB_SPIN(xb_ld(&bar[XB_TOPGEN]) == tg, bar);
            __builtin_amdgcn_fence(__ATOMIC_ACQUIRE, "agent");
            xb_add(&bar[XB_XGEN(b.x)], 1u);
            asm volatile("s_waitcnt vmcnt(0)" ::: "memory");
        } else {
            XB_SPIN(xb_ld(&bar[XB_XGEN(b.x)]) == gen, bar);
            __builtin_amdgcn_fence(__ATOMIC_ACQUIRE, "agent");
            asm volatile("s_waitcnt vmcnt(0)" ::: "memory");
        }
    }
    __syncthreads();
}

#define LDS_WAIT() asm volatile("s_waitcnt lgkmcnt(0)" ::: "memory")
__device__ __forceinline__ float wave_sum(float v) {
#pragma unroll
    for (int o = 1; o < 64; o <<= 1) v += __shfl_xor(v, o);
    return v;
}
constexpr int P0_SCR_BYTES = 64 * 65 * 4;
__device__ __forceinline__ void p0_transpose_item(const float* W, int K, int N, bf16* WT, LAS float* scr, int item, int lane) {
    const int nblk = N / 64, kb = item / nblk, nb = item % nblk, k0 = 64 * kb, n0 = 64 * nb;
    const int lr = lane >> 4, lc = (lane & 15) * 4;
    const GAS f32x4* src = (const GAS f32x4*)(W + (size_t)(k0 + lr) * N + n0 + lc);
    f32x4 v[16];
#pragma unroll
    for (int i = 0; i < 16; ++i) v[i] = src[(size_t)i * N];
#pragma unroll
    for (int i = 0; i < 16; ++i) { LAS float* d = scr + (4 * i + lr) * 65 + lc; d[0] = v[i].x; d[1] = v[i].y; d[2] = v[i].z; d[3] = v[i].w; }
    LDS_WAIT(); asm volatile("" ::: "memory");
    const int c = lane & 7;
#pragma unroll
    for (int j = 0; j < 8; ++j) { const int n = (lane >> 3) + 8 * j; const LAS float* q = scr + (8 * c) * 65 + n;
        u32x4 o; o.x = pk2(q[0 * 65], q[1 * 65]); o.y = pk2(q[2 * 65], q[3 * 65]); o.z = pk2(q[4 * 65], q[5 * 65]); o.w = pk2(q[6 * 65], q[7 * 65]);
        *(GAS u32x4*)(WT + (size_t)(n0 + n) * K + k0 + 8 * c) = o; }
    LDS_WAIT(); asm volatile("" ::: "memory");
}
__device__ __forceinline__ void rms_rows4_to_bf16(const float* xrow, const float* g, bf16* orow, int lane) {
    const GAS f32x4* xr = (const GAS f32x4*)xrow + lane; const GAS f32x4* gr = (const GAS f32x4*)g + lane;
    f32x4 v[4][4];
#pragma unroll
    for (int r = 0; r < 4; ++r)
#pragma unroll
        for (int j = 0; j < 4; ++j) v[r][j] = xr[256 * r + 64 * j];
    f32x4 gg[4];
#pragma unroll
    for (int j = 0; j < 4; ++j) gg[j] = gr[64 * j];
    GAS unsigned long long* o8 = (GAS unsigned long long*)orow + lane;
#pragma unroll
    for (int r = 0; r < 4; ++r) { float s = 0.f;
#pragma unroll
        for (int j = 0; j < 4; ++j) s += (v[r][j].x * v[r][j].x + v[r][j].y * v[r][j].y) + (v[r][j].z * v[r][j].z + v[r][j].w * v[r][j].w);
        const float rs = 1.0f / sqrtf(wave_sum(s) * (1.f / DM) + EPS);
#pragma unroll
        for (int j = 0; j < 4; ++j)
            o8[256 * r + 64 * j] = (unsigned long long)pk2(v[r][j].x * rs * gg[j].x, v[r][j].y * rs * gg[j].y) | ((unsigned long long)pk2(v[r][j].z * rs * gg[j].z, v[r][j].w * rs * gg[j].w) << 32); }
}

__device__ __forceinline__ const float* in_ptr(int k) {
    typedef __attribute__((address_space(4))) const char* cptr4;
    cptr4 ka = (cptr4)__builtin_amdgcn_kernarg_segment_ptr(); cptr4 kb;
    asm volatile("s_mov_b64 %0, %1" : "=s"(kb) : "s"(ka));
    typedef const float* cfp; typedef __attribute__((address_space(4))) const cfp* cfp4;
    return *(cfp4)(kb + k * 8);
}
constexpr int NWAVES = 8;
constexpr int RING_BYTES = 131072, LDS_BYTES = 163840, LDSCTL_OFF = LDS_BYTES - 1024, MISC_OFF = LDSCTL_OFF + 320;
struct Args { const float* in[14]; float* out; unsigned char* ws; int ph_lo, ph_hi, li, pad; };
constexpr int N_PHASES = 10;

__global__ void __launch_bounds__(NWAVES * 64, 2) mk_fwd(Args args) {
    extern __shared__ __attribute__((aligned(16))) unsigned char lds_raw[];
    LAS unsigned char* lds = (LAS unsigned char*)lds_raw;
    volatile LAS unsigned* MISC = (volatile LAS unsigned*)(lds + MISC_OFF);
    const int tid = threadIdx.x, lane_k = tid & 63, wave = __builtin_amdgcn_readfirstlane(tid >> 6);
    const int G = gridDim.x, bx = blockIdx.x; const int vcu = (G % 8 == 0) ? (bx % 8) * (G / 8) + bx / 8 : bx;
    unsigned char* const ws_k = (unsigned char*)in_ptr(15);
    unsigned* ctl = (unsigned*)(ws_k + WS_CTL);
    for (int u = tid; u < (LDS_BYTES - LDSCTL_OFF) / 4; u += NWAVES * 64) ((LAS unsigned*)(lds + LDSCTL_OFF))[u] = 0u;
    __syncthreads();
    const int lo = args.ph_lo, hi = args.ph_hi;
    XcdBarrier bar; bar.bar = ctl + CW_BAR + args.li * XCD_BAR_WORDS; bar.x = 0; bar.st = nullptr;
    if (hi - lo > 1) bar = xcd_barrier_post(ctl + CW_BAR + args.li * XCD_BAR_WORDS, MISC + 8);
#define IN(k) (lo <= (k) && (k) < hi)
#define SEAM(k) do { if (IN(k) && IN((k) + 1)) xcd_barrier(bar); } while (0)

    if (IN(0)) {
        unsigned char* const ws = ws_k; int lane = lane_k; asm volatile("" : "+v"(lane));
        LAS float* scr = (LAS float*)(lds + wave * P0_SCR_BYTES);
        const int gw = vcu * NWAVES + wave, NGW = G * NWAVES;
        constexpr int I_IN = (DM / 64) * (NIN / 64), I_SQ = (DM / 64) * (DM / 64);
        for (int it = gw; it < 2 * I_IN + 6 * I_SQ; it += NGW) {
            int r = it;
            if (r < 2 * I_IN) { const int l = r / I_IN; p0_transpose_item(in_ptr(2) + (size_t)l * DM * NIN, DM, NIN, (bf16*)(ws + (l == 0 ? WS_WIN0 : WS_WIN)), scr, r % I_IN, lane); continue; } r -= 2 * I_IN;
            const int which = r / I_SQ, item = r % I_SQ, l = which / 3, w = which % 3;
            const float* src = (w == 0 ? in_ptr(4) : w == 1 ? in_ptr(12) : in_ptr(13)) + (size_t)l * DM * DM;
            bf16* dst = (bf16*)(ws + (l == 0 ? WS_WRO : WS_W1) + (size_t)w * 2 * MiB);
            p0_transpose_item(src, DM, DM, dst, scr, item, lane);
        }
        const float* x0 = in_ptr(0); const float* g0 = in_ptr(1); bf16* H = (bf16*)in_ptr(14);
        for (int m = 4 * gw; m < T; m += 4 * NGW) rms_rows4_to_bf16(x0 + (size_t)m * DM, g0, H + (size_t)m * DM, lane);
        LDS_WAIT(); __syncthreads();
    }
    SEAM(0);

#pragma unroll 1
    for (int l = 0; l < DEPTH; ++l) {
        const int pb = 1 + 5 * l;
        if (IN(pb)) {
            unsigned char* const ws = ws_k;
            Epi<0> E; E.ws = ws; E.xin = nullptr; E.xout = nullptr; E.gq = in_ptr(5) + l * 64; E.gk = in_ptr(6) + l * 64;
            SchedG1A S{l == 0 ? (const char*)in_ptr(14) : (const char*)(ws + WS_H), (const char*)(ws + (l == 0 ? WS_WIN0 : WS_WIN)), G, bx};
            pg8::gemm_phase<Epi<0>, SchedG1A, true, true>(lds, DM, S, E);
        }
        SEAM(pb);
        if (IN(pb + 1)) {
            unsigned char* const ws = ws_k;
            float s1 = 0.f, s2 = 0.f; { const float* q1 = in_ptr(7) + l * 64; const float* k1 = in_ptr(8) + l * 64; const float* q2 = in_ptr(9) + l * 64; const float* k2 = in_ptr(10) + l * 64;
                for (int i = 0; i < 64; ++i) { s1 += q1[i] * k1[i]; s2 += q2[i] * k2[i]; } }
            const float lam_init = 0.8f - 0.6f * __expf(-0.3f * (float)l), lam = __expf(s1) - __expf(s2) + lam_init;
            const float* gsub = in_ptr(11) + l * 1024;
            float gqm = 0.f, gkm = 0.f; { const float* gq = in_ptr(5) + l * 64; const float* gk = in_ptr(6) + l * 64; for (int i = 0; i < 64; ++i) { gqm = fmaxf(gqm, fabsf(gq[i])); gkm = fmaxf(gkm, fabsf(gk[i])); } }
            const float Bnd = 1.02f * 8.0f * LOG2E * gqm * gkm;
            const float* gret = in_ptr(3) + l * 1024;
            unsigned* qbase = ctl + CW_QUEUE + 512 * l;
            int lst = (int)(xb_xcc_id() & 7u), tried = 0;
            for (;;) {
                if (tid == 0) {
                    unsigned it = 0xffffffffu;
                    while (tried < 8) { it = __hip_atomic_fetch_add(qbase + 32 * lst, 1u, __ATOMIC_RELAXED, __HIP_MEMORY_SCOPE_AGENT); if (it < (unsigned)MIX_LIST_ITEMS) break; it = 0xffffffffu; lst = (lst + 1) & 7; ++tried; }
                    MISC[16] = it; MISC[17] = (unsigned)lst;
                }
                __syncthreads();
                const unsigned item = MISC[16]; const int li_ = (int)MISC[17];
                __syncthreads();
                if (item == 0xffffffffu) break;
                const int bb = li_ >> 1; const unsigned htab = (li_ & 1) ? 0x0156u : 0x2347u;
                if (item < 16u) { const int hh = (int)((htab >> (4 * (item & 3u))) & 7u), qt = 3 - (int)(item >> 2); ret::ret_unit(lds, ws, bb, hh, gret, 8 * qt, 8 * qt + 8); }
                else { const unsigned a_ = item - 16u; const int hh = (int)((htab >> (4 * (a_ >> 5))) & 7u), qb = 31 - (int)(a_ & 31u);
                    const float wf = (2.0f * Bnd + 28.0f) / (__builtin_amdgcn_exp2f(-(float)(hh + 1)) * LOG2E);
                    att::attn_unit(lds, ws, bb, hh, qb, lam, 1.0f - lam_init, gsub, wf < 8192.f ? (int)wf + 1 : 8192); }
            }
        }
        SEAM(pb + 1);
        if (IN(pb + 2)) {
            unsigned char* const ws = ws_k;
            Epi<1> E; E.ws = ws; E.xin = nullptr; E.xout = nullptr; E.gq = nullptr; E.gk = nullptr;
            SchedP34 S{(const char*)ws, (const char*)(ws + (l == 0 ? WS_WRO : WS_W1)), l == 0 ? (const char*)in_ptr(14) : (const char*)(ws + WS_H), (const char*)(ws + (l == 0 ? WS_WIN0 : WS_WIN)), bx};
            pg8::gemm_phase<Epi<1>, SchedP34, true, true>(lds, DM, S, E);
        }
        SEAM(pb + 2);
        if (IN(pb + 3)) {
            unsigned char* const ws = ws_k;
            Epi<2> E; E.ws = ws; E.xin = (l == 0) ? in_ptr(0) : (const float*)in_ptr(14); E.xout = (float*)in_ptr(14); E.gq = nullptr; E.gk = nullptr;
            SchedG4 S{(const char*)(ws + WS_MBF), (const char*)(ws + (l == 0 ? WS_WRO : WS_W1) + 4 * MiB), bx};
            pg8::gemm_phase<Epi<2>, SchedG4, false, true>(lds, DM, S, E);
        }
        SEAM(pb + 3);
        if (l == 0) {
            if (IN(5)) {
                unsigned char* const ws = ws_k; int lane = lane_k; asm volatile("" : "+v"(lane));
                bf16* H = (bf16*)(ws + WS_H);
                const int gw = vcu * NWAVES + wave, NGW = G * NWAVES;
                const float* x1 = in_ptr(14); const float* g1 = in_ptr(1) + DM;
                for (int m = 4 * gw; m < T; m += 4 * NGW) rms_rows4_to_bf16(x1 + (size_t)m * DM, g1, H + (size_t)m * DM, lane);
                __syncthreads();
            }
            SEAM(5);
        }
    }
#undef IN
#undef SEAM
}

extern "C" void kernel_launch(void* const* d_in, const int* in_sizes, int n_in, void* d_out, int out_size, void* d_ws, size_t ws_size, hipStream_t stream) {
    static int ready = 0;
    if (ready == 0) {
        if (n_in != 14 || ws_size < WS_END || out_size != T * DM) { fprintf(stderr, "kernel_launch: unexpected problem (n_in %d, ws %zu, out %d)\n", n_in, ws_size, out_size); ready = -1; return; }
        if (hipFuncSetAttribute((const void*)mk_fwd, hipFuncAttributeMaxDynamicSharedMemorySize, LDS_BYTES) != hipSuccess) { fprintf(stderr, "kernel_launch: hipFuncSetAttribute failed\n"); ready = -1; return; }
        ready = 1;
    }
    if (ready < 0) return;
    (void)hipMemsetAsync((char*)d_ws + WS_CTL, 0, CTL_ZERO_BYTES, stream);
    Args a{};
    for (int i = 0; i < 14; ++i) a.in[i] = (const float*)d_in[i];
    a.out = (float*)d_out; a.ws = (unsigned char*)d_ws;
    a.ph_lo = 0; a.ph_hi = N_PHASES; a.li = 0;
    hipLaunchKernelGGL(mk_fwd, dim3(256), dim3(NWAVES * 64), LDS_BYTES, stream, a);
}
```

```cpp
#include <hip/hip_runtime.h>
#include <cstdio>
#include <cstdint>
#include <cstddef>

constexpr int DM = 1024, BATCH = 4, SEQ = 4096, DEPTH = 2, T = BATCH * SEQ, NIN = 9216;
constexpr float EPS = 1e-6f;
constexpr float LOG2E = 1.4426950408889634f;

typedef unsigned short bf16;
typedef short bf16x8 __attribute__((ext_vector_type(8)));
typedef float f32x4 __attribute__((ext_vector_type(4)));
typedef unsigned u32x4 __attribute__((ext_vector_type(4)));
#define LAS __attribute__((address_space(3)))
#define GAS __attribute__((address_space(1)))

__device__ __forceinline__ float bf2f(bf16 v) { return __uint_as_float(((unsigned)v) << 16); }
__device__ __forceinline__ unsigned f2bf_u(float f) { unsigned u = __float_as_uint(f); return (u + 0x7fffu + ((u >> 16) & 1u)) >> 16; }
__device__ __forceinline__ bf16 f2bf(float f) { return (bf16)f2bf_u(f); }
__device__ __forceinline__ unsigned pk2(float lo, float hi) { return f2bf_u(lo) | (f2bf_u(hi) << 16); }
typedef float f32x2_t __attribute__((ext_vector_type(2))); typedef __bf16 bf16x2_t __attribute__((ext_vector_type(2)));
__device__ __forceinline__ unsigned cvt_pk_bf16(float lo, float hi) { f32x2_t v = {lo, hi}; bf16x2_t b = __builtin_convertvector(v, bf16x2_t); return __builtin_bit_cast(unsigned, b); }
__device__ __forceinline__ float fast_sigmoid(float v) { return __builtin_amdgcn_rcpf(1.0f + __builtin_amdgcn_exp2f(-v * LOG2E)); }
__device__ __forceinline__ float lo_bf(unsigned w) { return __uint_as_float(w << 16); }
__device__ __forceinline__ float hi_bf(unsigned w) { return __uint_as_float(w & 0xffff0000u); }

constexpr size_t MiB = 1u << 20;
constexpr size_t WS_CTL = 0, CTL_ZERO_BYTES = 64 * 1024;
constexpr size_t WS_WIN = 1 * MiB, WS_WRO = 19 * MiB, WS_WDO = 21 * MiB, WS_WOUT = 23 * MiB;
constexpr size_t WS_H = 25 * MiB, WS_QR = 57 * MiB, WS_KR = 73 * MiB, WS_VR = 89 * MiB, WS_SGR = 121 * MiB, WS_QD = 153 * MiB, WS_KD = 185 * MiB,
                 WS_VD = 217 * MiB, WS_SGD = 249 * MiB;
constexpr size_t WS_WIN0 = WS_H;
constexpr size_t WS_W1 = 281 * MiB;
constexpr size_t WS_END = 287 * MiB;
constexpr size_t WS_MBUF = 57 * MiB;
constexpr size_t WS_MBF = WS_VD;
constexpr size_t WS_SMGR = WS_QD, WS_SMGD = WS_KD;
constexpr int CW_BAR = 4096;

namespace pg8 {
constexpr int BM = 256, BK = 64, HALF = 128, HTB = HALF * BK * 2, STAGE_BYTES = 8 * HTB, NXCD = 8, WGM = 8;
__host__ __device__ __forceinline__ int lds_byte(int r, int c) { const int st = (r >> 4) * 2 + (c >> 5), rr = r & 15, cc = c & 31, ob = rr * 64 + cc * 2; return st * 1024 + (ob ^ (((ob >> 9) & 1) << 5)); }
__host__ __device__ __forceinline__ void stage_rc(int b, int& R, int& C) { const int st = b / 1024, sb = b % 1024, swz = sb ^ (((sb >> 9) & 1) << 5); R = (st >> 1) * 16 + swz / 64; C = (st & 1) * 32 + (swz % 64) / 2; }
__host__ __device__ __forceinline__ int perm32(int rho) { const int n = rho >> 4, i = rho & 15; return 8 * (i >> 2) + 4 * n + (i & 3); }

struct Unit { int pm, pn, kind; const char* a; const char* b; };

__device__ __forceinline__ void tile_of(int L, int nM, int nN, int& pm, int& pn) {
    const int nwg = nM * nN; int wgid = L;
    { const int q = nwg / NXCD, r = nwg % NXCD, xcd = wgid % NXCD, off = wgid / NXCD; wgid = (xcd < r ? xcd * (q + 1) : r * (q + 1) + (xcd - r) * q) + off; }
    const int nig = WGM * nN, gid = wgid / nig, fm = gid * WGM, gsz = (nM - fm) < WGM ? (nM - fm) : WGM;
    pm = fm + ((wgid % nig) % gsz); pn = (wgid % nig) / gsz;
}

template <class Epi, class Sched, bool ALIGN_EPI, bool SP2>
__device__ __forceinline__ void gemm_phase(LAS unsigned char* lds, const int K, const Sched& S, const Epi& E) {
    int tid_ = threadIdx.x; asm volatile("" : "+v"(tid_));
    const int tid = tid_, wid = __builtin_amdgcn_readfirstlane(tid >> 6), lane = tid & 63, wr = wid >> 2, wc = wid & 3, fr = lane & 15, fq = lane >> 4;
    const int nt = K / BK;
    unsigned voffA[2], voffB[2];
#pragma unroll
    for (int i = 0; i < 2; ++i) { int R, C; stage_rc(tid * 16 + i * 8192, R, C); const int Rb = (R >> 5) * 64 + perm32(R & 31);
        voffA[i] = (unsigned)(R * K + C) * 2u; voffB[i] = (unsigned)(Rb * K + C) * 2u; }
    const size_t kstep = (size_t)(BK * 2);
    const size_t hstep = (size_t)HALF * K * 2;
    const size_t hstepB = (size_t)32 * K * 2;
    const unsigned ldsw = (unsigned)wid * 1024u;
    const int aoff = lds_byte(wr * 64 + fr, fq * 8), boff = lds_byte(wc * 32 + fr, fq * 8);
#define PG8_SA(b, h) (((b) * 2 + (h)) * HTB)
#define PG8_SB(b, h) ((4 + (b) * 2 + (h)) * HTB)
#define PG8_STAGE(bufoff, gbase, voff) do { _Pragma("unroll") for (int _i = 0; _i < 2; ++_i) \
        __builtin_amdgcn_global_load_lds((const unsigned*)((const char*)(gbase) + (voff)[_i]), (LAS unsigned*)(lds + (bufoff) + ldsw + _i * 8192), 16, 0, 0); } while (0)
#define PG8_LDA(dst, b, h) do { _Pragma("unroll") for (int m = 0; m < 4; ++m) _Pragma("unroll") for (int k = 0; k < 2; ++k) dst[m][k] = *(const LAS bf16x8*)(lds + PG8_SA(b, h) + aoff + m * 2048 + k * 1024); } while (0)
#define PG8_LDB(dst, b, h) do { _Pragma("unroll") for (int n = 0; n < 2; ++n) _Pragma("unroll") for (int k = 0; k < 2; ++k) dst[n][k] = *(const LAS bf16x8*)(lds + PG8_SB(b, h) + boff + n * 2048 + k * 1024); } while (0)
#define PG8_MMA(ai, bj, At, Bt) do { __builtin_amdgcn_s_setprio(1); _Pragma("unroll") for (int m = 0; m < 4; ++m) _Pragma("unroll") for (int n = 0; n < 2; ++n) _Pragma("unroll") for (int k = 0; k < 2; ++k) \
        acc[ai][bj][m][n] = __builtin_amdgcn_mfma_f32_16x16x32_bf16(Bt[n][k], At[m][k], acc[ai][bj][m][n], 0, 0, 0); __builtin_amdgcn_s_setprio(0); } while (0)
#define PG8_WAIT_V(n) asm volatile("s_waitcnt vmcnt(" #n ")" ::: "memory")
#define PG8_WAIT_L(n) asm volatile("s_waitcnt lgkmcnt(" #n ")" ::: "memory")
#define PG8_BAR __builtin_amdgcn_s_barrier()
#define PG8_SCHED __builtin_amdgcn_sched_barrier(0)
    Unit cur, nxt; int ui = 0;
    if (!S.next(0, cur)) return;
    f32x4 acc[2][2][4][2];
#pragma unroll
    for (int a = 0; a < 2; ++a)
#pragma unroll
        for (int b = 0; b < 2; ++b)
#pragma unroll
            for (int m = 0; m < 4; ++m)
#pragma unroll
                for (int n = 0; n < 2; ++n) acc[a][b][m][n] = (f32x4){0.f, 0.f, 0.f, 0.f};
    bf16x8 At[4][2], B0[2][2], B1[2][2];
    const char* cA = cur.a; const char* cB = cur.b;
    if constexpr (SP2) {
        PG8_STAGE(PG8_SB(0, 0), cB, voffB); PG8_STAGE(PG8_SB(0, 1), cB + hstepB, voffB); PG8_STAGE(PG8_SA(0, 0), cA, voffA); PG8_STAGE(PG8_SA(0, 1), cA + hstep, voffA);
        if (wr == 1) PG8_BAR;
        PG8_WAIT_V(2); PG8_BAR;
        PG8_STAGE(PG8_SB(1, 0), cB + kstep, voffB); PG8_STAGE(PG8_SA(1, 0), cA + kstep, voffA); PG8_STAGE(PG8_SB(1, 1), cB + hstepB + kstep, voffB);
        PG8_WAIT_V(6); PG8_BAR;
    } else {
        PG8_STAGE(PG8_SB(0, 0), cB, voffB); PG8_STAGE(PG8_SA(0, 0), cA, voffA); PG8_STAGE(PG8_SB(0, 1), cB + hstepB, voffB); PG8_STAGE(PG8_SA(0, 1), cA + hstep, voffA);
        if (wr == 1) PG8_BAR;
        PG8_WAIT_V(4); PG8_BAR;
        PG8_STAGE(PG8_SB(1, 0), cB + kstep, voffB); PG8_STAGE(PG8_SA(1, 0), cA + kstep, voffA); PG8_STAGE(PG8_SB(1, 1), cB + hstepB + kstep, voffB);
        PG8_WAIT_V(6); PG8_BAR;
    }
    for (;;) {
        const bool has_next = S.next(ui + 1, nxt);
        const char* nA = has_next ? nxt.a : cA; const char* nB = has_next ? nxt.b : cB;
        for (int t = 0; t < nt; t += 2) {
            const bool last = (t == nt - 2);
            const char* a1 = cA + (size_t)(t + 1) * kstep;
            const char* a2 = last ? nA : cA + (size_t)(t + 2) * kstep; const char* b2 = last ? nB : cB + (size_t)(t + 2) * kstep;
            const char* a3 = a2 + kstep; const char* b3 = b2 + kstep;
            if constexpr (SP2) {
            PG8_LDB(B0, 0, 0); PG8_LDB(B1, 0, 1); PG8_SCHED; PG8_LDA(At, 0, 0); PG8_STAGE(PG8_SA(1, 1), a1 + hstep, voffA);
            PG8_WAIT_V(8); PG8_WAIT_L(0); PG8_BAR; PG8_MMA(0, 0, At, B0); PG8_MMA(0, 1, At, B1); PG8_BAR; PG8_SCHED;
            PG8_LDA(At, 0, 1); PG8_STAGE(PG8_SB(0, 0), b2, voffB); PG8_STAGE(PG8_SB(0, 1), b2 + hstepB, voffB); PG8_STAGE(PG8_SA(0, 0), a2, voffA);
            PG8_WAIT_V(8); PG8_WAIT_L(0); PG8_BAR; PG8_MMA(1, 0, At, B0); PG8_MMA(1, 1, At, B1); PG8_BAR; PG8_SCHED;
            PG8_LDB(B0, 1, 0); PG8_LDB(B1, 1, 1); PG8_SCHED; PG8_LDA(At, 1, 0); PG8_STAGE(PG8_SA(0, 1), a2 + hstep, voffA);
            PG8_WAIT_V(8); PG8_WAIT_L(0); PG8_BAR; PG8_MMA(0, 0, At, B0); PG8_MMA(0, 1, At, B1); PG8_BAR; PG8_SCHED;
            PG8_LDA(At, 1, 1); PG8_STAGE(PG8_SB(1, 0), b3, voffB); PG8_STAGE(PG8_SB(1, 1), b3 + hstepB, voffB); PG8_STAGE(PG8_SA(1, 0), a3, voffA);
            PG8_WAIT_V(8); PG8_WAIT_L(0); PG8_BAR; PG8_MMA(1, 0, At, B0); PG8_MMA(1, 1, At, B1); PG8_BAR; PG8_SCHED;
            } else {
            PG8_LDB(B0, 0, 0); PG8_SCHED; PG8_LDA(At, 0, 0); PG8_STAGE(PG8_SA(1, 1), a1 + hstep, voffA);
            PG8_WAIT_L(8); PG8_BAR; PG8_WAIT_L(0); PG8_MMA(0, 0, At, B0); PG8_BAR; PG8_SCHED;
            PG8_LDB(B1, 0, 1); PG8_STAGE(PG8_SB(0, 0), b2, voffB);
            PG8_BAR; PG8_WAIT_L(0); PG8_MMA(0, 1, At, B1); PG8_BAR;
            PG8_LDA(At, 0, 1); PG8_STAGE(PG8_SA(0, 0), a2, voffA);
            PG8_BAR; PG8_WAIT_L(0); PG8_MMA(1, 0, At, B0); PG8_BAR; PG8_SCHED;
            PG8_STAGE(PG8_SB(0, 1), b2 + hstepB, voffB);
            PG8_WAIT_V(6); PG8_BAR; PG8_MMA(1, 1, At, B1); PG8_BAR;
            PG8_LDB(B0, 1, 0); PG8_SCHED; PG8_LDA(At, 1, 0); PG8_STAGE(PG8_SA(0, 1), a2 + hstep, voffA);
            PG8_WAIT_L(8); PG8_BAR; PG8_WAIT_L(0); PG8_MMA(0, 0, At, B0); PG8_BAR; PG8_SCHED;
            PG8_LDB(B1, 1, 1); PG8_STAGE(PG8_SB(1, 0), b3, voffB);
            PG8_BAR; PG8_WAIT_L(0); PG8_MMA(0, 1, At, B1); PG8_BAR;
            PG8_LDA(At, 1, 1); PG8_STAGE(PG8_SA(1, 0), a3, voffA);
            PG8_BAR; PG8_WAIT_L(0); PG8_MMA(1, 0, At, B0); PG8_BAR; PG8_SCHED;
            PG8_STAGE(PG8_SB(1, 1), b3 + hstepB, voffB);
            PG8_WAIT_V(6); PG8_BAR; PG8_MMA(1, 1, At, B1); PG8_BAR;
            }
        }
        if constexpr (ALIGN_EPI) { if (wr == 0) PG8_BAR; }
        E(acc, cur, wr, wc, fr, fq);
        if (!has_next) break;
#pragma unroll
        for (int a = 0; a < 2; ++a)
#pragma unroll
            for (int b = 0; b < 2; ++b)
#pragma unroll
                for (int m = 0; m < 4; ++m)
#pragma unroll
                    for (int n = 0; n < 2; ++n) acc[a][b][m][n] = (f32x4){0.f, 0.f, 0.f, 0.f};
        cur = nxt; cA = nA; cB = nB; ++ui;
        if constexpr (ALIGN_EPI) { if (wr == 1) PG8_BAR; }
    }
    PG8_WAIT_V(0);
    if constexpr (!ALIGN_EPI) { if (wr == 0) PG8_BAR; }
    PG8_BAR;
#undef PG8_SA
#undef PG8_SB
#undef PG8_STAGE
#undef PG8_LDA
#undef PG8_LDB
#undef PG8_MMA
#undef PG8_WAIT_V
#undef PG8_WAIT_L
#undef PG8_BAR
#undef PG8_SCHED
}
}

enum { K_QR = 0, K_KR, K_VR, K_SGR, K_QD, K_KD, K_VD, K_SGD, K_MGR, K_YR, K_MGD, K_YD, K_OUT };
constexpr size_t TSTEP = (size_t)256 * DM * 2;

template <int PC  > struct Epi {
    unsigned char* ws; const float* xin; float* xout; const float* gq; const float* gk;
    __device__ __forceinline__ static void st8(bf16* p, const f32x4 a, const f32x4 b) {
        u32x4 w; w.x = cvt_pk_bf16(a[0], a[1]); w.y = cvt_pk_bf16(a[2], a[3]); w.z = cvt_pk_bf16(b[0], b[1]); w.w = cvt_pk_bf16(b[2], b[3]); *(u32x4*)p = w; }
    __device__ __forceinline__ void operator()(const f32x4 (&acc)[2][2][4][2], const pg8::Unit& u, int wr, int wc, int fr, int fq) const {
        const int row0 = u.pm * 256 + wr * 64 + fr;
        const int cl = wc * 64 + 8 * fq;
        const int kind = u.kind;
        bf16* const qr = (bf16*)(ws + WS_QR); bf16* const kr = (bf16*)(ws + WS_KR); bf16* const vr = (bf16*)(ws + WS_VR); bf16* const sgr = (bf16*)(ws + WS_SGR);
        bf16* const qd = (bf16*)(ws + WS_QD); bf16* const kd = (bf16*)(ws + WS_KD); bf16* const vd = (bf16*)(ws + WS_VD); bf16* const sgd = (bf16*)(ws + WS_SGD);
        bf16* const smgr = (bf16*)(ws + WS_SMGR); bf16* const smgd = (bf16*)(ws + WS_SMGD); bf16* const mbf = (bf16*)(ws + WS_MBF); float* const mbuf = (float*)(ws + WS_MBUF);
        if (PC == 0 && (kind == K_VR || kind == K_VD)) {
            bf16* base = (kind == K_VR ? vr : vd) + u.pn * 256 + cl;
#pragma unroll
            for (int ai = 0; ai < 2; ++ai)
#pragma unroll
                for (int m = 0; m < 4; ++m) { bf16* rp = base + (size_t)(row0 + ai * 128 + m * 16) * 1024;
#pragma unroll
                    for (int bj = 0; bj < 2; ++bj) st8(rp + 32 * bj, acc[ai][bj][m][0], acc[ai][bj][m][1]); }
        } else if (PC == 0 && (kind == K_SGR || kind == K_SGD)) {
            bf16* base = (kind == K_SGR ? sgr : sgd) + u.pn * 256 + cl;
#pragma unroll
            for (int ai = 0; ai < 2; ++ai)
#pragma unroll
                for (int m = 0; m < 4; ++m) { bf16* rp = base + (size_t)(row0 + ai * 128 + m * 16) * 1024;
#pragma unroll
                    for (int bj = 0; bj < 2; ++bj) { f32x4 a = acc[ai][bj][m][0], b = acc[ai][bj][m][1];
#pragma unroll
                        for (int i = 0; i < 4; ++i) { a[i] = a[i] * fast_sigmoid(a[i]); b[i] = b[i] * fast_sigmoid(b[i]); }
                        st8(rp + 32 * bj, a, b); } }
        } else if (PC == 1 && (kind == K_MGR || kind == K_MGD)) {
            bf16* base = (kind == K_MGR ? smgr : smgd) + u.pn * 256 + cl;
#pragma unroll
            for (int ai = 0; ai < 2; ++ai)
#pragma unroll
                for (int m = 0; m < 4; ++m) { bf16* rp = base + (size_t)(row0 + ai * 128 + m * 16) * 1024;
#pragma unroll
                    for (int bj = 0; bj < 2; ++bj) { f32x4 a = acc[ai][bj][m][0], b = acc[ai][bj][m][1];
#pragma unroll
                        for (int i = 0; i < 4; ++i) { a[i] = fast_sigmoid(a[i]); b[i] = fast_sigmoid(b[i]); }
                        st8(rp + 32 * bj, a, b); } }
        } else if (PC == 0 && (kind == K_QR || kind == K_KR)) {
            const int h = u.pn * 4 + wc; const float lg = __log2f(1.0f - __builtin_amdgcn_exp2f(-5.0f - (float)h));
            bf16* base = (kind == K_QR ? qr : kr) + u.pn * 256 + cl;
            const float sgn = (kind == K_QR) ? lg : -lg, mul = (kind == K_QR) ? 1.0f : 0.125f;
#pragma unroll
            for (int ai = 0; ai < 2; ++ai)
#pragma unroll
                for (int m = 0; m < 4; ++m) { const int row = row0 + ai * 128 + m * 16; bf16* rp = base + (size_t)row * 512;
                    const float f = mul * __builtin_amdgcn_exp2f((float)(row & 127) * sgn);
#pragma unroll
                    for (int bj = 0; bj < 2; ++bj) st8(rp + 32 * bj, acc[ai][bj][m][0] * f, acc[ai][bj][m][1] * f); }
        } else if (PC == 0 && (kind == K_QD || kind == K_KD)) {
            const float* g = (kind == K_QD) ? gq : gk; const float mul = (kind == K_QD) ? 0.125f * LOG2E : 1.0f;
            bf16* base = (kind == K_QD ? qd : kd) + u.pn * 256 + cl;
            f32x4 gv[2][2];
#pragma unroll
            for (int bj = 0; bj < 2; ++bj)
#pragma unroll
                for (int n = 0; n < 2; ++n) gv[bj][n] = *(const f32x4*)(g + 32 * bj + 8 * fq + 4 * n) * mul;
#pragma unroll
            for (int ai = 0; ai < 2; ++ai)
#pragma unroll
                for (int m = 0; m < 4; ++m) { bf16* rp = base + (size_t)(row0 + ai * 128 + m * 16) * 1024;
                    float ss = 0.f;
#pragma unroll
                    for (int bj = 0; bj < 2; ++bj)
#pragma unroll
                        for (int n = 0; n < 2; ++n) { const f32x4 x = acc[ai][bj][m][n]; ss += (x[0] * x[0] + x[1] * x[1]) + (x[2] * x[2] + x[3] * x[3]); }
                    ss += __shfl_xor(ss, 16); ss += __shfl_xor(ss, 32);
                    const float rs = __builtin_amdgcn_rsqf(ss * (1.0f / 64.0f) + EPS);
#pragma unroll
                    for (int bj = 0; bj < 2; ++bj) st8(rp + 32 * bj, acc[ai][bj][m][0] * gv[bj][0] * rs, acc[ai][bj][m][1] * gv[bj][1] * rs); }
        } else if (PC == 1 && kind == K_YR) {
            bf16* const yrb = (bf16*)mbuf + (size_t)u.pn * 256 + cl;
#pragma unroll
            for (int ai = 0; ai < 2; ++ai)
#pragma unroll
                for (int m = 0; m < 4; ++m) { bf16* rp = yrb + (size_t)(row0 + ai * 128 + m * 16) * 1024;
#pragma unroll
                    for (int bj = 0; bj < 2; ++bj) st8(rp + 32 * bj, acc[ai][bj][m][0], acc[ai][bj][m][1]); }
        } else if (PC == 1 && kind == K_YD) {
            const size_t cb = (size_t)u.pn * 256 + cl; const bf16* const yrb = (const bf16*)mbuf;
#pragma unroll
            for (int ai = 0; ai < 2; ++ai)
#pragma unroll
                for (int m = 0; m < 4; ++m) { const size_t ro = (size_t)(row0 + ai * 128 + m * 16) * 1024 + cb;
#pragma unroll
                    for (int bj = 0; bj < 2; ++bj) { const u32x4 sr = *(const u32x4*)(smgr + ro + 32 * bj), sd = *(const u32x4*)(smgd + ro + 32 * bj), yr = *(const u32x4*)(yrb + ro + 32 * bj);
                        const f32x4 a = acc[ai][bj][m][0], b = acc[ai][bj][m][1];
                        f32x4 o0, o1;
                        o0[0] = lo_bf(sr.x) * lo_bf(yr.x) + lo_bf(sd.x) * a[0]; o0[1] = hi_bf(sr.x) * hi_bf(yr.x) + hi_bf(sd.x) * a[1];
                        o0[2] = lo_bf(sr.y) * lo_bf(yr.y) + lo_bf(sd.y) * a[2]; o0[3] = hi_bf(sr.y) * hi_bf(yr.y) + hi_bf(sd.y) * a[3];
                        o1[0] = lo_bf(sr.z) * lo_bf(yr.z) + lo_bf(sd.z) * b[0]; o1[1] = hi_bf(sr.z) * hi_bf(yr.z) + hi_bf(sd.z) * b[1];
                        o1[2] = lo_bf(sr.w) * lo_bf(yr.w) + lo_bf(sd.w) * b[2]; o1[3] = hi_bf(sr.w) * hi_bf(yr.w) + hi_bf(sd.w) * b[3];
                        st8(mbf + ro + 32 * bj, o0, o1); }
                    asm volatile("" ::: "memory"); }
        } else if (PC == 2 && kind == K_OUT) {
            const size_t cb = (size_t)u.pn * 256 + cl;
#pragma unroll
            for (int ai = 0; ai < 2; ++ai) {
                f32x4 pre[4][2][2];
#pragma unroll
                for (int m = 0; m < 4; ++m) { const size_t ro = (size_t)(row0 + ai * 128 + m * 16) * 1024 + cb;
#pragma unroll
                    for (int bj = 0; bj < 2; ++bj) { pre[m][bj][0] = *(const f32x4*)(xin + ro + 32 * bj); pre[m][bj][1] = *(const f32x4*)(xin + ro + 32 * bj + 4); } }
#pragma unroll
                for (int m = 0; m < 4; ++m) { const size_t ro = (size_t)(row0 + ai * 128 + m * 16) * 1024 + cb;
#pragma unroll
                    for (int bj = 0; bj < 2; ++bj) { *(f32x4*)(xout + ro + 32 * bj) = pre[m][bj][0] + acc[ai][bj][m][0]; *(f32x4*)(xout + ro + 32 * bj + 4) = pre[m][bj][1] + acc[ai][bj][m][1]; } }
                asm volatile("" ::: "memory");
            }
        }
    }
};

struct SchedG1A {
    const char* A; const char* B; int G, c;
    __device__ __forceinline__ bool next(int i, pg8::Unit& u) const {
        const int L = i * G + c; if (L >= 64 * 28) return false;
        int pm, pg; pg8::tile_of(L, 64, 28, pm, pg);
        u.pm = pm; u.a = A + (size_t)pm * TSTEP; u.b = B + (size_t)pg * TSTEP;
        if (pg < 2) { u.kind = K_QR; u.pn = pg; } else if (pg < 4) { u.kind = K_KR; u.pn = pg - 2; } else if (pg < 8) { u.kind = K_VR; u.pn = pg - 4; } else if (pg < 12) { u.kind = K_SGR; u.pn = pg - 8; }
        else if (pg < 16) { u.kind = K_QD; u.pn = pg - 12; } else if (pg < 20) { u.kind = K_KD; u.pn = pg - 16; } else if (pg < 24) { u.kind = K_VD; u.pn = pg - 20; } else { u.kind = K_SGD; u.pn = pg - 24; }
        return true;
    }
};
struct SchedP34 {
    const char *ws, *Wro, *H, *Win; int c;
    __device__ __forceinline__ bool next(int i, pg8::Unit& u) const {
        if (i >= 4) return false;
        const char* OR = ws + WS_SGR; const char* OD = ws + WS_SGD; const char* Wdo = Wro + 2 * MiB;
        int pm, pn; pg8::tile_of(c, 64, 4, pm, pn); u.pm = pm; u.pn = pn;
        if (i == 0) { u.kind = K_MGR; u.a = H + (size_t)pm * TSTEP; u.b = Win + (size_t)(28 + pn) * TSTEP; }
        else if (i == 1) { u.kind = K_MGD; u.a = H + (size_t)pm * TSTEP; u.b = Win + (size_t)(32 + pn) * TSTEP; }
        else if (i == 2) { u.kind = K_YR; u.a = OR + (size_t)pm * TSTEP; u.b = Wro + (size_t)pn * TSTEP; }
        else { u.kind = K_YD; u.a = OD + (size_t)pm * TSTEP; u.b = Wdo + (size_t)pn * TSTEP; }
        return true;
    }
};
struct SchedG4 {
    const char *Mb, *Wout; int c;
    __device__ __forceinline__ bool next(int i, pg8::Unit& u) const {
        if (i >= 1) return false;
        int pm, pn; pg8::tile_of(c, 64, 4, pm, pn); u.pm = pm; u.pn = pn; u.kind = K_OUT; u.a = Mb + (size_t)pm * TSTEP; u.b = Wout + (size_t)pn * TSTEP; return true;
    }
};


namespace att {
typedef float f32x16 __attribute__((ext_vector_type(16)));
typedef short s16x4 __attribute__((ext_vector_type(4)));
typedef short v4i16_t __attribute__((ext_vector_type(4)));
constexpr int SLOT_OFF = 65536, SLOT_BYTES = 32768, V_OFF = 16384;
__device__ __forceinline__ int crow(int r, int hi) { return (r & 3) + 8 * (r >> 2) + 4 * hi; }
__device__ __forceinline__ s16x4 vtr(LAS const unsigned char* p) { return __builtin_bit_cast(s16x4, __builtin_amdgcn_ds_read_tr16_b64_v4i16((LAS v4i16_t*)p)); }
#define ATT_MFMA(a, b, c) __builtin_amdgcn_mfma_f32_32x32x16_bf16(a, b, c, 0, 0, 0)

__device__ __forceinline__ void attn_unit(LAS unsigned char* lds, const unsigned char* ws, const int b, const int h, const int qb, const float lam, const float omli, const float* __restrict__ gsub, const int win) {
    int tid_ = threadIdx.x; asm volatile("" : "+v"(tid_));
    const int tid = tid_, lane = tid & 63, r32 = lane & 31, hi = lane >> 5, w = __builtin_amdgcn_readfirstlane(tid >> 6), rg = w & 3, kg = w >> 2;
    const bf16* QD = (const bf16*)(ws + WS_QD); const bf16* KD = (const bf16*)(ws + WS_KD); const bf16* VD = (const bf16*)(ws + WS_VD); bf16* SGD = (bf16*)(ws + WS_SGD);
    const size_t tb = (size_t)b * SEQ; const int q0 = qb * 128, NT = (q0 + 128) / 64;
    const int T0 = (q0 > win ? q0 - win : 0) >> 6;
#pragma unroll
    for (int k = 0; k < 4; ++k) { const int p = 4 * kg + k; const bf16* src = QD + (tb + q0 + 32 * rg + r32) * 1024 + h * 128 + (p >> 2) * 64 + (p & 3) * 16 + hi * 8;
        __builtin_amdgcn_global_load_lds((const unsigned*)src, (LAS unsigned*)(lds + rg * 8192 + p * 1024), 16, 0, 0); }
    const bf16* ksrc = KD + (tb + lane) * 1024 + h * 128 + (w & 7) * 8;
    const bf16* vsrc = VD + (tb + 16 * (w & 3) + (lane >> 2)) * 1024 + h * 128 + (w >> 2) * 32 + (lane & 3) * 8;
#define ATT_STAGE(t, slot) do { _Pragma("unroll") for (int rr = 0; rr < 2; ++rr) { \
        __builtin_amdgcn_global_load_lds((const unsigned*)(ksrc + (size_t)(t) * 65536 + rr * 64), (LAS unsigned*)(lds + SLOT_OFF + (slot) * SLOT_BYTES + (rr * 8 + w) * 1024), 16, 0, 0); \
        __builtin_amdgcn_global_load_lds((const unsigned*)(vsrc + (size_t)(t) * 65536 + rr * 64), (LAS unsigned*)(lds + SLOT_OFF + (slot) * SLOT_BYTES + V_OFF + (rr * 8 + w) * 1024), 16, 0, 0); } } while (0)
    ATT_STAGE(T0, 0);
    __syncthreads();
    const float slope = __builtin_amdgcn_exp2f(-(float)(h + 1)) * LOG2E;
    const int n = q0 + 32 * rg + r32;
    f32x16 O[2][4];
#pragma unroll
    for (int j = 0; j < 2; ++j)
#pragma unroll
        for (int e = 0; e < 4; ++e)
#pragma unroll
            for (int r = 0; r < 16; ++r) O[j][e][r] = 0.f;
    float lsum[2] = {0.f, 0.f};
    const int qoff = rg * 8192 + lane * 16;
    const int koff = hi * 1024 + (32 * kg + r32) * 16;
    const int voff = V_OFF + 2 * kg * 1024 + ((lane >> 4) & 1) * 32 + (lane & 3) * 8 + (4 * hi + ((lane & 15) >> 2)) * 64;
    for (int t = T0; t < NT; ++t) {
        if (t + 1 < NT) ATT_STAGE(t + 1, (t + 1 - T0) & 1);
        const int k0 = t * 64 + 32 * kg;
        if (k0 <= q0 + 32 * rg + 31) {
            LAS const unsigned char* slot = lds + SLOT_OFF + ((t - T0) & 1) * SLOT_BYTES;
            float sl = slope; asm volatile("" : "+v"(sl));
            const int dn = n - k0 - 4 * hi; const float base = -sl * (float)dn;
            const bool diag = (k0 + 31 > q0 + 32 * rg);
            f32x16 pA, pB;
#pragma unroll
            for (int r = 0; r < 16; ++r) { const int kc = (r & 3) + 8 * (r >> 2); pA[r] = __builtin_fmaf(sl, (float)kc, base); }
            if (diag) {
#pragma unroll
                for (int r = 0; r < 16; ++r) { const int kc = (r & 3) + 8 * (r >> 2); if (kc > dn) pA[r] = -INFINITY; }
            }
            pB = pA;
#pragma unroll
            for (int d0 = 0; d0 < 4; ++d0) {
                const bf16x8 kfa = *(LAS const bf16x8*)(slot + koff + (2 * d0) * 1024), kfb = *(LAS const bf16x8*)(slot + koff + (8 + 2 * d0) * 1024);
                const bf16x8 qfa = *(LAS const bf16x8*)(lds + qoff + d0 * 1024), qfb = *(LAS const bf16x8*)(lds + qoff + (4 + d0) * 1024);
                pA = ATT_MFMA(kfa, qfa, pA); pB = ATT_MFMA(kfb, qfb, pB);
            }
            bf16x8 vf[4][2];
#pragma unroll
            for (int eb = 0; eb < 4; ++eb)
#pragma unroll
                for (int ks = 0; ks < 2; ++ks) { const s16x4 vlo = vtr(slot + voff + eb * 4096 + ks * 1024), vhi = vtr(slot + voff + eb * 4096 + ks * 1024 + 512);
                    vf[eb][ks] = (bf16x8){vlo[0], vlo[1], vlo[2], vlo[3], vhi[0], vhi[1], vhi[2], vhi[3]}; }
            u32x4 pwA[2], pwB[2];
            { float s = 0.f;
#pragma unroll
              for (int r = 0; r < 16; ++r) { pA[r] = __builtin_amdgcn_exp2f(pA[r]); s += pA[r]; }
              lsum[0] += s;
#pragma unroll
              for (int i = 0; i < 4; ++i) { pwA[0][i] = cvt_pk_bf16(pA[2 * i], pA[2 * i + 1]); pwA[1][i] = cvt_pk_bf16(pA[8 + 2 * i], pA[9 + 2 * i]); } }
            { float s = 0.f;
#pragma unroll
              for (int r = 0; r < 16; ++r) { pB[r] = __builtin_amdgcn_exp2f(pB[r]); s += pB[r]; }
              lsum[1] += s;
#pragma unroll
              for (int i = 0; i < 4; ++i) { pwB[0][i] = cvt_pk_bf16(pB[2 * i], pB[2 * i + 1]); pwB[1][i] = cvt_pk_bf16(pB[8 + 2 * i], pB[9 + 2 * i]); } }
#pragma unroll
            for (int eb = 0; eb < 4; ++eb)
#pragma unroll
                for (int ks = 0; ks < 2; ++ks) {
                    O[0][eb] = ATT_MFMA(vf[eb][ks], __builtin_bit_cast(bf16x8, pwA[ks]), O[0][eb]);
                    O[1][eb] = ATT_MFMA(vf[eb][ks], __builtin_bit_cast(bf16x8, pwB[ks]), O[1][eb]);
                }
        }
        __syncthreads();
    }
    lsum[0] += __shfl_xor(lsum[0], 32); lsum[1] += __shfl_xor(lsum[1], 32);
    LAS float* dump = (LAS float*)(lds + rg * 32768);
    LAS float* lx = (LAS float*)(lds + 131072 + rg * 1024);
    int r32e = r32; asm volatile("" : "+v"(r32e));
    bf16* rowp = SGD + (tb + q0 + 32 * rg + r32e) * 1024 + h * 128 + 4 * hi;
    const float* gp = gsub + h * 128 + 4 * hi;
    unsigned long long gt[4][4];
    if (kg == 1) {
#pragma unroll
        for (int j = 0; j < 2; ++j)
#pragma unroll
            for (int eb = 0; eb < 4; ++eb)
#pragma unroll
                for (int q = 0; q < 4; ++q) *(LAS f32x4*)(dump + (((j * 4 + eb) * 4 + q) * 64 + lane) * 4) = (f32x4){O[j][eb][4 * q], O[j][eb][4 * q + 1], O[j][eb][4 * q + 2], O[j][eb][4 * q + 3]};
        lx[lane] = lsum[0]; lx[64 + lane] = lsum[1];
    } else {
#pragma unroll
        for (int eb = 0; eb < 2; ++eb)
#pragma unroll
            for (int g = 0; g < 4; ++g) gt[eb][g] = *(const unsigned long long*)(rowp + 32 * eb + 8 * g);
    }
    asm volatile("s_waitcnt lgkmcnt(0)" ::: "memory"); __builtin_amdgcn_s_barrier(); asm volatile("" ::: "memory");
    if (kg == 0) {
#pragma unroll
        for (int j = 0; j < 2; ++j)
#pragma unroll
            for (int eb = 0; eb < 4; ++eb)
                {
#pragma unroll
                  for (int q = 0; q < 4; ++q) { const f32x4 v = *(LAS const f32x4*)(dump + (((j * 4 + eb) * 4 + q) * 64 + lane) * 4); O[j][eb][4 * q] += v[0]; O[j][eb][4 * q + 1] += v[1]; O[j][eb][4 * q + 2] += v[2]; O[j][eb][4 * q + 3] += v[3]; }
                  asm volatile("s_waitcnt lgkmcnt(0)" : "+v"(O[j][eb]) :: "memory"); }
        lsum[0] += lx[lane]; lsum[1] += lx[64 + lane];
        asm volatile("s_waitcnt lgkmcnt(0)" ::: "memory");
#pragma unroll
        for (int eb = 2; eb < 4; ++eb)
#pragma unroll
            for (int g = 0; g < 4; ++g) gt[eb][g] = *(const unsigned long long*)(rowp + 32 * eb + 8 * g);
        const float i0 = 1.0f / lsum[0], i1 = lam / lsum[1];
        float ss = 0.f;
#pragma unroll
        for (int eb = 0; eb < 4; ++eb)
#pragma unroll
            for (int r = 0; r < 16; ++r) { const float o = O[0][eb][r] * i0 - O[1][eb][r] * i1; O[0][eb][r] = o; ss += o * o; }
        ss += __shfl_xor(ss, 32);
        const float rs = __builtin_amdgcn_rsqf(ss * (1.0f / 128.0f) + EPS) * omli;
#pragma unroll
        for (int eb = 0; eb < 4; ++eb) {
            f32x4 gg[4];
#pragma unroll
            for (int g = 0; g < 4; ++g) gg[g] = *(const f32x4*)(gp + 32 * eb + 8 * g);
#pragma unroll
            for (int g = 0; g < 4; ++g) { const unsigned glo = (unsigned)gt[eb][g], ghi = (unsigned)(gt[eb][g] >> 32);
                const unsigned w0 = cvt_pk_bf16(O[0][eb][4 * g] * rs * gg[g][0] * lo_bf(glo), O[0][eb][4 * g + 1] * rs * gg[g][1] * hi_bf(glo));
                const unsigned w1 = cvt_pk_bf16(O[0][eb][4 * g + 2] * rs * gg[g][2] * lo_bf(ghi), O[0][eb][4 * g + 3] * rs * gg[g][3] * hi_bf(ghi));
                *(unsigned long long*)(rowp + 32 * eb + 8 * g) = (unsigned long long)w0 | ((unsigned long long)w1 << 32); }
        }
    }
    asm volatile("s_waitcnt lgkmcnt(0)" ::: "memory");
    __syncthreads();
#undef ATT_STAGE
}
}

namespace ret {
using att::f32x16; using att::s16x4; using att::crow; using att::vtr;
constexpr int SET = 49152, KT = 0, VI = 16384, OST = 98304, ST = 131072, RED = 147456;
__device__ __forceinline__ void ret_unit(LAS unsigned char* lds, const unsigned char* ws, const int b, const int h, const float* __restrict__ gn, const int c0, const int c1) {
    int tid_ = threadIdx.x; asm volatile("" : "+v"(tid_));
    const int tid = tid_, lane = tid & 63, r32 = lane & 31, hi = lane >> 5, w = __builtin_amdgcn_readfirstlane(tid >> 6);
    const int ib = w & 3, eh = w >> 2, dh = w & 1, ebo = w >> 1;
    const bf16* QR = (const bf16*)(ws + WS_QR); const bf16* KR = (const bf16*)(ws + WS_KR); const bf16* VR = (const bf16*)(ws + WS_VR); bf16* SGR = (bf16*)(ws + WS_SGR);
    const size_t tb = (size_t)b * SEQ;
    const float lg = __log2f(1.0f - __builtin_amdgcn_exp2f(-5.0f - (float)h)), gC = __builtin_amdgcn_exp2f(128.0f * lg);
    for (int i = tid; i < 16384 / 16; i += 512) *(LAS u32x4*)(lds + ST + i * 16) = (u32x4){0u, 0u, 0u, 0u};
    f32x16 sblk;
#pragma unroll
    for (int r = 0; r < 16; ++r) sblk[r] = 0.f;
    const int vpat = ((lane >> 4) & 1) * 32 + (lane & 3) * 8 + (4 * hi + ((lane & 15) >> 2)) * 64;
    const int prow = tid >> 4, pcol = (tid & 15) * 8;
    f32x4 gA = *(const f32x4*)(gn + h * 128 + pcol), gB = *(const f32x4*)(gn + h * 128 + pcol + 4);
#define RET_STAGE(c, s) do { const size_t t0_ = tb + (size_t)(c) * 128; LAS unsigned char* sb_ = lds + (s) * SET; \
        _Pragma("unroll") for (int k = 0; k < 2; ++k) { const int p = 2 * w + k, d2 = p >> 3, kg = p & 7; \
            __builtin_amdgcn_global_load_lds((const unsigned*)(KR + (t0_ + 16 * kg + (lane >> 2)) * 512 + h * 64 + d2 * 32 + (lane & 3) * 8), (LAS unsigned*)(sb_ + KT + p * 1024), 16, 0, 0); } \
        _Pragma("unroll") for (int k = 0; k < 4; ++k) { const int p = 4 * w + k, eg = p >> 3, kg = p & 7; \
            __builtin_amdgcn_global_load_lds((const unsigned*)(VR + (t0_ + 16 * kg + (lane >> 2)) * 1024 + h * 128 + eg * 32 + (lane & 3) * 8), (LAS unsigned*)(sb_ + VI + p * 1024), 16, 0, 0); } } while (0)
    if (c0 > 0) {
        RET_STAGE(0, 0);
        for (int c = 0; c < c0; ++c) {
            __syncthreads();
            if (c + 1 < c0) RET_STAGE(c + 1, (c + 1) & 1);
            LAS const unsigned char* sb = lds + (c & 1) * SET;
            f32x16 kv;
#pragma unroll
            for (int r = 0; r < 16; ++r) kv[r] = 0.f;
#pragma unroll
            for (int ks = 0; ks < 8; ++ks) { LAS const unsigned char* kp = sb + KT + dh * 8192 + ks * 1024 + vpat; LAS const unsigned char* vp = sb + VI + ebo * 8192 + ks * 1024 + vpat;
                const s16x4 klo = vtr(kp), khi = vtr(kp + 512), vlo = vtr(vp), vhi = vtr(vp + 512);
                kv = ATT_MFMA(((bf16x8){klo[0], klo[1], klo[2], klo[3], khi[0], khi[1], khi[2], khi[3]}), ((bf16x8){vlo[0], vlo[1], vlo[2], vlo[3], vhi[0], vhi[1], vhi[2], vhi[3]}), kv); }
#pragma unroll
            for (int r = 0; r < 16; ++r) sblk[r] = gC * (sblk[r] + kv[r]);
        }
        __syncthreads();
#pragma unroll
        for (int g = 0; g < 4; ++g) { unsigned long long v = (unsigned long long)cvt_pk_bf16(sblk[4 * g], sblk[4 * g + 1]) | ((unsigned long long)cvt_pk_bf16(sblk[4 * g + 2], sblk[4 * g + 3]) << 32);
            *(LAS unsigned long long*)(lds + ST + (32 * ebo + r32) * 128 + (32 * dh + 8 * g + 4 * hi) * 2) = v; }
    }
    RET_STAGE(c0, c0 & 1);
    bf16x8 qn[4];
#pragma unroll
    for (int d0 = 0; d0 < 4; ++d0) qn[d0] = *(const bf16x8*)(QR + (tb + (size_t)c0 * 128 + 32 * ib + r32) * 512 + h * 64 + d0 * 16 + hi * 8);
    for (int c = c0; c < c1; ++c) {
        const size_t t0 = tb + (size_t)c * 128;
        __syncthreads();
        LAS const unsigned char* sb = lds + (c & 1) * SET;
        u32x4 gt[4];
#pragma unroll
        for (int k = 0; k < 4; ++k) gt[k] = *(const u32x4*)(SGR + (t0 + prow + 32 * k) * 1024 + h * 128 + pcol);
        bf16x8 qf[4];
#pragma unroll
        for (int d0 = 0; d0 < 4; ++d0) qf[d0] = qn[d0];
        if (c + 1 < c1) { RET_STAGE(c + 1, (c + 1) & 1);
#pragma unroll
            for (int d0 = 0; d0 < 4; ++d0) qn[d0] = *(const bf16x8*)(QR + (t0 + 128 + 32 * ib + r32) * 512 + h * 64 + d0 * 16 + hi * 8); }
        f32x16 O[2];
#pragma unroll
        for (int eb = 0; eb < 2; ++eb)
#pragma unroll
            for (int r = 0; r < 16; ++r) O[eb][r] = 0.f;
#pragma unroll
        for (int jb = 0; jb < 4; ++jb) {
            if (jb <= ib) {
                f32x16 s;
#pragma unroll
                for (int r = 0; r < 16; ++r) s[r] = 0.f;
#pragma unroll
                for (int d0 = 0; d0 < 4; ++d0) { const bf16x8 kf = *(LAS const bf16x8*)(sb + KT + (d0 >> 1) * 8192 + (32 * jb + r32) * 64 + ((d0 & 1) * 16 + 8 * hi) * 2); s = ATT_MFMA(kf, qf[d0], s); }
                if (jb == ib) {
#pragma unroll
                    for (int r = 0; r < 16; ++r) if (crow(r, hi) > r32) s[r] = 0.f;
                }
                u32x4 pw[2];
#pragma unroll
                for (int i = 0; i < 4; ++i) { pw[0][i] = cvt_pk_bf16(s[2 * i], s[2 * i + 1]); pw[1][i] = cvt_pk_bf16(s[8 + 2 * i], s[9 + 2 * i]); }
#pragma unroll
                for (int eb = 0; eb < 2; ++eb)
#pragma unroll
                    for (int ks = 0; ks < 2; ++ks) { LAS const unsigned char* vp = sb + VI + (2 * eh + eb) * 8192 + (2 * jb + ks) * 1024 + vpat;
                        const s16x4 vlo = vtr(vp), vhi = vtr(vp + 512);
                        O[eb] = ATT_MFMA(((bf16x8){vlo[0], vlo[1], vlo[2], vlo[3], vhi[0], vhi[1], vhi[2], vhi[3]}), __builtin_bit_cast(bf16x8, pw[ks]), O[eb]); }
            }
        }
#pragma unroll
        for (int eb = 0; eb < 2; ++eb)
#pragma unroll
            for (int d0 = 0; d0 < 4; ++d0) { const bf16x8 sf = *(LAS const bf16x8*)(lds + ST + (32 * (2 * eh + eb) + r32) * 128 + (16 * d0 + 8 * hi) * 2); O[eb] = ATT_MFMA(sf, qf[d0], O[eb]); }
        { f32x16 kv;
#pragma unroll
          for (int r = 0; r < 16; ++r) kv[r] = 0.f;
#pragma unroll
          for (int ks = 0; ks < 8; ++ks) { LAS const unsigned char* kp = sb + KT + dh * 8192 + ks * 1024 + vpat; LAS const unsigned char* vp = sb + VI + ebo * 8192 + ks * 1024 + vpat;
              const s16x4 klo = vtr(kp), khi = vtr(kp + 512), vlo = vtr(vp), vhi = vtr(vp + 512);
              kv = ATT_MFMA(((bf16x8){klo[0], klo[1], klo[2], klo[3], khi[0], khi[1], khi[2], khi[3]}), ((bf16x8){vlo[0], vlo[1], vlo[2], vlo[3], vhi[0], vhi[1], vhi[2], vhi[3]}), kv); }
#pragma unroll
          for (int r = 0; r < 16; ++r) sblk[r] = gC * (sblk[r] + kv[r]); }
        { float s2 = 0.f;
#pragma unroll
          for (int eb = 0; eb < 2; ++eb)
#pragma unroll
              for (int r = 0; r < 16; ++r) s2 += O[eb][r] * O[eb][r];
          s2 += __shfl_xor(s2, 32);
          if (hi == 0) ((LAS float*)(lds + RED))[(32 * ib + r32) * 2 + eh] = s2; }
#pragma unroll
        for (int eb = 0; eb < 2; ++eb)
#pragma unroll
            for (int g = 0; g < 4; ++g) *(LAS unsigned long long*)(lds + OST + (32 * ib + r32) * 256 + (64 * eh + 32 * eb + 8 * g + 4 * hi) * 2) =
                (unsigned long long)cvt_pk_bf16(O[eb][4 * g], O[eb][4 * g + 1]) | ((unsigned long long)cvt_pk_bf16(O[eb][4 * g + 2], O[eb][4 * g + 3]) << 32);
        asm volatile("s_waitcnt lgkmcnt(0)" ::: "memory"); __builtin_amdgcn_s_barrier(); asm volatile("" ::: "memory");
#pragma unroll
        for (int g = 0; g < 4; ++g) { unsigned long long v = (unsigned long long)cvt_pk_bf16(sblk[4 * g], sblk[4 * g + 1]) | ((unsigned long long)cvt_pk_bf16(sblk[4 * g + 2], sblk[4 * g + 3]) << 32);
            *(LAS unsigned long long*)(lds + ST + (32 * ebo + r32) * 128 + (32 * dh + 8 * g + 4 * hi) * 2) = v; }
#pragma unroll
        for (int k = 0; k < 4; ++k) { const int row = prow + 32 * k; const LAS float* rp = (const LAS float*)(lds + RED) + row * 2;
            const float rs = __builtin_amdgcn_rsqf((rp[0] + rp[1]) * (1.0f / 128.0f) + EPS);
            const u32x4 ov = *(LAS const u32x4*)(lds + OST + row * 256 + pcol * 2); const u32x4 gg = gt[k];
            u32x4 res;
            res.x = cvt_pk_bf16(lo_bf(ov.x) * rs * gA[0] * lo_bf(gg.x), hi_bf(ov.x) * rs * gA[1] * hi_bf(gg.x));
            res.y = cvt_pk_bf16(lo_bf(ov.y) * rs * gA[2] * lo_bf(gg.y), hi_bf(ov.y) * rs * gA[3] * hi_bf(gg.y));
            res.z = cvt_pk_bf16(lo_bf(ov.z) * rs * gB[0] * lo_bf(gg.z), hi_bf(ov.z) * rs * gB[1] * hi_bf(gg.z));
            res.w = cvt_pk_bf16(lo_bf(ov.w) * rs * gB[2] * lo_bf(gg.w), hi_bf(ov.w) * rs * gB[3] * hi_bf(gg.w));
            *(u32x4*)(SGR + (t0 + row) * 1024 + h * 128 + pcol) = res; }
    }
    __syncthreads();
#undef RET_STAGE
}
}

constexpr int MIX_LIST_ITEMS = 16 + 4 * 32;
constexpr int CW_QUEUE = 2048;

#define XB_TMO      128
#define XB_XCNT(j)  (256  + 64 * (j))
#define XB_XSUB(j)  (1280 + 64 * (j))
#define XB_XGEN(j)  (2304 + 64 * (j))
#define XB_TOP      3328
#define XB_TOPGEN   3392
#define XCD_BAR_WORDS 3456
#define XB_SPIN_CAP (1u << 18)
__device__ __forceinline__ unsigned xb_ld(unsigned* p)              { return __hip_atomic_load(p, __ATOMIC_RELAXED, __HIP_MEMORY_SCOPE_AGENT); }
__device__ __forceinline__ unsigned xb_add(unsigned* p, unsigned v) { return __hip_atomic_fetch_add(p, v, __ATOMIC_RELAXED, __HIP_MEMORY_SCOPE_AGENT); }
__device__ __forceinline__ unsigned xb_xcc_id() { return (unsigned)__builtin_amdgcn_s_getreg((3 << 11) | 20) & 0xFu; }
#define XB_SPIN(cond, bar) do { unsigned _sp = 0; while (cond) { __builtin_amdgcn_s_sleep(1); \
    if ((++_sp & 255u) == 0u) { if (xb_ld(&(bar)[XB_TMO])) break; if (_sp > XB_SPIN_CAP) { atomicAdd(&(bar)[XB_TMO], 1u); break; } } } } while (0)
struct XcdBarrier { unsigned* bar; unsigned x; volatile LAS unsigned* st; };
__device__ __forceinline__ XcdBarrier xcd_barrier_post(unsigned* bar, volatile LAS unsigned* st) {
    XcdBarrier b; b.bar = bar; b.x = xb_xcc_id(); b.st = st;
    if (threadIdx.x == 0) (void)xb_add(&bar[XB_XCNT(b.x)], 1u);
    return b;
}
__device__ __forceinline__ void xcd_barrier_complete(unsigned* bar, unsigned x, unsigned& nloc, unsigned& nx) {
    const unsigned G = gridDim.x * gridDim.y * gridDim.z;
    unsigned sum, cnt, mine, sp = 0u;
    for (;;) {
        sum = 0u; cnt = 0u; mine = 0u;
#pragma unroll
        for (unsigned j = 0; j < 16; ++j) { const unsigned c = xb_ld(&bar[XB_XCNT(j)]); sum += c; cnt += (c > 0u) ? 1u : 0u; mine = (j == x) ? c : mine; }
        if (sum == G) break;
        __builtin_amdgcn_s_sleep(1);
        if ((++sp & 255u) == 0u) { if (xb_ld(&bar[XB_TMO])) break; if (sp > XB_SPIN_CAP) { atomicAdd(&bar[XB_TMO], 1u); break; } }
    }
    nloc = mine > 0u ? mine : 1u; nx = cnt > 0u ? cnt : 1u;
}
__device__ __forceinline__ void xcd_barrier(const XcdBarrier& b) {
    asm volatile("s_waitcnt vmcnt(0)" ::: "memory");
    __syncthreads();
    if (threadIdx.x == 0) {
        unsigned* bar = b.bar;
        __builtin_amdgcn_s_waitcnt(0);
        unsigned nloc = b.st[0], nx = b.st[1];
        if (nloc == 0u) { xcd_barrier_complete(bar, b.x, nloc, nx); b.st[0] = nloc; b.st[1] = nx; }
        const unsigned old = xb_add(&bar[XB_XSUB(b.x)], 1u);
        const unsigned gen = old / nloc;
        if (old + 1u == (gen + 1u) * nloc) {
            __builtin_amdgcn_fence(__ATOMIC_RELEASE, "agent");
            asm volatile("s_waitcnt vmcnt(0)" ::: "memory");
            const unsigned og = xb_add(&bar[XB_TOP], 1u);
            const unsigned tg = og / nx;
            if (og + 1u == (tg + 1u) * nx) xb_add(&bar[XB_TOPGEN], 1u);
            else XB_SPIN(xb_ld(&bar[XB_TOPGEN]) == tg, bar);
            __builtin_amdgcn_fence(__ATOMIC_ACQUIRE, "agent");
            xb_add(&bar[XB_XGEN(b.x)], 1u);
            asm volatile("s_waitcnt vmcnt(0)" ::: "memory");
        } else {
            XB_SPIN(xb_ld(&bar[XB_XGEN(b.x)]) == gen, bar);
            __builtin_amdgcn_fence(__ATOMIC_ACQUIRE, "agent");
            asm volatile("s_waitcnt vmcnt(0)" ::: "memory");
        }
    }
    __syncthreads();
}

#define LDS_WAIT() asm volatile("s_waitcnt lgkmcnt(0)" ::: "memory")
__device__ __forceinline__ float wave_sum(float v) {
#pragma unroll
    for (int o = 1; o < 64; o <<= 1) v += __shfl_xor(v, o);
    return v;
}
constexpr int P0_SCR_BYTES = 64 * 65 * 4;
__device__ __forceinline__ void p0_transpose_item(const float* W, int K, int N, bf16* WT, LAS float* scr, int item, int lane) {
    const int nblk = N / 64, kb = item / nblk, nb = item % nblk, k0 = 64 * kb, n0 = 64 * nb;
    const int lr = lane >> 4, lc = (lane & 15) * 4;
    const GAS f32x4* src = (const GAS f32x4*)(W + (size_t)(k0 + lr) * N + n0 + lc);
    f32x4 v[16];
#pragma unroll
    for (int i = 0; i < 16; ++i) v[i] = src[(size_t)i * N];
#pragma unroll
    for (int i = 0; i < 16; ++i) { LAS float* d = scr + (4 * i + lr) * 65 + lc; d[0] = v[i].x; d[1] = v[i].y; d[2] = v[i].z; d[3] = v[i].w; }
    LDS_WAIT(); asm volatile("" ::: "memory");
    const int c = lane & 7;
#pragma unroll
    for (int j = 0; j < 8; ++j) { const int n = (lane >> 3) + 8 * j; const LAS float* q = scr + (8 * c) * 65 + n;
        u32x4 o; o.x = pk2(q[0 * 65], q[1 * 65]); o.y = pk2(q[2 * 65], q[3 * 65]); o.z = pk2(q[4 * 65], q[5 * 65]); o.w = pk2(q[6 * 65], q[7 * 65]);
        *(GAS u32x4*)(WT + (size_t)(n0 + n) * K + k0 + 8 * c) = o; }
    LDS_WAIT(); asm volatile("" ::: "memory");
}
__device__ __forceinline__ void rms_rows4_to_bf16(const float* xrow, const float* g, bf16* orow, int lane) {
    const GAS f32x4* xr = (const GAS f32x4*)xrow + lane; const GAS f32x4* gr = (const GAS f32x4*)g + lane;
    f32x4 v[4][4];
#pragma unroll
    for (int r = 0; r < 4; ++r)
#pragma unroll
        for (int j = 0; j < 4; ++j) v[r][j] = xr[256 * r + 64 * j];
    f32x4 gg[4];
#pragma unroll
    for (int j = 0; j < 4; ++j) gg[j] = gr[64 * j];
    GAS unsigned long long* o8 = (GAS unsigned long long*)orow + lane;
#pragma unroll
    for (int r = 0; r < 4; ++r) { float s = 0.f;
#pragma unroll
        for (int j = 0; j < 4; ++j) s += (v[r][j].x * v[r][j].x + v[r][j].y * v[r][j].y) + (v[r][j].z * v[r][j].z + v[r][j].w * v[r][j].w);
        const float rs = 1.0f / sqrtf(wave_sum(s) * (1.f / DM) + EPS);
#pragma unroll
        for (int j = 0; j < 4; ++j)
            o8[256 * r + 64 * j] = (unsigned long long)pk2(v[r][j].x * rs * gg[j].x, v[r][j].y * rs * gg[j].y) | ((unsigned long long)pk2(v[r][j].z * rs * gg[j].z, v[r][j].w * rs * gg[j].w) << 32); }
}

__device__ __forceinline__ const float* in_ptr(int k) {
    typedef __attribute__((address_space(4))) const char* cptr4;
    cptr4 ka = (cptr4)__builtin_amdgcn_kernarg_segment_ptr(); cptr4 kb;
    asm volatile("s_mov_b64 %0, %1" : "=s"(kb) : "s"(ka));
    typedef const float* cfp; typedef __attribute__((address_space(4))) const cfp* cfp4;
    return *(cfp4)(kb + k * 8);
}
constexpr int NWAVES = 8;
constexpr int RING_BYTES = 131072, LDS_BYTES = 163840, LDSCTL_OFF = LDS_BYTES - 1024, MISC_OFF = LDSCTL_OFF + 320;
struct Args { const float* in[14]; float* out; unsigned char* ws; int ph_lo, ph_hi, li, pad; };
constexpr int N_PHASES = 10;

__global__ void __launch_bounds__(NWAVES * 64, 2) mk_fwd(Args args) {
    extern __shared__ __attribute__((aligned(16))) unsigned char lds_raw[];
    LAS unsigned char* lds = (LAS unsigned char*)lds_raw;
    volatile LAS unsigned* MISC = (volatile LAS unsigned*)(lds + MISC_OFF);
    const int tid = threadIdx.x, lane_k = tid & 63, wave = __builtin_amdgcn_readfirstlane(tid >> 6);
    const int G = gridDim.x, bx = blockIdx.x; const int vcu = (G % 8 == 0) ? (bx % 8) * (G / 8) + bx / 8 : bx;
    unsigned char* const ws_k = (unsigned char*)in_ptr(15);
    unsigned* ctl = (unsigned*)(ws_k + WS_CTL);
    for (int u = tid; u < (LDS_BYTES - LDSCTL_OFF) / 4; u += NWAVES * 64) ((LAS unsigned*)(lds + LDSCTL_OFF))[u] = 0u;
    __syncthreads();
    const int lo = args.ph_lo, hi = args.ph_hi;
    XcdBarrier bar; bar.bar = ctl + CW_BAR + args.li * XCD_BAR_WORDS; bar.x = 0; bar.st = nullptr;
    if (hi - lo > 1) bar = xcd_barrier_post(ctl + CW_BAR + args.li * XCD_BAR_WORDS, MISC + 8);
#define IN(k) (lo <= (k) && (k) < hi)
#define SEAM(k) do { if (IN(k) && IN((k) + 1)) xcd_barrier(bar); } while (0)

    if (IN(0)) {
        unsigned char* const ws = ws_k; int lane = lane_k; asm volatile("" : "+v"(lane));
        LAS float* scr = (LAS float*)(lds + wave * P0_SCR_BYTES);
        const int gw = vcu * NWAVES + wave, NGW = G * NWAVES;
        constexpr int I_IN = (DM / 64) * (NIN / 64), I_SQ = (DM / 64) * (DM / 64);
        for (int it = gw; it < 2 * I_IN + 6 * I_SQ; it += NGW) {
            int r = it;
            if (r < 2 * I_IN) { const int l = r / I_IN; p0_transpose_item(in_ptr(2) + (size_t)l * DM * NIN, DM, NIN, (bf16*)(ws + (l == 0 ? WS_WIN0 : WS_WIN)), scr, r % I_IN, lane); continue; } r -= 2 * I_IN;
            const int which = r / I_SQ, item = r % I_SQ, l = which / 3, w = which % 3;
            const float* src = (w == 0 ? in_ptr(4) : w == 1 ? in_ptr(12) : in_ptr(13)) + (size_t)l * DM * DM;
            bf16* dst = (bf16*)(ws + (l == 0 ? WS_WRO : WS_W1) + (size_t)w * 2 * MiB);
            p0_transpose_item(src, DM, DM, dst, scr, item, lane);
        }
        const float* x0 = in_ptr(0); const float* g0 = in_ptr(1); bf16* H = (bf16*)in_ptr(14);
        for (int m = 4 * gw; m < T; m += 4 * NGW) rms_rows4_to_bf16(x0 + (size_t)m * DM, g0, H + (size_t)m * DM, lane);
        LDS_WAIT(); __syncthreads();
    }
    SEAM(0);

#pragma unroll 1
    for (int l = 0; l < DEPTH; ++l) {
        const int pb = 1 + 5 * l;
        if (IN(pb)) {
            unsigned char* const ws = ws_k;
            Epi<0> E; E.ws = ws; E.xin = nullptr; E.xout = nullptr; E.gq = in_ptr(5) + l * 64; E.gk = in_ptr(6) + l * 64;
            SchedG1A S{l == 0 ? (const char*)in_ptr(14) : (const char*)(ws + WS_H), (const char*)(ws + (l == 0 ? WS_WIN0 : WS_WIN)), G, bx};
            pg8::gemm_phase<Epi<0>, SchedG1A, true, true>(lds, DM, S, E);
        }
        SEAM(pb);
        if (IN(pb + 1)) {
            unsigned char* const ws = ws_k;
            float s1 = 0.f, s2 = 0.f; { const float* q1 = in_ptr(7) + l * 64; const float* k1 = in_ptr(8) + l * 64; const float* q2 = in_ptr(9) + l * 64; const float* k2 = in_ptr(10) + l * 64;
                for (int i = 0; i < 64; ++i) { s1 += q1[i] * k1[i]; s2 += q2[i] * k2[i]; } }
            const float lam_init = 0.8f - 0.6f * __expf(-0.3f * (float)l), lam = __expf(s1) - __expf(s2) + lam_init;
            const float* gsub = in_ptr(11) + l * 1024;
            float gqm = 0.f, gkm = 0.f; { const float* gq = in_ptr(5) + l * 64; const float* gk = in_ptr(6) + l * 64; for (int i = 0; i < 64; ++i) { gqm = fmaxf(gqm, fabsf(gq[i])); gkm = fmaxf(gkm, fabsf(gk[i])); } }
            const float Bnd = 1.02f * 8.0f * LOG2E * gqm * gkm;
            const float* gret = in_ptr(3) + l * 1024;
            unsigned* qbase = ctl + CW_QUEUE + 512 * l;
            int lst = (int)(xb_xcc_id() & 7u), tried = 0;
            for (;;) {
                if (tid == 0) {
                    unsigned it = 0xffffffffu;
                    while (tried < 8) { it = __hip_atomic_fetch_add(qbase + 32 * lst, 1u, __ATOMIC_RELAXED, __HIP_MEMORY_SCOPE_AGENT); if (it < (unsigned)MIX_LIST_ITEMS) break; it = 0xffffffffu; lst = (lst + 1) & 7; ++tried; }
                    MISC[16] = it; MISC[17] = (unsigned)lst;
                }
                __syncthreads();
                const unsigned item = MISC[16]; const int li_ = (int)MISC[17];
                __syncthreads();
                if (item == 0xffffffffu) break;
                const int bb = li_ >> 1; const unsigned htab = (li_ & 1) ? 0x0156u : 0x2347u;
                if (item < 16u) { const int hh = (int)((htab >> (4 * (item & 3u))) & 7u), qt = 3 - (int)(item >> 2); ret::ret_unit(lds, ws, bb, hh, gret, 8 * qt, 8 * qt + 8); }
                else { const unsigned a_ = item - 16u; const int hh = (int)((htab >> (4 * (a_ >> 5))) & 7u), qb = 31 - (int)(a_ & 31u);
                    const float wf = (2.0f * Bnd + 28.0f) / (__builtin_amdgcn_exp2f(-(float)(hh + 1)) * LOG2E);
                    att::attn_unit(lds, ws, bb, hh, qb, lam, 1.0f - lam_init, gsub, wf < 8192.f ? (int)wf + 1 : 8192); }
            }
        }
        SEAM(pb + 1);
        if (IN(pb + 2)) {
            unsigned char* const ws = ws_k;
            Epi<1> E; E.ws = ws; E.xin = nullptr; E.xout = nullptr; E.gq = nullptr; E.gk = nullptr;
            SchedP34 S{(const char*)ws, (const char*)(ws + (l == 0 ? WS_WRO : WS_W1)), l == 0 ? (const char*)in_ptr(14) : (const char*)(ws + WS_H), (const char*)(ws + (l == 0 ? WS_WIN0 : WS_WIN)), bx};
            pg8::gemm_phase<Epi<1>, SchedP34, true, true>(lds, DM, S, E);
        }
        SEAM(pb + 2);
        if (IN(pb + 3)) {
            unsigned char* const ws = ws_k;
            Epi<2> E; E.ws = ws; E.xin = (l == 0) ? in_ptr(0) : (const float*)in_ptr(14); E.xout = (float*)in_ptr(14); E.gq = nullptr; E.gk = nullptr;
            SchedG4 S{(const char*)(ws + WS_MBF), (const char*)(ws + (l == 0 ? WS_WRO : WS_W1) + 4 * MiB), bx};
            pg8::gemm_phase<Epi<2>, SchedG4, false, true>(lds, DM, S, E);
        }
        SEAM(pb + 3);
        if (l == 0) {
            if (IN(5)) {
                unsigned char* const ws = ws_k; int lane = lane_k; asm volatile("" : "+v"(lane));
                bf16* H = (bf16*)(ws + WS_H);
                const int gw = vcu * NWAVES + wave, NGW = G * NWAVES;
                const float* x1 = in_ptr(14); const float* g1 = in_ptr(1) + DM;
                for (int m = 4 * gw; m < T; m += 4 * NGW) rms_rows4_to_bf16(x1 + (size_t)m * DM, g1, H + (size_t)m * DM, lane);
                __syncthreads();
            }
            SEAM(5);
        }
    }
#undef IN
#undef SEAM
}

extern "C" void kernel_launch(void* const* d_in, const int* in_sizes, int n_in, void* d_out, int out_size, void* d_ws, size_t ws_size, hipStream_t stream) {
    static int ready = 0;
    if (ready == 0) {
        if (n_in != 14 || ws_size < WS_END || out_size != T * DM) { fprintf(stderr, "kernel_launch: unexpected problem (n_in %d, ws %zu, out %d)\n", n_in, ws_size, out_size); ready = -1; return; }
        if (hipFuncSetAttribute((const void*)mk_fwd, hipFuncAttributeMaxDynamicSharedMemorySize, LDS_BYTES) != hipSuccess) { fprintf(stderr, "kernel_launch: hipFuncSetAttribute failed\n"); ready = -1; return; }
        ready = 1;
    }
    if (ready < 0) return;
    (void)hipMemsetAsync((char*)d_ws + WS_CTL, 0, CTL_ZERO_BYTES, stream);
    Args a{};
    for (int i = 0; i < 14; ++i) a.in[i] = (const float*)d_in[i];
    a.out = (float*)d_out; a.ws = (unsigned char*)d_ws;
    a.ph_lo = 0; a.ph_hi = N_PHASES; a.li = 0;
    hipLaunchKernelGGL(mk_fwd, dim3(256), dim3(NWAVES * 64), LDS_BYTES, stream, a);
}
```

```cpp
#include <hip/hip_runtime.h>
#include <cstdio>
#include <cstdint>
#include <cstddef>

constexpr int DM = 1024, BATCH = 4, SEQ = 4096, DEPTH = 2, T = BATCH * SEQ, NIN = 9216;
constexpr float EPS = 1e-6f;
constexpr float LOG2E = 1.4426950408889634f;

typedef unsigned short bf16;
typedef short bf16x8 __attribute__((ext_vector_type(8)));
typedef float f32x4 __attribute__((ext_vector_type(4)));
typedef unsigned u32x4 __attribute__((ext_vector_type(4)));
#define LAS __attribute__((address_space(3)))
#define GAS __attribute__((address_space(1)))

__device__ __forceinline__ float bf2f(bf16 v) { return __uint_as_float(((unsigned)v) << 16); }
__device__ __forceinline__ unsigned f2bf_u(float f) { unsigned u = __float_as_uint(f); return (u + 0x7fffu + ((u >> 16) & 1u)) >> 16; }
__device__ __forceinline__ bf16 f2bf(float f) { return (bf16)f2bf_u(f); }
__device__ __forceinline__ unsigned pk2(float lo, float hi) { return f2bf_u(lo) | (f2bf_u(hi) << 16); }
typedef float f32x2_t __attribute__((ext_vector_type(2))); typedef __bf16 bf16x2_t __attribute__((ext_vector_type(2)));
__device__ __forceinline__ unsigned cvt_pk_bf16(float lo, float hi) { f32x2_t v = {lo, hi}; bf16x2_t b = __builtin_convertvector(v, bf16x2_t); return __builtin_bit_cast(unsigned, b); }
__device__ __forceinline__ float fast_sigmoid(float v) { return __builtin_amdgcn_rcpf(1.0f + __builtin_amdgcn_exp2f(-v * LOG2E)); }
__device__ __forceinline__ float lo_bf(unsigned w) { return __uint_as_float(w << 16); }
__device__ __forceinline__ float hi_bf(unsigned w) { return __uint_as_float(w & 0xffff0000u); }

constexpr size_t MiB = 1u << 20;
constexpr size_t WS_CTL = 0, CTL_ZERO_BYTES = 64 * 1024;
constexpr size_t WS_WIN = 1 * MiB, WS_WRO = 19 * MiB, WS_WDO = 21 * MiB, WS_WOUT = 23 * MiB;
constexpr size_t WS_H = 25 * MiB, WS_QR = 57 * MiB, WS_KR = 73 * MiB, WS_VR = 89 * MiB, WS_SGR = 121 * MiB, WS_QD = 153 * MiB, WS_KD = 185 * MiB,
                 WS_VD = 217 * MiB, WS_SGD = 249 * MiB;
constexpr size_t WS_WIN0 = WS_H;
constexpr size_t WS_W1 = 281 * MiB;
constexpr size_t WS_END = 287 * MiB;
constexpr size_t WS_MBUF = 57 * MiB;
constexpr size_t WS_MBF = WS_VD;
constexpr size_t WS_SMGR = WS_QD, WS_SMGD = WS_KD;
constexpr int CW_BAR = 4096;

namespace pg8 {
constexpr int BM = 256, BK = 64, HALF = 128, HTB = HALF * BK * 2, STAGE_BYTES = 8 * HTB, NXCD = 8, WGM = 8;
__host__ __device__ __forceinline__ int lds_byte(int r, int c) { const int st = (r >> 4) * 2 + (c >> 5), rr = r & 15, cc = c & 31, ob = rr * 64 + cc * 2; return st * 1024 + (ob ^ (((ob >> 9) & 1) << 5)); }
__host__ __device__ __forceinline__ void stage_rc(int b, int& R, int& C) { const int st = b / 1024, sb = b % 1024, swz = sb ^ (((sb >> 9) & 1) << 5); R = (st >> 1) * 16 + swz / 64; C = (st & 1) * 32 + (swz % 64) / 2; }
__host__ __device__ __forceinline__ int perm32(int rho) { const int n = rho >> 4, i = rho & 15; return 8 * (i >> 2) + 4 * n + (i & 3); }

struct Unit { int pm, pn, kind; const char* a; const char* b; };

__device__ __forceinline__ void tile_of(int L, int nM, int nN, int& pm, int& pn) {
    const int nwg = nM * nN; int wgid = L;
    { const int q = nwg / NXCD, r = nwg % NXCD, xcd = wgid % NXCD, off = wgid / NXCD; wgid = (xcd < r ? xcd * (q + 1) : r * (q + 1) + (xcd - r) * q) + off; }
    const int nig = WGM * nN, gid = wgid / nig, fm = gid * WGM, gsz = (nM - fm) < WGM ? (nM - fm) : WGM;
    pm = fm + ((wgid % nig) % gsz); pn = (wgid % nig) / gsz;
}

template <class Epi, class Sched, bool ALIGN_EPI, bool SP2>
__device__ __forceinline__ void gemm_phase(LAS unsigned char* lds, const int K, const Sched& S, const Epi& E) {
    int tid_ = threadIdx.x; asm volatile("" : "+v"(tid_));
    const int tid = tid_, wid = __builtin_amdgcn_readfirstlane(tid >> 6), lane = tid & 63, wr = wid >> 2, wc = wid & 3, fr = lane & 15, fq = lane >> 4;
    const int nt = K / BK;
    unsigned voffA[2], voffB[2];
#pragma unroll
    for (int i = 0; i < 2; ++i) { int R, C; stage_rc(tid * 16 + i * 8192, R, C); const int Rb = (R >> 5) * 64 + perm32(R & 31);
        voffA[i] = (unsigned)(R * K + C) * 2u; voffB[i] = (unsigned)(Rb * K + C) * 2u; }
    const size_t kstep = (size_t)(BK * 2);
    const size_t hstep = (size_t)HALF * K * 2;
    const size_t hstepB = (size_t)32 * K * 2;
    const unsigned ldsw = (unsigned)wid * 1024u;
    const int aoff = lds_byte(wr * 64 + fr, fq * 8), boff = lds_byte(wc * 32 + fr, fq * 8);
#define PG8_SA(b, h) (((b) * 2 + (h)) * HTB)
#define PG8_SB(b, h) ((4 + (b) * 2 + (h)) * HTB)
#define PG8_STAGE(bufoff, gbase, voff) do { _Pragma("unroll") for (int _i = 0; _i < 2; ++_i) \
        __builtin_amdgcn_global_load_lds((const unsigned*)((const char*)(gbase) + (voff)[_i]), (LAS unsigned*)(lds + (bufoff) + ldsw + _i * 8192), 16, 0, 0); } while (0)
#define PG8_LDA(dst, b, h) do { _Pragma("unroll") for (int m = 0; m < 4; ++m) _Pragma("unroll") for (int k = 0; k < 2; ++k) dst[m][k] = *(const LAS bf16x8*)(lds + PG8_SA(b, h) + aoff + m * 2048 + k * 1024); } while (0)
#define PG8_LDB(dst, b, h) do { _Pragma("unroll") for (int n = 0; n < 2; ++n) _Pragma("unroll") for (int k = 0; k < 2; ++k) dst[n][k] = *(const LAS bf16x8*)(lds + PG8_SB(b, h) + boff + n * 2048 + k * 1024); } while (0)
#define PG8_MMA(ai, bj, At, Bt) do { __builtin_amdgcn_s_setprio(1); _Pragma("unroll") for (int m = 0; m < 4; ++m) _Pragma("unroll") for (int n = 0; n < 2; ++n) _Pragma("unroll") for (int k = 0; k < 2; ++k) \
        acc[ai][bj][m][n] = __builtin_amdgcn_mfma_f32_16x16x32_bf16(Bt[n][k], At[m][k], acc[ai][bj][m][n], 0, 0, 0); __builtin_amdgcn_s_setprio(0); } while (0)
#define PG8_WAIT_V(n) asm volatile("s_waitcnt vmcnt(" #n ")" ::: "memory")
#define PG8_WAIT_L(n) asm volatile("s_waitcnt lgkmcnt(" #n ")" ::: "memory")
#define PG8_BAR __builtin_amdgcn_s_barrier()
#define PG8_SCHED __builtin_amdgcn_sched_barrier(0)
    Unit cur, nxt; int ui = 0;
    if (!S.next(0, cur)) return;
    f32x4 acc[2][2][4][2];
#pragma unroll
    for (int a = 0; a < 2; ++a)
#pragma unroll
        for (int b = 0; b < 2; ++b)
#pragma unroll
            for (int m = 0; m < 4; ++m)
#pragma unroll
                for (int n = 0; n < 2; ++n) acc[a][b][m][n] = (f32x4){0.f, 0.f, 0.f, 0.f};
    bf16x8 At[4][2], B0[2][2], B1[2][2];
    const char* cA = cur.a; const char* cB = cur.b;
    if constexpr (SP2) {
        PG8_STAGE(PG8_SB(0, 0), cB, voffB); PG8_STAGE(PG8_SB(0, 1), cB + hstepB, voffB); PG8_STAGE(PG8_SA(0, 0), cA, voffA); PG8_STAGE(PG8_SA(0, 1), cA + hstep, voffA);
        if (wr == 1) PG8_BAR;
        PG8_WAIT_V(2); PG8_BAR;
        PG8_STAGE(PG8_SB(1, 0), cB + kstep, voffB); PG8_STAGE(PG8_SA(1, 0), cA + kstep, voffA); PG8_STAGE(PG8_SB(1, 1), cB + hstepB + kstep, voffB);
        PG8_WAIT_V(6); PG8_BAR;
    } else {
        PG8_STAGE(PG8_SB(0, 0), cB, voffB); PG8_STAGE(PG8_SA(0, 0), cA, voffA); PG8_STAGE(PG8_SB(0, 1), cB + hstepB, voffB); PG8_STAGE(PG8_SA(0, 1), cA + hstep, voffA);
        if (wr == 1) PG8_BAR;
        PG8_WAIT_V(4); PG8_BAR;
        PG8_STAGE(PG8_SB(1, 0), cB + kstep, voffB); PG8_STAGE(PG8_SA(1, 0), cA + kstep, voffA); PG8_STAGE(PG8_SB(1, 1), cB + hstepB + kstep, voffB);
        PG8_WAIT_V(6); PG8_BAR;
    }
    for (;;) {
        const bool has_next = S.next(ui + 1, nxt);
        const char* nA = has_next ? nxt.a : cA; const char* nB = has_next ? nxt.b : cB;
        for (int t = 0; t < nt; t += 2) {
            const bool last = (t == nt - 2);
            const char* a1 = cA + (size_t)(t + 1) * kstep;
            const char* a2 = last ? nA : cA + (size_t)(t + 2) * kstep; const char* b2 = last ? nB : cB + (size_t)(t + 2) * kstep;
            const char* a3 = a2 + kstep; const char* b3 = b2 + kstep;
            if constexpr (SP2) {
            PG8_LDB(B0, 0, 0); PG8_LDB(B1, 0, 1); PG8_SCHED; PG8_LDA(At, 0, 0); PG8_STAGE(PG8_SA(1, 1), a1 + hstep, voffA);
            PG8_WAIT_V(8); PG8_WAIT_L(0); PG8_BAR; PG8_MMA(0, 0, At, B0); PG8_MMA(0, 1, At, B1); PG8_BAR; PG8_SCHED;
            PG8_LDA(At, 0, 1); PG8_STAGE(PG8_SB(0, 0), b2, voffB); PG8_STAGE(PG8_SB(0, 1), b2 + hstepB, voffB); PG8_STAGE(PG8_SA(0, 0), a2, voffA);
            PG8_WAIT_V(8); PG8_WAIT_L(0); PG8_BAR; PG8_MMA(1, 0, At, B0); PG8_MMA(1, 1, At, B1); PG8_BAR; PG8_SCHED;
            PG8_LDB(B0, 1, 0); PG8_LDB(B1, 1, 1); PG8_SCHED; PG8_LDA(At, 1, 0); PG8_STAGE(PG8_SA(0, 1), a2 + hstep, voffA);
            PG8_WAIT_V(8); PG8_WAIT_L(0); PG8_BAR; PG8_MMA(0, 0, At, B0); PG8_MMA(0, 1, At, B1); PG8_BAR; PG8_SCHED;
            PG8_LDA(At, 1, 1); PG8_STAGE(PG8_SB(1, 0), b3, voffB); PG8_STAGE(PG8_SB(1, 1), b3 + hstepB, voffB); PG8_STAGE(PG8_SA(1, 0), a3, voffA);
            PG8_WAIT_V(8); PG8_WAIT_L(0); PG8_BAR; PG8_MMA(1, 0, At, B0); PG8_MMA(1, 1, At, B1); PG8_BAR; PG8_SCHED;
            } else {
            PG8_LDB(B0, 0, 0); PG8_SCHED; PG8_LDA(At, 0, 0); PG8_STAGE(PG8_SA(1, 1), a1 + hstep, voffA);
            PG8_WAIT_L(8); PG8_BAR; PG8_WAIT_L(0); PG8_MMA(0, 0, At, B0); PG8_BAR; PG8_SCHED;
            PG8_LDB(B1, 0, 1); PG8_STAGE(PG8_SB(0, 0), b2, voffB);
            PG8_BAR; PG8_WAIT_L(0); PG8_MMA(0, 1, At, B1); PG8_BAR;
            PG8_LDA(At, 0, 1); PG8_STAGE(PG8_SA(0, 0), a2, voffA);
            PG8_BAR; PG8_WAIT_L(0); PG8_MMA(1, 0, At, B0); PG8_BAR; PG8_SCHED;
            PG8_STAGE(PG8_SB(0, 1), b2 + hstepB, voffB);
            PG8_WAIT_V(6); PG8_BAR; PG8_MMA(1, 1, At, B1); PG8_BAR;
            PG8_LDB(B0, 1, 0); PG8_SCHED; PG8_LDA(At, 1, 0); PG8_STAGE(PG8_SA(0, 1), a2 + hstep, voffA);
            PG8_WAIT_L(8); PG8_BAR; PG8_WAIT_L(0); PG8_MMA(0, 0, At, B0); PG8_BAR; PG8_SCHED;
            PG8_LDB(B1, 1, 1); PG8_STAGE(PG8_SB(1, 0), b3, voffB);
            PG8_BAR; PG8_WAIT_L(0); PG8_MMA(0, 1, At, B1); PG8_BAR;
            PG8_LDA(At, 1, 1); PG8_STAGE(PG8_SA(1, 0), a3, voffA);
            PG8_BAR; PG8_WAIT_L(0); PG8_MMA(1, 0, At, B0); PG8_BAR; PG8_SCHED;
            PG8_STAGE(PG8_SB(1, 1), b3 + hstepB, voffB);
            PG8_WAIT_V(6); PG8_BAR; PG8_MMA(1, 1, At, B1); PG8_BAR;
            }
        }
        if constexpr (ALIGN_EPI) { if (wr == 0) PG8_BAR; }
        E(acc, cur, wr, wc, fr, fq);
        if (!has_next) break;
#pragma unroll
        for (int a = 0; a < 2; ++a)
#pragma unroll
            for (int b = 0; b < 2; ++b)
#pragma unroll
                for (int m = 0; m < 4; ++m)
#pragma unroll
                    for (int n = 0; n < 2; ++n) acc[a][b][m][n] = (f32x4){0.f, 0.f, 0.f, 0.f};
        cur = nxt; cA = nA; cB = nB; ++ui;
        if constexpr (ALIGN_EPI) { if (wr == 1) PG8_BAR; }
    }
    PG8_WAIT_V(0);
    if constexpr (!ALIGN_EPI) { if (wr == 0) PG8_BAR; }
    PG8_BAR;
#undef PG8_SA
#undef PG8_SB
#undef PG8_STAGE
#undef PG8_LDA
#undef PG8_LDB
#undef PG8_MMA
#undef PG8_WAIT_V
#undef PG8_WAIT_L
#undef PG8_BAR
#undef PG8_SCHED
}
}

enum { K_QR = 0, K_KR, K_VR, K_SGR, K_QD, K_KD, K_VD, K_SGD, K_MGR, K_YR, K_MGD, K_YD, K_OUT };
constexpr size_t TSTEP = (size_t)256 * DM * 2;

template <int PC  > struct Epi {
    unsigned char* ws; const float* xin; float* xout; const float* gq; const float* gk;
    __device__ __forceinline__ static void st8(bf16* p, const f32x4 a, const f32x4 b) {
        u32x4 w; w.x = cvt_pk_bf16(a[0], a[1]); w.y = cvt_pk_bf16(a[2], a[3]); w.z = cvt_pk_bf16(b[0], b[1]); w.w = cvt_pk_bf16(b[2], b[3]); *(u32x4*)p = w; }
    __device__ __forceinline__ void operator()(const f32x4 (&acc)[2][2][4][2], const pg8::Unit& u, int wr, int wc, int fr, int fq) const {
        const int row0 = u.pm * 256 + wr * 64 + fr;
        const int cl = wc * 64 + 8 * fq;
        const int kind = u.kind;
        bf16* const qr = (bf16*)(ws + WS_QR); bf16* const kr = (bf16*)(ws + WS_KR); bf16* const vr = (bf16*)(ws + WS_VR); bf16* const sgr = (bf16*)(ws + WS_SGR);
        bf16* const qd = (bf16*)(ws + WS_QD); bf16* const kd = (bf16*)(ws + WS_KD); bf16* const vd = (bf16*)(ws + WS_VD); bf16* const sgd = (bf16*)(ws + WS_SGD);
        bf16* const smgr = (bf16*)(ws + WS_SMGR); bf16* const smgd = (bf16*)(ws + WS_SMGD); bf16* const mbf = (bf16*)(ws + WS_MBF); float* const mbuf = (float*)(ws + WS_MBUF);
        if (PC == 0 && (kind == K_VR || kind == K_VD)) {
            bf16* base = (kind == K_VR ? vr : vd) + u.pn * 256 + cl;
#pragma unroll
            for (int ai = 0; ai < 2; ++ai)
#pragma unroll
                for (int m = 0; m < 4; ++m) { bf16* rp = base + (size_t)(row0 + ai * 128 + m * 16) * 1024;
#pragma unroll
                    for (int bj = 0; bj < 2; ++bj) st8(rp + 32 * bj, acc[ai][bj][m][0], acc[ai][bj][m][1]); }
        } else if (PC == 0 && (kind == K_SGR || kind == K_SGD)) {
            bf16* base = (kind == K_SGR ? sgr : sgd) + u.pn * 256 + cl;
#pragma unroll
            for (int ai = 0; ai < 2; ++ai)
#pragma unroll
                for (int m = 0; m < 4; ++m) { bf16* rp = base + (size_t)(row0 + ai * 128 + m * 16) * 1024;
#pragma unroll
                    for (int bj = 0; bj < 2; ++bj) { f32x4 a = acc[ai][bj][m][0], b = acc[ai][bj][m][1];
#pragma unroll
                        for (int i = 0; i < 4; ++i) { a[i] = a[i] * fast_sigmoid(a[i]); b[i] = b[i] * fast_sigmoid(b[i]); }
                        st8(rp + 32 * bj, a, b); } }
        } else if (PC == 1 && (kind == K_MGR || kind == K_MGD)) {
            bf16* base = (kind == K_MGR ? smgr : smgd) + u.pn * 256 + cl;
#pragma unroll
            for (int ai = 0; ai < 2; ++ai)
#pragma unroll
                for (int m = 0; m < 4; ++m) { bf16* rp = base + (size_t)(row0 + ai * 128 + m * 16) * 1024;
#pragma unroll
                    for (int bj = 0; bj < 2; ++bj) { f32x4 a = acc[ai][bj][m][0], b = acc[ai][bj][m][1];
#pragma unroll
                        for (int i = 0; i < 4; ++i) { a[i] = fast_sigmoid(a[i]); b[i] = fast_sigmoid(b[i]); }
                        st8(rp + 32 * bj, a, b); } }
        } else if (PC == 0 && (kind == K_QR || kind == K_KR)) {
            const int h = u.pn * 4 + wc; const float lg = __log2f(1.0f - __builtin_amdgcn_exp2f(-5.0f - (float)h));
            bf16* base = (kind == K_QR ? qr : kr) + u.pn * 256 + cl;
            const float sgn = (kind == K_QR) ? lg : -lg, mul = (kind == K_QR) ? 1.0f : 0.125f;
#pragma unroll
            for (int ai = 0; ai < 2; ++ai)
#pragma unroll
                for (int m = 0; m < 4; ++m) { const int row = row0 + ai * 128 + m * 16; bf16* rp = base + (size_t)row * 512;
                    const float f = mul * __builtin_amdgcn_exp2f((float)(row & 127) * sgn);
#pragma unroll
                    for (int bj = 0; bj < 2; ++bj) st8(rp + 32 * bj, acc[ai][bj][m][0] * f, acc[ai][bj][m][1] * f); }
        } else if (PC == 0 && (kind == K_QD || kind == K_KD)) {
            const float* g = (kind == K_QD) ? gq : gk; const float mul = (kind == K_QD) ? 0.125f * LOG2E : 1.0f;
            bf16* base = (kind == K_QD ? qd : kd) + u.pn * 256 + cl;
            f32x4 gv[2][2];
#pragma unroll
            for (int bj = 0; bj < 2; ++bj)
#pragma unroll
                for (int n = 0; n < 2; ++n) gv[bj][n] = *(const f32x4*)(g + 32 * bj + 8 * fq + 4 * n) * mul;
#pragma unroll
            for (int ai = 0; ai < 2; ++ai)
#pragma unroll
                for (int m = 0; m < 4; ++m) { bf16* rp = base + (size_t)(row0 + ai * 128 + m * 16) * 1024;
                    float ss = 0.f;
#pragma unroll
                    for (int bj = 0; bj < 2; ++bj)
#pragma unroll
                        for (int n = 0; n < 2; ++n) { const f32x4 x = acc[ai][bj][m][n]; ss += (x[0] * x[0] + x[1] * x[1]) + (x[2] * x[2] + x[3] * x[3]); }
                    ss += __shfl_xor(ss, 16); ss += __shfl_xor(ss, 32);
                    const float rs = __builtin_amdgcn_rsqf(ss * (1.0f / 64.0f) + EPS);
#pragma unroll
                    for (int bj = 0; bj < 2; ++bj) st8(rp + 32 * bj, acc[ai][bj][m][0] * gv[bj][0] * rs, acc[ai][bj][m][1] * gv[bj][1] * rs); }
        } else if (PC == 1 && kind == K_YR) {
            bf16* const yrb = (bf16*)mbuf + (size_t)u.pn * 256 + cl;
#pragma unroll
            for (int ai = 0; ai < 2; ++ai)
#pragma unroll
                for (int m = 0; m < 4; ++m) { bf16* rp = yrb + (size_t)(row0 + ai * 128 + m * 16) * 1024;
#pragma unroll
                    for (int bj = 0; bj < 2; ++bj) st8(rp + 32 * bj, acc[ai][bj][m][0], acc[ai][bj][m][1]); }
        } else if (PC == 1 && kind == K_YD) {
            const size_t cb = (size_t)u.pn * 256 + cl; const bf16* const yrb = (const bf16*)mbuf;
#pragma unroll
            for (int ai = 0; ai < 2; ++ai)
#pragma unroll
                for (int m = 0; m < 4; ++m) { const size_t ro = (size_t)(row0 + ai * 128 + m * 16) * 1024 + cb;
#pragma unroll
                    for (int bj = 0; bj < 2; ++bj) { const u32x4 sr = *(const u32x4*)(smgr + ro + 32 * bj), sd = *(const u32x4*)(smgd + ro + 32 * bj), yr = *(const u32x4*)(yrb + ro + 32 * bj);
                        const f32x4 a = acc[ai][bj][m][0], b = acc[ai][bj][m][1];
                        f32x4 o0, o1;
                        o0[0] = lo_bf(sr.x) * lo_bf(yr.x) + lo_bf(sd.x) * a[0]; o0[1] = hi_bf(sr.x) * hi_bf(yr.x) + hi_bf(sd.x) * a[1];
                        o0[2] = lo_bf(sr.y) * lo_bf(yr.y) + lo_bf(sd.y) * a[2]; o0[3] = hi_bf(sr.y) * hi_bf(yr.y) + hi_bf(sd.y) * a[3];
                        o1[0] = lo_bf(sr.z) * lo_bf(yr.z) + lo_bf(sd.z) * b[0]; o1[1] = hi_bf(sr.z) * hi_bf(yr.z) + hi_bf(sd.z) * b[1];
                        o1[2] = lo_bf(sr.w) * lo_bf(yr.w) + lo_bf(sd.w) * b[2]; o1[3] = hi_bf(sr.w) * hi_bf(yr.w) + hi_bf(sd.w) * b[3];
                        st8(mbf + ro + 32 * bj, o0, o1); }
                    asm volatile("" ::: "memory"); }
        } else if (PC == 2 && kind == K_OUT) {
            const size_t cb = (size_t)u.pn * 256 + cl;
#pragma unroll
            for (int ai = 0; ai < 2; ++ai) {
                f32x4 pre[4][2][2];
#pragma unroll
                for (int m = 0; m < 4; ++m) { const size_t ro = (size_t)(row0 + ai * 128 + m * 16) * 1024 + cb;
#pragma unroll
                    for (int bj = 0; bj < 2; ++bj) { pre[m][bj][0] = *(const f32x4*)(xin + ro + 32 * bj); pre[m][bj][1] = *(const f32x4*)(xin + ro + 32 * bj + 4); } }
#pragma unroll
                for (int m = 0; m < 4; ++m) { const size_t ro = (size_t)(row0 + ai * 128 + m * 16) * 1024 + cb;
#pragma unroll
                    for (int bj = 0; bj < 2; ++bj) { *(f32x4*)(xout + ro + 32 * bj) = pre[m][bj][0] + acc[ai][bj][m][0]; *(f32x4*)(xout + ro + 32 * bj + 4) = pre[m][bj][1] + acc[ai][bj][m][1]; } }
                asm volatile("" ::: "memory");
            }
        }
    }
};

struct SchedG1A {
    const char* A; const char* B; int G, c;
    __device__ __forceinline__ bool next(int i, pg8::Unit& u) const {
        const int L = i * G + c; if (L >= 64 * 28) return false;
        int pm, pg; pg8::tile_of(L, 64, 28, pm, pg);
        u.pm = pm; u.a = A + (size_t)pm * TSTEP; u.b = B + (size_t)pg * TSTEP;
        if (pg < 2) { u.kind = K_QR; u.pn = pg; } else if (pg < 4) { u.kind = K_KR; u.pn = pg - 2; } else if (pg < 8) { u.kind = K_VR; u.pn = pg - 4; } else if (pg < 12) { u.kind = K_SGR; u.pn = pg - 8; }
        else if (pg < 16) { u.kind = K_QD; u.pn = pg - 12; } else if (pg < 20) { u.kind = K_KD; u.pn = pg - 16; } else if (pg < 24) { u.kind = K_VD; u.pn = pg - 20; } else { u.kind = K_SGD; u.pn = pg - 24; }
        return true;
    }
};
struct SchedP34 {
    const char *ws, *Wro, *H, *Win; int c;
    __device__ __forceinline__ bool next(int i, pg8::Unit& u) const {
        if (i >= 4) return false;
        const char* OR = ws + WS_SGR; const char* OD = ws + WS_SGD; const char* Wdo = Wro + 2 * MiB;
        int pm, pn; pg8::tile_of(c, 64, 4, pm, pn); u.pm = pm; u.pn = pn;
        if (i == 0) { u.kind = K_MGR; u.a = H + (size_t)pm * TSTEP; u.b = Win + (size_t)(28 + pn) * TSTEP; }
        else if (i == 1) { u.kind = K_MGD; u.a = H + (size_t)pm * TSTEP; u.b = Win + (size_t)(32 + pn) * TSTEP; }
        else if (i == 2) { u.kind = K_YR; u.a = OR + (size_t)pm * TSTEP; u.b = Wro + (size_t)pn * TSTEP; }
        else { u.kind = K_YD; u.a = OD + (size_t)pm * TSTEP; u.b = Wdo + (size_t)pn * TSTEP; }
        return true;
    }
};
struct SchedG4 {
    const char *Mb, *Wout; int c;
    __device__ __forceinline__ bool next(int i, pg8::Unit& u) const {
        if (i >= 1) return false;
        int pm, pn; pg8::tile_of(c, 64, 4, pm, pn); u.pm = pm; u.pn = pn; u.kind = K_OUT; u.a = Mb + (size_t)pm * TSTEP; u.b = Wout + (size_t)pn * TSTEP; return true;
    }
};


namespace att {
typedef float f32x16 __attribute__((ext_vector_type(16)));
typedef short s16x4 __attribute__((ext_vector_type(4)));
typedef short v4i16_t __attribute__((ext_vector_type(4)));
constexpr int SLOT_OFF = 65536, SLOT_BYTES = 32768, V_OFF = 16384;
__device__ __forceinline__ int crow(int r, int hi) { return (r & 3) + 8 * (r >> 2) + 4 * hi; }
__device__ __forceinline__ s16x4 vtr(LAS const unsigned char* p) { return __builtin_bit_cast(s16x4, __builtin_amdgcn_ds_read_tr16_b64_v4i16((LAS v4i16_t*)p)); }
#define ATT_MFMA(a, b, c) __builtin_amdgcn_mfma_f32_32x32x16_bf16(a, b, c, 0, 0, 0)

__device__ __forceinline__ void attn_unit(LAS unsigned char* lds, const unsigned char* ws, const int b, const int h, const int qb, const float lam, const float omli, const float* __restrict__ gsub, const int win) {
    int tid_ = threadIdx.x; asm volatile("" : "+v"(tid_));
    const int tid = tid_, lane = tid & 63, r32 = lane & 31, hi = lane >> 5, w = __builtin_amdgcn_readfirstlane(tid >> 6), rg = w & 3, kg = w >> 2;
    const bf16* QD = (const bf16*)(ws + WS_QD); const bf16* KD = (const bf16*)(ws + WS_KD); const bf16* VD = (const bf16*)(ws + WS_VD); bf16* SGD = (bf16*)(ws + WS_SGD);
    const size_t tb = (size_t)b * SEQ; const int q0 = qb * 128, NT = (q0 + 128) / 64;
    const int T0 = (q0 > win ? q0 - win : 0) >> 6;
#pragma unroll
    for (int k = 0; k < 4; ++k) { const int p = 4 * kg + k; const bf16* src = QD + (tb + q0 + 32 * rg + r32) * 1024 + h * 128 + (p >> 2) * 64 + (p & 3) * 16 + hi * 8;
        __builtin_amdgcn_global_load_lds((const unsigned*)src, (LAS unsigned*)(lds + rg * 8192 + p * 1024), 16, 0, 0); }
    const bf16* ksrc = KD + (tb + lane) * 1024 + h * 128 + (w & 7) * 8;
    const bf16* vsrc = VD + (tb + 16 * (w & 3) + (lane >> 2)) * 1024 + h * 128 + (w >> 2) * 32 + (lane & 3) * 8;
#define ATT_STAGE(t, slot) do { _Pragma("unroll") for (int rr = 0; rr < 2; ++rr) { \
        __builtin_amdgcn_global_load_lds((const unsigned*)(ksrc + (size_t)(t) * 65536 + rr * 64), (LAS unsigned*)(lds + SLOT_OFF + (slot) * SLOT_BYTES + (rr * 8 + w) * 1024), 16, 0, 0); \
        __builtin_amdgcn_global_load_lds((const unsigned*)(vsrc + (size_t)(t) * 65536 + rr * 64), (LAS unsigned*)(lds + SLOT_OFF + (slot) * SLOT_BYTES + V_OFF + (rr * 8 + w) * 1024), 16, 0, 0); } } while (0)
    ATT_STAGE(T0, 0);
    __syncthreads();
    const float slope = __builtin_amdgcn_exp2f(-(float)(h + 1)) * LOG2E;
    const int n = q0 + 32 * rg + r32;
    f32x16 O[2][4];
#pragma unroll
    for (int j = 0; j < 2; ++j)
#pragma unroll
        for (int e = 0; e < 4; ++e)
#pragma unroll
            for (int r = 0; r < 16; ++r) O[j][e][r] = 0.f;
    float lsum[2] = {0.f, 0.f};
    const int qoff = rg * 8192 + lane * 16;
    const int koff = hi * 1024 + (32 * kg + r32) * 16;
    const int voff = V_OFF + 2 * kg * 1024 + ((lane >> 4) & 1) * 32 + (lane & 3) * 8 + (4 * hi + ((lane & 15) >> 2)) * 64;
    for (int t = T0; t < NT; ++t) {
        if (t + 1 < NT) ATT_STAGE(t + 1, (t + 1 - T0) & 1);
        const int k0 = t * 64 + 32 * kg;
        if (k0 <= q0 + 32 * rg + 31) {
            LAS const unsigned char* slot = lds + SLOT_OFF + ((t - T0) & 1) * SLOT_BYTES;
            float sl = slope; asm volatile("" : "+v"(sl));
            const int dn = n - k0 - 4 * hi; const float base = -sl * (float)dn;
            const bool diag = (k0 + 31 > q0 + 32 * rg);
            f32x16 pA, pB;
#pragma unroll
            for (int r = 0; r < 16; ++r) { const int kc = (r & 3) + 8 * (r >> 2); pA[r] = __builtin_fmaf(sl, (float)kc, base); }
            if (diag) {
#pragma unroll
                for (int r = 0; r < 16; ++r) { const int kc = (r & 3) + 8 * (r >> 2); if (kc > dn) pA[r] = -INFINITY; }
            }
            pB = pA;
#pragma unroll
            for (int d0 = 0; d0 < 4; ++d0) {
                const bf16x8 kfa = *(LAS const bf16x8*)(slot + koff + (2 * d0) * 1024), kfb = *(LAS const bf16x8*)(slot + koff + (8 + 2 * d0) * 1024);
                const bf16x8 qfa = *(LAS const bf16x8*)(lds + qoff + d0 * 1024), qfb = *(LAS const bf16x8*)(lds + qoff + (4 + d0) * 1024);
                pA = ATT_MFMA(kfa, qfa, pA); pB = ATT_MFMA(kfb, qfb, pB);
            }
            bf16x8 vf[4][2];
#pragma unroll
            for (int eb = 0; eb < 4; ++eb)
#pragma unroll
                for (int ks = 0; ks < 2; ++ks) { const s16x4 vlo = vtr(slot + voff + eb * 4096 + ks * 1024), vhi = vtr(slot + voff + eb * 4096 + ks * 1024 + 512);
                    vf[eb][ks] = (bf16x8){vlo[0], vlo[1], vlo[2], vlo[3], vhi[0], vhi[1], vhi[2], vhi[3]}; }
            u32x4 pwA[2], pwB[2];
            { float s = 0.f;
#pragma unroll
              for (int r = 0; r < 16; ++r) { pA[r] = __builtin_amdgcn_exp2f(pA[r]); s += pA[r]; }
              lsum[0] += s;
#pragma unroll
              for (int i = 0; i < 4; ++i) { pwA[0][i] = cvt_pk_bf16(pA[2 * i], pA[2 * i + 1]); pwA[1][i] = cvt_pk_bf16(pA[8 + 2 * i], pA[9 + 2 * i]); } }
            { float s = 0.f;
#pragma unroll
              for (int r = 0; r < 16; ++r) { pB[r] = __builtin_amdgcn_exp2f(pB[r]); s += pB[r]; }
              lsum[1] += s;
#pragma unroll
              for (int i = 0; i < 4; ++i) { pwB[0][i] = cvt_pk_bf16(pB[2 * i], pB[2 * i + 1]); pwB[1][i] = cvt_pk_bf16(pB[8 + 2 * i], pB[9 + 2 * i]); } }
#pragma unroll
            for (int eb = 0; eb < 4; ++eb)
#pragma unroll
                for (int ks = 0; ks < 2; ++ks) {
                    O[0][eb] = ATT_MFMA(vf[eb][ks], __builtin_bit_cast(bf16x8, pwA[ks]), O[0][eb]);
                    O[1][eb] = ATT_MFMA(vf[eb][ks], __builtin_bit_cast(bf16x8, pwB[ks]), O[1][eb]);
                }
        }
        __syncthreads();
    }
    lsum[0] += __shfl_xor(lsum[0], 32); lsum[1] += __shfl_xor(lsum[1], 32);
    LAS float* dump = (LAS float*)(lds + rg * 32768);
    LAS float* lx = (LAS float*)(lds + 131072 + rg * 1024);
    int r32e = r32; asm volatile("" : "+v"(r32e));
    bf16* rowp = SGD + (tb + q0 + 32 * rg + r32e) * 1024 + h * 128 + 4 * hi;
    const float* gp = gsub + h * 128 + 4 * hi;
    unsigned long long gt[4][4];
    if (kg == 1) {
#pragma unroll
        for (int j = 0; j < 2; ++j)
#pragma unroll
            for (int eb = 0; eb < 4; ++eb)
#pragma unroll
                for (int q = 0; q < 4; ++q) *(LAS f32x4*)(dump + (((j * 4 + eb) * 4 + q) * 64 + lane) * 4) = (f32x4){O[j][eb][4 * q], O[j][eb][4 * q + 1], O[j][eb][4 * q + 2], O[j][eb][4 * q + 3]};
        lx[lane] = lsum[0]; lx[64 + lane] = lsum[1];
    } else {
#pragma unroll
        for (int eb = 0; eb < 2; ++eb)
#pragma unroll
            for (int g = 0; g < 4; ++g) gt[eb][g] = *(const unsigned long long*)(rowp + 32 * eb + 8 * g);
    }
    asm volatile("s_waitcnt lgkmcnt(0)" ::: "memory"); __builtin_amdgcn_s_barrier(); asm volatile("" ::: "memory");
    if (kg == 0) {
#pragma unroll
        for (int j = 0; j < 2; ++j)
#pragma unroll
            for (int eb = 0; eb < 4; ++eb)
                {
#pragma unroll
                  for (int q = 0; q < 4; ++q) { const f32x4 v = *(LAS const f32x4*)(dump + (((j * 4 + eb) * 4 + q) * 64 + lane) * 4); O[j][eb][4 * q] += v[0]; O[j][eb][4 * q + 1] += v[1]; O[j][eb][4 * q + 2] += v[2]; O[j][eb][4 * q + 3] += v[3]; }
                  asm volatile("s_waitcnt lgkmcnt(0)" : "+v"(O[j][eb]) :: "memory"); }
        lsum[0] += lx[lane]; lsum[1] += lx[64 + lane];
        asm volatile("s_waitcnt lgkmcnt(0)" ::: "memory");
#pragma unroll
        for (int eb = 2; eb < 4; ++eb)
#pragma unroll
            for (int g = 0; g < 4; ++g) gt[eb][g] = *(const unsigned long long*)(rowp + 32 * eb + 8 * g);
        const float i0 = 1.0f / lsum[0], i1 = lam / lsum[1];
        float ss = 0.f;
#pragma unroll
        for (int eb = 0; eb < 4; ++eb)
#pragma unroll
            for (int r = 0; r < 16; ++r) { const float o = O[0][eb][r] * i0 - O[1][eb][r] * i1; O[0][eb][r] = o; ss += o * o; }
        ss += __shfl_xor(ss, 32);
        const float rs = __builtin_amdgcn_rsqf(ss * (1.0f / 128.0f) + EPS) * omli;
#pragma unroll
        for (int eb = 0; eb < 4; ++eb) {
            f32x4 gg[4];
#pragma unroll
            for (int g = 0; g < 4; ++g) gg[g] = *(const f32x4*)(gp + 32 * eb + 8 * g);
#pragma unroll
            for (int g = 0; g < 4; ++g) { const unsigned glo = (unsigned)gt[eb][g], ghi = (unsigned)(gt[eb][g] >> 32);
                const unsigned w0 = cvt_pk_bf16(O[0][eb][4 * g] * rs * gg[g][0] * lo_bf(glo), O[0][eb][4 * g + 1] * rs * gg[g][1] * hi_bf(glo));
                const unsigned w1 = cvt_pk_bf16(O[0][eb][4 * g + 2] * rs * gg[g][2] * lo_bf(ghi), O[0][eb][4 * g + 3] * rs * gg[g][3] * hi_bf(ghi));
                *(unsigned long long*)(rowp + 32 * eb + 8 * g) = (unsigned long long)w0 | ((unsigned long long)w1 << 32); }
        }
    }
    asm volatile("s_waitcnt lgkmcnt(0)" ::: "memory");
    __syncthreads();
#undef ATT_STAGE
}
}

namespace ret {
using att::f32x16; using att::s16x4; using att::crow; using att::vtr;
constexpr int SET = 49152, KT = 0, VI = 16384, OST = 98304, ST = 131072, RED = 147456;
__device__ __forceinline__ void ret_unit(LAS unsigned char* lds, const unsigned char* ws, const int b, const int h, const float* __restrict__ gn, const int c0, const int c1) {
    int tid_ = threadIdx.x; asm volatile("" : "+v"(tid_));
    const int tid = tid_, lane = tid & 63, r32 = lane & 31, hi = lane >> 5, w = __builtin_amdgcn_readfirstlane(tid >> 6);
    const int ib = w & 3, eh = w >> 2, dh = w & 1, ebo = w >> 1;
    const bf16* QR = (const bf16*)(ws + WS_QR); const bf16* KR = (const bf16*)(ws + WS_KR); const bf16* VR = (const bf16*)(ws + WS_VR); bf16* SGR = (bf16*)(ws + WS_SGR);
    const size_t tb = (size_t)b * SEQ;
    const float lg = __log2f(1.0f - __builtin_amdgcn_exp2f(-5.0f - (float)h)), gC = __builtin_amdgcn_exp2f(128.0f * lg);
    for (int i = tid; i < 16384 / 16; i += 512) *(LAS u32x4*)(lds + ST + i * 16) = (u32x4){0u, 0u, 0u, 0u};
    f32x16 sblk;
#pragma unroll
    for (int r = 0; r < 16; ++r) sblk[r] = 0.f;
    const int vpat = ((lane >> 4) & 1) * 32 + (lane & 3) * 8 + (4 * hi + ((lane & 15) >> 2)) * 64;
    const int prow = tid >> 4, pcol = (tid & 15) * 8;
    f32x4 gA = *(const f32x4*)(gn + h * 128 + pcol), gB = *(const f32x4*)(gn + h * 128 + pcol + 4);
#define RET_TR8(p) ([&]() { const s16x4 lo_ = vtr(p), hi_ = vtr((p) + 512); return (bf16x8){lo_[0], lo_[1], lo_[2], lo_[3], hi_[0], hi_[1], hi_[2], hi_[3]}; }())
#define RET_STAGE(c, s) do { const size_t t0_ = tb + (size_t)(c) * 128; LAS unsigned char* sb_ = lds + (s) * SET; \
        _Pragma("unroll") for (int k = 0; k < 2; ++k) { const int p = 2 * w + k, d2 = p >> 3, kg = p & 7; \
            __builtin_amdgcn_global_load_lds((const unsigned*)(KR + (t0_ + 16 * kg + (lane >> 2)) * 512 + h * 64 + d2 * 32 + (lane & 3) * 8), (LAS unsigned*)(sb_ + KT + p * 1024), 16, 0, 0); } \
        _Pragma("unroll") for (int k = 0; k < 4; ++k) { const int p = 4 * w + k, eg = p >> 3, kg = p & 7; \
            __builtin_amdgcn_global_load_lds((const unsigned*)(VR + (t0_ + 16 * kg + (lane >> 2)) * 1024 + h * 128 + eg * 32 + (lane & 3) * 8), (LAS unsigned*)(sb_ + VI + p * 1024), 16, 0, 0); } } while (0)
    if (c0 > 0) {
        RET_STAGE(0, 0);
        for (int c = 0; c < c0; ++c) {
            __syncthreads();
            if (c + 1 < c0) RET_STAGE(c + 1, (c + 1) & 1);
            LAS const unsigned char* sb = lds + (c & 1) * SET;
            f32x16 kv, kv2;
#pragma unroll
            for (int r = 0; r < 16; ++r) { kv[r] = 0.f; kv2[r] = 0.f; }
            bf16x8 kfr[8], vfr[8];
#pragma unroll
            for (int ks = 0; ks < 8; ++ks) { kfr[ks] = RET_TR8(sb + KT + dh * 8192 + ks * 1024 + vpat); vfr[ks] = RET_TR8(sb + VI + ebo * 8192 + ks * 1024 + vpat); }
            __builtin_amdgcn_sched_barrier(0);
#pragma unroll
            for (int ks = 0; ks < 8; ks += 2) { kv = ATT_MFMA(kfr[ks], vfr[ks], kv); kv2 = ATT_MFMA(kfr[ks + 1], vfr[ks + 1], kv2); }
#pragma unroll
            for (int r = 0; r < 16; ++r) sblk[r] = gC * (sblk[r] + (kv[r] + kv2[r]));
        }
        __syncthreads();
#pragma unroll
        for (int g = 0; g < 4; ++g) { unsigned long long v = (unsigned long long)cvt_pk_bf16(sblk[4 * g], sblk[4 * g + 1]) | ((unsigned long long)cvt_pk_bf16(sblk[4 * g + 2], sblk[4 * g + 3]) << 32);
            *(LAS unsigned long long*)(lds + ST + (32 * ebo + r32) * 128 + (32 * dh + 8 * g + 4 * hi) * 2) = v; }
    }
    RET_STAGE(c0, c0 & 1);
    bf16x8 qn[4];
#pragma unroll
    for (int d0 = 0; d0 < 4; ++d0) qn[d0] = *(const bf16x8*)(QR + (tb + (size_t)c0 * 128 + 32 * ib + r32) * 512 + h * 64 + d0 * 16 + hi * 8);
    for (int c = c0; c < c1; ++c) {
        const size_t t0 = tb + (size_t)c * 128;
        __syncthreads();
        LAS const unsigned char* sb = lds + (c & 1) * SET;
        u32x4 gt[4];
#pragma unroll
        for (int k = 0; k < 4; ++k) gt[k] = *(const u32x4*)(SGR + (t0 + prow + 32 * k) * 1024 + h * 128 + pcol);
        bf16x8 qf[4];
#pragma unroll
        for (int d0 = 0; d0 < 4; ++d0) qf[d0] = qn[d0];
        if (c + 1 < c1) { RET_STAGE(c + 1, (c + 1) & 1);
#pragma unroll
            for (int d0 = 0; d0 < 4; ++d0) qn[d0] = *(const bf16x8*)(QR + (t0 + 128 + 32 * ib + r32) * 512 + h * 64 + d0 * 16 + hi * 8); }
        f32x16 O[2];
#pragma unroll
        for (int eb = 0; eb < 2; ++eb)
#pragma unroll
            for (int r = 0; r < 16; ++r) O[eb][r] = 0.f;
#pragma unroll
        for (int jb = 0; jb < 4; ++jb) {
            if (jb <= ib) {
                f32x16 s;
#pragma unroll
                for (int r = 0; r < 16; ++r) s[r] = 0.f;
                bf16x8 kf[4], vq[2][2];
#pragma unroll
                for (int d0 = 0; d0 < 4; ++d0) kf[d0] = *(LAS const bf16x8*)(sb + KT + (d0 >> 1) * 8192 + (32 * jb + r32) * 64 + ((d0 & 1) * 16 + 8 * hi) * 2);
#pragma unroll
                for (int eb = 0; eb < 2; ++eb)
#pragma unroll
                    for (int ks = 0; ks < 2; ++ks) vq[eb][ks] = RET_TR8(sb + VI + (2 * eh + eb) * 8192 + (2 * jb + ks) * 1024 + vpat);
                __builtin_amdgcn_sched_barrier(0);
#pragma unroll
                for (int d0 = 0; d0 < 4; ++d0) s = ATT_MFMA(kf[d0], qf[d0], s);
                if (jb == ib) {
#pragma unroll
                    for (int r = 0; r < 16; ++r) if (crow(r, hi) > r32) s[r] = 0.f;
                }
                u32x4 pw[2];
#pragma unroll
                for (int i = 0; i < 4; ++i) { pw[0][i] = cvt_pk_bf16(s[2 * i], s[2 * i + 1]); pw[1][i] = cvt_pk_bf16(s[8 + 2 * i], s[9 + 2 * i]); }
#pragma unroll
                for (int eb = 0; eb < 2; ++eb)
#pragma unroll
                    for (int ks = 0; ks < 2; ++ks) O[eb] = ATT_MFMA(vq[eb][ks], __builtin_bit_cast(bf16x8, pw[ks]), O[eb]);
            }
        }
        bf16x8 sfr[2][4];
#pragma unroll
        for (int eb = 0; eb < 2; ++eb)
#pragma unroll
            for (int d0 = 0; d0 < 4; ++d0) sfr[eb][d0] = *(LAS const bf16x8*)(lds + ST + (32 * (2 * eh + eb) + r32) * 128 + (16 * d0 + 8 * hi) * 2);
        __builtin_amdgcn_sched_barrier(0);
#pragma unroll
        for (int d0 = 0; d0 < 4; ++d0)
#pragma unroll
            for (int eb = 0; eb < 2; ++eb) O[eb] = ATT_MFMA(sfr[eb][d0], qf[d0], O[eb]);
        { f32x16 kv, kv2;
#pragma unroll
          for (int r = 0; r < 16; ++r) { kv[r] = 0.f; kv2[r] = 0.f; }
          bf16x8 kfr[8], vfr[8];
#pragma unroll
          for (int ks = 0; ks < 8; ++ks) { kfr[ks] = RET_TR8(sb + KT + dh * 8192 + ks * 1024 + vpat); vfr[ks] = RET_TR8(sb + VI + ebo * 8192 + ks * 1024 + vpat); }
          __builtin_amdgcn_sched_barrier(0);
#pragma unroll
          for (int ks = 0; ks < 8; ks += 2) { kv = ATT_MFMA(kfr[ks], vfr[ks], kv); kv2 = ATT_MFMA(kfr[ks + 1], vfr[ks + 1], kv2); }
#pragma unroll
          for (int r = 0; r < 16; ++r) sblk[r] = gC * (sblk[r] + (kv[r] + kv2[r])); }
        { float s2 = 0.f;
#pragma unroll
          for (int eb = 0; eb < 2; ++eb)
#pragma unroll
              for (int r = 0; r < 16; ++r) s2 += O[eb][r] * O[eb][r];
          s2 += __shfl_xor(s2, 32);
          if (hi == 0) ((LAS float*)(lds + RED))[(32 * ib + r32) * 2 + eh] = s2; }
#pragma unroll
        for (int eb = 0; eb < 2; ++eb)
#pragma unroll
            for (int g = 0; g < 4; ++g) *(LAS unsigned long long*)(lds + OST + (32 * ib + r32) * 256 + (64 * eh + 32 * eb + 8 * g + 4 * hi) * 2) =
                (unsigned long long)cvt_pk_bf16(O[eb][4 * g], O[eb][4 * g + 1]) | ((unsigned long long)cvt_pk_bf16(O[eb][4 * g + 2], O[eb][4 * g + 3]) << 32);
        asm volatile("s_waitcnt lgkmcnt(0)" ::: "memory"); __builtin_amdgcn_s_barrier(); asm volatile("" ::: "memory");
#pragma unroll
        for (int g = 0; g < 4; ++g) { unsigned long long v = (unsigned long long)cvt_pk_bf16(sblk[4 * g], sblk[4 * g + 1]) | ((unsigned long long)cvt_pk_bf16(sblk[4 * g + 2], sblk[4 * g + 3]) << 32);
            *(LAS unsigned long long*)(lds + ST + (32 * ebo + r32) * 128 + (32 * dh + 8 * g + 4 * hi) * 2) = v; }
#pragma unroll
        for (int k = 0; k < 4; ++k) { const int row = prow + 32 * k; const LAS float* rp = (const LAS float*)(lds + RED) + row * 2;
            const float rs = __builtin_amdgcn_rsqf((rp[0] + rp[1]) * (1.0f / 128.0f) + EPS);
            const u32x4 ov = *(LAS const u32x4*)(lds + OST + row * 256 + pcol * 2); const u32x4 gg = gt[k];
            u32x4 res;
            res.x = cvt_pk_bf16(lo_bf(ov.x) * rs * gA[0] * lo_bf(gg.x), hi_bf(ov.x) * rs * gA[1] * hi_bf(gg.x));
            res.y = cvt_pk_bf16(lo_bf(ov.y) * rs * gA[2] * lo_bf(gg.y), hi_bf(ov.y) * rs * gA[3] * hi_bf(gg.y));
            res.z = cvt_pk_bf16(lo_bf(ov.z) * rs * gB[0] * lo_bf(gg.z), hi_bf(ov.z) * rs * gB[1] * hi_bf(gg.z));
            res.w = cvt_pk_bf16(lo_bf(ov.w) * rs * gB[2] * lo_bf(gg.w), hi_bf(ov.w) * rs * gB[3] * hi_bf(gg.w));
            *(u32x4*)(SGR + (t0 + row) * 1024 + h * 128 + pcol) = res; }
    }
    __syncthreads();
#undef RET_STAGE
#undef RET_TR8
}
}

constexpr int MIX_LIST_ITEMS = 16 + 4 * 32;
constexpr int CW_QUEUE = 2048;

#define XB_TMO      128
#define XB_XCNT(j)  (256  + 64 * (j))
#define XB_XSUB(j)  (1280 + 64 * (j))
#define XB_XGEN(j)  (2304 + 64 * (j))
#define XB_TOP      3328
#define XB_TOPGEN   3392
#define XCD_BAR_WORDS 3456
#define XB_SPIN_CAP (1u << 18)
__device__ __forceinline__ unsigned xb_ld(unsigned* p)              { return __hip_atomic_load(p, __ATOMIC_RELAXED, __HIP_MEMORY_SCOPE_AGENT); }
__device__ __forceinline__ unsigned xb_add(unsigned* p, unsigned v) { return __hip_atomic_fetch_add(p, v, __ATOMIC_RELAXED, __HIP_MEMORY_SCOPE_AGENT); }
__device__ __forceinline__ unsigned xb_xcc_id() { return (unsigned)__builtin_amdgcn_s_getreg((3 << 11) | 20) & 0xFu; }
#define XB_SPIN(cond, bar) do { unsigned _sp = 0; while (cond) { __builtin_amdgcn_s_sleep(1); \
    if ((++_sp & 255u) == 0u) { if (xb_ld(&(bar)[XB_TMO])) break; if (_sp > XB_SPIN_CAP) { atomicAdd(&(bar)[XB_TMO], 1u); break; } } } } while (0)
struct XcdBarrier { unsigned* bar; unsigned x; volatile LAS unsigned* st; };
__device__ __forceinline__ XcdBarrier xcd_barrier_post(unsigned* bar, volatile LAS unsigned* st) {
    XcdBarrier b; b.bar = bar; b.x = xb_xcc_id(); b.st = st;
    if (threadIdx.x == 0) (void)xb_add(&bar[XB_XCNT(b.x)], 1u);
    return b;
}
__device__ __forceinline__ void xcd_barrier_complete(unsigned* bar, unsigned x, unsigned& nloc, unsigned& nx) {
    const unsigned G = gridDim.x * gridDim.y * gridDim.z;
    unsigned sum, cnt, mine, sp = 0u;
    for (;;) {
        sum = 0u; cnt = 0u; mine = 0u;
#pragma unroll
        for (unsigned j = 0; j < 16; ++j) { const unsigned c = xb_ld(&bar[XB_XCNT(j)]); sum += c; cnt += (c > 0u) ? 1u : 0u; mine = (j == x) ? c : mine; }
        if (sum == G) break;
        __builtin_amdgcn_s_sleep(1);
        if ((++sp & 255u) == 0u) { if (xb_ld(&bar[XB_TMO])) break; if (sp > XB_SPIN_CAP) { atomicAdd(&bar[XB_TMO], 1u); break; } }
    }
    nloc = mine > 0u ? mine : 1u; nx = cnt > 0u ? cnt : 1u;
}
__device__ __forceinline__ void xcd_barrier(const XcdBarrier& b) {
    asm volatile("s_waitcnt vmcnt(0)" ::: "memory");
    __syncthreads();
    if (threadIdx.x == 0) {
        unsigned* bar = b.bar;
        __builtin_amdgcn_s_waitcnt(0);
        unsigned nloc = b.st[0], nx = b.st[1];
        if (nloc == 0u) { xcd_barrier_complete(bar, b.x, nloc, nx); b.st[0] = nloc; b.st[1] = nx; }
        const unsigned old = xb_add(&bar[XB_XSUB(b.x)], 1u);
        const unsigned gen = old / nloc;
        if (old + 1u == (gen + 1u) * nloc) {
            __builtin_amdgcn_fence(__ATOMIC_RELEASE, "agent");
            asm volatile("s_waitcnt vmcnt(0)" ::: "memory");
            const unsigned og = xb_add(&bar[XB_TOP], 1u);
            const unsigned tg = og / nx;
            if (og + 1u == (tg + 1u) * nx) xb_add(&bar[XB_TOPGEN], 1u);
            else XB_SPIN(xb_ld(&bar[XB_TOPGEN]) == tg, bar);
            __builtin_amdgcn_fence(__ATOMIC_ACQUIRE, "agent");
            xb_add(&bar[XB_XGEN(b.x)], 1u);
            asm volatile("s_waitcnt vmcnt(0)" ::: "memory");
        } else {
            XB_SPIN(xb_ld(&bar[XB_XGEN(b.x)]) == gen, bar);
            __builtin_amdgcn_fence(__ATOMIC_ACQUIRE, "agent");
            asm volatile("s_waitcnt vmcnt(0)" ::: "memory");
        }
    }
    __syncthreads();
}

#define LDS_WAIT() asm volatile("s_waitcnt lgkmcnt(0)" ::: "memory")
__device__ __forceinline__ float wave_sum(float v) {
#pragma unroll
    for (int o = 1; o < 64; o <<= 1) v += __shfl_xor(v, o);
    return v;
}
constexpr int P0_SCR_BYTES = 64 * 65 * 4;
__device__ __forceinline__ void p0_transpose_item(const float* W, int K, int N, bf16* WT, LAS float* scr, int item, int lane) {
    const int nblk = N / 64, kb = item / nblk, nb = item % nblk, k0 = 64 * kb, n0 = 64 * nb;
    const int lr = lane >> 4, lc = (lane & 15) * 4;
    const GAS f32x4* src = (const GAS f32x4*)(W + (size_t)(k0 + lr) * N + n0 + lc);
    f32x4 v[16];
#pragma unroll
    for (int i = 0; i < 16; ++i) v[i] = src[(size_t)i * N];
#pragma unroll
    for (int i = 0; i < 16; ++i) { LAS float* d = scr + (4 * i + lr) * 65 + lc; d[0] = v[i].x; d[1] = v[i].y; d[2] = v[i].z; d[3] = v[i].w; }
    LDS_WAIT(); asm volatile("" ::: "memory");
    const int c = lane & 7;
#pragma unroll
    for (int j = 0; j < 8; ++j) { const int n = (lane >> 3) + 8 * j; const LAS float* q = scr + (8 * c) * 65 + n;
        u32x4 o; o.x = pk2(q[0 * 65], q[1 * 65]); o.y = pk2(q[2 * 65], q[3 * 65]); o.z = pk2(q[4 * 65], q[5 * 65]); o.w = pk2(q[6 * 65], q[7 * 65]);
        *(GAS u32x4*)(WT + (size_t)(n0 + n) * K + k0 + 8 * c) = o; }
    LDS_WAIT(); asm volatile("" ::: "memory");
}
__device__ __forceinline__ void rms_rows4_to_bf16(const float* xrow, const float* g, bf16* orow, int lane) {
    const GAS f32x4* xr = (const GAS f32x4*)xrow + lane; const GAS f32x4* gr = (const GAS f32x4*)g + lane;
    f32x4 v[4][4];
#pragma unroll
    for (int r = 0; r < 4; ++r)
#pragma unroll
        for (int j = 0; j < 4; ++j) v[r][j] = xr[256 * r + 64 * j];
    f32x4 gg[4];
#pragma unroll
    for (int j = 0; j < 4; ++j) gg[j] = gr[64 * j];
    GAS unsigned long long* o8 = (GAS unsigned long long*)orow + lane;
#pragma unroll
    for (int r = 0; r < 4; ++r) { float s = 0.f;
#pragma unroll
        for (int j = 0; j < 4; ++j) s += (v[r][j].x * v[r][j].x + v[r][j].y * v[r][j].y) + (v[r][j].z * v[r][j].z + v[r][j].w * v[r][j].w);
        const float rs = 1.0f / sqrtf(wave_sum(s) * (1.f / DM) + EPS);
#pragma unroll
        for (int j = 0; j < 4; ++j)
            o8[256 * r + 64 * j] = (unsigned long long)pk2(v[r][j].x * rs * gg[j].x, v[r][j].y * rs * gg[j].y) | ((unsigned long long)pk2(v[r][j].z * rs * gg[j].z, v[r][j].w * rs * gg[j].w) << 32); }
}

__device__ __forceinline__ const float* in_ptr(int k) {
    typedef __attribute__((address_space(4))) const char* cptr4;
    cptr4 ka = (cptr4)__builtin_amdgcn_kernarg_segment_ptr(); cptr4 kb;
    asm volatile("s_mov_b64 %0, %1" : "=s"(kb) : "s"(ka));
    typedef const float* cfp; typedef __attribute__((address_space(4))) const cfp* cfp4;
    return *(cfp4)(kb + k * 8);
}
constexpr int NWAVES = 8;
constexpr int RING_BYTES = 131072, LDS_BYTES = 163840, LDSCTL_OFF = LDS_BYTES - 1024, MISC_OFF = LDSCTL_OFF + 320;
struct Args { const float* in[14]; float* out; unsigned char* ws; int ph_lo, ph_hi, li, pad; };
constexpr int N_PHASES = 10;

__global__ void __launch_bounds__(NWAVES * 64, 2) mk_fwd(Args args) {
    extern __shared__ __attribute__((aligned(16))) unsigned char lds_raw[];
    LAS unsigned char* lds = (LAS unsigned char*)lds_raw;
    volatile LAS unsigned* MISC = (volatile LAS unsigned*)(lds + MISC_OFF);
    const int tid = threadIdx.x, lane_k = tid & 63, wave = __builtin_amdgcn_readfirstlane(tid >> 6);
    const int G = gridDim.x, bx = blockIdx.x; const int vcu = (G % 8 == 0) ? (bx % 8) * (G / 8) + bx / 8 : bx;
    unsigned char* const ws_k = (unsigned char*)in_ptr(15);
    unsigned* ctl = (unsigned*)(ws_k + WS_CTL);
    for (int u = tid; u < (LDS_BYTES - LDSCTL_OFF) / 4; u += NWAVES * 64) ((LAS unsigned*)(lds + LDSCTL_OFF))[u] = 0u;
    __syncthreads();
    const int lo = args.ph_lo, hi = args.ph_hi;
    XcdBarrier bar; bar.bar = ctl + CW_BAR + args.li * XCD_BAR_WORDS; bar.x = 0; bar.st = nullptr;
    if (hi - lo > 1) bar = xcd_barrier_post(ctl + CW_BAR + args.li * XCD_BAR_WORDS, MISC + 8);
#define IN(k) (lo <= (k) && (k) < hi)
#define SEAM(k) do { if (IN(k) && IN((k) + 1)) xcd_barrier(bar); } while (0)

    if (IN(0)) {
        unsigned char* const ws = ws_k; int lane = lane_k; asm volatile("" : "+v"(lane));
        LAS float* scr = (LAS float*)(lds + wave * P0_SCR_BYTES);
        const int gw = vcu * NWAVES + wave, NGW = G * NWAVES;
        constexpr int I_IN = (DM / 64) * (NIN / 64), I_SQ = (DM / 64) * (DM / 64);
        for (int it = gw; it < 2 * I_IN + 6 * I_SQ; it += NGW) {
            int r = it;
            if (r < 2 * I_IN) { const int l = r / I_IN; p0_transpose_item(in_ptr(2) + (size_t)l * DM * NIN, DM, NIN, (bf16*)(ws + (l == 0 ? WS_WIN0 : WS_WIN)), scr, r % I_IN, lane); continue; } r -= 2 * I_IN;
            const int which = r / I_SQ, item = r % I_SQ, l = which / 3, w = which % 3;
            const float* src = (w == 0 ? in_ptr(4) : w == 1 ? in_ptr(12) : in_ptr(13)) + (size_t)l * DM * DM;
            bf16* dst = (bf16*)(ws + (l == 0 ? WS_WRO : WS_W1) + (size_t)w * 2 * MiB);
            p0_transpose_item(src, DM, DM, dst, scr, item, lane);
        }
        const float* x0 = in_ptr(0); const float* g0 = in_ptr(1); bf16* H = (bf16*)in_ptr(14);
        for (int m = 4 * gw; m < T; m += 4 * NGW) rms_rows4_to_bf16(x0 + (size_t)m * DM, g0, H + (size_t)m * DM, lane);
        LDS_WAIT(); __syncthreads();
    }
    SEAM(0);

#pragma unroll 1
    for (int l = 0; l < DEPTH; ++l) {
        const int pb = 1 + 5 * l;
        if (IN(pb)) {
            unsigned char* const ws = ws_k;
            Epi<0> E; E.ws = ws; E.xin = nullptr; E.xout = nullptr; E.gq = in_ptr(5) + l * 64; E.gk = in_ptr(6) + l * 64;
            SchedG1A S{l == 0 ? (const char*)in_ptr(14) : (const char*)(ws + WS_H), (const char*)(ws + (l == 0 ? WS_WIN0 : WS_WIN)), G, bx};
            pg8::gemm_phase<Epi<0>, SchedG1A, true, true>(lds, DM, S, E);
        }
        SEAM(pb);
        if (IN(pb + 1)) {
            unsigned char* const ws = ws_k;
            float s1 = 0.f, s2 = 0.f; { const float* q1 = in_ptr(7) + l * 64; const float* k1 = in_ptr(8) + l * 64; const float* q2 = in_ptr(9) + l * 64; const float* k2 = in_ptr(10) + l * 64;
                for (int i = 0; i < 64; ++i) { s1 += q1[i] * k1[i]; s2 += q2[i] * k2[i]; } }
            const float lam_init = 0.8f - 0.6f * __expf(-0.3f * (float)l), lam = __expf(s1) - __expf(s2) + lam_init;
            const float* gsub = in_ptr(11) + l * 1024;
            float gqm = 0.f, gkm = 0.f; { const float* gq = in_ptr(5) + l * 64; const float* gk = in_ptr(6) + l * 64; for (int i = 0; i < 64; ++i) { gqm = fmaxf(gqm, fabsf(gq[i])); gkm = fmaxf(gkm, fabsf(gk[i])); } }
            const float Bnd = 1.02f * 8.0f * LOG2E * gqm * gkm;
            const float* gret = in_ptr(3) + l * 1024;
            unsigned* qbase = ctl + CW_QUEUE + 512 * l;
            int lst = (int)(xb_xcc_id() & 7u), tried = 0;
            for (;;) {
                if (tid == 0) {
                    unsigned it = 0xffffffffu;
                    while (tried < 8) { it = __hip_atomic_fetch_add(qbase + 32 * lst, 1u, __ATOMIC_RELAXED, __HIP_MEMORY_SCOPE_AGENT); if (it < (unsigned)MIX_LIST_ITEMS) break; it = 0xffffffffu; lst = (lst + 1) & 7; ++tried; }
                    MISC[16] = it; MISC[17] = (unsigned)lst;
                }
                __syncthreads();
                const unsigned item = MISC[16]; const int li_ = (int)MISC[17];
                __syncthreads();
                if (item == 0xffffffffu) break;
                const int bb = li_ >> 1; const unsigned htab = (li_ & 1) ? 0x0156u : 0x2347u;
                if (item < 16u) { const int hh = (int)((htab >> (4 * (item & 3u))) & 7u), qt = 3 - (int)(item >> 2); ret::ret_unit(lds, ws, bb, hh, gret, 8 * qt, 8 * qt + 8); }
                else { const unsigned a_ = item - 16u; const int hh = (int)((htab >> (4 * (a_ >> 5))) & 7u), qb = 31 - (int)(a_ & 31u);
                    const float wf = (2.0f * Bnd + 28.0f) / (__builtin_amdgcn_exp2f(-(float)(hh + 1)) * LOG2E);
                    att::attn_unit(lds, ws, bb, hh, qb, lam, 1.0f - lam_init, gsub, wf < 8192.f ? (int)wf + 1 : 8192); }
            }
        }
        SEAM(pb + 1);
        if (IN(pb + 2)) {
            unsigned char* const ws = ws_k;
            Epi<1> E; E.ws = ws; E.xin = nullptr; E.xout = nullptr; E.gq = nullptr; E.gk = nullptr;
            SchedP34 S{(const char*)ws, (const char*)(ws + (l == 0 ? WS_WRO : WS_W1)), l == 0 ? (const char*)in_ptr(14) : (const char*)(ws + WS_H), (const char*)(ws + (l == 0 ? WS_WIN0 : WS_WIN)), bx};
            pg8::gemm_phase<Epi<1>, SchedP34, true, true>(lds, DM, S, E);
        }
        SEAM(pb + 2);
        if (IN(pb + 3)) {
            unsigned char* const ws = ws_k;
            Epi<2> E; E.ws = ws; E.xin = (l == 0) ? in_ptr(0) : (const float*)in_ptr(14); E.xout = (float*)in_ptr(14); E.gq = nullptr; E.gk = nullptr;
            SchedG4 S{(const char*)(ws + WS_MBF), (const char*)(ws + (l == 0 ? WS_WRO : WS_W1) + 4 * MiB), bx};
            pg8::gemm_phase<Epi<2>, SchedG4, false, true>(lds, DM, S, E);
        }
        SEAM(pb + 3);
        if (l == 0) {
            if (IN(5)) {
                unsigned char* const ws = ws_k; int lane = lane_k; asm volatile("" : "+v"(lane));
                bf16* H = (bf16*)(ws + WS_H);
                const int gw = vcu * NWAVES + wave, NGW = G * NWAVES;
                const float* x1 = in_ptr(14); const float* g1 = in_ptr(1) + DM;
                for (int m = 4 * gw; m < T; m += 4 * NGW) rms_rows4_to_bf16(x1 + (size_t)m * DM, g1, H + (size_t)m * DM, lane);
                __syncthreads();
            }
            SEAM(5);
        }
    }
#undef IN
#undef SEAM
}

extern "C" void kernel_launch(void* const* d_in, const int* in_sizes, int n_in, void* d_out, int out_size, void* d_ws, size_t ws_size, hipStream_t stream) {
    static int ready = 0;
    if (ready == 0) {
        if (n_in != 14 || ws_size < WS_END || out_size != T * DM) { fprintf(stderr, "kernel_launch: unexpected problem (n_in %d, ws %zu, out %d)\n", n_in, ws_size, out_size); ready = -1; return; }
        if (hipFuncSetAttribute((const void*)mk_fwd, hipFuncAttributeMaxDynamicSharedMemorySize, LDS_BYTES) != hipSuccess) { fprintf(stderr, "kernel_launch: hipFuncSetAttribute failed\n"); ready = -1; return; }
        ready = 1;
    }
    if (ready < 0) return;
    (void)hipMemsetAsync((char*)d_ws + WS_CTL, 0, CTL_ZERO_BYTES, stream);
    Args a{};
    for (int i = 0; i < 14; ++i) a.in[i] = (const float*)d_in[i];
    a.out = (float*)d_out; a.ws = (unsigned char*)d_ws;
    a.ph_lo = 0; a.ph_hi = N_PHASES; a.li = 0;
    hipLaunchKernelGGL(mk_fwd, dim3(256), dim3(NWAVES * 64), LDS_BYTES, stream, a);
}
```

```cpp
#include <hip/hip_runtime.h>
#include <cstdio>
#include <cstdint>
#include <cstddef>

constexpr int DM = 1024, BATCH = 4, SEQ = 4096, DEPTH = 2, T = BATCH * SEQ, NIN = 9216;
constexpr float EPS = 1e-6f;
constexpr float LOG2E = 1.4426950408889634f;

typedef unsigned short bf16;
typedef short bf16x8 __attribute__((ext_vector_type(8)));
typedef float f32x4 __attribute__((ext_vector_type(4)));
typedef unsigned u32x4 __attribute__((ext_vector_type(4)));
#define LAS __attribute__((address_space(3)))
#define GAS __attribute__((address_space(1)))

__device__ __forceinline__ float bf2f(bf16 v) { return __uint_as_float(((unsigned)v) << 16); }
__device__ __forceinline__ unsigned f2bf_u(float f) { unsigned u = __float_as_uint(f); return (u + 0x7fffu + ((u >> 16) & 1u)) >> 16; }
__device__ __forceinline__ bf16 f2bf(float f) { return (bf16)f2bf_u(f); }
__device__ __forceinline__ unsigned pk2(float lo, float hi) { return f2bf_u(lo) | (f2bf_u(hi) << 16); }
typedef float f32x2_t __attribute__((ext_vector_type(2))); typedef __bf16 bf16x2_t __attribute__((ext_vector_type(2)));
__device__ __forceinline__ unsigned cvt_pk_bf16(float lo, float hi) { f32x2_t v = {lo, hi}; bf16x2_t b = __builtin_convertvector(v, bf16x2_t); return __builtin_bit_cast(unsigned, b); }
__device__ __forceinline__ float fast_sigmoid(float v) { return __builtin_amdgcn_rcpf(1.0f + __builtin_amdgcn_exp2f(-v * LOG2E)); }
__device__ __forceinline__ float lo_bf(unsigned w) { return __uint_as_float(w << 16); }
__device__ __forceinline__ float hi_bf(unsigned w) { return __uint_as_float(w & 0xffff0000u); }

constexpr size_t MiB = 1u << 20;
constexpr size_t WS_CTL = 0, CTL_ZERO_BYTES = 64 * 1024;
constexpr size_t WS_WIN = 1 * MiB, WS_WRO = 19 * MiB, WS_WDO = 21 * MiB, WS_WOUT = 23 * MiB;
constexpr size_t WS_H = 25 * MiB, WS_QR = 57 * MiB, WS_KR = 73 * MiB, WS_VR = 89 * MiB, WS_SGR = 121 * MiB, WS_QD = 153 * MiB, WS_KD = 185 * MiB,
                 WS_VD = 217 * MiB, WS_SGD = 249 * MiB;
constexpr size_t WS_WIN0 = WS_H;
constexpr size_t WS_W1 = 281 * MiB;
constexpr size_t WS_END = 287 * MiB;
constexpr size_t WS_MBUF = 57 * MiB;
constexpr size_t WS_MBF = WS_VD;
constexpr size_t WS_SMGR = WS_QD, WS_SMGD = WS_KD;
constexpr int CW_BAR = 4096;

namespace pg8 {
constexpr int BM = 256, BK = 64, HALF = 128, HTB = HALF * BK * 2, STAGE_BYTES = 8 * HTB, NXCD = 8, WGM = 8;
__host__ __device__ __forceinline__ int lds_byte(int r, int c) { const int st = (r >> 4) * 2 + (c >> 5), rr = r & 15, cc = c & 31, ob = rr * 64 + cc * 2; return st * 1024 + (ob ^ (((ob >> 9) & 1) << 5)); }
__host__ __device__ __forceinline__ void stage_rc(int b, int& R, int& C) { const int st = b / 1024, sb = b % 1024, swz = sb ^ (((sb >> 9) & 1) << 5); R = (st >> 1) * 16 + swz / 64; C = (st & 1) * 32 + (swz % 64) / 2; }
__host__ __device__ __forceinline__ int perm32(int rho) { const int n = rho >> 4, i = rho & 15; return 8 * (i >> 2) + 4 * n + (i & 3); }

struct Unit { int pm, pn, kind; const char* a; const char* b; };

__device__ __forceinline__ void tile_of(int L, int nM, int nN, int& pm, int& pn) {
    const int nwg = nM * nN; int wgid = L;
    { const int q = nwg / NXCD, r = nwg % NXCD, xcd = wgid % NXCD, off = wgid / NXCD; wgid = (xcd < r ? xcd * (q + 1) : r * (q + 1) + (xcd - r) * q) + off; }
    const int nig = WGM * nN, gid = wgid / nig, fm = gid * WGM, gsz = (nM - fm) < WGM ? (nM - fm) : WGM;
    pm = fm + ((wgid % nig) % gsz); pn = (wgid % nig) / gsz;
}

template <class Epi, class Sched, bool ALIGN_EPI, bool SP2>
__device__ __forceinline__ void gemm_phase(LAS unsigned char* lds, const int K, const Sched& S, const Epi& E) {
    int tid_ = threadIdx.x; asm volatile("" : "+v"(tid_));
    const int tid = tid_, wid = __builtin_amdgcn_readfirstlane(tid >> 6), lane = tid & 63, wr = wid >> 2, wc = wid & 3, fr = lane & 15, fq = lane >> 4;
    const int nt = K / BK;
    unsigned voffA[2], voffB[2];
#pragma unroll
    for (int i = 0; i < 2; ++i) { int R, C; stage_rc(tid * 16 + i * 8192, R, C); const int Rb = (R >> 5) * 64 + perm32(R & 31);
        voffA[i] = (unsigned)(R * K + C) * 2u; voffB[i] = (unsigned)(Rb * K + C) * 2u; }
    const size_t kstep = (size_t)(BK * 2);
    const size_t hstep = (size_t)HALF * K * 2;
    const size_t hstepB = (size_t)32 * K * 2;
    const unsigned ldsw = (unsigned)wid * 1024u;
    const int aoff = lds_byte(wr * 64 + fr, fq * 8), boff = lds_byte(wc * 32 + fr, fq * 8);
#define PG8_SA(b, h) (((b) * 2 + (h)) * HTB)
#define PG8_SB(b, h) ((4 + (b) * 2 + (h)) * HTB)
#define PG8_STAGE(bufoff, gbase, voff) do { _Pragma("unroll") for (int _i = 0; _i < 2; ++_i) \
        __builtin_amdgcn_global_load_lds((const unsigned*)((const char*)(gbase) + (voff)[_i]), (LAS unsigned*)(lds + (bufoff) + ldsw + _i * 8192), 16, 0, 0); } while (0)
#define PG8_LDA(dst, b, h) do { _Pragma("unroll") for (int m = 0; m < 4; ++m) _Pragma("unroll") for (int k = 0; k < 2; ++k) dst[m][k] = *(const LAS bf16x8*)(lds + PG8_SA(b, h) + aoff + m * 2048 + k * 1024); } while (0)
#define PG8_LDB(dst, b, h) do { _Pragma("unroll") for (int n = 0; n < 2; ++n) _Pragma("unroll") for (int k = 0; k < 2; ++k) dst[n][k] = *(const LAS bf16x8*)(lds + PG8_SB(b, h) + boff + n * 2048 + k * 1024); } while (0)
#define PG8_MMA(ai, bj, At, Bt) do { __builtin_amdgcn_s_setprio(1); _Pragma("unroll") for (int m = 0; m < 4; ++m) _Pragma("unroll") for (int n = 0; n < 2; ++n) _Pragma("unroll") for (int k = 0; k < 2; ++k) \
        acc[ai][bj][m][n] = __builtin_amdgcn_mfma_f32_16x16x32_bf16(Bt[n][k], At[m][k], acc[ai][bj][m][n], 0, 0, 0); __builtin_amdgcn_s_setprio(0); } while (0)
#define PG8_WAIT_V(n) asm volatile("s_waitcnt vmcnt(" #n ")" ::: "memory")
#define PG8_WAIT_L(n) asm volatile("s_waitcnt lgkmcnt(" #n ")" ::: "memory")
#define PG8_BAR __builtin_amdgcn_s_barrier()
#define PG8_SCHED __builtin_amdgcn_sched_barrier(0)
    Unit cur, nxt; int ui = 0;
    if (!S.next(0, cur)) return;
    f32x4 acc[2][2][4][2];
#pragma unroll
    for (int a = 0; a < 2; ++a)
#pragma unroll
        for (int b = 0; b < 2; ++b)
#pragma unroll
            for (int m = 0; m < 4; ++m)
#pragma unroll
                for (int n = 0; n < 2; ++n) acc[a][b][m][n] = (f32x4){0.f, 0.f, 0.f, 0.f};
    bf16x8 At[4][2], B0[2][2], B1[2][2];
    const char* cA = cur.a; const char* cB = cur.b;
    if constexpr (SP2) {
        PG8_STAGE(PG8_SB(0, 0), cB, voffB); PG8_STAGE(PG8_SB(0, 1), cB + hstepB, voffB); PG8_STAGE(PG8_SA(0, 0), cA, voffA); PG8_STAGE(PG8_SA(0, 1), cA + hstep, voffA);
        if (wr == 1) PG8_BAR;
        PG8_WAIT_V(2); PG8_BAR;
        PG8_STAGE(PG8_SB(1, 0), cB + kstep, voffB); PG8_STAGE(PG8_SA(1, 0), cA + kstep, voffA); PG8_STAGE(PG8_SB(1, 1), cB + hstepB + kstep, voffB);
        PG8_WAIT_V(6); PG8_BAR;
    } else {
        PG8_STAGE(PG8_SB(0, 0), cB, voffB); PG8_STAGE(PG8_SA(0, 0), cA, voffA); PG8_STAGE(PG8_SB(0, 1), cB + hstepB, voffB); PG8_STAGE(PG8_SA(0, 1), cA + hstep, voffA);
        if (wr == 1) PG8_BAR;
        PG8_WAIT_V(4); PG8_BAR;
        PG8_STAGE(PG8_SB(1, 0), cB + kstep, voffB); PG8_STAGE(PG8_SA(1, 0), cA + kstep, voffA); PG8_STAGE(PG8_SB(1, 1), cB + hstepB + kstep, voffB);
        PG8_WAIT_V(6); PG8_BAR;
    }
    for (;;) {
        const bool has_next = S.next(ui + 1, nxt);
        const char* nA = has_next ? nxt.a : cA; const char* nB = has_next ? nxt.b : cB;
        for (int t = 0; t < nt; t += 2) {
            const bool last = (t == nt - 2);
            const char* a1 = cA + (size_t)(t + 1) * kstep;
            const char* a2 = last ? nA : cA + (size_t)(t + 2) * kstep; const char* b2 = last ? nB : cB + (size_t)(t + 2) * kstep;
            const char* a3 = a2 + kstep; const char* b3 = b2 + kstep;
            if constexpr (SP2) {
            PG8_LDB(B0, 0, 0); PG8_LDB(B1, 0, 1); PG8_SCHED; PG8_LDA(At, 0, 0); PG8_STAGE(PG8_SA(1, 1), a1 + hstep, voffA);
            PG8_WAIT_V(8); PG8_WAIT_L(0); PG8_BAR; PG8_MMA(0, 0, At, B0); PG8_MMA(0, 1, At, B1); PG8_BAR; PG8_SCHED;
            PG8_LDA(At, 0, 1); PG8_STAGE(PG8_SB(0, 0), b2, voffB); PG8_STAGE(PG8_SB(0, 1), b2 + hstepB, voffB); PG8_STAGE(PG8_SA(0, 0), a2, voffA);
            PG8_WAIT_V(8); PG8_WAIT_L(0); PG8_BAR; PG8_MMA(1, 0, At, B0); PG8_MMA(1, 1, At, B1); PG8_BAR; PG8_SCHED;
            PG8_LDB(B0, 1, 0); PG8_LDB(B1, 1, 1); PG8_SCHED; PG8_LDA(At, 1, 0); PG8_STAGE(PG8_SA(0, 1), a2 + hstep, voffA);
            PG8_WAIT_V(8); PG8_WAIT_L(0); PG8_BAR; PG8_MMA(0, 0, At, B0); PG8_MMA(0, 1, At, B1); PG8_BAR; PG8_SCHED;
            PG8_LDA(At, 1, 1); PG8_STAGE(PG8_SB(1, 0), b3, voffB); PG8_STAGE(PG8_SB(1, 1), b3 + hstepB, voffB); PG8_STAGE(PG8_SA(1, 0), a3, voffA);
            PG8_WAIT_V(8); PG8_WAIT_L(0); PG8_BAR; PG8_MMA(1, 0, At, B0); PG8_MMA(1, 1, At, B1); PG8_BAR; PG8_SCHED;
            } else {
            PG8_LDB(B0, 0, 0); PG8_SCHED; PG8_LDA(At, 0, 0); PG8_STAGE(PG8_SA(1, 1), a1 + hstep, voffA);
            PG8_WAIT_L(8); PG8_BAR; PG8_WAIT_L(0); PG8_MMA(0, 0, At, B0); PG8_BAR; PG8_SCHED;
            PG8_LDB(B1, 0, 1); PG8_STAGE(PG8_SB(0, 0), b2, voffB);
            PG8_BAR; PG8_WAIT_L(0); PG8_MMA(0, 1, At, B1); PG8_BAR;
            PG8_LDA(At, 0, 1); PG8_STAGE(PG8_SA(0, 0), a2, voffA);
            PG8_BAR; PG8_WAIT_L(0); PG8_MMA(1, 0, At, B0); PG8_BAR; PG8_SCHED;
            PG8_STAGE(PG8_SB(0, 1), b2 + hstepB, voffB);
            PG8_WAIT_V(6); PG8_BAR; PG8_MMA(1, 1, At, B1); PG8_BAR;
            PG8_LDB(B0, 1, 0); PG8_SCHED; PG8_LDA(At, 1, 0); PG8_STAGE(PG8_SA(0, 1), a2 + hstep, voffA);
            PG8_WAIT_L(8); PG8_BAR; PG8_WAIT_L(0); PG8_MMA(0, 0, At, B0); PG8_BAR; PG8_SCHED;
            PG8_LDB(B1, 1, 1); PG8_STAGE(PG8_SB(1, 0), b3, voffB);
            PG8_BAR; PG8_WAIT_L(0); PG8_MMA(0, 1, At, B1); PG8_BAR;
            PG8_LDA(At, 1, 1); PG8_STAGE(PG8_SA(1, 0), a3, voffA);
            PG8_BAR; PG8_WAIT_L(0); PG8_MMA(1, 0, At, B0); PG8_BAR; PG8_SCHED;
            PG8_STAGE(PG8_SB(1, 1), b3 + hstepB, voffB);
            PG8_WAIT_V(6); PG8_BAR; PG8_MMA(1, 1, At, B1); PG8_BAR;
            }
        }
        if constexpr (ALIGN_EPI) { if (wr == 0) PG8_BAR; }
        E(acc, cur, wr, wc, fr, fq);
        if (!has_next) break;
#pragma unroll
        for (int a = 0; a < 2; ++a)
#pragma unroll
            for (int b = 0; b < 2; ++b)
#pragma unroll
                for (int m = 0; m < 4; ++m)
#pragma unroll
                    for (int n = 0; n < 2; ++n) acc[a][b][m][n] = (f32x4){0.f, 0.f, 0.f, 0.f};
        cur = nxt; cA = nA; cB = nB; ++ui;
        if constexpr (ALIGN_EPI) { if (wr == 1) PG8_BAR; }
    }
    PG8_WAIT_V(0);
    if constexpr (!ALIGN_EPI) { if (wr == 0) PG8_BAR; }
    PG8_BAR;
#undef PG8_SA
#undef PG8_SB
#undef PG8_STAGE
#undef PG8_LDA
#undef PG8_LDB
#undef PG8_MMA
#undef PG8_WAIT_V
#undef PG8_WAIT_L
#undef PG8_BAR
#undef PG8_SCHED
}
}

enum { K_QR = 0, K_KR, K_VR, K_SGR, K_QD, K_KD, K_VD, K_SGD, K_MGR, K_YR, K_MGD, K_YD, K_OUT };
constexpr size_t TSTEP = (size_t)256 * DM * 2;

template <int PC  > struct Epi {
    unsigned char* ws; const float* xin; float* xout; const float* gq; const float* gk;
    __device__ __forceinline__ static void st8(bf16* p, const f32x4 a, const f32x4 b) {
        u32x4 w; w.x = cvt_pk_bf16(a[0], a[1]); w.y = cvt_pk_bf16(a[2], a[3]); w.z = cvt_pk_bf16(b[0], b[1]); w.w = cvt_pk_bf16(b[2], b[3]); *(u32x4*)p = w; }
    __device__ __forceinline__ void operator()(const f32x4 (&acc)[2][2][4][2], const pg8::Unit& u, int wr, int wc, int fr, int fq) const {
        const int row0 = u.pm * 256 + wr * 64 + fr;
        const int cl = wc * 64 + 8 * fq;
        const int kind = u.kind;
        bf16* const qr = (bf16*)(ws + WS_QR); bf16* const kr = (bf16*)(ws + WS_KR); bf16* const vr = (bf16*)(ws + WS_VR); bf16* const sgr = (bf16*)(ws + WS_SGR);
        bf16* const qd = (bf16*)(ws + WS_QD); bf16* const kd = (bf16*)(ws + WS_KD); bf16* const vd = (bf16*)(ws + WS_VD); bf16* const sgd = (bf16*)(ws + WS_SGD);
        bf16* const smgr = (bf16*)(ws + WS_SMGR); bf16* const smgd = (bf16*)(ws + WS_SMGD); bf16* const mbf = (bf16*)(ws + WS_MBF); float* const mbuf = (float*)(ws + WS_MBUF);
        if (PC == 0 && (kind == K_VR || kind == K_VD)) {
            bf16* base = (kind == K_VR ? vr : vd) + u.pn * 256 + cl;
#pragma unroll
            for (int ai = 0; ai < 2; ++ai)
#pragma unroll
                for (int m = 0; m < 4; ++m) { bf16* rp = base + (size_t)(row0 + ai * 128 + m * 16) * 1024;
#pragma unroll
                    for (int bj = 0; bj < 2; ++bj) st8(rp + 32 * bj, acc[ai][bj][m][0], acc[ai][bj][m][1]); }
        } else if (PC == 0 && (kind == K_SGR || kind == K_SGD)) {
            bf16* base = (kind == K_SGR ? sgr : sgd) + u.pn * 256 + cl;
#pragma unroll
            for (int ai = 0; ai < 2; ++ai)
#pragma unroll
                for (int m = 0; m < 4; ++m) { bf16* rp = base + (size_t)(row0 + ai * 128 + m * 16) * 1024;
#pragma unroll
                    for (int bj = 0; bj < 2; ++bj) { f32x4 a = acc[ai][bj][m][0], b = acc[ai][bj][m][1];
#pragma unroll
                        for (int i = 0; i < 4; ++i) { a[i] = a[i] * fast_sigmoid(a[i]); b[i] = b[i] * fast_sigmoid(b[i]); }
                        st8(rp + 32 * bj, a, b); } }
        } else if (PC == 1 && (kind == K_MGR || kind == K_MGD)) {
            bf16* base = (kind == K_MGR ? smgr : smgd) + u.pn * 256 + cl;
#pragma unroll
            for (int ai = 0; ai < 2; ++ai)
#pragma unroll
                for (int m = 0; m < 4; ++m) { bf16* rp = base + (size_t)(row0 + ai * 128 + m * 16) * 1024;
#pragma unroll
                    for (int bj = 0; bj < 2; ++bj) { f32x4 a = acc[ai][bj][m][0], b = acc[ai][bj][m][1];
#pragma unroll
                        for (int i = 0; i < 4; ++i) { a[i] = fast_sigmoid(a[i]); b[i] = fast_sigmoid(b[i]); }
                        st8(rp + 32 * bj, a, b); } }
        } else if (PC == 0 && (kind == K_QR || kind == K_KR)) {
            const int h = u.pn * 4 + wc; const float lg = __log2f(1.0f - __builtin_amdgcn_exp2f(-5.0f - (float)h));
            bf16* base = (kind == K_QR ? qr : kr) + u.pn * 256 + cl;
            const float sgn = (kind == K_QR) ? lg : -lg, mul = (kind == K_QR) ? 1.0f : 0.125f;
#pragma unroll
            for (int ai = 0; ai < 2; ++ai)
#pragma unroll
                for (int m = 0; m < 4; ++m) { const int row = row0 + ai * 128 + m * 16; bf16* rp = base + (size_t)row * 512;
                    const float f = mul * __builtin_amdgcn_exp2f((float)(row & 127) * sgn);
#pragma unroll
                    for (int bj = 0; bj < 2; ++bj) st8(rp + 32 * bj, acc[ai][bj][m][0] * f, acc[ai][bj][m][1] * f); }
        } else if (PC == 0 && (kind == K_QD || kind == K_KD)) {
            const float* g = (kind == K_QD) ? gq : gk; const float mul = (kind == K_QD) ? 0.125f * LOG2E : 1.0f;
            bf16* base = (kind == K_QD ? qd : kd) + u.pn * 256 + cl;
            f32x4 gv[2][2];
#pragma unroll
            for (int bj = 0; bj < 2; ++bj)
#pragma unroll
                for (int n = 0; n < 2; ++n) gv[bj][n] = *(const f32x4*)(g + 32 * bj + 8 * fq + 4 * n) * mul;
#pragma unroll
            for (int ai = 0; ai < 2; ++ai)
#pragma unroll
                for (int m = 0; m < 4; ++m) { bf16* rp = base + (size_t)(row0 + ai * 128 + m * 16) * 1024;
                    float ss = 0.f;
#pragma unroll
                    for (int bj = 0; bj < 2; ++bj)
#pragma unroll
                        for (int n = 0; n < 2; ++n) { const f32x4 x = acc[ai][bj][m][n]; ss += (x[0] * x[0] + x[1] * x[1]) + (x[2] * x[2] + x[3] * x[3]); }
                    ss += __shfl_xor(ss, 16); ss += __shfl_xor(ss, 32);
                    const float rs = __builtin_amdgcn_rsqf(ss * (1.0f / 64.0f) + EPS);
#pragma unroll
                    for (int bj = 0; bj < 2; ++bj) st8(rp + 32 * bj, acc[ai][bj][m][0] * gv[bj][0] * rs, acc[ai][bj][m][1] * gv[bj][1] * rs); }
        } else if (PC == 1 && kind == K_YR) {
            bf16* const yrb = (bf16*)mbuf + (size_t)u.pn * 256 + cl;
#pragma unroll
            for (int ai = 0; ai < 2; ++ai)
#pragma unroll
                for (int m = 0; m < 4; ++m) { bf16* rp = yrb + (size_t)(row0 + ai * 128 + m * 16) * 1024;
#pragma unroll
                    for (int bj = 0; bj < 2; ++bj) st8(rp + 32 * bj, acc[ai][bj][m][0], acc[ai][bj][m][1]); }
        } else if (PC == 1 && kind == K_YD) {
            const size_t cb = (size_t)u.pn * 256 + cl; const bf16* const yrb = (const bf16*)mbuf;
#pragma unroll
            for (int ai = 0; ai < 2; ++ai)
#pragma unroll
                for (int m = 0; m < 4; ++m) { const size_t ro = (size_t)(row0 + ai * 128 + m * 16) * 1024 + cb;
#pragma unroll
                    for (int bj = 0; bj < 2; ++bj) { const u32x4 sr = *(const u32x4*)(smgr + ro + 32 * bj), sd = *(const u32x4*)(smgd + ro + 32 * bj), yr = *(const u32x4*)(yrb + ro + 32 * bj);
                        const f32x4 a = acc[ai][bj][m][0], b = acc[ai][bj][m][1];
                        f32x4 o0, o1;
                        o0[0] = lo_bf(sr.x) * lo_bf(yr.x) + lo_bf(sd.x) * a[0]; o0[1] = hi_bf(sr.x) * hi_bf(yr.x) + hi_bf(sd.x) * a[1];
                        o0[2] = lo_bf(sr.y) * lo_bf(yr.y) + lo_bf(sd.y) * a[2]; o0[3] = hi_bf(sr.y) * hi_bf(yr.y) + hi_bf(sd.y) * a[3];
                        o1[0] = lo_bf(sr.z) * lo_bf(yr.z) + lo_bf(sd.z) * b[0]; o1[1] = hi_bf(sr.z) * hi_bf(yr.z) + hi_bf(sd.z) * b[1];
                        o1[2] = lo_bf(sr.w) * lo_bf(yr.w) + lo_bf(sd.w) * b[2]; o1[3] = hi_bf(sr.w) * hi_bf(yr.w) + hi_bf(sd.w) * b[3];
                        st8(mbf + ro + 32 * bj, o0, o1); }
                    asm volatile("" ::: "memory"); }
        } else if (PC == 2 && kind == K_OUT) {
            const size_t cb = (size_t)u.pn * 256 + cl;
#pragma unroll
            for (int ai = 0; ai < 2; ++ai) {
                f32x4 pre[4][2][2];
#pragma unroll
                for (int m = 0; m < 4; ++m) { const size_t ro = (size_t)(row0 + ai * 128 + m * 16) * 1024 + cb;
#pragma unroll
                    for (int bj = 0; bj < 2; ++bj) { pre[m][bj][0] = *(const f32x4*)(xin + ro + 32 * bj); pre[m][bj][1] = *(const f32x4*)(xin + ro + 32 * bj + 4); } }
#pragma unroll
                for (int m = 0; m < 4; ++m) { const size_t ro = (size_t)(row0 + ai * 128 + m * 16) * 1024 + cb;
#pragma unroll
                    for (int bj = 0; bj < 2; ++bj) { *(f32x4*)(xout + ro + 32 * bj) = pre[m][bj][0] + acc[ai][bj][m][0]; *(f32x4*)(xout + ro + 32 * bj + 4) = pre[m][bj][1] + acc[ai][bj][m][1]; } }
                asm volatile("" ::: "memory");
            }
        }
    }
};

struct SchedG1A {
    const char* A; const char* B; int G, c;
    __device__ __forceinline__ bool next(int i, pg8::Unit& u) const {
        const int L = i * G + c; if (L >= 64 * 28) return false;
        int pm, pg; pg8::tile_of(L, 64, 28, pm, pg);
        u.pm = pm; u.a = A + (size_t)pm * TSTEP; u.b = B + (size_t)pg * TSTEP;
        if (pg < 2) { u.kind = K_QR; u.pn = pg; } else if (pg < 4) { u.kind = K_KR; u.pn = pg - 2; } else if (pg < 8) { u.kind = K_VR; u.pn = pg - 4; } else if (pg < 12) { u.kind = K_SGR; u.pn = pg - 8; }
        else if (pg < 16) { u.kind = K_QD; u.pn = pg - 12; } else if (pg < 20) { u.kind = K_KD; u.pn = pg - 16; } else if (pg < 24) { u.kind = K_VD; u.pn = pg - 20; } else { u.kind = K_SGD; u.pn = pg - 24; }
        return true;
    }
};
struct SchedP34 {
    const char *ws, *Wro, *H, *Win; int c;
    __device__ __forceinline__ bool next(int i, pg8::Unit& u) const {
        if (i >= 4) return false;
        const char* OR = ws + WS_SGR; const char* OD = ws + WS_SGD; const char* Wdo = Wro + 2 * MiB;
        int pm, pn; pg8::tile_of(c, 64, 4, pm, pn); u.pm = pm; u.pn = pn;
        if (i == 0) { u.kind = K_MGR; u.a = H + (size_t)pm * TSTEP; u.b = Win + (size_t)(28 + pn) * TSTEP; }
        else if (i == 1) { u.kind = K_MGD; u.a = H + (size_t)pm * TSTEP; u.b = Win + (size_t)(32 + pn) * TSTEP; }
        else if (i == 2) { u.kind = K_YR; u.a = OR + (size_t)pm * TSTEP; u.b = Wro + (size_t)pn * TSTEP; }
        else { u.kind = K_YD; u.a = OD + (size_t)pm * TSTEP; u.b = Wdo + (size_t)pn * TSTEP; }
        return true;
    }
};
struct SchedG4 {
    const char *Mb, *Wout; int c;
    __device__ __forceinline__ bool next(int i, pg8::Unit& u) const {
        if (i >= 1) return false;
        int pm, pn; pg8::tile_of(c, 64, 4, pm, pn); u.pm = pm; u.pn = pn; u.kind = K_OUT; u.a = Mb + (size_t)pm * TSTEP; u.b = Wout + (size_t)pn * TSTEP; return true;
    }
};


namespace att {
typedef float f32x16 __attribute__((ext_vector_type(16)));
typedef short s16x4 __attribute__((ext_vector_type(4)));
typedef short v4i16_t __attribute__((ext_vector_type(4)));
constexpr int SLOT_OFF = 65536, SLOT_BYTES = 32768, V_OFF = 16384;
__device__ __forceinline__ int crow(int r, int hi) { return (r & 3) + 8 * (r >> 2) + 4 * hi; }
__device__ __forceinline__ s16x4 vtr(LAS const unsigned char* p) { return __builtin_bit_cast(s16x4, __builtin_amdgcn_ds_read_tr16_b64_v4i16((LAS v4i16_t*)p)); }
#define ATT_MFMA(a, b, c) __builtin_amdgcn_mfma_f32_32x32x16_bf16(a, b, c, 0, 0, 0)

template <class Hook> __device__ __forceinline__ void attn_unit(LAS unsigned char* lds, const unsigned char* ws, const int b, const int h, const int qb, const float lam, const float omli, const float* __restrict__ gsub, const int win, const Hook& after_tiles) {
    int tid_ = threadIdx.x; asm volatile("" : "+v"(tid_));
    const int tid = tid_, lane = tid & 63, r32 = lane & 31, hi = lane >> 5, w = __builtin_amdgcn_readfirstlane(tid >> 6), rg = w & 3, kg = w >> 2;
    const bf16* QD = (const bf16*)(ws + WS_QD); const bf16* KD = (const bf16*)(ws + WS_KD); const bf16* VD = (const bf16*)(ws + WS_VD); bf16* SGD = (bf16*)(ws + WS_SGD);
    const size_t tb = (size_t)b * SEQ; const int q0 = qb * 128, NT = (q0 + 128) / 64;
    const int T0 = (q0 > win ? q0 - win : 0) >> 6;
#pragma unroll
    for (int k = 0; k < 4; ++k) { const int p = 4 * kg + k; const bf16* src = QD + (tb + q0 + 32 * rg + r32) * 1024 + h * 128 + (p >> 2) * 64 + (p & 3) * 16 + hi * 8;
        __builtin_amdgcn_global_load_lds((const unsigned*)src, (LAS unsigned*)(lds + rg * 8192 + p * 1024), 16, 0, 0); }
    const bf16* ksrc = KD + (tb + lane) * 1024 + h * 128 + (w & 7) * 8;
    const bf16* vsrc = VD + (tb + 16 * (w & 3) + (lane >> 2)) * 1024 + h * 128 + (w >> 2) * 32 + (lane & 3) * 8;
#define ATT_STAGE(t, slot) do { _Pragma("unroll") for (int rr = 0; rr < 2; ++rr) { \
        __builtin_amdgcn_global_load_lds((const unsigned*)(ksrc + (size_t)(t) * 65536 + rr * 64), (LAS unsigned*)(lds + SLOT_OFF + (slot) * SLOT_BYTES + (rr * 8 + w) * 1024), 16, 0, 0); \
        __builtin_amdgcn_global_load_lds((const unsigned*)(vsrc + (size_t)(t) * 65536 + rr * 64), (LAS unsigned*)(lds + SLOT_OFF + (slot) * SLOT_BYTES + V_OFF + (rr * 8 + w) * 1024), 16, 0, 0); } } while (0)
    ATT_STAGE(T0, 0);
    __syncthreads();
    const float slope = __builtin_amdgcn_exp2f(-(float)(h + 1)) * LOG2E;
    const int n = q0 + 32 * rg + r32;
    f32x16 O[2][4];
#pragma unroll
    for (int j = 0; j < 2; ++j)
#pragma unroll
        for (int e = 0; e < 4; ++e)
#pragma unroll
            for (int r = 0; r < 16; ++r) O[j][e][r] = 0.f;
    float lsum[2] = {0.f, 0.f};
    const int qoff = rg * 8192 + lane * 16;
    const int koff = hi * 1024 + (32 * kg + r32) * 16;
    const int voff = V_OFF + 2 * kg * 1024 + ((lane >> 4) & 1) * 32 + (lane & 3) * 8 + (4 * hi + ((lane & 15) >> 2)) * 64;
    for (int t = T0; t < NT; ++t) {
        if (t + 1 < NT) ATT_STAGE(t + 1, (t + 1 - T0) & 1);
        const int k0 = t * 64 + 32 * kg;
        if (k0 <= q0 + 32 * rg + 31) {
            LAS const unsigned char* slot = lds + SLOT_OFF + ((t - T0) & 1) * SLOT_BYTES;
            float sl = slope; asm volatile("" : "+v"(sl));
            const int dn = n - k0 - 4 * hi; const float base = -sl * (float)dn;
            const bool diag = (k0 + 31 > q0 + 32 * rg);
            f32x16 pA, pB;
#pragma unroll
            for (int r = 0; r < 16; ++r) { const int kc = (r & 3) + 8 * (r >> 2); pA[r] = __builtin_fmaf(sl, (float)kc, base); }
            if (diag) {
#pragma unroll
                for (int r = 0; r < 16; ++r) { const int kc = (r & 3) + 8 * (r >> 2); if (kc > dn) pA[r] = -INFINITY; }
            }
            pB = pA;
#pragma unroll
            for (int d0 = 0; d0 < 4; ++d0) {
                const bf16x8 kfa = *(LAS const bf16x8*)(slot + koff + (2 * d0) * 1024), kfb = *(LAS const bf16x8*)(slot + koff + (8 + 2 * d0) * 1024);
                const bf16x8 qfa = *(LAS const bf16x8*)(lds + qoff + d0 * 1024), qfb = *(LAS const bf16x8*)(lds + qoff + (4 + d0) * 1024);
                pA = ATT_MFMA(kfa, qfa, pA); pB = ATT_MFMA(kfb, qfb, pB);
            }
            bf16x8 vf[4][2];
#pragma unroll
            for (int eb = 0; eb < 4; ++eb)
#pragma unroll
                for (int ks = 0; ks < 2; ++ks) { const s16x4 vlo = vtr(slot + voff + eb * 4096 + ks * 1024), vhi = vtr(slot + voff + eb * 4096 + ks * 1024 + 512);
                    vf[eb][ks] = (bf16x8){vlo[0], vlo[1], vlo[2], vlo[3], vhi[0], vhi[1], vhi[2], vhi[3]}; }
            u32x4 pwA[2], pwB[2];
            { float s = 0.f;
#pragma unroll
              for (int r = 0; r < 16; ++r) { pA[r] = __builtin_amdgcn_exp2f(pA[r]); s += pA[r]; }
              lsum[0] += s;
#pragma unroll
              for (int i = 0; i < 4; ++i) { pwA[0][i] = cvt_pk_bf16(pA[2 * i], pA[2 * i + 1]); pwA[1][i] = cvt_pk_bf16(pA[8 + 2 * i], pA[9 + 2 * i]); } }
            { float s = 0.f;
#pragma unroll
              for (int r = 0; r < 16; ++r) { pB[r] = __builtin_amdgcn_exp2f(pB[r]); s += pB[r]; }
              lsum[1] += s;
#pragma unroll
              for (int i = 0; i < 4; ++i) { pwB[0][i] = cvt_pk_bf16(pB[2 * i], pB[2 * i + 1]); pwB[1][i] = cvt_pk_bf16(pB[8 + 2 * i], pB[9 + 2 * i]); } }
#pragma unroll
            for (int eb = 0; eb < 4; ++eb)
#pragma unroll
                for (int ks = 0; ks < 2; ++ks) {
                    O[0][eb] = ATT_MFMA(vf[eb][ks], __builtin_bit_cast(bf16x8, pwA[ks]), O[0][eb]);
                    O[1][eb] = ATT_MFMA(vf[eb][ks], __builtin_bit_cast(bf16x8, pwB[ks]), O[1][eb]);
                }
        }
        __syncthreads();
    }
    after_tiles();
    lsum[0] += __shfl_xor(lsum[0], 32); lsum[1] += __shfl_xor(lsum[1], 32);
    LAS float* dump = (LAS float*)(lds + rg * 32768);
    LAS float* lx = (LAS float*)(lds + 131072 + rg * 1024);
    int r32e = r32; asm volatile("" : "+v"(r32e));
    bf16* rowp = SGD + (tb + q0 + 32 * rg + r32e) * 1024 + h * 128 + 4 * hi;
    const float* gp = gsub + h * 128 + 4 * hi;
    unsigned long long gt[4][4];
    if (kg == 1) {
#pragma unroll
        for (int j = 0; j < 2; ++j)
#pragma unroll
            for (int eb = 0; eb < 4; ++eb)
#pragma unroll
                for (int q = 0; q < 4; ++q) *(LAS f32x4*)(dump + (((j * 4 + eb) * 4 + q) * 64 + lane) * 4) = (f32x4){O[j][eb][4 * q], O[j][eb][4 * q + 1], O[j][eb][4 * q + 2], O[j][eb][4 * q + 3]};
        lx[lane] = lsum[0]; lx[64 + lane] = lsum[1];
    } else {
#pragma unroll
        for (int eb = 0; eb < 2; ++eb)
#pragma unroll
            for (int g = 0; g < 4; ++g) gt[eb][g] = *(const unsigned long long*)(rowp + 32 * eb + 8 * g);
    }
    asm volatile("s_waitcnt lgkmcnt(0)" ::: "memory"); __builtin_amdgcn_s_barrier(); asm volatile("" ::: "memory");
    if (kg == 0) {
#pragma unroll
        for (int j = 0; j < 2; ++j)
#pragma unroll
            for (int eb = 0; eb < 4; ++eb)
                {
#pragma unroll
                  for (int q = 0; q < 4; ++q) { const f32x4 v = *(LAS const f32x4*)(dump + (((j * 4 + eb) * 4 + q) * 64 + lane) * 4); O[j][eb][4 * q] += v[0]; O[j][eb][4 * q + 1] += v[1]; O[j][eb][4 * q + 2] += v[2]; O[j][eb][4 * q + 3] += v[3]; }
                  asm volatile("s_waitcnt lgkmcnt(0)" : "+v"(O[j][eb]) :: "memory"); }
        lsum[0] += lx[lane]; lsum[1] += lx[64 + lane];
        asm volatile("s_waitcnt lgkmcnt(0)" ::: "memory");
#pragma unroll
        for (int eb = 2; eb < 4; ++eb)
#pragma unroll
            for (int g = 0; g < 4; ++g) gt[eb][g] = *(const unsigned long long*)(rowp + 32 * eb + 8 * g);
        const float i0 = 1.0f / lsum[0], i1 = lam / lsum[1];
        float ss = 0.f;
#pragma unroll
        for (int eb = 0; eb < 4; ++eb)
#pragma unroll
            for (int r = 0; r < 16; ++r) { const float o = O[0][eb][r] * i0 - O[1][eb][r] * i1; O[0][eb][r] = o; ss += o * o; }
        ss += __shfl_xor(ss, 32);
        const float rs = __builtin_amdgcn_rsqf(ss * (1.0f / 128.0f) + EPS) * omli;
#pragma unroll
        for (int eb = 0; eb < 4; ++eb) {
            f32x4 gg[4];
#pragma unroll
            for (int g = 0; g < 4; ++g) gg[g] = *(const f32x4*)(gp + 32 * eb + 8 * g);
#pragma unroll
            for (int g = 0; g < 4; ++g) { const unsigned glo = (unsigned)gt[eb][g], ghi = (unsigned)(gt[eb][g] >> 32);
                const unsigned w0 = cvt_pk_bf16(O[0][eb][4 * g] * rs * gg[g][0] * lo_bf(glo), O[0][eb][4 * g + 1] * rs * gg[g][1] * hi_bf(glo));
                const unsigned w1 = cvt_pk_bf16(O[0][eb][4 * g + 2] * rs * gg[g][2] * lo_bf(ghi), O[0][eb][4 * g + 3] * rs * gg[g][3] * hi_bf(ghi));
                *(unsigned long long*)(rowp + 32 * eb + 8 * g) = (unsigned long long)w0 | ((unsigned long long)w1 << 32); }
        }
    }
    asm volatile("s_waitcnt lgkmcnt(0)" ::: "memory");
    __syncthreads();
#undef ATT_STAGE
}
}

namespace ret {
using att::f32x16; using att::s16x4; using att::crow; using att::vtr;
constexpr int SET = 49152, KT = 0, VI = 16384, OST = 98304, ST = 131072, RED = 147456;
__device__ __forceinline__ void ret_unit(LAS unsigned char* lds, const unsigned char* ws, const int b, const int h, const float* __restrict__ gn, const int c0, const int c1) {
    int tid_ = threadIdx.x; asm volatile("" : "+v"(tid_));
    const int tid = tid_, lane = tid & 63, r32 = lane & 31, hi = lane >> 5, w = __builtin_amdgcn_readfirstlane(tid >> 6);
    const int ib = w & 3, eh = w >> 2, dh = w & 1, ebo = w >> 1;
    const bf16* QR = (const bf16*)(ws + WS_QR); const bf16* KR = (const bf16*)(ws + WS_KR); const bf16* VR = (const bf16*)(ws + WS_VR); bf16* SGR = (bf16*)(ws + WS_SGR);
    const size_t tb = (size_t)b * SEQ;
    const float lg = __log2f(1.0f - __builtin_amdgcn_exp2f(-5.0f - (float)h)), gC = __builtin_amdgcn_exp2f(128.0f * lg);
    for (int i = tid; i < 16384 / 16; i += 512) *(LAS u32x4*)(lds + ST + i * 16) = (u32x4){0u, 0u, 0u, 0u};
    f32x16 sblk;
#pragma unroll
    for (int r = 0; r < 16; ++r) sblk[r] = 0.f;
    const int vpat = ((lane >> 4) & 1) * 32 + (lane & 3) * 8 + (4 * hi + ((lane & 15) >> 2)) * 64;
    const int prow = tid >> 4, pcol = (tid & 15) * 8;
    f32x4 gA = *(const f32x4*)(gn + h * 128 + pcol), gB = *(const f32x4*)(gn + h * 128 + pcol + 4);
#define RET_STAGE(c, s) do { const size_t t0_ = tb + (size_t)(c) * 128; LAS unsigned char* sb_ = lds + (s) * SET; \
        _Pragma("unroll") for (int k = 0; k < 2; ++k) { const int p = 2 * w + k, d2 = p >> 3, kg = p & 7; \
            __builtin_amdgcn_global_load_lds((const unsigned*)(KR + (t0_ + 16 * kg + (lane >> 2)) * 512 + h * 64 + d2 * 32 + (lane & 3) * 8), (LAS unsigned*)(sb_ + KT + p * 1024), 16, 0, 0); } \
        _Pragma("unroll") for (int k = 0; k < 4; ++k) { const int p = 4 * w + k, eg = p >> 3, kg = p & 7; \
            __builtin_amdgcn_global_load_lds((const unsigned*)(VR + (t0_ + 16 * kg + (lane >> 2)) * 1024 + h * 128 + eg * 32 + (lane & 3) * 8), (LAS unsigned*)(sb_ + VI + p * 1024), 16, 0, 0); } } while (0)
    if (c0 > 0) {
        RET_STAGE(0, 0);
        for (int c = 0; c < c0; ++c) {
            __syncthreads();
            if (c + 1 < c0) RET_STAGE(c + 1, (c + 1) & 1);
            LAS const unsigned char* sb = lds + (c & 1) * SET;
            f32x16 kv;
#pragma unroll
            for (int r = 0; r < 16; ++r) kv[r] = 0.f;
#pragma unroll
            for (int ks = 0; ks < 8; ++ks) { LAS const unsigned char* kp = sb + KT + dh * 8192 + ks * 1024 + vpat; LAS const unsigned char* vp = sb + VI + ebo * 8192 + ks * 1024 + vpat;
                const s16x4 klo = vtr(kp), khi = vtr(kp + 512), vlo = vtr(vp), vhi = vtr(vp + 512);
                kv = ATT_MFMA(((bf16x8){klo[0], klo[1], klo[2], klo[3], khi[0], khi[1], khi[2], khi[3]}), ((bf16x8){vlo[0], vlo[1], vlo[2], vlo[3], vhi[0], vhi[1], vhi[2], vhi[3]}), kv); }
#pragma unroll
            for (int r = 0; r < 16; ++r) sblk[r] = gC * (sblk[r] + kv[r]);
        }
        __syncthreads();
#pragma unroll
        for (int g = 0; g < 4; ++g) { unsigned long long v = (unsigned long long)cvt_pk_bf16(sblk[4 * g], sblk[4 * g + 1]) | ((unsigned long long)cvt_pk_bf16(sblk[4 * g + 2], sblk[4 * g + 3]) << 32);
            *(LAS unsigned long long*)(lds + ST + (32 * ebo + r32) * 128 + (32 * dh + 8 * g + 4 * hi) * 2) = v; }
    }
    RET_STAGE(c0, c0 & 1);
    bf16x8 qn[4];
#pragma unroll
    for (int d0 = 0; d0 < 4; ++d0) qn[d0] = *(const bf16x8*)(QR + (tb + (size_t)c0 * 128 + 32 * ib + r32) * 512 + h * 64 + d0 * 16 + hi * 8);
    for (int c = c0; c < c1; ++c) {
        const size_t t0 = tb + (size_t)c * 128;
        __syncthreads();
        LAS const unsigned char* sb = lds + (c & 1) * SET;
        u32x4 gt[4];
#pragma unroll
        for (int k = 0; k < 4; ++k) gt[k] = *(const u32x4*)(SGR + (t0 + prow + 32 * k) * 1024 + h * 128 + pcol);
        bf16x8 qf[4];
#pragma unroll
        for (int d0 = 0; d0 < 4; ++d0) qf[d0] = qn[d0];
        if (c + 1 < c1) { RET_STAGE(c + 1, (c + 1) & 1);
#pragma unroll
            for (int d0 = 0; d0 < 4; ++d0) qn[d0] = *(const bf16x8*)(QR + (t0 + 128 + 32 * ib + r32) * 512 + h * 64 + d0 * 16 + hi * 8); }
        f32x16 O[2];
#pragma unroll
        for (int eb = 0; eb < 2; ++eb)
#pragma unroll
            for (int r = 0; r < 16; ++r) O[eb][r] = 0.f;
#pragma unroll
        for (int jb = 0; jb < 4; ++jb) {
            if (jb <= ib) {
                f32x16 s;
#pragma unroll
                for (int r = 0; r < 16; ++r) s[r] = 0.f;
#pragma unroll
                for (int d0 = 0; d0 < 4; ++d0) { const bf16x8 kf = *(LAS const bf16x8*)(sb + KT + (d0 >> 1) * 8192 + (32 * jb + r32) * 64 + ((d0 & 1) * 16 + 8 * hi) * 2); s = ATT_MFMA(kf, qf[d0], s); }
                if (jb == ib) {
#pragma unroll
                    for (int r = 0; r < 16; ++r) if (crow(r, hi) > r32) s[r] = 0.f;
                }
                u32x4 pw[2];
#pragma unroll
                for (int i = 0; i < 4; ++i) { pw[0][i] = cvt_pk_bf16(s[2 * i], s[2 * i + 1]); pw[1][i] = cvt_pk_bf16(s[8 + 2 * i], s[9 + 2 * i]); }
#pragma unroll
                for (int eb = 0; eb < 2; ++eb)
#pragma unroll
                    for (int ks = 0; ks < 2; ++ks) { LAS const unsigned char* vp = sb + VI + (2 * eh + eb) * 8192 + (2 * jb + ks) * 1024 + vpat;
                        const s16x4 vlo = vtr(vp), vhi = vtr(vp + 512);
                        O[eb] = ATT_MFMA(((bf16x8){vlo[0], vlo[1], vlo[2], vlo[3], vhi[0], vhi[1], vhi[2], vhi[3]}), __builtin_bit_cast(bf16x8, pw[ks]), O[eb]); }
            }
        }
#pragma unroll
        for (int eb = 0; eb < 2; ++eb)
#pragma unroll
            for (int d0 = 0; d0 < 4; ++d0) { const bf16x8 sf = *(LAS const bf16x8*)(lds + ST + (32 * (2 * eh + eb) + r32) * 128 + (16 * d0 + 8 * hi) * 2); O[eb] = ATT_MFMA(sf, qf[d0], O[eb]); }
        { f32x16 kv;
#pragma unroll
          for (int r = 0; r < 16; ++r) kv[r] = 0.f;
#pragma unroll
          for (int ks = 0; ks < 8; ++ks) { LAS const unsigned char* kp = sb + KT + dh * 8192 + ks * 1024 + vpat; LAS const unsigned char* vp = sb + VI + ebo * 8192 + ks * 1024 + vpat;
              const s16x4 klo = vtr(kp), khi = vtr(kp + 512), vlo = vtr(vp), vhi = vtr(vp + 512);
              kv = ATT_MFMA(((bf16x8){klo[0], klo[1], klo[2], klo[3], khi[0], khi[1], khi[2], khi[3]}), ((bf16x8){vlo[0], vlo[1], vlo[2], vlo[3], vhi[0], vhi[1], vhi[2], vhi[3]}), kv); }
#pragma unroll
          for (int r = 0; r < 16; ++r) sblk[r] = gC * (sblk[r] + kv[r]); }
        { float s2 = 0.f;
#pragma unroll
          for (int eb = 0; eb < 2; ++eb)
#pragma unroll
              for (int r = 0; r < 16; ++r) s2 += O[eb][r] * O[eb][r];
          s2 += __shfl_xor(s2, 32);
          if (hi == 0) ((LAS float*)(lds + RED))[(32 * ib + r32) * 2 + eh] = s2; }
#pragma unroll
        for (int eb = 0; eb < 2; ++eb)
#pragma unroll
            for (int g = 0; g < 4; ++g) *(LAS unsigned long long*)(lds + OST + (32 * ib + r32) * 256 + (64 * eh + 32 * eb + 8 * g + 4 * hi) * 2) =
                (unsigned long long)cvt_pk_bf16(O[eb][4 * g], O[eb][4 * g + 1]) | ((unsigned long long)cvt_pk_bf16(O[eb][4 * g + 2], O[eb][4 * g + 3]) << 32);
        asm volatile("s_waitcnt lgkmcnt(0)" ::: "memory"); __builtin_amdgcn_s_barrier(); asm volatile("" ::: "memory");
#pragma unroll
        for (int g = 0; g < 4; ++g) { unsigned long long v = (unsigned long long)cvt_pk_bf16(sblk[4 * g], sblk[4 * g + 1]) | ((unsigned long long)cvt_pk_bf16(sblk[4 * g + 2], sblk[4 * g + 3]) << 32);
            *(LAS unsigned long long*)(lds + ST + (32 * ebo + r32) * 128 + (32 * dh + 8 * g + 4 * hi) * 2) = v; }
#pragma unroll
        for (int k = 0; k < 4; ++k) { const int row = prow + 32 * k; const LAS float* rp = (const LAS float*)(lds + RED) + row * 2;
            const float rs = __builtin_amdgcn_rsqf((rp[0] + rp[1]) * (1.0f / 128.0f) + EPS);
            const u32x4 ov = *(LAS const u32x4*)(lds + OST + row * 256 + pcol * 2); const u32x4 gg = gt[k];
            u32x4 res;
            res.x = cvt_pk_bf16(lo_bf(ov.x) * rs * gA[0] * lo_bf(gg.x), hi_bf(ov.x) * rs * gA[1] * hi_bf(gg.x));
            res.y = cvt_pk_bf16(lo_bf(ov.y) * rs * gA[2] * lo_bf(gg.y), hi_bf(ov.y) * rs * gA[3] * hi_bf(gg.y));
            res.z = cvt_pk_bf16(lo_bf(ov.z) * rs * gB[0] * lo_bf(gg.z), hi_bf(ov.z) * rs * gB[1] * hi_bf(gg.z));
            res.w = cvt_pk_bf16(lo_bf(ov.w) * rs * gB[2] * lo_bf(gg.w), hi_bf(ov.w) * rs * gB[3] * hi_bf(gg.w));
            *(u32x4*)(SGR + (t0 + row) * 1024 + h * 128 + pcol) = res; }
    }
    __syncthreads();
#undef RET_STAGE
}
}

constexpr int MIX_LIST_ITEMS = 16 + 4 * 32;
constexpr int CW_QUEUE = 2048;

#define XB_TMO      128
#define XB_XCNT(j)  (256  + 64 * (j))
#define XB_XSUB(j)  (1280 + 64 * (j))
#define XB_XGEN(j)  (2304 + 64 * (j))
#define XB_TOP      3328
#define XB_TOPGEN   3392
#define XCD_BAR_WORDS 3456
#define XB_SPIN_CAP (1u << 18)
__device__ __forceinline__ unsigned xb_ld(unsigned* p)              { return __hip_atomic_load(p, __ATOMIC_RELAXED, __HIP_MEMORY_SCOPE_AGENT); }
__device__ __forceinline__ unsigned xb_add(unsigned* p, unsigned v) { return __hip_atomic_fetch_add(p, v, __ATOMIC_RELAXED, __HIP_MEMORY_SCOPE_AGENT); }
__device__ __forceinline__ unsigned xb_xcc_id() { return (unsigned)__builtin_amdgcn_s_getreg((3 << 11) | 20) & 0xFu; }
#define XB_SPIN(cond, bar) do { unsigned _sp = 0; while (cond) { __builtin_amdgcn_s_sleep(1); \
    if ((++_sp & 255u) == 0u) { if (xb_ld(&(bar)[XB_TMO])) break; if (_sp > XB_SPIN_CAP) { atomicAdd(&(bar)[XB_TMO], 1u); break; } } } } while (0)
struct XcdBarrier { unsigned* bar; unsigned x; volatile LAS unsigned* st; };
__device__ __forceinline__ XcdBarrier xcd_barrier_post(unsigned* bar, volatile LAS unsigned* st) {
    XcdBarrier b; b.bar = bar; b.x = xb_xcc_id(); b.st = st;
    if (threadIdx.x == 0) (void)xb_add(&bar[XB_XCNT(b.x)], 1u);
    return b;
}
__device__ __forceinline__ void xcd_barrier_complete(unsigned* bar, unsigned x, unsigned& nloc, unsigned& nx) {
    const unsigned G = gridDim.x * gridDim.y * gridDim.z;
    unsigned sum, cnt, mine, sp = 0u;
    for (;;) {
        sum = 0u; cnt = 0u; mine = 0u;
#pragma unroll
        for (unsigned j = 0; j < 16; ++j) { const unsigned c = xb_ld(&bar[XB_XCNT(j)]); sum += c; cnt += (c > 0u) ? 1u : 0u; mine = (j == x) ? c : mine; }
        if (sum == G) break;
        __builtin_amdgcn_s_sleep(1);
        if ((++sp & 255u) == 0u) { if (xb_ld(&bar[XB_TMO])) break; if (sp > XB_SPIN_CAP) { atomicAdd(&bar[XB_TMO], 1u); break; } }
    }
    nloc = mine > 0u ? mine : 1u; nx = cnt > 0u ? cnt : 1u;
}
__device__ __forceinline__ void xcd_barrier(const XcdBarrier& b) {
    asm volatile("s_waitcnt vmcnt(0)" ::: "memory");
    __syncthreads();
    if (threadIdx.x == 0) {
        unsigned* bar = b.bar;
        __builtin_amdgcn_s_waitcnt(0);
        unsigned nloc = b.st[0], nx = b.st[1];
        if (nloc == 0u) { xcd_barrier_complete(bar, b.x, nloc, nx); b.st[0] = nloc; b.st[1] = nx; }
        const unsigned old = xb_add(&bar[XB_XSUB(b.x)], 1u);
        const unsigned gen = old / nloc;
        if (old + 1u == (gen + 1u) * nloc) {
            __builtin_amdgcn_fence(__ATOMIC_RELEASE, "agent");
            asm volatile("s_waitcnt vmcnt(0)" ::: "memory");
            const unsigned og = xb_add(&bar[XB_TOP], 1u);
            const unsigned tg = og / nx;
            if (og + 1u == (tg + 1u) * nx) xb_add(&bar[XB_TOPGEN], 1u);
            else XB_SPIN(xb_ld(&bar[XB_TOPGEN]) == tg, bar);
            __builtin_amdgcn_fence(__ATOMIC_ACQUIRE, "agent");
            xb_add(&bar[XB_XGEN(b.x)], 1u);
            asm volatile("s_waitcnt vmcnt(0)" ::: "memory");
        } else {
            XB_SPIN(xb_ld(&bar[XB_XGEN(b.x)]) == gen, bar);
            __builtin_amdgcn_fence(__ATOMIC_ACQUIRE, "agent");
            asm volatile("s_waitcnt vmcnt(0)" ::: "memory");
        }
    }
    __syncthreads();
}

#define LDS_WAIT() asm volatile("s_waitcnt lgkmcnt(0)" ::: "memory")
__device__ __forceinline__ float wave_sum(float v) {
#pragma unroll
    for (int o = 1; o < 64; o <<= 1) v += __shfl_xor(v, o);
    return v;
}
constexpr int P0_SCR_BYTES = 64 * 65 * 4;
__device__ __forceinline__ void p0_transpose_item(const float* W, int K, int N, bf16* WT, LAS float* scr, int item, int lane) {
    const int nblk = N / 64, kb = item / nblk, nb = item % nblk, k0 = 64 * kb, n0 = 64 * nb;
    const int lr = lane >> 4, lc = (lane & 15) * 4;
    const GAS f32x4* src = (const GAS f32x4*)(W + (size_t)(k0 + lr) * N + n0 + lc);
    f32x4 v[16];
#pragma unroll
    for (int i = 0; i < 16; ++i) v[i] = src[(size_t)i * N];
#pragma unroll
    for (int i = 0; i < 16; ++i) { LAS float* d = scr + (4 * i + lr) * 65 + lc; d[0] = v[i].x; d[1] = v[i].y; d[2] = v[i].z; d[3] = v[i].w; }
    LDS_WAIT(); asm volatile("" ::: "memory");
    const int c = lane & 7;
#pragma unroll
    for (int j = 0; j < 8; ++j) { const int n = (lane >> 3) + 8 * j; const LAS float* q = scr + (8 * c) * 65 + n;
        u32x4 o; o.x = pk2(q[0 * 65], q[1 * 65]); o.y = pk2(q[2 * 65], q[3 * 65]); o.z = pk2(q[4 * 65], q[5 * 65]); o.w = pk2(q[6 * 65], q[7 * 65]);
        *(GAS u32x4*)(WT + (size_t)(n0 + n) * K + k0 + 8 * c) = o; }
    LDS_WAIT(); asm volatile("" ::: "memory");
}
__device__ __forceinline__ void rms_rows4_to_bf16(const float* xrow, const float* g, bf16* orow, int lane) {
    const GAS f32x4* xr = (const GAS f32x4*)xrow + lane; const GAS f32x4* gr = (const GAS f32x4*)g + lane;
    f32x4 v[4][4];
#pragma unroll
    for (int r = 0; r < 4; ++r)
#pragma unroll
        for (int j = 0; j < 4; ++j) v[r][j] = xr[256 * r + 64 * j];
    f32x4 gg[4];
#pragma unroll
    for (int j = 0; j < 4; ++j) gg[j] = gr[64 * j];
    GAS unsigned long long* o8 = (GAS unsigned long long*)orow + lane;
#pragma unroll
    for (int r = 0; r < 4; ++r) { float s = 0.f;
#pragma unroll
        for (int j = 0; j < 4; ++j) s += (v[r][j].x * v[r][j].x + v[r][j].y * v[r][j].y) + (v[r][j].z * v[r][j].z + v[r][j].w * v[r][j].w);
        const float rs = 1.0f / sqrtf(wave_sum(s) * (1.f / DM) + EPS);
#pragma unroll
        for (int j = 0; j < 4; ++j)
            o8[256 * r + 64 * j] = (unsigned long long)pk2(v[r][j].x * rs * gg[j].x, v[r][j].y * rs * gg[j].y) | ((unsigned long long)pk2(v[r][j].z * rs * gg[j].z, v[r][j].w * rs * gg[j].w) << 32); }
}

__device__ __forceinline__ const float* in_ptr(int k) {
    typedef __attribute__((address_space(4))) const char* cptr4;
    cptr4 ka = (cptr4)__builtin_amdgcn_kernarg_segment_ptr(); cptr4 kb;
    asm volatile("s_mov_b64 %0, %1" : "=s"(kb) : "s"(ka));
    typedef const float* cfp; typedef __attribute__((address_space(4))) const cfp* cfp4;
    return *(cfp4)(kb + k * 8);
}
constexpr int NWAVES = 8;
constexpr int RING_BYTES = 131072, LDS_BYTES = 163840, LDSCTL_OFF = LDS_BYTES - 1024, MISC_OFF = LDSCTL_OFF + 320;
struct Args { const float* in[14]; float* out; unsigned char* ws; int ph_lo, ph_hi, li, pad; };
constexpr int N_PHASES = 10;

__global__ void __launch_bounds__(NWAVES * 64, 2) mk_fwd(Args args) {
    extern __shared__ __attribute__((aligned(16))) unsigned char lds_raw[];
    LAS unsigned char* lds = (LAS unsigned char*)lds_raw;
    volatile LAS unsigned* MISC = (volatile LAS unsigned*)(lds + MISC_OFF);
    const int tid = threadIdx.x, lane_k = tid & 63, wave = __builtin_amdgcn_readfirstlane(tid >> 6);
    const int G = gridDim.x, bx = blockIdx.x; const int vcu = (G % 8 == 0) ? (bx % 8) * (G / 8) + bx / 8 : bx;
    unsigned char* const ws_k = (unsigned char*)in_ptr(15);
    unsigned* ctl = (unsigned*)(ws_k + WS_CTL);
    for (int u = tid; u < (LDS_BYTES - LDSCTL_OFF) / 4; u += NWAVES * 64) ((LAS unsigned*)(lds + LDSCTL_OFF))[u] = 0u;
    __syncthreads();
    const int lo = args.ph_lo, hi = args.ph_hi;
    XcdBarrier bar; bar.bar = ctl + CW_BAR + args.li * XCD_BAR_WORDS; bar.x = 0; bar.st = nullptr;
    if (hi - lo > 1) bar = xcd_barrier_post(ctl + CW_BAR + args.li * XCD_BAR_WORDS, MISC + 8);
#define IN(k) (lo <= (k) && (k) < hi)
#define SEAM(k) do { if (IN(k) && IN((k) + 1)) xcd_barrier(bar); } while (0)

    if (IN(0)) {
        unsigned char* const ws = ws_k; int lane = lane_k; asm volatile("" : "+v"(lane));
        LAS float* scr = (LAS float*)(lds + wave * P0_SCR_BYTES);
        const int gw = vcu * NWAVES + wave, NGW = G * NWAVES;
        constexpr int I_IN = (DM / 64) * (NIN / 64), I_SQ = (DM / 64) * (DM / 64);
        for (int it = gw; it < 2 * I_IN + 6 * I_SQ; it += NGW) {
            int r = it;
            if (r < 2 * I_IN) { const int l = r / I_IN; p0_transpose_item(in_ptr(2) + (size_t)l * DM * NIN, DM, NIN, (bf16*)(ws + (l == 0 ? WS_WIN0 : WS_WIN)), scr, r % I_IN, lane); continue; } r -= 2 * I_IN;
            const int which = r / I_SQ, item = r % I_SQ, l = which / 3, w = which % 3;
            const float* src = (w == 0 ? in_ptr(4) : w == 1 ? in_ptr(12) : in_ptr(13)) + (size_t)l * DM * DM;
            bf16* dst = (bf16*)(ws + (l == 0 ? WS_WRO : WS_W1) + (size_t)w * 2 * MiB);
            p0_transpose_item(src, DM, DM, dst, scr, item, lane);
        }
        const float* x0 = in_ptr(0); const float* g0 = in_ptr(1); bf16* H = (bf16*)in_ptr(14);
        for (int m = 4 * gw; m < T; m += 4 * NGW) rms_rows4_to_bf16(x0 + (size_t)m * DM, g0, H + (size_t)m * DM, lane);
        LDS_WAIT(); __syncthreads();
    }
    SEAM(0);

#pragma unroll 1
    for (int l = 0; l < DEPTH; ++l) {
        const int pb = 1 + 5 * l;
        if (IN(pb)) {
            unsigned char* const ws = ws_k;
            Epi<0> E; E.ws = ws; E.xin = nullptr; E.xout = nullptr; E.gq = in_ptr(5) + l * 64; E.gk = in_ptr(6) + l * 64;
            SchedG1A S{l == 0 ? (const char*)in_ptr(14) : (const char*)(ws + WS_H), (const char*)(ws + (l == 0 ? WS_WIN0 : WS_WIN)), G, bx};
            pg8::gemm_phase<Epi<0>, SchedG1A, true, true>(lds, DM, S, E);
        }
        SEAM(pb);
        if (IN(pb + 1)) {
            unsigned char* const ws = ws_k;
            float s1 = 0.f, s2 = 0.f; { const float* q1 = in_ptr(7) + l * 64; const float* k1 = in_ptr(8) + l * 64; const float* q2 = in_ptr(9) + l * 64; const float* k2 = in_ptr(10) + l * 64;
                for (int i = 0; i < 64; ++i) { s1 += q1[i] * k1[i]; s2 += q2[i] * k2[i]; } }
            const float lam_init = 0.8f - 0.6f * __expf(-0.3f * (float)l), lam = __expf(s1) - __expf(s2) + lam_init;
            const float* gsub = in_ptr(11) + l * 1024;
            float gqm = 0.f, gkm = 0.f; { const float* gq = in_ptr(5) + l * 64; const float* gk = in_ptr(6) + l * 64; for (int i = 0; i < 64; ++i) { gqm = fmaxf(gqm, fabsf(gq[i])); gkm = fmaxf(gkm, fabsf(gk[i])); } }
            const float Bnd = 1.02f * 8.0f * LOG2E * gqm * gkm;
            const float* gret = in_ptr(3) + l * 1024;
            unsigned* qbase = ctl + CW_QUEUE + 512 * l;
            int lst = (int)(xb_xcc_id() & 7u), tried = 0;
            unsigned pf_raw = 0u; bool have = false;
            auto fetch = [&](unsigned& it) { it = 0xffffffffu;
                while (tried < 8) { it = __hip_atomic_fetch_add(qbase + 32 * lst, 1u, __ATOMIC_RELAXED, __HIP_MEMORY_SCOPE_AGENT); if (it < (unsigned)MIX_LIST_ITEMS) break; it = 0xffffffffu; lst = (lst + 1) & 7; ++tried; } };
            auto hook = [&]() { if (tid == 0 && tried < 8) { pf_raw = __hip_atomic_fetch_add(qbase + 32 * lst, 1u, __ATOMIC_RELAXED, __HIP_MEMORY_SCOPE_AGENT); have = true; } };
            for (;;) {
                if (tid == 0) {
                    unsigned it;
                    if (have) { have = false; it = pf_raw; if (it >= (unsigned)MIX_LIST_ITEMS) { lst = (lst + 1) & 7; ++tried; fetch(it); } } else fetch(it);
                    MISC[16] = it; MISC[17] = (unsigned)lst;
                }
                __syncthreads();
                const unsigned item = MISC[16]; const int li_ = (int)MISC[17];
                __syncthreads();
                if (item == 0xffffffffu) break;
                const int bb = li_ >> 1; const unsigned htab = (li_ & 1) ? 0x0156u : 0x2347u;
                if (item < 16u) { const int hh = (int)((htab >> (4 * (item & 3u))) & 7u), qt = 3 - (int)(item >> 2); ret::ret_unit(lds, ws, bb, hh, gret, 8 * qt, 8 * qt + 8); }
                else { const unsigned a_ = item - 16u; const int hh = (int)((htab >> (4 * (a_ >> 5))) & 7u), qb = 31 - (int)(a_ & 31u);
                    const float wf = (2.0f * Bnd + 28.0f) / (__builtin_amdgcn_exp2f(-(float)(hh + 1)) * LOG2E);
                    att::attn_unit(lds, ws, bb, hh, qb, lam, 1.0f - lam_init, gsub, wf < 8192.f ? (int)wf + 1 : 8192, hook); }
            }
        }
        SEAM(pb + 1);
        if (IN(pb + 2)) {
            unsigned char* const ws = ws_k;
            Epi<1> E; E.ws = ws; E.xin = nullptr; E.xout = nullptr; E.gq = nullptr; E.gk = nullptr;
            SchedP34 S{(const char*)ws, (const char*)(ws + (l == 0 ? WS_WRO : WS_W1)), l == 0 ? (const char*)in_ptr(14) : (const char*)(ws + WS_H), (const char*)(ws + (l == 0 ? WS_WIN0 : WS_WIN)), bx};
            pg8::gemm_phase<Epi<1>, SchedP34, true, true>(lds, DM, S, E);
        }
        SEAM(pb + 2);
        if (IN(pb + 3)) {
            unsigned char* const ws = ws_k;
            Epi<2> E; E.ws = ws; E.xin = (l == 0) ? in_ptr(0) : (const float*)in_ptr(14); E.xout = (float*)in_ptr(14); E.gq = nullptr; E.gk = nullptr;
            SchedG4 S{(const char*)(ws + WS_MBF), (const char*)(ws + (l == 0 ? WS_WRO : WS_W1) + 4 * MiB), bx};
            pg8::gemm_phase<Epi<2>, SchedG4, false, true>(lds, DM, S, E);
        }
        SEAM(pb + 3);
        if (l == 0) {
            if (IN(5)) {
                unsigned char* const ws = ws_k; int lane = lane_k; asm volatile("" : "+v"(lane));
                bf16* H = (bf16*)(ws + WS_H);
                const int gw = vcu * NWAVES + wave, NGW = G * NWAVES;
                const float* x1 = in_ptr(14); const float* g1 = in_ptr(1) + DM;
                for (int m = 4 * gw; m < T; m += 4 * NGW) rms_rows4_to_bf16(x1 + (size_t)m * DM, g1, H + (size_t)m * DM, lane);
                __syncthreads();
            }
            SEAM(5);
        }
    }
#undef IN
#undef SEAM
}

extern "C" void kernel_launch(void* const* d_in, const int* in_sizes, int n_in, void* d_out, int out_size, void* d_ws, size_t ws_size, hipStream_t stream) {
    static int ready = 0;
    if (ready == 0) {
        if (n_in != 14 || ws_size < WS_END || out_size != T * DM) { fprintf(stderr, "kernel_launch: unexpected problem (n_in %d, ws %zu, out %d)\n", n_in, ws_size, out_size); ready = -1; return; }
        if (hipFuncSetAttribute((const void*)mk_fwd, hipFuncAttributeMaxDynamicSharedMemorySize, LDS_BYTES) != hipSuccess) { fprintf(stderr, "kernel_launch: hipFuncSetAttribute failed\n"); ready = -1; return; }
        ready = 1;
    }
    if (ready < 0) return;
    (void)hipMemsetAsync((char*)d_ws + WS_CTL, 0, CTL_ZERO_BYTES, stream);
    Args a{};
    for (int i = 0; i < 14; ++i) a.in[i] = (const float*)d_in[i];
    a.out = (float*)d_out; a.ws = (unsigned char*)d_ws;
    a.ph_lo = 0; a.ph_hi = N_PHASES; a.li = 0;
    hipLaunchKernelGGL(mk_fwd, dim3(256), dim3(NWAVES * 64), LDS_BYTES, stream, a);
}
```

```cpp
#include <hip/hip_runtime.h>
#include <cstdio>
#include <cstdint>
#include <cstddef>

constexpr int DM = 1024, BATCH = 4, SEQ = 4096, DEPTH = 2, T = BATCH * SEQ, NIN = 9216;
constexpr float EPS = 1e-6f;
constexpr float LOG2E = 1.4426950408889634f;

typedef unsigned short bf16;
typedef short bf16x8 __attribute__((ext_vector_type(8)));
typedef float f32x4 __attribute__((ext_vector_type(4)));
typedef unsigned u32x4 __attribute__((ext_vector_type(4)));
#define LAS __attribute__((address_space(3)))
#define GAS __attribute__((address_space(1)))

__device__ __forceinline__ float bf2f(bf16 v) { return __uint_as_float(((unsigned)v) << 16); }
__device__ __forceinline__ unsigned f2bf_u(float f) { unsigned u = __float_as_uint(f); return (u + 0x7fffu + ((u >> 16) & 1u)) >> 16; }
__device__ __forceinline__ bf16 f2bf(float f) { return (bf16)f2bf_u(f); }
__device__ __forceinline__ unsigned pk2(float lo, float hi) { return f2bf_u(lo) | (f2bf_u(hi) << 16); }
typedef float f32x2_t __attribute__((ext_vector_type(2))); typedef __bf16 bf16x2_t __attribute__((ext_vector_type(2)));
__device__ __forceinline__ unsigned cvt_pk_bf16(float lo, float hi) { f32x2_t v = {lo, hi}; bf16x2_t b = __builtin_convertvector(v, bf16x2_t); return __builtin_bit_cast(unsigned, b); }
__device__ __forceinline__ float fast_sigmoid(float v) { return __builtin_amdgcn_rcpf(1.0f + __builtin_amdgcn_exp2f(-v * LOG2E)); }
__device__ __forceinline__ float lo_bf(unsigned w) { return __uint_as_float(w << 16); }
__device__ __forceinline__ float hi_bf(unsigned w) { return __uint_as_float(w & 0xffff0000u); }

constexpr size_t MiB = 1u << 20;
constexpr size_t WS_CTL = 0, CTL_ZERO_BYTES = 64 * 1024;
constexpr size_t WS_WIN = 1 * MiB, WS_WRO = 19 * MiB, WS_WDO = 21 * MiB, WS_WOUT = 23 * MiB;
constexpr size_t WS_H = 25 * MiB, WS_QR = 57 * MiB, WS_KR = 73 * MiB, WS_VR = 89 * MiB, WS_SGR = 121 * MiB, WS_QD = 153 * MiB, WS_KD = 185 * MiB,
                 WS_VD = 217 * MiB, WS_SGD = 249 * MiB;
constexpr size_t WS_WIN0 = WS_H;
constexpr size_t WS_W1 = 281 * MiB;
constexpr size_t WS_END = 287 * MiB;
constexpr size_t WS_MBUF = 57 * MiB;
constexpr size_t WS_MBF = WS_VD;
constexpr size_t WS_SMGR = WS_QD, WS_SMGD = WS_KD;
constexpr int CW_BAR = 4096;

namespace pg8 {
constexpr int BM = 256, BK = 64, HALF = 128, HTB = HALF * BK * 2, STAGE_BYTES = 8 * HTB, NXCD = 8, WGM = 8;
__host__ __device__ __forceinline__ int lds_byte(int r, int c) { const int st = (r >> 4) * 2 + (c >> 5), rr = r & 15, cc = c & 31, ob = rr * 64 + cc * 2; return st * 1024 + (ob ^ (((ob >> 9) & 1) << 5)); }
__host__ __device__ __forceinline__ void stage_rc(int b, int& R, int& C) { const int st = b / 1024, sb = b % 1024, swz = sb ^ (((sb >> 9) & 1) << 5); R = (st >> 1) * 16 + swz / 64; C = (st & 1) * 32 + (swz % 64) / 2; }
__host__ __device__ __forceinline__ int perm32(int rho) { const int n = rho >> 4, i = rho & 15; return 8 * (i >> 2) + 4 * n + (i & 3); }

struct Unit { int pm, pn, kind; const char* a; const char* b; };

__device__ __forceinline__ void tile_of(int L, int nM, int nN, int& pm, int& pn) {
    const int nwg = nM * nN; int wgid = L;
    { const int q = nwg / NXCD, r = nwg % NXCD, xcd = wgid % NXCD, off = wgid / NXCD; wgid = (xcd < r ? xcd * (q + 1) : r * (q + 1) + (xcd - r) * q) + off; }
    const int nig = WGM * nN, gid = wgid / nig, fm = gid * WGM, gsz = (nM - fm) < WGM ? (nM - fm) : WGM;
    pm = fm + ((wgid % nig) % gsz); pn = (wgid % nig) / gsz;
}

template <class Epi, class Sched, bool ALIGN_EPI, bool SP2>
__device__ __forceinline__ void gemm_phase(LAS unsigned char* lds, const int K, const Sched& S, const Epi& E) {
    int tid_ = threadIdx.x; asm volatile("" : "+v"(tid_));
    const int tid = tid_, wid = __builtin_amdgcn_readfirstlane(tid >> 6), lane = tid & 63, wr = wid >> 2, wc = wid & 3, fr = lane & 15, fq = lane >> 4;
    const int nt = K / BK;
    unsigned voffA[2], voffB[2];
#pragma unroll
    for (int i = 0; i < 2; ++i) { int R, C; stage_rc(tid * 16 + i * 8192, R, C); const int Rb = (R >> 5) * 64 + perm32(R & 31);
        voffA[i] = (unsigned)(R * K + C) * 2u; voffB[i] = (unsigned)(Rb * K + C) * 2u; }
    const size_t kstep = (size_t)(BK * 2);
    const size_t hstep = (size_t)HALF * K * 2;
    const size_t hstepB = (size_t)32 * K * 2;
    const unsigned ldsw = (unsigned)wid * 1024u;
    const int aoff = lds_byte(wr * 64 + fr, fq * 8), boff = lds_byte(wc * 32 + fr, fq * 8);
#define PG8_SA(b, h) (((b) * 2 + (h)) * HTB)
#define PG8_SB(b, h) ((4 + (b) * 2 + (h)) * HTB)
#define PG8_STAGE(bufoff, gbase, voff) do { _Pragma("unroll") for (int _i = 0; _i < 2; ++_i) \
        __builtin_amdgcn_global_load_lds((const unsigned*)((const char*)(gbase) + (voff)[_i]), (LAS unsigned*)(lds + (bufoff) + ldsw + _i * 8192), 16, 0, 0); } while (0)
#define PG8_LDA(dst, b, h) do { _Pragma("unroll") for (int m = 0; m < 4; ++m) _Pragma("unroll") for (int k = 0; k < 2; ++k) dst[m][k] = *(const LAS bf16x8*)(lds + PG8_SA(b, h) + aoff + m * 2048 + k * 1024); } while (0)
#define PG8_LDB(dst, b, h) do { _Pragma("unroll") for (int n = 0; n < 2; ++n) _Pragma("unroll") for (int k = 0; k < 2; ++k) dst[n][k] = *(const LAS bf16x8*)(lds + PG8_SB(b, h) + boff + n * 2048 + k * 1024); } while (0)
#define PG8_MMA(ai, bj, At, Bt) do { __builtin_amdgcn_s_setprio(1); _Pragma("unroll") for (int m = 0; m < 4; ++m) _Pragma("unroll") for (int n = 0; n < 2; ++n) _Pragma("unroll") for (int k = 0; k < 2; ++k) \
        acc[ai][bj][m][n] = __builtin_amdgcn_mfma_f32_16x16x32_bf16(Bt[n][k], At[m][k], acc[ai][bj][m][n], 0, 0, 0); __builtin_amdgcn_s_setprio(0); } while (0)
#define PG8_WAIT_V(n) asm volatile("s_waitcnt vmcnt(" #n ")" ::: "memory")
#define PG8_WAIT_L(n) asm volatile("s_waitcnt lgkmcnt(" #n ")" ::: "memory")
#define PG8_BAR __builtin_amdgcn_s_barrier()
#define PG8_SCHED __builtin_amdgcn_sched_barrier(0)
    Unit cur, nxt; int ui = 0;
    if (!S.next(0, cur)) return;
    f32x4 acc[2][2][4][2];
#pragma unroll
    for (int a = 0; a < 2; ++a)
#pragma unroll
        for (int b = 0; b < 2; ++b)
#pragma unroll
            for (int m = 0; m < 4; ++m)
#pragma unroll
                for (int n = 0; n < 2; ++n) acc[a][b][m][n] = (f32x4){0.f, 0.f, 0.f, 0.f};
    bf16x8 At[4][2], B0[2][2], B1[2][2];
    const char* cA = cur.a; const char* cB = cur.b;
    if constexpr (SP2) {
        PG8_STAGE(PG8_SB(0, 0), cB, voffB); PG8_STAGE(PG8_SB(0, 1), cB + hstepB, voffB); PG8_STAGE(PG8_SA(0, 0), cA, voffA); PG8_STAGE(PG8_SA(0, 1), cA + hstep, voffA);
        if (wr == 1) PG8_BAR;
        PG8_WAIT_V(2); PG8_BAR;
        PG8_STAGE(PG8_SB(1, 0), cB + kstep, voffB); PG8_STAGE(PG8_SA(1, 0), cA + kstep, voffA); PG8_STAGE(PG8_SB(1, 1), cB + hstepB + kstep, voffB);
        PG8_WAIT_V(6); PG8_BAR;
    } else {
        PG8_STAGE(PG8_SB(0, 0), cB, voffB); PG8_STAGE(PG8_SA(0, 0), cA, voffA); PG8_STAGE(PG8_SB(0, 1), cB + hstepB, voffB); PG8_STAGE(PG8_SA(0, 1), cA + hstep, voffA);
        if (wr == 1) PG8_BAR;
        PG8_WAIT_V(4); PG8_BAR;
        PG8_STAGE(PG8_SB(1, 0), cB + kstep, voffB); PG8_STAGE(PG8_SA(1, 0), cA + kstep, voffA); PG8_STAGE(PG8_SB(1, 1), cB + hstepB + kstep, voffB);
        PG8_WAIT_V(6); PG8_BAR;
    }
    for (;;) {
        const bool has_next = S.next(ui + 1, nxt);
        const char* nA = has_next ? nxt.a : cA; const char* nB = has_next ? nxt.b : cB;
        for (int t = 0; t < nt; t += 2) {
            const bool last = (t == nt - 2);
            const char* a1 = cA + (size_t)(t + 1) * kstep;
            const char* a2 = last ? nA : cA + (size_t)(t + 2) * kstep; const char* b2 = last ? nB : cB + (size_t)(t + 2) * kstep;
            const char* a3 = a2 + kstep; const char* b3 = b2 + kstep;
            if constexpr (SP2) {
            PG8_LDB(B0, 0, 0); PG8_LDB(B1, 0, 1); PG8_SCHED; PG8_LDA(At, 0, 0); PG8_STAGE(PG8_SA(1, 1), a1 + hstep, voffA);
            PG8_WAIT_V(8); PG8_WAIT_L(0); PG8_BAR; PG8_MMA(0, 0, At, B0); PG8_MMA(0, 1, At, B1); PG8_BAR; PG8_SCHED;
            PG8_LDA(At, 0, 1); PG8_STAGE(PG8_SB(0, 0), b2, voffB); PG8_STAGE(PG8_SB(0, 1), b2 + hstepB, voffB); PG8_STAGE(PG8_SA(0, 0), a2, voffA);
            PG8_WAIT_V(8); PG8_WAIT_L(0); PG8_BAR; PG8_MMA(1, 0, At, B0); PG8_MMA(1, 1, At, B1); PG8_BAR; PG8_SCHED;
            PG8_LDB(B0, 1, 0); PG8_LDB(B1, 1, 1); PG8_SCHED; PG8_LDA(At, 1, 0); PG8_STAGE(PG8_SA(0, 1), a2 + hstep, voffA);
            PG8_WAIT_V(8); PG8_WAIT_L(0); PG8_BAR; PG8_MMA(0, 0, At, B0); PG8_MMA(0, 1, At, B1); PG8_BAR; PG8_SCHED;
            PG8_LDA(At, 1, 1); PG8_STAGE(PG8_SB(1, 0), b3, voffB); PG8_STAGE(PG8_SB(1, 1), b3 + hstepB, voffB); PG8_STAGE(PG8_SA(1, 0), a3, voffA);
            PG8_WAIT_V(8); PG8_WAIT_L(0); PG8_BAR; PG8_MMA(1, 0, At, B0); PG8_MMA(1, 1, At, B1); PG8_BAR; PG8_SCHED;
            } else {
            PG8_LDB(B0, 0, 0); PG8_SCHED; PG8_LDA(At, 0, 0); PG8_STAGE(PG8_SA(1, 1), a1 + hstep, voffA);
            PG8_WAIT_L(8); PG8_BAR; PG8_WAIT_L(0); PG8_MMA(0, 0, At, B0); PG8_BAR; PG8_SCHED;
            PG8_LDB(B1, 0, 1); PG8_STAGE(PG8_SB(0, 0), b2, voffB);
            PG8_BAR; PG8_WAIT_L(0); PG8_MMA(0, 1, At, B1); PG8_BAR;
            PG8_LDA(At, 0, 1); PG8_STAGE(PG8_SA(0, 0), a2, voffA);
            PG8_BAR; PG8_WAIT_L(0); PG8_MMA(1, 0, At, B0); PG8_BAR; PG8_SCHED;
            PG8_STAGE(PG8_SB(0, 1), b2 + hstepB, voffB);
            PG8_WAIT_V(6); PG8_BAR; PG8_MMA(1, 1, At, B1); PG8_BAR;
            PG8_LDB(B0, 1, 0); PG8_SCHED; PG8_LDA(At, 1, 0); PG8_STAGE(PG8_SA(0, 1), a2 + hstep, voffA);
            PG8_WAIT_L(8); PG8_BAR; PG8_WAIT_L(0); PG8_MMA(0, 0, At, B0); PG8_BAR; PG8_SCHED;
            PG8_LDB(B1, 1, 1); PG8_STAGE(PG8_SB(1, 0), b3, voffB);
            PG8_BAR; PG8_WAIT_L(0); PG8_MMA(0, 1, At, B1); PG8_BAR;
            PG8_LDA(At, 1, 1); PG8_STAGE(PG8_SA(1, 0), a3, voffA);
            PG8_BAR; PG8_WAIT_L(0); PG8_MMA(1, 0, At, B0); PG8_BAR; PG8_SCHED;
            PG8_STAGE(PG8_SB(1, 1), b3 + hstepB, voffB);
            PG8_WAIT_V(6); PG8_BAR; PG8_MMA(1, 1, At, B1); PG8_BAR;
            }
        }
        if constexpr (ALIGN_EPI) { if (wr == 0) PG8_BAR; }
        E(acc, cur, wr, wc, fr, fq);
        if (!has_next) break;
#pragma unroll
        for (int a = 0; a < 2; ++a)
#pragma unroll
            for (int b = 0; b < 2; ++b)
#pragma unroll
                for (int m = 0; m < 4; ++m)
#pragma unroll
                    for (int n = 0; n < 2; ++n) acc[a][b][m][n] = (f32x4){0.f, 0.f, 0.f, 0.f};
        cur = nxt; cA = nA; cB = nB; ++ui;
        if constexpr (ALIGN_EPI) { if (wr == 1) PG8_BAR; }
    }
    PG8_WAIT_V(0);
    if constexpr (!ALIGN_EPI) { if (wr == 0) PG8_BAR; }
    PG8_BAR;
#undef PG8_SA
#undef PG8_SB
#undef PG8_STAGE
#undef PG8_LDA
#undef PG8_LDB
#undef PG8_MMA
#undef PG8_WAIT_V
#undef PG8_WAIT_L
#undef PG8_BAR
#undef PG8_SCHED
}
}

enum { K_QR = 0, K_KR, K_VR, K_SGR, K_QD, K_KD, K_VD, K_SGD, K_MGR, K_YR, K_MGD, K_YD, K_OUT };
constexpr size_t TSTEP = (size_t)256 * DM * 2;

template <int PC  > struct Epi {
    unsigned char* ws; const float* xin; float* xout; const float* gq; const float* gk;
    __device__ __forceinline__ static void st8(bf16* p, const f32x4 a, const f32x4 b) {
        u32x4 w; w.x = cvt_pk_bf16(a[0], a[1]); w.y = cvt_pk_bf16(a[2], a[3]); w.z = cvt_pk_bf16(b[0], b[1]); w.w = cvt_pk_bf16(b[2], b[3]); *(u32x4*)p = w; }
    __device__ __forceinline__ void operator()(const f32x4 (&acc)[2][2][4][2], const pg8::Unit& u, int wr, int wc, int fr, int fq) const {
        const int row0 = u.pm * 256 + wr * 64 + fr;
        const int cl = wc * 64 + 8 * fq;
        const int kind = u.kind;
        bf16* const qr = (bf16*)(ws + WS_QR); bf16* const kr = (bf16*)(ws + WS_KR); bf16* const vr = (bf16*)(ws + WS_VR); bf16* const sgr = (bf16*)(ws + WS_SGR);
        bf16* const qd = (bf16*)(ws + WS_QD); bf16* const kd = (bf16*)(ws + WS_KD); bf16* const vd = (bf16*)(ws + WS_VD); bf16* const sgd = (bf16*)(ws + WS_SGD);
        bf16* const smgr = (bf16*)(ws + WS_SMGR); bf16* const smgd = (bf16*)(ws + WS_SMGD); bf16* const mbf = (bf16*)(ws + WS_MBF); float* const mbuf = (float*)(ws + WS_MBUF);
        if (PC == 0 && (kind == K_VR || kind == K_VD)) {
            bf16* base = (kind == K_VR ? vr : vd) + u.pn * 256 + cl;
#pragma unroll
            for (int ai = 0; ai < 2; ++ai)
#pragma unroll
                for (int m = 0; m < 4; ++m) { bf16* rp = base + (size_t)(row0 + ai * 128 + m * 16) * 1024;
#pragma unroll
                    for (int bj = 0; bj < 2; ++bj) st8(rp + 32 * bj, acc[ai][bj][m][0], acc[ai][bj][m][1]); }
        } else if (PC == 0 && (kind == K_SGR || kind == K_SGD)) {
            bf16* base = (kind == K_SGR ? sgr : sgd) + u.pn * 256 + cl;
#pragma unroll
            for (int ai = 0; ai < 2; ++ai)
#pragma unroll
                for (int m = 0; m < 4; ++m) { bf16* rp = base + (size_t)(row0 + ai * 128 + m * 16) * 1024;
#pragma unroll
                    for (int bj = 0; bj < 2; ++bj) { f32x4 a = acc[ai][bj][m][0], b = acc[ai][bj][m][1];
#pragma unroll
                        for (int i = 0; i < 4; ++i) { a[i] = a[i] * fast_sigmoid(a[i]); b[i] = b[i] * fast_sigmoid(b[i]); }
                        st8(rp + 32 * bj, a, b); } }
        } else if (PC == 1 && (kind == K_MGR || kind == K_MGD)) {
            bf16* base = (kind == K_MGR ? smgr : smgd) + u.pn * 256 + cl;
#pragma unroll
            for (int ai = 0; ai < 2; ++ai)
#pragma unroll
                for (int m = 0; m < 4; ++m) { bf16* rp = base + (size_t)(row0 + ai * 128 + m * 16) * 1024;
#pragma unroll
                    for (int bj = 0; bj < 2; ++bj) { f32x4 a = acc[ai][bj][m][0], b = acc[ai][bj][m][1];
#pragma unroll
                        for (int i = 0; i < 4; ++i) { a[i] = fast_sigmoid(a[i]); b[i] = fast_sigmoid(b[i]); }
                        st8(rp + 32 * bj, a, b); } }
        } else if (PC == 0 && (kind == K_QR || kind == K_KR)) {
            const int h = u.pn * 4 + wc; const float lg = __log2f(1.0f - __builtin_amdgcn_exp2f(-5.0f - (float)h));
            bf16* base = (kind == K_QR ? qr : kr) + u.pn * 256 + cl;
            const float sgn = (kind == K_QR) ? lg : -lg, mul = (kind == K_QR) ? 1.0f : 0.125f;
#pragma unroll
            for (int ai = 0; ai < 2; ++ai)
#pragma unroll
                for (int m = 0; m < 4; ++m) { const int row = row0 + ai * 128 + m * 16; bf16* rp = base + (size_t)row * 512;
                    const float f = mul * __builtin_amdgcn_exp2f((float)(row & 127) * sgn);
#pragma unroll
                    for (int bj = 0; bj < 2; ++bj) st8(rp + 32 * bj, acc[ai][bj][m][0] * f, acc[ai][bj][m][1] * f); }
        } else if (PC == 0 && (kind == K_QD || kind == K_KD)) {
            const float* g = (kind == K_QD) ? gq : gk; const float mul = (kind == K_QD) ? 0.125f * LOG2E : 1.0f;
            bf16* base = (kind == K_QD ? qd : kd) + u.pn * 256 + cl;
            f32x4 gv[2][2];
#pragma unroll
            for (int bj = 0; bj < 2; ++bj)
#pragma unroll
                for (int n = 0; n < 2; ++n) gv[bj][n] = *(const f32x4*)(g + 32 * bj + 8 * fq + 4 * n) * mul;
#pragma unroll
            for (int ai = 0; ai < 2; ++ai)
#pragma unroll
                for (int m = 0; m < 4; ++m) { bf16* rp = base + (size_t)(row0 + ai * 128 + m * 16) * 1024;
                    float ss = 0.f;
#pragma unroll
                    for (int bj = 0; bj < 2; ++bj)
#pragma unroll
                        for (int n = 0; n < 2; ++n) { const f32x4 x = acc[ai][bj][m][n]; ss += (x[0] * x[0] + x[1] * x[1]) + (x[2] * x[2] + x[3] * x[3]); }
                    ss += __shfl_xor(ss, 16); ss += __shfl_xor(ss, 32);
                    const float rs = __builtin_amdgcn_rsqf(ss * (1.0f / 64.0f) + EPS);
#pragma unroll
                    for (int bj = 0; bj < 2; ++bj) st8(rp + 32 * bj, acc[ai][bj][m][0] * gv[bj][0] * rs, acc[ai][bj][m][1] * gv[bj][1] * rs); }
        } else if (PC == 1 && kind == K_YR) {
            bf16* const yrb = (bf16*)mbuf + (size_t)u.pn * 256 + cl;
#pragma unroll
            for (int ai = 0; ai < 2; ++ai)
#pragma unroll
                for (int m = 0; m < 4; ++m) { bf16* rp = yrb + (size_t)(row0 + ai * 128 + m * 16) * 1024;
#pragma unroll
                    for (int bj = 0; bj < 2; ++bj) st8(rp + 32 * bj, acc[ai][bj][m][0], acc[ai][bj][m][1]); }
        } else if (PC == 1 && kind == K_YD) {
            const size_t cb = (size_t)u.pn * 256 + cl; const bf16* const yrb = (const bf16*)mbuf;
#pragma unroll
            for (int ai = 0; ai < 2; ++ai)
#pragma unroll
            for (int mh = 0; mh < 2; ++mh) {
                u32x4 sr[2][2], sd[2][2], yr[2][2];
#pragma unroll
                for (int mm = 0; mm < 2; ++mm) { const size_t ro = (size_t)(row0 + ai * 128 + (2 * mh + mm) * 16) * 1024 + cb;
#pragma unroll
                    for (int bj = 0; bj < 2; ++bj) { sr[mm][bj] = *(const u32x4*)(smgr + ro + 32 * bj); sd[mm][bj] = *(const u32x4*)(smgd + ro + 32 * bj); yr[mm][bj] = *(const u32x4*)(yrb + ro + 32 * bj); } }
#pragma unroll
                for (int mm = 0; mm < 2; ++mm) { const int m = 2 * mh + mm; const size_t ro = (size_t)(row0 + ai * 128 + m * 16) * 1024 + cb;
#pragma unroll
                    for (int bj = 0; bj < 2; ++bj) { const u32x4 r_ = sr[mm][bj], d_ = sd[mm][bj], y_ = yr[mm][bj];
                        const f32x4 a = acc[ai][bj][m][0], b = acc[ai][bj][m][1];
                        f32x4 o0, o1;
                        o0[0] = lo_bf(r_.x) * lo_bf(y_.x) + lo_bf(d_.x) * a[0]; o0[1] = hi_bf(r_.x) * hi_bf(y_.x) + hi_bf(d_.x) * a[1];
                        o0[2] = lo_bf(r_.y) * lo_bf(y_.y) + lo_bf(d_.y) * a[2]; o0[3] = hi_bf(r_.y) * hi_bf(y_.y) + hi_bf(d_.y) * a[3];
                        o1[0] = lo_bf(r_.z) * lo_bf(y_.z) + lo_bf(d_.z) * b[0]; o1[1] = hi_bf(r_.z) * hi_bf(y_.z) + hi_bf(d_.z) * b[1];
                        o1[2] = lo_bf(r_.w) * lo_bf(y_.w) + lo_bf(d_.w) * b[2]; o1[3] = hi_bf(r_.w) * hi_bf(y_.w) + hi_bf(d_.w) * b[3];
                        st8(mbf + ro + 32 * bj, o0, o1); } }
                asm volatile("" ::: "memory");
            }
        } else if (PC == 2 && kind == K_OUT) {
            const size_t cb = (size_t)u.pn * 256 + cl;
#pragma unroll
            for (int ai = 0; ai < 2; ++ai) {
                f32x4 pre[4][2][2];
#pragma unroll
                for (int m = 0; m < 4; ++m) { const size_t ro = (size_t)(row0 + ai * 128 + m * 16) * 1024 + cb;
#pragma unroll
                    for (int bj = 0; bj < 2; ++bj) { pre[m][bj][0] = *(const f32x4*)(xin + ro + 32 * bj); pre[m][bj][1] = *(const f32x4*)(xin + ro + 32 * bj + 4); } }
#pragma unroll
                for (int m = 0; m < 4; ++m) { const size_t ro = (size_t)(row0 + ai * 128 + m * 16) * 1024 + cb;
#pragma unroll
                    for (int bj = 0; bj < 2; ++bj) { *(f32x4*)(xout + ro + 32 * bj) = pre[m][bj][0] + acc[ai][bj][m][0]; *(f32x4*)(xout + ro + 32 * bj + 4) = pre[m][bj][1] + acc[ai][bj][m][1]; } }
                asm volatile("" ::: "memory");
            }
        }
    }
};

struct SchedG1A {
    const char* A; const char* B; int G, c;
    __device__ __forceinline__ bool next(int i, pg8::Unit& u) const {
        const int L = i * G + c; if (L >= 64 * 28) return false;
        int pm, pg; pg8::tile_of(L, 64, 28, pm, pg);
        u.pm = pm; u.a = A + (size_t)pm * TSTEP; u.b = B + (size_t)pg * TSTEP;
        if (pg < 2) { u.kind = K_QR; u.pn = pg; } else if (pg < 4) { u.kind = K_KR; u.pn = pg - 2; } else if (pg < 8) { u.kind = K_VR; u.pn = pg - 4; } else if (pg < 12) { u.kind = K_SGR; u.pn = pg - 8; }
        else if (pg < 16) { u.kind = K_QD; u.pn = pg - 12; } else if (pg < 20) { u.kind = K_KD; u.pn = pg - 16; } else if (pg < 24) { u.kind = K_VD; u.pn = pg - 20; } else { u.kind = K_SGD; u.pn = pg - 24; }
        return true;
    }
};
struct SchedP34 {
    const char *ws, *Wro, *H, *Win; int c;
    __device__ __forceinline__ bool next(int i, pg8::Unit& u) const {
        if (i >= 4) return false;
        const char* OR = ws + WS_SGR; const char* OD = ws + WS_SGD; const char* Wdo = Wro + 2 * MiB;
        int pm, pn; pg8::tile_of(c, 64, 4, pm, pn); u.pm = pm; u.pn = pn;
        if (i == 0) { u.kind = K_MGR; u.a = H + (size_t)pm * TSTEP; u.b = Win + (size_t)(28 + pn) * TSTEP; }
        else if (i == 1) { u.kind = K_MGD; u.a = H + (size_t)pm * TSTEP; u.b = Win + (size_t)(32 + pn) * TSTEP; }
        else if (i == 2) { u.kind = K_YR; u.a = OR + (size_t)pm * TSTEP; u.b = Wro + (size_t)pn * TSTEP; }
        else { u.kind = K_YD; u.a = OD + (size_t)pm * TSTEP; u.b = Wdo + (size_t)pn * TSTEP; }
        return true;
    }
};
struct SchedG4 {
    const char *Mb, *Wout; int c;
    __device__ __forceinline__ bool next(int i, pg8::Unit& u) const {
        if (i >= 1) return false;
        int pm, pn; pg8::tile_of(c, 64, 4, pm, pn); u.pm = pm; u.pn = pn; u.kind = K_OUT; u.a = Mb + (size_t)pm * TSTEP; u.b = Wout + (size_t)pn * TSTEP; return true;
    }
};


namespace att {
typedef float f32x16 __attribute__((ext_vector_type(16)));
typedef short s16x4 __attribute__((ext_vector_type(4)));
typedef short v4i16_t __attribute__((ext_vector_type(4)));
constexpr int SLOT_OFF = 65536, SLOT_BYTES = 32768, V_OFF = 16384;
__device__ __forceinline__ int crow(int r, int hi) { return (r & 3) + 8 * (r >> 2) + 4 * hi; }
__device__ __forceinline__ s16x4 vtr(LAS const unsigned char* p) { return __builtin_bit_cast(s16x4, __builtin_amdgcn_ds_read_tr16_b64_v4i16((LAS v4i16_t*)p)); }
#define ATT_MFMA(a, b, c) __builtin_amdgcn_mfma_f32_32x32x16_bf16(a, b, c, 0, 0, 0)

template <class Hook> __device__ __forceinline__ void attn_unit(LAS unsigned char* lds, const unsigned char* ws, const int b, const int h, const int qb, const float lam, const float omli, const float* __restrict__ gsub, const int win, const Hook& after_tiles) {
    int tid_ = threadIdx.x; asm volatile("" : "+v"(tid_));
    const int tid = tid_, lane = tid & 63, r32 = lane & 31, hi = lane >> 5, w = __builtin_amdgcn_readfirstlane(tid >> 6), rg = w & 3, kg = w >> 2;
    const bf16* QD = (const bf16*)(ws + WS_QD); const bf16* KD = (const bf16*)(ws + WS_KD); const bf16* VD = (const bf16*)(ws + WS_VD); bf16* SGD = (bf16*)(ws + WS_SGD);
    const size_t tb = (size_t)b * SEQ; const int q0 = qb * 128, NT = (q0 + 128) / 64;
    const int T0 = (q0 > win ? q0 - win : 0) >> 6;
#pragma unroll
    for (int k = 0; k < 4; ++k) { const int p = 4 * kg + k; const bf16* src = QD + (tb + q0 + 32 * rg + r32) * 1024 + h * 128 + (p >> 2) * 64 + (p & 3) * 16 + hi * 8;
        __builtin_amdgcn_global_load_lds((const unsigned*)src, (LAS unsigned*)(lds + rg * 8192 + p * 1024), 16, 0, 0); }
    const bf16* ksrc = KD + (tb + lane) * 1024 + h * 128 + (w & 7) * 8;
    const bf16* vsrc = VD + (tb + 16 * (w & 3) + (lane >> 2)) * 1024 + h * 128 + (w >> 2) * 32 + (lane & 3) * 8;
#define ATT_STAGE(t, slot) do { _Pragma("unroll") for (int rr = 0; rr < 2; ++rr) { \
        __builtin_amdgcn_global_load_lds((const unsigned*)(ksrc + (size_t)(t) * 65536 + rr * 64), (LAS unsigned*)(lds + SLOT_OFF + (slot) * SLOT_BYTES + (rr * 8 + w) * 1024), 16, 0, 0); \
        __builtin_amdgcn_global_load_lds((const unsigned*)(vsrc + (size_t)(t) * 65536 + rr * 64), (LAS unsigned*)(lds + SLOT_OFF + (slot) * SLOT_BYTES + V_OFF + (rr * 8 + w) * 1024), 16, 0, 0); } } while (0)
    ATT_STAGE(T0, 0);
    __syncthreads();
    const float slope = __builtin_amdgcn_exp2f(-(float)(h + 1)) * LOG2E;
    const int n = q0 + 32 * rg + r32;
    f32x16 O[2][4];
#pragma unroll
    for (int j = 0; j < 2; ++j)
#pragma unroll
        for (int e = 0; e < 4; ++e)
#pragma unroll
            for (int r = 0; r < 16; ++r) O[j][e][r] = 0.f;
    float lsum[2] = {0.f, 0.f};
    const int qoff = rg * 8192 + lane * 16;
    const int koff = hi * 1024 + (32 * kg + r32) * 16;
    const int voff = V_OFF + 2 * kg * 1024 + ((lane >> 4) & 1) * 32 + (lane & 3) * 8 + (4 * hi + ((lane & 15) >> 2)) * 64;
    for (int t = T0; t < NT; ++t) {
        if (t + 1 < NT) ATT_STAGE(t + 1, (t + 1 - T0) & 1);
        const int k0 = t * 64 + 32 * kg;
        if (k0 <= q0 + 32 * rg + 31) {
            LAS const unsigned char* slot = lds + SLOT_OFF + ((t - T0) & 1) * SLOT_BYTES;
            float sl = slope; asm volatile("" : "+v"(sl));
            const int dn = n - k0 - 4 * hi; const float base = -sl * (float)dn;
            const bool diag = (k0 + 31 > q0 + 32 * rg);
            f32x16 pA, pB;
#pragma unroll
            for (int r = 0; r < 16; ++r) { const int kc = (r & 3) + 8 * (r >> 2); pA[r] = __builtin_fmaf(sl, (float)kc, base); }
            if (diag) {
#pragma unroll
                for (int r = 0; r < 16; ++r) { const int kc = (r & 3) + 8 * (r >> 2); if (kc > dn) pA[r] = -INFINITY; }
            }
            pB = pA;
#pragma unroll
            for (int d0 = 0; d0 < 4; ++d0) {
                const bf16x8 kfa = *(LAS const bf16x8*)(slot + koff + (2 * d0) * 1024), kfb = *(LAS const bf16x8*)(slot + koff + (8 + 2 * d0) * 1024);
                const bf16x8 qfa = *(LAS const bf16x8*)(lds + qoff + d0 * 1024), qfb = *(LAS const bf16x8*)(lds + qoff + (4 + d0) * 1024);
                pA = ATT_MFMA(kfa, qfa, pA); pB = ATT_MFMA(kfb, qfb, pB);
            }
            bf16x8 vf[4][2];
#pragma unroll
            for (int eb = 0; eb < 4; ++eb)
#pragma unroll
                for (int ks = 0; ks < 2; ++ks) { const s16x4 vlo = vtr(slot + voff + eb * 4096 + ks * 1024), vhi = vtr(slot + voff + eb * 4096 + ks * 1024 + 512);
                    vf[eb][ks] = (bf16x8){vlo[0], vlo[1], vlo[2], vlo[3], vhi[0], vhi[1], vhi[2], vhi[3]}; }
            u32x4 pwA[2], pwB[2];
            { float s = 0.f;
#pragma unroll
              for (int r = 0; r < 16; ++r) { pA[r] = __builtin_amdgcn_exp2f(pA[r]); s += pA[r]; }
              lsum[0] += s;
#pragma unroll
              for (int i = 0; i < 4; ++i) { pwA[0][i] = cvt_pk_bf16(pA[2 * i], pA[2 * i + 1]); pwA[1][i] = cvt_pk_bf16(pA[8 + 2 * i], pA[9 + 2 * i]); } }
            { float s = 0.f;
#pragma unroll
              for (int r = 0; r < 16; ++r) { pB[r] = __builtin_amdgcn_exp2f(pB[r]); s += pB[r]; }
              lsum[1] += s;
#pragma unroll
              for (int i = 0; i < 4; ++i) { pwB[0][i] = cvt_pk_bf16(pB[2 * i], pB[2 * i + 1]); pwB[1][i] = cvt_pk_bf16(pB[8 + 2 * i], pB[9 + 2 * i]); } }
#pragma unroll
            for (int eb = 0; eb < 4; ++eb)
#pragma unroll
                for (int ks = 0; ks < 2; ++ks) {
                    O[0][eb] = ATT_MFMA(vf[eb][ks], __builtin_bit_cast(bf16x8, pwA[ks]), O[0][eb]);
                    O[1][eb] = ATT_MFMA(vf[eb][ks], __builtin_bit_cast(bf16x8, pwB[ks]), O[1][eb]);
                }
        }
        __syncthreads();
    }
    after_tiles();
    lsum[0] += __shfl_xor(lsum[0], 32); lsum[1] += __shfl_xor(lsum[1], 32);
    LAS float* dump = (LAS float*)(lds + rg * 32768);
    LAS float* lx = (LAS float*)(lds + 131072 + rg * 1024);
    int r32e = r32; asm volatile("" : "+v"(r32e));
    bf16* rowp = SGD + (tb + q0 + 32 * rg + r32e) * 1024 + h * 128 + 4 * hi;
    const float* gp = gsub + h * 128 + 4 * hi;
    unsigned long long gt[4][4];
    if (kg == 1) {
#pragma unroll
        for (int j = 0; j < 2; ++j)
#pragma unroll
            for (int eb = 0; eb < 4; ++eb)
#pragma unroll
                for (int q = 0; q < 4; ++q) *(LAS f32x4*)(dump + (((j * 4 + eb) * 4 + q) * 64 + lane) * 4) = (f32x4){O[j][eb][4 * q], O[j][eb][4 * q + 1], O[j][eb][4 * q + 2], O[j][eb][4 * q + 3]};
        lx[lane] = lsum[0]; lx[64 + lane] = lsum[1];
    } else {
#pragma unroll
        for (int eb = 0; eb < 2; ++eb)
#pragma unroll
            for (int g = 0; g < 4; ++g) gt[eb][g] = *(const unsigned long long*)(rowp + 32 * eb + 8 * g);
    }
    asm volatile("s_waitcnt lgkmcnt(0)" ::: "memory"); __builtin_amdgcn_s_barrier(); asm volatile("" ::: "memory");
    if (kg == 0) {
#pragma unroll
        for (int j = 0; j < 2; ++j)
#pragma unroll
            for (int eb = 0; eb < 4; ++eb)
                {
#pragma unroll
                  for (int q = 0; q < 4; ++q) { const f32x4 v = *(LAS const f32x4*)(dump + (((j * 4 + eb) * 4 + q) * 64 + lane) * 4); O[j][eb][4 * q] += v[0]; O[j][eb][4 * q + 1] += v[1]; O[j][eb][4 * q + 2] += v[2]; O[j][eb][4 * q + 3] += v[3]; }
                  asm volatile("s_waitcnt lgkmcnt(0)" : "+v"(O[j][eb]) :: "memory"); }
        lsum[0] += lx[lane]; lsum[1] += lx[64 + lane];
        asm volatile("s_waitcnt lgkmcnt(0)" ::: "memory");
#pragma unroll
        for (int eb = 2; eb < 4; ++eb)
#pragma unroll
            for (int g = 0; g < 4; ++g) gt[eb][g] = *(const unsigned long long*)(rowp + 32 * eb + 8 * g);
        const float i0 = 1.0f / lsum[0], i1 = lam / lsum[1];
        float ss = 0.f;
#pragma unroll
        for (int eb = 0; eb < 4; ++eb)
#pragma unroll
            for (int r = 0; r < 16; ++r) { const float o = O[0][eb][r] * i0 - O[1][eb][r] * i1; O[0][eb][r] = o; ss += o * o; }
        ss += __shfl_xor(ss, 32);
        const float rs = __builtin_amdgcn_rsqf(ss * (1.0f / 128.0f) + EPS) * omli;
#pragma unroll
        for (int eb = 0; eb < 4; ++eb) {
            f32x4 gg[4];
#pragma unroll
            for (int g = 0; g < 4; ++g) gg[g] = *(const f32x4*)(gp + 32 * eb + 8 * g);
#pragma unroll
            for (int g = 0; g < 4; ++g) { const unsigned glo = (unsigned)gt[eb][g], ghi = (unsigned)(gt[eb][g] >> 32);
                const unsigned w0 = cvt_pk_bf16(O[0][eb][4 * g] * rs * gg[g][0] * lo_bf(glo), O[0][eb][4 * g + 1] * rs * gg[g][1] * hi_bf(glo));
                const unsigned w1 = cvt_pk_bf16(O[0][eb][4 * g + 2] * rs * gg[g][2] * lo_bf(ghi), O[0][eb][4 * g + 3] * rs * gg[g][3] * hi_bf(ghi));
                *(unsigned long long*)(rowp + 32 * eb + 8 * g) = (unsigned long long)w0 | ((unsigned long long)w1 << 32); }
        }
    }
    asm volatile("s_waitcnt lgkmcnt(0)" ::: "memory");
    __syncthreads();
#undef ATT_STAGE
}
}

namespace ret {
using att::f32x16; using att::s16x4; using att::crow; using att::vtr;
constexpr int SET = 49152, KT = 0, VI = 16384, OST = 98304, ST = 131072, RED = 147456;
__device__ __forceinline__ void ret_unit(LAS unsigned char* lds, const unsigned char* ws, const int b, const int h, const float* __restrict__ gn, const int c0, const int c1) {
    int tid_ = threadIdx.x; asm volatile("" : "+v"(tid_));
    const int tid = tid_, lane = tid & 63, r32 = lane & 31, hi = lane >> 5, w = __builtin_amdgcn_readfirstlane(tid >> 6);
    const int ib = w & 3, eh = w >> 2, dh = w & 1, ebo = w >> 1;
    const bf16* QR = (const bf16*)(ws + WS_QR); const bf16* KR = (const bf16*)(ws + WS_KR); const bf16* VR = (const bf16*)(ws + WS_VR); bf16* SGR = (bf16*)(ws + WS_SGR);
    const size_t tb = (size_t)b * SEQ;
    const float lg = __log2f(1.0f - __builtin_amdgcn_exp2f(-5.0f - (float)h)), gC = __builtin_amdgcn_exp2f(128.0f * lg);
    for (int i = tid; i < 16384 / 16; i += 512) *(LAS u32x4*)(lds + ST + i * 16) = (u32x4){0u, 0u, 0u, 0u};
    f32x16 sblk;
#pragma unroll
    for (int r = 0; r < 16; ++r) sblk[r] = 0.f;
    const int vpat = ((lane >> 4) & 1) * 32 + (lane & 3) * 8 + (4 * hi + ((lane & 15) >> 2)) * 64;
    const int prow = tid >> 4, pcol = (tid & 15) * 8;
    f32x4 gA = *(const f32x4*)(gn + h * 128 + pcol), gB = *(const f32x4*)(gn + h * 128 + pcol + 4);
#define RET_STAGE(c, s) do { const size_t t0_ = tb + (size_t)(c) * 128; LAS unsigned char* sb_ = lds + (s) * SET; \
        _Pragma("unroll") for (int k = 0; k < 2; ++k) { const int p = 2 * w + k, d2 = p >> 3, kg = p & 7; \
            __builtin_amdgcn_global_load_lds((const unsigned*)(KR + (t0_ + 16 * kg + (lane >> 2)) * 512 + h * 64 + d2 * 32 + (lane & 3) * 8), (LAS unsigned*)(sb_ + KT + p * 1024), 16, 0, 0); } \
        _Pragma("unroll") for (int k = 0; k < 4; ++k) { const int p = 4 * w + k, eg = p >> 3, kg = p & 7; \
            __builtin_amdgcn_global_load_lds((const unsigned*)(VR + (t0_ + 16 * kg + (lane >> 2)) * 1024 + h * 128 + eg * 32 + (lane & 3) * 8), (LAS unsigned*)(sb_ + VI + p * 1024), 16, 0, 0); } } while (0)
    if (c0 > 0) {
        RET_STAGE(0, 0);
        for (int c = 0; c < c0; ++c) {
            __syncthreads();
            if (c + 1 < c0) RET_STAGE(c + 1, (c + 1) & 1);
            LAS const unsigned char* sb = lds + (c & 1) * SET;
            f32x16 kv;
#pragma unroll
            for (int r = 0; r < 16; ++r) kv[r] = 0.f;
#pragma unroll
            for (int ks = 0; ks < 8; ++ks) { LAS const unsigned char* kp = sb + KT + dh * 8192 + ks * 1024 + vpat; LAS const unsigned char* vp = sb + VI + ebo * 8192 + ks * 1024 + vpat;
                const s16x4 klo = vtr(kp), khi = vtr(kp + 512), vlo = vtr(vp), vhi = vtr(vp + 512);
                kv = ATT_MFMA(((bf16x8){klo[0], klo[1], klo[2], klo[3], khi[0], khi[1], khi[2], khi[3]}), ((bf16x8){vlo[0], vlo[1], vlo[2], vlo[3], vhi[0], vhi[1], vhi[2], vhi[3]}), kv); }
#pragma unroll
            for (int r = 0; r < 16; ++r) sblk[r] = gC * (sblk[r] + kv[r]);
        }
        __syncthreads();
#pragma unroll
        for (int g = 0; g < 4; ++g) { unsigned long long v = (unsigned long long)cvt_pk_bf16(sblk[4 * g], sblk[4 * g + 1]) | ((unsigned long long)cvt_pk_bf16(sblk[4 * g + 2], sblk[4 * g + 3]) << 32);
            *(LAS unsigned long long*)(lds + ST + (32 * ebo + r32) * 128 + (32 * dh + 8 * g + 4 * hi) * 2) = v; }
    }
    RET_STAGE(c0, c0 & 1);
    bf16x8 qn[4];
#pragma unroll
    for (int d0 = 0; d0 < 4; ++d0) qn[d0] = *(const bf16x8*)(QR + (tb + (size_t)c0 * 128 + 32 * ib + r32) * 512 + h * 64 + d0 * 16 + hi * 8);
    for (int c = c0; c < c1; ++c) {
        const size_t t0 = tb + (size_t)c * 128;
        __syncthreads();
        LAS const unsigned char* sb = lds + (c & 1) * SET;
        u32x4 gt[4];
#pragma unroll
        for (int k = 0; k < 4; ++k) gt[k] = *(const u32x4*)(SGR + (t0 + prow + 32 * k) * 1024 + h * 128 + pcol);
        bf16x8 qf[4];
#pragma unroll
        for (int d0 = 0; d0 < 4; ++d0) qf[d0] = qn[d0];
        if (c + 1 < c1) { RET_STAGE(c + 1, (c + 1) & 1);
#pragma unroll
            for (int d0 = 0; d0 < 4; ++d0) qn[d0] = *(const bf16x8*)(QR + (t0 + 128 + 32 * ib + r32) * 512 + h * 64 + d0 * 16 + hi * 8); }
        f32x16 O[2];
#pragma unroll
        for (int eb = 0; eb < 2; ++eb)
#pragma unroll
            for (int r = 0; r < 16; ++r) O[eb][r] = 0.f;
#pragma unroll
        for (int jb = 0; jb < 4; ++jb) {
            if (jb <= ib) {
                f32x16 s;
#pragma unroll
                for (int r = 0; r < 16; ++r) s[r] = 0.f;
#pragma unroll
                for (int d0 = 0; d0 < 4; ++d0) { const bf16x8 kf = *(LAS const bf16x8*)(sb + KT + (d0 >> 1) * 8192 + (32 * jb + r32) * 64 + ((d0 & 1) * 16 + 8 * hi) * 2); s = ATT_MFMA(kf, qf[d0], s); }
                if (jb == ib) {
#pragma unroll
                    for (int r = 0; r < 16; ++r) if (crow(r, hi) > r32) s[r] = 0.f;
                }
                u32x4 pw[2];
#pragma unroll
                for (int i = 0; i < 4; ++i) { pw[0][i] = cvt_pk_bf16(s[2 * i], s[2 * i + 1]); pw[1][i] = cvt_pk_bf16(s[8 + 2 * i], s[9 + 2 * i]); }
#pragma unroll
                for (int eb = 0; eb < 2; ++eb)
#pragma unroll
                    for (int ks = 0; ks < 2; ++ks) { LAS const unsigned char* vp = sb + VI + (2 * eh + eb) * 8192 + (2 * jb + ks) * 1024 + vpat;
                        const s16x4 vlo = vtr(vp), vhi = vtr(vp + 512);
                        O[eb] = ATT_MFMA(((bf16x8){vlo[0], vlo[1], vlo[2], vlo[3], vhi[0], vhi[1], vhi[2], vhi[3]}), __builtin_bit_cast(bf16x8, pw[ks]), O[eb]); }
            }
        }
#pragma unroll
        for (int eb = 0; eb < 2; ++eb)
#pragma unroll
            for (int d0 = 0; d0 < 4; ++d0) { const bf16x8 sf = *(LAS const bf16x8*)(lds + ST + (32 * (2 * eh + eb) + r32) * 128 + (16 * d0 + 8 * hi) * 2); O[eb] = ATT_MFMA(sf, qf[d0], O[eb]); }
        { f32x16 kv;
#pragma unroll
          for (int r = 0; r < 16; ++r) kv[r] = 0.f;
#pragma unroll
          for (int ks = 0; ks < 8; ++ks) { LAS const unsigned char* kp = sb + KT + dh * 8192 + ks * 1024 + vpat; LAS const unsigned char* vp = sb + VI + ebo * 8192 + ks * 1024 + vpat;
              const s16x4 klo = vtr(kp), khi = vtr(kp + 512), vlo = vtr(vp), vhi = vtr(vp + 512);
              kv = ATT_MFMA(((bf16x8){klo[0], klo[1], klo[2], klo[3], khi[0], khi[1], khi[2], khi[3]}), ((bf16x8){vlo[0], vlo[1], vlo[2], vlo[3], vhi[0], vhi[1], vhi[2], vhi[3]}), kv); }
#pragma unroll
          for (int r = 0; r < 16; ++r) sblk[r] = gC * (sblk[r] + kv[r]); }
        { float s2 = 0.f;
#pragma unroll
          for (int eb = 0; eb < 2; ++eb)
#pragma unroll
              for (int r = 0; r < 16; ++r) s2 += O[eb][r] * O[eb][r];
          s2 += __shfl_xor(s2, 32);
          if (hi == 0) ((LAS float*)(lds + RED))[(32 * ib + r32) * 2 + eh] = s2; }
#pragma unroll
        for (int eb = 0; eb < 2; ++eb)
#pragma unroll
            for (int g = 0; g < 4; ++g) *(LAS unsigned long long*)(lds + OST + (32 * ib + r32) * 256 + (64 * eh + 32 * eb + 8 * g + 4 * hi) * 2) =
                (unsigned long long)cvt_pk_bf16(O[eb][4 * g], O[eb][4 * g + 1]) | ((unsigned long long)cvt_pk_bf16(O[eb][4 * g + 2], O[eb][4 * g + 3]) << 32);
        asm volatile("s_waitcnt lgkmcnt(0)" ::: "memory"); __builtin_amdgcn_s_barrier(); asm volatile("" ::: "memory");
#pragma unroll
        for (int g = 0; g < 4; ++g) { unsigned long long v = (unsigned long long)cvt_pk_bf16(sblk[4 * g], sblk[4 * g + 1]) | ((unsigned long long)cvt_pk_bf16(sblk[4 * g + 2], sblk[4 * g + 3]) << 32);
            *(LAS unsigned long long*)(lds + ST + (32 * ebo + r32) * 128 + (32 * dh + 8 * g + 4 * hi) * 2) = v; }
#pragma unroll
        for (int k = 0; k < 4; ++k) { const int row = prow + 32 * k; const LAS float* rp = (const LAS float*)(lds + RED) + row * 2;
            const float rs = __builtin_amdgcn_rsqf((rp[0] + rp[1]) * (1.0f / 128.0f) + EPS);
            const u32x4 ov = *(LAS const u32x4*)(lds + OST + row * 256 + pcol * 2); const u32x4 gg = gt[k];
            u32x4 res;
            res.x = cvt_pk_bf16(lo_bf(ov.x) * rs * gA[0] * lo_bf(gg.x), hi_bf(ov.x) * rs * gA[1] * hi_bf(gg.x));
            res.y = cvt_pk_bf16(lo_bf(ov.y) * rs * gA[2] * lo_bf(gg.y), hi_bf(ov.y) * rs * gA[3] * hi_bf(gg.y));
            res.z = cvt_pk_bf16(lo_bf(ov.z) * rs * gB[0] * lo_bf(gg.z), hi_bf(ov.z) * rs * gB[1] * hi_bf(gg.z));
            res.w = cvt_pk_bf16(lo_bf(ov.w) * rs * gB[2] * lo_bf(gg.w), hi_bf(ov.w) * rs * gB[3] * hi_bf(gg.w));
            *(u32x4*)(SGR + (t0 + row) * 1024 + h * 128 + pcol) = res; }
    }
    __syncthreads();
#undef RET_STAGE
}
}

constexpr int MIX_LIST_ITEMS = 16 + 4 * 32;
constexpr int CW_QUEUE = 2048;

#define XB_TMO      128
#define XB_XCNT(j)  (256  + 64 * (j))
#define XB_XSUB(j)  (1280 + 64 * (j))
#define XB_XGEN(j)  (2304 + 64 * (j))
#define XB_TOP      3328
#define XB_TOPGEN   3392
#define XCD_BAR_WORDS 3456
#define XB_SPIN_CAP (1u << 18)
__device__ __forceinline__ unsigned xb_ld(unsigned* p)              { return __hip_atomic_load(p, __ATOMIC_RELAXED, __HIP_MEMORY_SCOPE_AGENT); }
__device__ __forceinline__ unsigned xb_add(unsigned* p, unsigned v) { return __hip_atomic_fetch_add(p, v, __ATOMIC_RELAXED, __HIP_MEMORY_SCOPE_AGENT); }
__device__ __forceinline__ unsigned xb_xcc_id() { return (unsigned)__builtin_amdgcn_s_getreg((3 << 11) | 20) & 0xFu; }
#define XB_SPIN(cond, bar) do { unsigned _sp = 0; while (cond) { __builtin_amdgcn_s_sleep(1); \
    if ((++_sp & 255u) == 0u) { if (xb_ld(&(bar)[XB_TMO])) break; if (_sp > XB_SPIN_CAP) { atomicAdd(&(bar)[XB_TMO], 1u); break; } } } } while (0)
struct XcdBarrier { unsigned* bar; unsigned x; volatile LAS unsigned* st; };
__device__ __forceinline__ XcdBarrier xcd_barrier_post(unsigned* bar, volatile LAS unsigned* st) {
    XcdBarrier b; b.bar = bar; b.x = xb_xcc_id(); b.st = st;
    if (threadIdx.x == 0) (void)xb_add(&bar[XB_XCNT(b.x)], 1u);
    return b;
}
__device__ __forceinline__ void xcd_barrier_complete(unsigned* bar, unsigned x, unsigned& nloc, unsigned& nx) {
    const unsigned G = gridDim.x * gridDim.y * gridDim.z;
    unsigned sum, cnt, mine, sp = 0u;
    for (;;) {
        sum = 0u; cnt = 0u; mine = 0u;
#pragma unroll
        for (unsigned j = 0; j < 16; ++j) { const unsigned c = xb_ld(&bar[XB_XCNT(j)]); sum += c; cnt += (c > 0u) ? 1u : 0u; mine = (j == x) ? c : mine; }
        if (sum == G) break;
        __builtin_amdgcn_s_sleep(1);
        if ((++sp & 255u) == 0u) { if (xb_ld(&bar[XB_TMO])) break; if (sp > XB_SPIN_CAP) { atomicAdd(&bar[XB_TMO], 1u); break; } }
    }
    nloc = mine > 0u ? mine : 1u; nx = cnt > 0u ? cnt : 1u;
}
__device__ __forceinline__ void xcd_barrier(const XcdBarrier& b) {
    asm volatile("s_waitcnt vmcnt(0)" ::: "memory");
    __syncthreads();
    if (threadIdx.x == 0) {
        unsigned* bar = b.bar;
        __builtin_amdgcn_s_waitcnt(0);
        unsigned nloc = b.st[0], nx = b.st[1];
        if (nloc == 0u) { xcd_barrier_complete(bar, b.x, nloc, nx); b.st[0] = nloc; b.st[1] = nx; }
        const unsigned old = xb_add(&bar[XB_XSUB(b.x)], 1u);
        const unsigned gen = old / nloc;
        if (old + 1u == (gen + 1u) * nloc) {
            __builtin_amdgcn_fence(__ATOMIC_RELEASE, "agent");
            asm volatile("s_waitcnt vmcnt(0)" ::: "memory");
            const unsigned og = xb_add(&bar[XB_TOP], 1u);
            const unsigned tg = og / nx;
            if (og + 1u == (tg + 1u) * nx) xb_add(&bar[XB_TOPGEN], 1u);
            else XB_SPIN(xb_ld(&bar[XB_TOPGEN]) == tg, bar);
            __builtin_amdgcn_fence(__ATOMIC_ACQUIRE, "agent");
            xb_add(&bar[XB_XGEN(b.x)], 1u);
            asm volatile("s_waitcnt vmcnt(0)" ::: "memory");
        } else {
            XB_SPIN(xb_ld(&bar[XB_XGEN(b.x)]) == gen, bar);
            __builtin_amdgcn_fence(__ATOMIC_ACQUIRE, "agent");
            asm volatile("s_waitcnt vmcnt(0)" ::: "memory");
        }
    }
    __syncthreads();
}

#define LDS_WAIT() asm volatile("s_waitcnt lgkmcnt(0)" ::: "memory")
__device__ __forceinline__ float wave_sum(float v) {
#pragma unroll
    for (int o = 1; o < 64; o <<= 1) v += __shfl_xor(v, o);
    return v;
}
constexpr int P0_SCR_BYTES = 64 * 65 * 4;
__device__ __forceinline__ void p0_transpose_item(const float* W, int K, int N, bf16* WT, LAS float* scr, int item, int lane) {
    const int nblk = N / 64, kb = item / nblk, nb = item % nblk, k0 = 64 * kb, n0 = 64 * nb;
    const int lr = lane >> 4, lc = (lane & 15) * 4;
    const GAS f32x4* src = (const GAS f32x4*)(W + (size_t)(k0 + lr) * N + n0 + lc);
    f32x4 v[16];
#pragma unroll
    for (int i = 0; i < 16; ++i) v[i] = src[(size_t)i * N];
#pragma unroll
    for (int i = 0; i < 16; ++i) { LAS float* d = scr + (4 * i + lr) * 65 + lc; d[0] = v[i].x; d[1] = v[i].y; d[2] = v[i].z; d[3] = v[i].w; }
    LDS_WAIT(); asm volatile("" ::: "memory");
    const int c = lane & 7;
#pragma unroll
    for (int j = 0; j < 8; ++j) { const int n = (lane >> 3) + 8 * j; const LAS float* q = scr + (8 * c) * 65 + n;
        u32x4 o; o.x = pk2(q[0 * 65], q[1 * 65]); o.y = pk2(q[2 * 65], q[3 * 65]); o.z = pk2(q[4 * 65], q[5 * 65]); o.w = pk2(q[6 * 65], q[7 * 65]);
        *(GAS u32x4*)(WT + (size_t)(n0 + n) * K + k0 + 8 * c) = o; }
    LDS_WAIT(); asm volatile("" ::: "memory");
}
__device__ __forceinline__ void rms_rows4_to_bf16(const float* xrow, const float* g, bf16* orow, int lane) {
    const GAS f32x4* xr = (const GAS f32x4*)xrow + lane; const GAS f32x4* gr = (const GAS f32x4*)g + lane;
    f32x4 v[4][4];
#pragma unroll
    for (int r = 0; r < 4; ++r)
#pragma unroll
        for (int j = 0; j < 4; ++j) v[r][j] = xr[256 * r + 64 * j];
    f32x4 gg[4];
#pragma unroll
    for (int j = 0; j < 4; ++j) gg[j] = gr[64 * j];
    GAS unsigned long long* o8 = (GAS unsigned long long*)orow + lane;
#pragma unroll
    for (int r = 0; r < 4; ++r) { float s = 0.f;
#pragma unroll
        for (int j = 0; j < 4; ++j) s += (v[r][j].x * v[r][j].x + v[r][j].y * v[r][j].y) + (v[r][j].z * v[r][j].z + v[r][j].w * v[r][j].w);
        const float rs = 1.0f / sqrtf(wave_sum(s) * (1.f / DM) + EPS);
#pragma unroll
        for (int j = 0; j < 4; ++j)
            o8[256 * r + 64 * j] = (unsigned long long)pk2(v[r][j].x * rs * gg[j].x, v[r][j].y * rs * gg[j].y) | ((unsigned long long)pk2(v[r][j].z * rs * gg[j].z, v[r][j].w * rs * gg[j].w) << 32); }
}

__device__ __forceinline__ const float* in_ptr(int k) {
    typedef __attribute__((address_space(4))) const char* cptr4;
    cptr4 ka = (cptr4)__builtin_amdgcn_kernarg_segment_ptr(); cptr4 kb;
    asm volatile("s_mov_b64 %0, %1" : "=s"(kb) : "s"(ka));
    typedef const float* cfp; typedef __attribute__((address_space(4))) const cfp* cfp4;
    return *(cfp4)(kb + k * 8);
}
constexpr int NWAVES = 8;
constexpr int RING_BYTES = 131072, LDS_BYTES = 163840, LDSCTL_OFF = LDS_BYTES - 1024, MISC_OFF = LDSCTL_OFF + 320;
struct Args { const float* in[14]; float* out; unsigned char* ws; int ph_lo, ph_hi, li, pad; };
constexpr int N_PHASES = 10;

__global__ void __launch_bounds__(NWAVES * 64, 2) mk_fwd(Args args) {
    extern __shared__ __attribute__((aligned(16))) unsigned char lds_raw[];
    LAS unsigned char* lds = (LAS unsigned char*)lds_raw;
    volatile LAS unsigned* MISC = (volatile LAS unsigned*)(lds + MISC_OFF);
    const int tid = threadIdx.x, lane_k = tid & 63, wave = __builtin_amdgcn_readfirstlane(tid >> 6);
    const int G = gridDim.x, bx = blockIdx.x; const int vcu = (G % 8 == 0) ? (bx % 8) * (G / 8) + bx / 8 : bx;
    unsigned char* const ws_k = (unsigned char*)in_ptr(15);
    unsigned* ctl = (unsigned*)(ws_k + WS_CTL);
    for (int u = tid; u < (LDS_BYTES - LDSCTL_OFF) / 4; u += NWAVES * 64) ((LAS unsigned*)(lds + LDSCTL_OFF))[u] = 0u;
    __syncthreads();
    const int lo = args.ph_lo, hi = args.ph_hi;
    XcdBarrier bar; bar.bar = ctl + CW_BAR + args.li * XCD_BAR_WORDS; bar.x = 0; bar.st = nullptr;
    if (hi - lo > 1) bar = xcd_barrier_post(ctl + CW_BAR + args.li * XCD_BAR_WORDS, MISC + 8);
#define IN(k) (lo <= (k) && (k) < hi)
#define SEAM(k) do { if (IN(k) && IN((k) + 1)) xcd_barrier(bar); } while (0)

    if (IN(0)) {
        unsigned char* const ws = ws_k; int lane = lane_k; asm volatile("" : "+v"(lane));
        LAS float* scr = (LAS float*)(lds + wave * P0_SCR_BYTES);
        const int gw = vcu * NWAVES + wave, NGW = G * NWAVES;
        constexpr int I_IN = (DM / 64) * (NIN / 64), I_SQ = (DM / 64) * (DM / 64);
        for (int it = gw; it < 2 * I_IN + 6 * I_SQ; it += NGW) {
            int r = it;
            if (r < 2 * I_IN) { const int l = r / I_IN; p0_transpose_item(in_ptr(2) + (size_t)l * DM * NIN, DM, NIN, (bf16*)(ws + (l == 0 ? WS_WIN0 : WS_WIN)), scr, r % I_IN, lane); continue; } r -= 2 * I_IN;
            const int which = r / I_SQ, item = r % I_SQ, l = which / 3, w = which % 3;
            const float* src = (w == 0 ? in_ptr(4) : w == 1 ? in_ptr(12) : in_ptr(13)) + (size_t)l * DM * DM;
            bf16* dst = (bf16*)(ws + (l == 0 ? WS_WRO : WS_W1) + (size_t)w * 2 * MiB);
            p0_transpose_item(src, DM, DM, dst, scr, item, lane);
        }
        const float* x0 = in_ptr(0); const float* g0 = in_ptr(1); bf16* H = (bf16*)in_ptr(14);
        for (int m = 4 * gw; m < T; m += 4 * NGW) rms_rows4_to_bf16(x0 + (size_t)m * DM, g0, H + (size_t)m * DM, lane);
        LDS_WAIT(); __syncthreads();
    }
    SEAM(0);

#pragma unroll 1
    for (int l = 0; l < DEPTH; ++l) {
        const int pb = 1 + 5 * l;
        if (IN(pb)) {
            unsigned char* const ws = ws_k;
            Epi<0> E; E.ws = ws; E.xin = nullptr; E.xout = nullptr; E.gq = in_ptr(5) + l * 64; E.gk = in_ptr(6) + l * 64;
            SchedG1A S{l == 0 ? (const char*)in_ptr(14) : (const char*)(ws + WS_H), (const char*)(ws + (l == 0 ? WS_WIN0 : WS_WIN)), G, bx};
            pg8::gemm_phase<Epi<0>, SchedG1A, true, true>(lds, DM, S, E);
        }
        SEAM(pb);
        if (IN(pb + 1)) {
            unsigned char* const ws = ws_k;
            float s1 = 0.f, s2 = 0.f; { const float* q1 = in_ptr(7) + l * 64; const float* k1 = in_ptr(8) + l * 64; const float* q2 = in_ptr(9) + l * 64; const float* k2 = in_ptr(10) + l * 64;
                for (int i = 0; i < 64; ++i) { s1 += q1[i] * k1[i]; s2 += q2[i] * k2[i]; } }
            const float lam_init = 0.8f - 0.6f * __expf(-0.3f * (float)l), lam = __expf(s1) - __expf(s2) + lam_init;
            const float* gsub = in_ptr(11) + l * 1024;
            float gqm = 0.f, gkm = 0.f; { const float* gq = in_ptr(5) + l * 64; const float* gk = in_ptr(6) + l * 64; for (int i = 0; i < 64; ++i) { gqm = fmaxf(gqm, fabsf(gq[i])); gkm = fmaxf(gkm, fabsf(gk[i])); } }
            const float Bnd = 1.02f * 8.0f * LOG2E * gqm * gkm;
            const float* gret = in_ptr(3) + l * 1024;
            unsigned* qbase = ctl + CW_QUEUE + 512 * l;
            int lst = (int)(xb_xcc_id() & 7u), tried = 0;
            unsigned pf_raw = 0u; bool have = false;
            auto fetch = [&](unsigned& it) { it = 0xffffffffu;
                while (tried < 8) { it = __hip_atomic_fetch_add(qbase + 32 * lst, 1u, __ATOMIC_RELAXED, __HIP_MEMORY_SCOPE_AGENT); if (it < (unsigned)MIX_LIST_ITEMS) break; it = 0xffffffffu; lst = (lst + 1) & 7; ++tried; } };
            auto hook = [&]() { if (tid == 0 && tried < 8) { pf_raw = __hip_atomic_fetch_add(qbase + 32 * lst, 1u, __ATOMIC_RELAXED, __HIP_MEMORY_SCOPE_AGENT); have = true; } };
            for (;;) {
                if (tid == 0) {
                    unsigned it;
                    if (have) { have = false; it = pf_raw; if (it >= (unsigned)MIX_LIST_ITEMS) { lst = (lst + 1) & 7; ++tried; fetch(it); } } else fetch(it);
                    MISC[16] = it; MISC[17] = (unsigned)lst;
                }
                __syncthreads();
                const unsigned item = MISC[16]; const int li_ = (int)MISC[17];
                __syncthreads();
                if (item == 0xffffffffu) break;
                const int bb = li_ >> 1; const unsigned htab = (li_ & 1) ? 0x0156u : 0x2347u;
                if (item < 16u) { const int hh = (int)((htab >> (4 * (item & 3u))) & 7u), qt = 3 - (int)(item >> 2); ret::ret_unit(lds, ws, bb, hh, gret, 8 * qt, 8 * qt + 8); }
                else { const unsigned a_ = item - 16u; const int hh = (int)((htab >> (4 * (a_ >> 5))) & 7u), qb = 31 - (int)(a_ & 31u);
                    const float wf = (2.0f * Bnd + 28.0f) / (__builtin_amdgcn_exp2f(-(float)(hh + 1)) * LOG2E);
                    att::attn_unit(lds, ws, bb, hh, qb, lam, 1.0f - lam_init, gsub, wf < 8192.f ? (int)wf + 1 : 8192, hook); }
            }
        }
        SEAM(pb + 1);
        if (IN(pb + 2)) {
            unsigned char* const ws = ws_k;
            Epi<1> E; E.ws = ws; E.xin = nullptr; E.xout = nullptr; E.gq = nullptr; E.gk = nullptr;
            SchedP34 S{(const char*)ws, (const char*)(ws + (l == 0 ? WS_WRO : WS_W1)), l == 0 ? (const char*)in_ptr(14) : (const char*)(ws + WS_H), (const char*)(ws + (l == 0 ? WS_WIN0 : WS_WIN)), bx};
            pg8::gemm_phase<Epi<1>, SchedP34, true, true>(lds, DM, S, E);
        }
        SEAM(pb + 2);
        if (IN(pb + 3)) {
            unsigned char* const ws = ws_k;
            Epi<2> E; E.ws = ws; E.xin = (l == 0) ? in_ptr(0) : (const float*)in_ptr(14); E.xout = (float*)in_ptr(14); E.gq = nullptr; E.gk = nullptr;
            SchedG4 S{(const char*)(ws + WS_MBF), (const char*)(ws + (l == 0 ? WS_WRO : WS_W1) + 4 * MiB), bx};
            pg8::gemm_phase<Epi<2>, SchedG4, false, true>(lds, DM, S, E);
        }
        SEAM(pb + 3);
        if (l == 0) {
            if (IN(5)) {
                unsigned char* const ws = ws_k; int lane = lane_k; asm volatile("" : "+v"(lane));
                bf16* H = (bf16*)(ws + WS_H);
                const int gw = vcu * NWAVES + wave, NGW = G * NWAVES;
                const float* x1 = in_ptr(14); const float* g1 = in_ptr(1) + DM;
                for (int m = 4 * gw; m < T; m += 4 * NGW) rms_rows4_to_bf16(x1 + (size_t)m * DM, g1, H + (size_t)m * DM, lane);
                __syncthreads();
            }
            SEAM(5);
        }
    }
#undef IN
#undef SEAM
}

extern "C" void kernel_launch(void* const* d_in, const int* in_sizes, int n_in, void* d_out, int out_size, void* d_ws, size_t ws_size, hipStream_t stream) {
    static int ready = 0;
    if (ready == 0) {
        if (n_in != 14 || ws_size < WS_END || out_size != T * DM) { fprintf(stderr, "kernel_launch: unexpected problem (n_in %d, ws %zu, out %d)\n", n_in, ws_size, out_size); ready = -1; return; }
        if (hipFuncSetAttribute((const void*)mk_fwd, hipFuncAttributeMaxDynamicSharedMemorySize, LDS_BYTES) != hipSuccess) { fprintf(stderr, "kernel_launch: hipFuncSetAttribute failed\n"); ready = -1; return; }
        ready = 1;
    }
    if (ready < 0) return;
    (void)hipMemsetAsync((char*)d_ws + WS_CTL, 0, CTL_ZERO_BYTES, stream);
    Args a{};
    for (int i = 0; i < 14; ++i) a.in[i] = (const float*)d_in[i];
    a.out = (float*)d_out; a.ws = (unsigned char*)d_ws;
    a.ph_lo = 0; a.ph_hi = N_PHASES; a.li = 0;
    hipLaunchKernelGGL(mk_fwd, dim3(256), dim3(NWAVES * 64), LDS_BYTES, stream, a);
}
```
